# Optimizing an MI355X kernel written in HIP

```python
import jax
import jax.numpy as jnp
from jax import lax
import numpy as np

D_MODEL = 1024
BATCH = 1
SEQ = 16384
DEPTH = 2

GRID_W = 64
CTX_LEN = 256
N_MOD = 6
EPS = 1e-6
NEG = -1e30

CONV_CH = 256
CONV_W = 3
DN_HEADS = 6
DN_HEAD_DIM = 64
DN_DIM = DN_HEADS * DN_HEAD_DIM
DN_CONV_W = 3
DN_CHUNK = 64
ATT_HEADS = 6
ATT_KV_HEADS = 2
ATT_GROUP = ATT_HEADS // ATT_KV_HEADS
HEAD_DIM = 64
ATT_DIM = ATT_HEADS * HEAD_DIM
ATT_KV_DIM = ATT_KV_HEADS * HEAD_DIM
WINDOW = 128
ATT_BLOCK = 128
ROPE_BASE = 10000.0
AXIS_DIM = HEAD_DIM // 2

MIX_DIM = CONV_CH + DN_DIM + ATT_DIM
IN_SPLITS = (CONV_CH, CONV_CH, CONV_CH, 3 * DN_DIM, DN_DIM, 2 * DN_HEADS, 2 * DN_HEADS, ATT_DIM, ATT_KV_DIM, ATT_KV_DIM)
IN_COLS = 3 * CONV_CH + 4 * DN_DIM + 4 * DN_HEADS + ATT_DIM + 2 * ATT_KV_DIM

D_FF = 2816
N_EXPERTS = 8
TOP_K = 2
D_FF_EXPERT = 3584
MOE_BLOCK = 128
N_DENSE = (DEPTH + 1) // 2
N_MOE = DEPTH // 2

kernel_name = 'hybrid_conv_deltanet_swa_moe_dit'

F32 = jnp.float32


def rmsnorm(x, g=None):
    xf = x.astype(F32)
    y = xf * lax.rsqrt(jnp.mean(xf * xf, axis=-1, keepdims=True) + EPS)
    if g is not None:
        y = y * g.astype(F32)
    return y.astype(x.dtype)


def modulate(h, shift, scale):
    return h * (1 + scale) + shift


def l2norm(t):
    return t * lax.rsqrt(jnp.sum(t * t, axis=-1, keepdims=True) + 1e-6)


def split_proj(p):
    idx, acc = [], 0
    for s in IN_SPLITS[:-1]:
        acc += s
        idx.append(acc)
    return jnp.split(p, idx, axis=-1)


def dwconv_centred(u, w):
    k = w.shape[0]
    return lax.conv_general_dilated(u, w[:, None, :].astype(u.dtype), window_strides=(1,),
                                    padding=[(k // 2, k // 2)], dimension_numbers=('NWC', 'WIO', 'NWC'),
                                    feature_group_count=u.shape[-1])


def axial_rope_tables(n):
    rows = n // GRID_W
    r = jnp.broadcast_to(jnp.arange(rows, dtype=F32)[:, None], (rows, GRID_W)).reshape(n)
    col = jnp.broadcast_to(jnp.arange(GRID_W, dtype=F32)[None, :], (rows, GRID_W)).reshape(n)
    inv = ROPE_BASE ** (-jnp.arange(0, AXIS_DIM, 2, dtype=F32) / AXIS_DIM)
    ang = jnp.stack([r[:, None] * inv, col[:, None] * inv], axis=1)
    return jnp.cos(ang), jnp.sin(ang)


def apply_axial_rope(x, cos, sin):
    b, n, h, d = x.shape
    xr = x.astype(F32).reshape(b, n, h, 2, 2, AXIS_DIM // 2)
    x1, x2 = xr[..., 0, :], xr[..., 1, :]
    cs, sn = cos[None, :, None], sin[None, :, None]
    out = jnp.stack([x1 * cs - x2 * sn, x2 * cs + x1 * sn], axis=-2)
    return out.reshape(b, n, h, d).astype(x.dtype)


def window_attention(q, k, v, kc, vc, sink):
    b, n = q.shape[:2]
    nb = n // ATT_BLOCK
    qb = q.astype(F32).reshape(b, nb, ATT_BLOCK, ATT_KV_HEADS, ATT_GROUP, HEAD_DIM) * HEAD_DIM ** -0.5

    def band(t):
        tp = jnp.pad(t.astype(F32), ((0, 0), (ATT_BLOCK, ATT_BLOCK), (0, 0), (0, 0)))
        tp = tp.reshape(b, nb + 2, ATT_BLOCK, ATT_KV_HEADS, HEAD_DIM)
        return jnp.concatenate([tp[:, :-2], tp[:, 1:-1], tp[:, 2:]], axis=2)

    kw, vw = band(k), band(v)
    s_loc = jnp.einsum('bnqhgd,bnkhd->bnhgqk', qb, kw)
    qpos = jnp.arange(nb)[:, None] * ATT_BLOCK + jnp.arange(ATT_BLOCK)[None]
    kpos = (jnp.arange(nb)[:, None] - 1) * ATT_BLOCK + jnp.arange(3 * ATT_BLOCK)[None]
    valid = ((jnp.abs(qpos[:, :, None] - kpos[:, None, :]) <= WINDOW)
             & (kpos[:, None, :] >= 0) & (kpos[:, None, :] < n))
    s_loc = jnp.where(valid[None, :, None, None], s_loc, NEG)
    s_ctx = jnp.einsum('bnqhgd,blhd->bnhgql', qb, kc.astype(F32))
    s_sink = sink.astype(F32).reshape(1, 1, ATT_KV_HEADS, ATT_GROUP, 1, 1)
    m = jnp.maximum(jnp.maximum(s_loc.max(-1, keepdims=True), s_ctx.max(-1, keepdims=True)), s_sink)
    p_loc = jnp.exp(s_loc - m)
    p_ctx = jnp.exp(s_ctx - m)
    denom = p_loc.sum(-1, keepdims=True) + p_ctx.sum(-1, keepdims=True) + jnp.exp(s_sink - m)
    o = (jnp.einsum('bnhgqk,bnkhd->bnhgqd', p_loc, vw)
         + jnp.einsum('bnhgql,blhd->bnhgqd', p_ctx, vc.astype(F32))) / denom
    return o.transpose(0, 1, 4, 2, 3, 5).reshape(b, n, ATT_DIM).astype(q.dtype)


def context_attention(q, k, v, sink):
    b, l = q.shape[:2]
    qg = q.astype(F32).reshape(b, l, ATT_KV_HEADS, ATT_GROUP, HEAD_DIM) * HEAD_DIM ** -0.5
    s = jnp.einsum('blhgd,bmhd->bhglm', qg, k.astype(F32))
    s_sink = jnp.broadcast_to(sink.astype(F32).reshape(1, ATT_KV_HEADS, ATT_GROUP, 1, 1), s.shape[:-1] + (1,))
    p = jax.nn.softmax(jnp.concatenate([s, s_sink], axis=-1), axis=-1)[..., :-1]
    o = jnp.einsum('bhglm,bmhd->blhgd', p, v.astype(F32))
    return o.reshape(b, l, ATT_DIM).astype(q.dtype)


def delta_prep(qkv, a, bt, conv_w, a_log, dt_bias):
    b, n, _ = qkv.shape
    qkv = jax.nn.silu(dwconv_centred(qkv, conv_w)).astype(F32).reshape(b, n, 3, DN_HEADS, DN_HEAD_DIM)
    q = l2norm(qkv[:, :, 0]) * DN_HEAD_DIM ** -0.5
    k = l2norm(qkv[:, :, 1])
    v = qkv[:, :, 2]
    a = a.astype(F32).reshape(b, n, 2, DN_HEADS)
    g = -jnp.exp(a_log.astype(F32)) * jax.nn.softplus(a + dt_bias.astype(F32))
    beta = jax.nn.sigmoid(bt.astype(F32).reshape(b, n, 2, DN_HEADS))
    return q, k, v, g, beta


def gated_delta_chunked(q, k, v, g, beta, s0):
    b, n, h, _ = q.shape
    dv = v.shape[-1]
    nc = n // DN_CHUNK

    def chunks(t):
        t = t.reshape((b, nc, DN_CHUNK, h) + t.shape[3:])
        return jnp.moveaxis(t, 3, 1)

    q, k, v, g, beta = (chunks(t) for t in (q, k, v, g, beta))
    gcum = jnp.cumsum(g, axis=-1)
    incl = jnp.tril(jnp.ones((DN_CHUNK, DN_CHUNK), bool))
    strict = jnp.tril(jnp.ones((DN_CHUNK, DN_CHUNK), bool), -1)
    diff = gcum[..., :, None] - gcum[..., None, :]
    decay = jnp.where(incl, jnp.exp(jnp.where(incl, diff, 0.0)), 0.0)
    kb = k * beta[..., None]
    a_mat = jnp.where(strict, jnp.einsum('bhcid,bhcjd->bhcij', kb, k) * decay, 0.0)
    lmat = a_mat + jnp.eye(DN_CHUNK, dtype=F32)
    rhs = jnp.concatenate([v * beta[..., None], kb * jnp.exp(gcum)[..., None]], axis=-1)
    sol = lax.linalg.triangular_solve(lmat, rhs, left_side=True, lower=True, unit_diagonal=True)
    u, w = sol[..., :dv], sol[..., dv:]
    qk = jnp.where(incl, jnp.einsum('bhcid,bhcjd->bhcij', q, k) * decay, 0.0)
    qg = q * jnp.exp(gcum)[..., None]
    kd = k * jnp.exp(gcum[..., -1:] - gcum)[..., None]
    gl = jnp.exp(gcum[..., -1])
    xs = tuple(jnp.moveaxis(t, 2, 0) for t in (qg, qk, u, w, kd, gl))

    def step(s, inp):
        qg_c, qk_c, u_c, w_c, kd_c, gl_c = inp
        v_new = u_c - jnp.einsum('bhik,bhkv->bhiv', w_c, s)
        o = jnp.einsum('bhik,bhkv->bhiv', qg_c, s) + jnp.einsum('bhij,bhjv->bhiv', qk_c, v_new)
        s = s * gl_c[..., None, None] + jnp.einsum('bhik,bhiv->bhkv', kd_c, v_new)
        return s, o

    s_fin, o = lax.scan(step, s0, xs)
    return o.transpose(1, 0, 3, 2, 4).reshape(b, n, h, dv), s_fin


def gated_delta_bidir(ctx_t, lat_t, need_ctx):
    qc, kc, vc, gc, bc = ctx_t
    qx, kx, vx, gx, bx = lat_t
    b = qx.shape[0]
    outs_x, outs_c = [], []
    for d in range(2):
        rev = (lambda t: jnp.flip(t, axis=1)) if d == 1 else (lambda t: t)
        s0 = jnp.zeros((b, DN_HEADS, DN_HEAD_DIM, DN_HEAD_DIM), F32)
        oc, s_ctx = gated_delta_chunked(rev(qc), rev(kc), rev(vc), rev(gc[:, :, d]), rev(bc[:, :, d]), s0)
        ox, _ = gated_delta_chunked(rev(qx), rev(kx), rev(vx), rev(gx[:, :, d]), rev(bx[:, :, d]), s_ctx)
        outs_x.append(rev(ox))
        outs_c.append(rev(oc))
    o_x = outs_x[0] + outs_x[1]
    o_c = outs_c[0] + outs_c[1] if need_ctx else None
    return o_x, o_c


def delta_output(o, z, norm_g):
    b, n = z.shape[:2]
    zf = z.astype(F32).reshape(b, n, DN_HEADS, DN_HEAD_DIM)
    y = rmsnorm(o, norm_g) * jax.nn.silu(zf)
    return y.reshape(b, n, DN_DIM).astype(z.dtype)


def token_mixers(px, pc, conv_w, dn_conv_w, dn_a_log, dn_dt_bias, dn_norm_g, sink, cos, sin, need_ctx):
    b, n, _ = px.shape
    l = pc.shape[1]
    xb_, xc_, xh_, xqkv, xz, xa, xbt, xq, xk, xv = split_proj(px)
    cb_, cc_, ch_, cqkv, cz, ca, cbt, cq, ck, cv = split_proj(pc)
    ya_x = xb_ * dwconv_centred(xc_ * xh_, conv_w)
    dx = delta_prep(xqkv, xa, xbt, dn_conv_w, dn_a_log, dn_dt_bias)
    dc = delta_prep(cqkv, ca, cbt, dn_conv_w, dn_a_log, dn_dt_bias)
    ob_x, ob_c = gated_delta_bidir(dc, dx, need_ctx)
    yb_x = delta_output(ob_x, xz, dn_norm_g)
    qx = apply_axial_rope(xq.reshape(b, n, ATT_HEADS, HEAD_DIM), cos, sin)
    kx = apply_axial_rope(xk.reshape(b, n, ATT_KV_HEADS, HEAD_DIM), cos, sin)
    vx = xv.reshape(b, n, ATT_KV_HEADS, HEAD_DIM)
    kc = ck.reshape(b, l, ATT_KV_HEADS, HEAD_DIM)
    vc = cv.reshape(b, l, ATT_KV_HEADS, HEAD_DIM)
    yc_x = window_attention(qx, kx, vx, kc, vc, sink)
    o_x = jnp.concatenate([ya_x, yb_x, yc_x], axis=-1)
    if not need_ctx:
        return o_x, None
    ya_c = cb_ * dwconv_centred(cc_ * ch_, conv_w)
    yb_c = delta_output(ob_c, cz, dn_norm_g)
    yc_c = context_attention(cq.reshape(b, l, ATT_HEADS, HEAD_DIM), kc, vc, sink)
    o_c = jnp.concatenate([ya_c, yb_c, yc_c], axis=-1)
    return o_x, o_c


def swiglu(h, w_gate, w_up, w_down):
    return (jax.nn.silu(h @ w_gate) * (h @ w_up)) @ w_down


def moe_swiglu(h, w_router, w_gate, w_up, w_down):
    t, d = h.shape
    logits = h.astype(F32) @ w_router.astype(F32)
    top_logit, top_e = lax.top_k(logits, TOP_K)
    gates = jax.nn.softmax(top_logit, axis=-1)
    a = t * TOP_K
    flat_e = top_e.reshape(a)
    flat_tok = jnp.arange(a, dtype=jnp.int32) // TOP_K
    flat_g = gates.reshape(a)
    order = jnp.argsort(flat_e)
    e_sorted = flat_e[order]
    counts = jnp.zeros((N_EXPERTS,), jnp.int32).at[flat_e].add(1)
    starts = jnp.cumsum(counts) - counts
    padded = (counts + MOE_BLOCK - 1) // MOE_BLOCK * MOE_BLOCK
    pad_ends = jnp.cumsum(padded)
    pad_starts = pad_ends - padded
    dest = pad_starts[e_sorted] + jnp.arange(a, dtype=jnp.int32) - starts[e_sorted]
    cap = -(-a // MOE_BLOCK) * MOE_BLOCK + N_EXPERTS * MOE_BLOCK
    n_blk = cap // MOE_BLOCK
    row_tok = jnp.zeros((cap,), jnp.int32).at[dest].set(flat_tok[order])
    row_gate = jnp.zeros((cap,), h.dtype).at[dest].set(flat_g[order].astype(h.dtype))
    blk_e = jnp.minimum(jnp.searchsorted(pad_ends, jnp.arange(n_blk, dtype=jnp.int32) * MOE_BLOCK, side='right'),
                        N_EXPERTS - 1)
    xb = h[row_tok].reshape(n_blk, MOE_BLOCK, d)

    def block_ffn(args):
        xblk, e = args
        return swiglu(xblk, w_gate[e], w_up[e], w_down[e])

    yb = lax.map(block_ffn, (xb, blk_e))
    return jax.ops.segment_sum(yb.reshape(cap, d) * row_gate[:, None], row_tok, num_segments=t)


def channel_mixer(h, layer, ffn_w_gate, ffn_w_up, ffn_w_down, moe_router, moe_w_gate, moe_w_up, moe_w_down):
    i = layer // 2
    if layer % 2 == 0:
        return swiglu(h, ffn_w_gate[i], ffn_w_up[i], ffn_w_down[i])
    return moe_swiglu(h, moe_router[i], moe_w_gate[i], moe_w_up[i], moe_w_down[i])


def setup_inputs(seed: int = 0) -> dict:
    key = jax.random.key(seed)
    ks = jax.random.split(key, 24)

    def nrm(k, shape, scale):
        return jax.random.normal(k, shape, F32) * scale

    dt = jnp.exp(jax.random.uniform(ks[11], (DEPTH, 2, DN_HEADS), F32, jnp.log(1e-3), jnp.log(1e-1)))
    return {
        'x': nrm(ks[0], (BATCH, SEQ, D_MODEL), 1.0),
        'c': nrm(ks[1], (BATCH, D_MODEL), 1.0),
        'ctx': nrm(ks[2], (BATCH, CTX_LEN, D_MODEL), 1.0),
        'c_ctx': nrm(ks[3], (D_MODEL,), 1.0),
        'w_mod': nrm(ks[4], (DEPTH, D_MODEL, N_MOD * D_MODEL), 0.5 * D_MODEL ** -0.5),
        'b_mod': nrm(ks[5], (DEPTH, N_MOD * D_MODEL), 0.02),
        'w_in': nrm(ks[6], (DEPTH, D_MODEL, IN_COLS), D_MODEL ** -0.5),
        'w_out': nrm(ks[7], (DEPTH, MIX_DIM, D_MODEL), MIX_DIM ** -0.5),
        'conv_w': nrm(ks[8], (DEPTH, CONV_W, CONV_CH), CONV_W ** -0.5),
        'dn_conv_w': nrm(ks[9], (DEPTH, DN_CONV_W, 3 * DN_DIM), DN_CONV_W ** -0.5),
        'dn_a_log': jnp.log(jax.random.uniform(ks[10], (DEPTH, 2, DN_HEADS), F32, 1.0, 16.0)),
        'dn_dt_bias': dt + jnp.log(-jnp.expm1(-dt)),
        'dn_norm_g': 1.0 + nrm(ks[12], (DEPTH, DN_HEAD_DIM), 0.02),
        'attn_sink': nrm(ks[13], (DEPTH, ATT_HEADS), 0.5),
        'ffn_w_gate': nrm(ks[14], (N_DENSE, D_MODEL, D_FF), D_MODEL ** -0.5),
        'ffn_w_up': nrm(ks[15], (N_DENSE, D_MODEL, D_FF), D_MODEL ** -0.5),
        'ffn_w_down': nrm(ks[16], (N_DENSE, D_FF, D_MODEL), D_FF ** -0.5),
        'moe_router': nrm(ks[17], (N_MOE, D_MODEL, N_EXPERTS), D_MODEL ** -0.5),
        'moe_w_gate': nrm(ks[18], (N_MOE, N_EXPERTS, D_MODEL, D_FF_EXPERT), D_MODEL ** -0.5),
        'moe_w_up': nrm(ks[19], (N_MOE, N_EXPERTS, D_MODEL, D_FF_EXPERT), D_MODEL ** -0.5),
        'moe_w_down': nrm(ks[20], (N_MOE, N_EXPERTS, D_FF_EXPERT, D_MODEL), D_FF_EXPERT ** -0.5),
        'final_norm_g': 1.0 + nrm(ks[21], (D_MODEL,), 0.02),
    }


def reference(x, c, ctx, c_ctx, w_mod, b_mod, w_in, w_out, conv_w, dn_conv_w, dn_a_log, dn_dt_bias, dn_norm_g,
              attn_sink, ffn_w_gate, ffn_w_up, ffn_w_down, moe_router, moe_w_gate, moe_w_up, moe_w_down,
              final_norm_g):
    b, n, d = x.shape
    ctx_len = ctx.shape[1]
    cos, sin = axial_rope_tables(n)
    s_c = jax.nn.silu(c)
    s_cc = jax.nn.silu(c_ctx)
    hc = ctx
    for layer in range(DEPTH):
        need_ctx = layer < DEPTH - 1
        mod_x = (s_c @ w_mod[layer] + b_mod[layer]).reshape(b, N_MOD, 1, d)
        mod_c = (s_cc @ w_mod[layer] + b_mod[layer]).reshape(N_MOD, d)
        px = modulate(rmsnorm(x), mod_x[:, 0], mod_x[:, 1]) @ w_in[layer]
        pc = modulate(rmsnorm(hc), mod_c[0], mod_c[1]) @ w_in[layer]
        o_x, o_c = token_mixers(px, pc, conv_w[layer], dn_conv_w[layer], dn_a_log[layer], dn_dt_bias[layer],
                                dn_norm_g[layer], attn_sink[layer], cos, sin, need_ctx)
        x = x + mod_x[:, 2] * (o_x @ w_out[layer])
        hx = modulate(rmsnorm(x), mod_x[:, 3], mod_x[:, 4])
        if need_ctx:
            hc = hc + mod_c[2] * (o_c @ w_out[layer])
            hcc = modulate(rmsnorm(hc), mod_c[3], mod_c[4])
            tokens = jnp.concatenate([hcc.reshape(-1, d), hx.reshape(-1, d)], axis=0)
        else:
            tokens = hx.reshape(-1, d)
        f = channel_mixer(tokens, layer, ffn_w_gate, ffn_w_up, ffn_w_down, moe_router, moe_w_gate, moe_w_up,
                          moe_w_down)
        if need_ctx:
            hc = hc + mod_c[5] * f[:b * ctx_len].reshape(b, ctx_len, d)
            f = f[b * ctx_len:]
        x = x + mod_x[:, 5] * f.reshape(b, n, d)
    return rmsnorm(x, final_norm_g)
```

```cpp
#define STOP_AFTER 0
#include <hip/hip_runtime.h>
#include <cstdint>
#include <cstdio>

#define GAS __attribute__((address_space(1)))
#define LAS __attribute__((address_space(3)))
typedef unsigned short bf16_t;
typedef short bf16x8 __attribute__((ext_vector_type(8)));
typedef short bf16x4 __attribute__((ext_vector_type(4)));
typedef float f32x4 __attribute__((ext_vector_type(4)));
typedef float f32x2 __attribute__((ext_vector_type(2)));
typedef unsigned u32x4 __attribute__((ext_vector_type(4)));
typedef unsigned u32x2 __attribute__((ext_vector_type(2)));
typedef GAS unsigned gu32;

constexpr int D = 1024, NL = 16384, NC = 256, NT = NL + NC;
constexpr int INC = 2968, INP = 3072;
constexpr int C_CB = 0, C_CC = 256, C_CH = 512, C_DQ = 768, C_DK = 1152, C_DV = 1536, C_DZ = 1920, C_DA = 2304, C_DB = 2316, C_AQ = 2328, C_AK = 2712, C_AV = 2840;
constexpr int DFF = 2816, NEXP = 8, DFE = 3584;
constexpr int NWAVES = 8, NTHREADS = 512;
constexpr float EPS = 1e-6f;

constexpr size_t MiB = 1u << 20;
constexpr size_t WS_CTL = 0, CTL_ZERO_BYTES = 1 * MiB;
constexpr size_t WS_MOD = 1 * MiB;
constexpr size_t WS_ROPE = 1 * MiB + 128 * 1024;
constexpr size_t WS_HC = 2 * MiB;
constexpr size_t WS_G = 3 * MiB;
constexpr size_t WS_BETA = 4 * MiB;
constexpr size_t WS_ROUTE = 5 * MiB;
constexpr size_t WS_WIN = 8 * MiB;
constexpr size_t WS_WOUT = 20 * MiB;
constexpr size_t WS_WGU = 24 * MiB;
constexpr size_t WS_WDN = 35 * MiB;
constexpr size_t WS_MGU = 41 * MiB;
constexpr size_t WS_MDN = 153 * MiB;
constexpr size_t WS_ACT = 209 * MiB;
constexpr size_t WS_BIG = 242 * MiB;
constexpr size_t WS_PX = WS_BIG;
constexpr size_t WS_QD = 340 * MiB;
constexpr size_t QKV_STRIDE = 12 * MiB + 512 * 1024;
constexpr size_t WS_DN = 378 * MiB;
constexpr size_t DN_STRIDE = 25 * MiB;
constexpr size_t WS_END = 512 * MiB;
static_assert(WS_QD + 3 * QKV_STRIDE <= WS_DN && WS_DN + 5 * DN_STRIDE <= WS_END, "ws map");
static_assert((size_t)NT * INP * 2 <= WS_QD - WS_PX && (size_t)NT * 384 * 2 <= QKV_STRIDE && (size_t)3120 * 8192 <= DN_STRIDE, "ws map 2");

constexpr int SCR_BYTES = 139264;
constexpr int MISC_OFF = SCR_BYTES;
constexpr int LDS_BYTES = 147456;

#define RLX_AGENT __ATOMIC_RELAXED, __HIP_MEMORY_SCOPE_AGENT
#define LDS_WAIT() asm volatile("s_waitcnt lgkmcnt(0)" ::: "memory")
#define VM_WAIT() asm volatile("s_waitcnt vmcnt(0)" ::: "memory")

__device__ __forceinline__ unsigned f2bf(float f) { unsigned u = __builtin_bit_cast(unsigned, f); return (u + 0x7fffu + ((u >> 16) & 1u)) >> 16; }
__device__ __forceinline__ unsigned pk2(float lo, float hi) { return f2bf(lo) | (f2bf(hi) << 16); }
__device__ __forceinline__ float bf2f(unsigned h) { return __builtin_bit_cast(float, h << 16); }
__device__ __forceinline__ float silu_f(float x) { return x / (1.f + __expf(-x)); }
__device__ __forceinline__ int opq(int v) { asm volatile("" : "+v"(v)); return v; }
__device__ __forceinline__ float wave_sum(float v) {
#pragma unroll
    for (int o = 1; o < 64; o <<= 1) v += __shfl_xor(v, o);
    return v;
}

#define XB_TMO      128
#define XB_XCNT(j)  (256  + 64 * (j))
#define XB_XSUB(j)  (1280 + 64 * (j))
#define XB_XGEN(j)  (2304 + 64 * (j))
#define XB_TOP      3328
#define XB_TOPGEN   3392
#define XCD_BAR_WORDS 3456
#define XB_SPIN_CAP (1u << 22)
__device__ __forceinline__ unsigned xb_ld(unsigned* p)              { return __hip_atomic_load(p, __ATOMIC_RELAXED, __HIP_MEMORY_SCOPE_AGENT); }
__device__ __forceinline__ unsigned xb_add(unsigned* p, unsigned v) { return __hip_atomic_fetch_add(p, v, __ATOMIC_RELAXED, __HIP_MEMORY_SCOPE_AGENT); }
__device__ __forceinline__ unsigned xb_xcc_id() { return (unsigned)__builtin_amdgcn_s_getreg((3 << 11) | 20) & 0xFu; }
#define XB_SPIN(cond, bar) do { unsigned _sp = 0; while (cond) { __builtin_amdgcn_s_sleep(1); \
    if ((++_sp & 255u) == 0u) { if (xb_ld(&(bar)[XB_TMO])) break; if (_sp > XB_SPIN_CAP) { atomicAdd(&(bar)[XB_TMO], 1u); break; } } } } while (0)
struct XcdBarrier { unsigned* bar; unsigned x; volatile LAS unsigned* st; };
__device__ __forceinline__ XcdBarrier xcd_barrier_post(unsigned* bar, volatile LAS unsigned* st) {
    XcdBarrier b; b.bar = bar; b.x = xb_xcc_id(); b.st = st;
    if (threadIdx.x == 0) (void)xb_add(&bar[XB_XCNT(b.x)], 1u);
    return b;
}
__device__ __forceinline__ void xcd_barrier_complete(unsigned* bar, unsigned x, unsigned& nloc, unsigned& nx) {
    const unsigned G = gridDim.x * gridDim.y * gridDim.z;
    unsigned sum, cnt, mine, sp = 0u;
    for (;;) {
        sum = 0u; cnt = 0u; mine = 0u;
#pragma unroll
        for (unsigned j = 0; j < 16; ++j) { const unsigned c = xb_ld(&bar[XB_XCNT(j)]); sum += c; cnt += (c > 0u) ? 1u : 0u; mine = (j == x) ? c : mine; }
        if (sum == G) break;
        __builtin_amdgcn_s_sleep(1);
        if ((++sp & 255u) == 0u) { if (xb_ld(&bar[XB_TMO])) break; if (sp > XB_SPIN_CAP) { atomicAdd(&bar[XB_TMO], 1u); break; } }
    }
    nloc = mine > 0u ? mine : 1u; nx = cnt > 0u ? cnt : 1u;
}
__device__ __forceinline__ void xcd_barrier(const XcdBarrier& b) {
    asm volatile("s_waitcnt vmcnt(0)" ::: "memory");
    __syncthreads();
    if (threadIdx.x == 0) {
        unsigned* bar = b.bar;
        __builtin_amdgcn_s_waitcnt(0);
        unsigned nloc = b.st[0], nx = b.st[1];
        if (nloc == 0u) { xcd_barrier_complete(bar, b.x, nloc, nx); b.st[0] = nloc; b.st[1] = nx; }
        const unsigned old = xb_add(&bar[XB_XSUB(b.x)], 1u);
        const unsigned gen = old / nloc;
        if (old + 1u == (gen + 1u) * nloc) {
            __builtin_amdgcn_fence(__ATOMIC_RELEASE, "agent");
            asm volatile("s_waitcnt vmcnt(0)" ::: "memory");
            const unsigned og = xb_add(&bar[XB_TOP], 1u);
            const unsigned tg = og / nx;
            if (og + 1u == (tg + 1u) * nx) xb_add(&bar[XB_TOPGEN], 1u);
            else XB_SPIN(xb_ld(&bar[XB_TOPGEN]) == tg, bar);
            __builtin_amdgcn_fence(__ATOMIC_ACQUIRE, "agent");
            xb_add(&bar[XB_XGEN(b.x)], 1u);
            asm volatile("s_waitcnt vmcnt(0)" ::: "memory");
        } else {
            XB_SPIN(xb_ld(&bar[XB_XGEN(b.x)]) == gen, bar);
            __builtin_amdgcn_fence(__ATOMIC_ACQUIRE, "agent");
            asm volatile("s_waitcnt vmcnt(0)" ::: "memory");
        }
    }
    __syncthreads();
}

struct Args { const float* in[22]; float* out; unsigned char* ws; };
enum { I_X = 0, I_C, I_CTX, I_CCTX, I_WMOD, I_BMOD, I_WIN, I_WOUT, I_CONVW, I_DNCONVW, I_ALOG, I_DTB, I_NORMG, I_SINK, I_FG, I_FU, I_FD, I_ROUTER, I_MG, I_MU, I_MD, I_FNG };
struct Frame {
    LAS unsigned char* lds;
    int tid, lane, wave, vcu, G, gw, NGW;
    unsigned char* ws;
};

__device__ __forceinline__ void transpose_item(const float* __restrict__ W, int K, int N, bf16_t* WT, int mode, LAS float* scr, int kb, int nb, int lane) {
    const int k0 = 64 * kb, n0 = 64 * nb;
    const int nn = n0 + lane; const bool ok = nn < N;
    const float* src = W + (size_t)k0 * N + (ok ? nn : 0);
#pragma unroll 8
    for (int i = 0; i < 64; ++i) { float v = src[(size_t)i * N]; scr[i * 65 + lane] = ok ? v : 0.f; }
    LDS_WAIT(); asm volatile("" ::: "memory");
    const int c = lane & 7;
#pragma unroll
    for (int j = 0; j < 8; ++j) {
        const int n = (lane >> 3) + 8 * j; const LAS float* s = scr + (8 * c) * 65 + n;
        u32x4 o; o.x = pk2(s[0 * 65], s[1 * 65]); o.y = pk2(s[2 * 65], s[3 * 65]); o.z = pk2(s[4 * 65], s[5 * 65]); o.w = pk2(s[6 * 65], s[7 * 65]);
        const int ng = n0 + n; int drow = ng;
        if (mode == 1) drow = (ng >> 2) * 8 + (ng & 3); else if (mode == 2) drow = (ng >> 2) * 8 + 4 + (ng & 3);
        *(GAS u32x4*)(WT + (size_t)drow * K + k0 + 8 * c) = o;
    }
    LDS_WAIT(); asm volatile("" ::: "memory");
}

__device__ __forceinline__ void p0_prologue(Frame& F, const Args& A) {
    if (blockIdx.x < 192) {
        LAS float* sc = (LAS float*)F.lds;
        for (int i = F.tid; i < 1024; i += NTHREADS) { sc[i] = silu_f(A.in[I_C][i]); sc[1024 + i] = silu_f(A.in[I_CCTX][i]); }
        __syncthreads();
        const int l = blockIdx.x / 96, cg = blockIdx.x % 96;
        const float* W = A.in[I_WMOD] + (size_t)l * 1024 * 6144 + cg * 64 + F.lane;
        float ax = 0.f, ac = 0.f;
        const int kb = F.wave * 128;
#pragma unroll 8
        for (int k = 0; k < 128; ++k) { const float wv = W[(size_t)(kb + k) * 6144]; ax += sc[kb + k] * wv; ac += sc[1024 + kb + k] * wv; }
        LAS float* red = sc + 2048;
        red[F.wave * 64 + F.lane] = ax; red[512 + F.wave * 64 + F.lane] = ac;
        __syncthreads();
        if (F.wave == 0) {
            float sx = 0.f, sc2 = 0.f;
#pragma unroll
            for (int w = 0; w < 8; ++w) { sx += red[w * 64 + F.lane]; sc2 += red[512 + w * 64 + F.lane]; }
            const float b = A.in[I_BMOD][l * 6144 + cg * 64 + F.lane];
            float* mod = (float*)(F.ws + WS_MOD);
            mod[(l * 2 + 0) * 6144 + cg * 64 + F.lane] = sx + b;
            mod[(l * 2 + 1) * 6144 + cg * 64 + F.lane] = sc2 + b;
        }
        __syncthreads();
    } else if (blockIdx.x == 192) {
        float* rope = (float*)(F.ws + WS_ROPE);
        for (int i = F.tid; i < 256 * 16; i += NTHREADS) {
            const int pos = i >> 4, f = i & 15;
            const float inv = powf(10000.0f, -(float)(2 * f) / 32.0f);
            const float ang = (float)pos * inv;
            rope[2 * i] = cosf(ang); rope[2 * i + 1] = sinf(ang);
        }
    }
    LAS float* scr = (LAS float*)(F.lds + F.wave * 16640);
    constexpr int N_WIN = 2 * 16 * 48, N_WOUT = 2 * 16 * 16, N_FG = 16 * 44, N_FD = 44 * 16, N_MG = 8 * 16 * 56, N_MD = 8 * 56 * 16;
    constexpr int NITEMS = N_WIN + N_WOUT + 2 * N_FG + N_FD + 2 * N_MG + N_MD;
    bf16_t* ws16 = (bf16_t*)F.ws;
    for (int it = F.gw; it < NITEMS; it += F.NGW) {
        int r = it;
        if (r < N_WIN) { const int l = r / (16 * 48), q = r % (16 * 48); transpose_item(A.in[I_WIN] + (size_t)l * 1024 * INC, 1024, INC, (bf16_t*)(F.ws + WS_WIN) + (size_t)l * INP * 1024, 0, scr, q / 48, q % 48, F.lane); continue; } r -= N_WIN;
        if (r < N_WOUT) { const int l = r / 256, q = r % 256; transpose_item(A.in[I_WOUT] + (size_t)l * 1024 * 1024, 1024, 1024, (bf16_t*)(F.ws + WS_WOUT) + (size_t)l * 1024 * 1024, 0, scr, q / 16, q % 16, F.lane); continue; } r -= N_WOUT;
        if (r < N_FG) { transpose_item(A.in[I_FG], 1024, DFF, (bf16_t*)(F.ws + WS_WGU), 1, scr, r / 44, r % 44, F.lane); continue; } r -= N_FG;
        if (r < N_FG) { transpose_item(A.in[I_FU], 1024, DFF, (bf16_t*)(F.ws + WS_WGU), 2, scr, r / 44, r % 44, F.lane); continue; } r -= N_FG;
        if (r < N_FD) { transpose_item(A.in[I_FD], DFF, 1024, (bf16_t*)(F.ws + WS_WDN), 0, scr, r / 16, r % 16, F.lane); continue; } r -= N_FD;
        if (r < N_MG) { const int e = r / (16 * 56), q = r % (16 * 56); transpose_item(A.in[I_MG] + (size_t)e * 1024 * DFE, 1024, DFE, (bf16_t*)(F.ws + WS_MGU) + (size_t)e * 2 * DFE * 1024, 1, scr, q / 56, q % 56, F.lane); continue; } r -= N_MG;
        if (r < N_MG) { const int e = r / (16 * 56), q = r % (16 * 56); transpose_item(A.in[I_MU] + (size_t)e * 1024 * DFE, 1024, DFE, (bf16_t*)(F.ws + WS_MGU) + (size_t)e * 2 * DFE * 1024, 2, scr, q / 56, q % 56, F.lane); continue; } r -= N_MG;
        { const int e = r / (56 * 16), q = r % (56 * 16); transpose_item(A.in[I_MD] + (size_t)e * DFE * 1024, DFE, 1024, (bf16_t*)(F.ws + WS_MDN) + (size_t)e * 1024 * DFE, 0, scr, q / 16, q % 16, F.lane); }
    }
    (void)ws16;
}

__device__ __forceinline__ void norm_mod_row(const float* xrow, const float* shift, const float* scale, bf16_t* orow, int lane) {
    const GAS f32x4* xr = (const GAS f32x4*)xrow + lane;
    f32x4 v[4]; float s = 0.f;
#pragma unroll
    for (int j = 0; j < 4; ++j) { v[j] = xr[64 * j]; s += (v[j].x * v[j].x + v[j].y * v[j].y) + (v[j].z * v[j].z + v[j].w * v[j].w); }
    const float rstd = 1.0f / sqrtf(wave_sum(s) * (1.f / D) + EPS);
    GAS u32x2* o8 = (GAS u32x2*)orow + lane;
#pragma unroll
    for (int j = 0; j < 4; ++j) {
        const f32x4 sh = ((const GAS f32x4*)shift)[lane + 64 * j], sc = ((const GAS f32x4*)scale)[lane + 64 * j];
        const f32x4 y = v[j] * rstd * (sc + 1.0f) + sh;
        u32x2 w; w.x = pk2(y.x, y.y); w.y = pk2(y.z, y.w); o8[64 * j] = w;
    }
}
__device__ __forceinline__ void norm_phase(Frame& F, const float* xl, const float* xc, int layer, int s_shift, int s_scale, int nrows) {
    const float* mod = (const float*)(F.ws + WS_MOD);
    const float* mx = mod + (layer * 2 + 0) * 6144; const float* mc = mod + (layer * 2 + 1) * 6144;
    bf16_t* act = (bf16_t*)(F.ws + WS_ACT);
    for (int m = F.gw; m < nrows; m += F.NGW) {
        if (m < NL) norm_mod_row(xl + (size_t)m * D, mx + s_shift * 1024, mx + s_scale * 1024, act + (size_t)m * D, F.lane);
        else norm_mod_row(xc + (size_t)(m - NL) * D, mc + s_shift * 1024, mc + s_scale * 1024, act + (size_t)m * D, F.lane);
    }
}

namespace pg8 {
constexpr int BM = 256, BK = 64, HALF = 128, HTB = HALF * BK * 2, STAGE_BYTES = 8 * HTB, NXCD = 8, WGM = 8;
__host__ __device__ __forceinline__ int lds_byte(int r, int c) { const int st = (r >> 4) * 2 + (c >> 5), rr = r & 15, cc = c & 31, ob = rr * 64 + cc * 2; return st * 1024 + (ob ^ (((ob >> 9) & 1) << 5)); }
__host__ __device__ __forceinline__ void stage_rc(int b, int& R, int& C) { const int st = b / 1024, sb = b % 1024, swz = sb ^ (((sb >> 9) & 1) << 5); R = (st >> 1) * 16 + swz / 64; C = (st & 1) * 32 + (swz % 64) / 2; }
__host__ __device__ __forceinline__ int perm32(int rho) { const int n = rho >> 4, i = rho & 15; return 8 * (i >> 2) + 4 * n + (i & 3); }
struct Unit { int pm, pn; const char* a; const char* b; };
typedef __bf16 bf16x2_t __attribute__((ext_vector_type(2)));
__device__ __forceinline__ unsigned cvt_pk_bf16(float lo, float hi) { f32x2 v = {lo, hi}; bf16x2_t b = __builtin_convertvector(v, bf16x2_t); return __builtin_bit_cast(unsigned, b); }

__device__ __forceinline__ bool tile_order(int i, int G, int c, int nM, int nN, int& pm, int& pn) {
    const int nwg = nM * nN; const long L = (long)i * G + c; if (L >= nwg) return false;
    int wgid = (int)L; { const int q = nwg / NXCD, r = nwg % NXCD, xcd = wgid % NXCD, off = wgid / NXCD; wgid = (xcd < r ? xcd * (q + 1) : r * (q + 1) + (xcd - r) * q) + off; }
    const int nig = WGM * nN, gid = wgid / nig, fm = gid * WGM, gsz = (nM - fm) < WGM ? (nM - fm) : WGM;
    pm = fm + ((wgid % nig) % gsz); pn = (wgid % nig) / gsz; return true;
}
struct DenseSched {
    int nM, nN, G, c; const char* A; const char* B; size_t tstep;
    __device__ __forceinline__ bool next(int i, Unit& u) const {
        int pm, pn; if (!tile_order(i, G, c, nM, nN, pm, pn)) return false;
        u.pm = pm; u.pn = pn; u.a = A + (size_t)pm * tstep; u.b = B + (size_t)pn * tstep; return true;
    }
};
struct MoeSched {
    int nM, nN, G, c; const char* A; const char* B; size_t tstep, estride; const unsigned* tile_e; int t0, pm_off;
    __device__ __forceinline__ bool next(int i, Unit& u) const {
        int pm, pn; if (!tile_order(i, G, c, nM, nN, pm, pn)) return false;
        const unsigned e = __builtin_amdgcn_readfirstlane(__hip_atomic_load(tile_e + t0 + pm, __ATOMIC_RELAXED, __HIP_MEMORY_SCOPE_AGENT)) & 7u;
        u.pm = pm + pm_off; u.pn = pn; u.a = A + (size_t)pm * tstep; u.b = B + (size_t)e * estride + (size_t)pn * tstep; return true;
    }
};

struct EpiStoreBf16 {
    static constexpr bool PERM = true;
    bf16_t* O; int ldc;
    __device__ __forceinline__ void operator()(const f32x4 (&acc)[2][2][4][2], const Unit& u, int wr, int wc, int fr, int fq) const {
        const int row0 = u.pm * BM + wr * 64 + fr, col0 = u.pn * BM + wc * 32 + 8 * fq;
#pragma unroll
        for (int ai = 0; ai < 2; ++ai)
#pragma unroll
            for (int m = 0; m < 4; ++m) { bf16_t* rowp = O + (size_t)(row0 + ai * HALF + m * 16) * ldc + col0;
#pragma unroll
                for (int bj = 0; bj < 2; ++bj) { const f32x4 v0 = acc[ai][bj][m][0], v1 = acc[ai][bj][m][1];
                    u32x4 w; w.x = cvt_pk_bf16(v0[0], v0[1]); w.y = cvt_pk_bf16(v0[2], v0[3]); w.z = cvt_pk_bf16(v1[0], v1[1]); w.w = cvt_pk_bf16(v1[2], v1[3]);
                    *(u32x4*)(rowp + bj * HALF) = w; } }
    }
};
struct EpiSwiGLU {
    static constexpr bool PERM = true;
    bf16_t* H; int ldh;
    __device__ __forceinline__ void operator()(const f32x4 (&acc)[2][2][4][2], const Unit& u, int wr, int wc, int fr, int fq) const {
        const int row0 = u.pm * BM + wr * 64 + fr, col0 = u.pn * 128 + wc * 16 + 4 * fq;
#pragma unroll
        for (int ai = 0; ai < 2; ++ai)
#pragma unroll
            for (int m = 0; m < 4; ++m) { bf16_t* rowp = H + (size_t)(row0 + ai * HALF + m * 16) * ldh + col0;
#pragma unroll
                for (int bj = 0; bj < 2; ++bj) { const f32x4 g = acc[ai][bj][m][0], up = acc[ai][bj][m][1];
                    float h[4];
#pragma unroll
                    for (int e = 0; e < 4; ++e) h[e] = g[e] * __builtin_amdgcn_rcpf(1.f + __expf(-g[e])) * up[e];
                    u32x2 w; w.x = cvt_pk_bf16(h[0], h[1]); w.y = cvt_pk_bf16(h[2], h[3]);
                    *(u32x2*)(rowp + bj * 64) = w; }
                asm volatile("" ::: "memory"); }
    }
};
struct EpiResid {
    static constexpr bool PERM = false;
    const float* base_l; float* out_l; const float* gate_l; const float* base_c; float* out_c; const float* gate_c; int ctx_tile;
    __device__ __forceinline__ void operator()(const f32x4 (&acc)[2][2][4][2], const Unit& u, int wr, int wc, int fr, int fq) const {
        const bool isc = u.pm >= ctx_tile;
        const float* base = isc ? base_c : base_l; float* out = isc ? out_c : out_l; const float* gate = isc ? gate_c : gate_l;
        const int row0 = (isc ? (u.pm - ctx_tile) : u.pm) * BM + wr * 64 + fr, col0 = u.pn * BM + wc * 32 + 4 * fq;
        f32x4 gv[2][2];
#pragma unroll
        for (int bj = 0; bj < 2; ++bj)
#pragma unroll
            for (int n = 0; n < 2; ++n) gv[bj][n] = *(const f32x4*)(gate + col0 + bj * HALF + n * 16);
#pragma unroll
        for (int ai = 0; ai < 2; ++ai)
#pragma unroll
            for (int m = 0; m < 4; ++m) { const size_t off = (size_t)(row0 + ai * HALF + m * 16) * D + col0;
#pragma unroll
                for (int bj = 0; bj < 2; ++bj)
#pragma unroll
                    for (int n = 0; n < 2; ++n) { const f32x4 bs = *(const f32x4*)(base + off + bj * HALF + n * 16);
                        *(f32x4*)(out + off + bj * HALF + n * 16) = bs + gv[bj][n] * acc[ai][bj][m][n]; } }
    }
};

template <class Epi, class Sched>
__device__ __forceinline__ void gemm_phase(LAS unsigned char* lds, const int K, const Sched& S, const Epi& E) {
    int tid_ = threadIdx.x; asm volatile("" : "+v"(tid_));
    const int tid = tid_, wid = __builtin_amdgcn_readfirstlane(tid >> 6), lane = tid & 63, wr = wid >> 2, wc = wid & 3, fr = lane & 15, fq = lane >> 4;
    const int nt = K / BK;
    unsigned voffA[2], voffB[2];
#pragma unroll
    for (int i = 0; i < 2; ++i) { int R, C; stage_rc(tid * 16 + i * 8192, R, C); const int Rb = Epi::PERM ? ((R & ~31) + perm32(R & 31)) : R;
        voffA[i] = (unsigned)(R * K + C) * 2u; voffB[i] = (unsigned)(Rb * K + C) * 2u; }
    const size_t kstep = (size_t)(BK * 2);
    const size_t hstep = (size_t)HALF * K * 2;
    const unsigned ldsw = (unsigned)wid * 1024u;
    const int aoff = lds_byte(wr * 64 + fr, fq * 8), boff = lds_byte(wc * 32 + fr, fq * 8);
#define PG8_SA(b, h) (((b) * 2 + (h)) * HTB)
#define PG8_SB(b, h) ((4 + (b) * 2 + (h)) * HTB)
#define PG8_STAGE(bufoff, gbase, voff) do { _Pragma("unroll") for (int _i = 0; _i < 2; ++_i) \
        __builtin_amdgcn_global_load_lds((const unsigned*)((const char*)(gbase) + (voff)[_i]), (LAS unsigned*)(lds + (bufoff) + ldsw + _i * 8192), 16, 0, 0); } while (0)
#define PG8_LDA(dst, b, h) do { _Pragma("unroll") for (int m = 0; m < 4; ++m) _Pragma("unroll") for (int k = 0; k < 2; ++k) dst[m][k] = *(const LAS bf16x8*)(lds + PG8_SA(b, h) + aoff + m * 2048 + k * 1024); } while (0)
#define PG8_LDB(dst, b, h) do { _Pragma("unroll") for (int n = 0; n < 2; ++n) _Pragma("unroll") for (int k = 0; k < 2; ++k) dst[n][k] = *(const LAS bf16x8*)(lds + PG8_SB(b, h) + boff + n * 2048 + k * 1024); } while (0)
#define PG8_MMA(ai, bj, At, Bt) do { __builtin_amdgcn_s_setprio(1); _Pragma("unroll") for (int m = 0; m < 4; ++m) _Pragma("unroll") for (int n = 0; n < 2; ++n) _Pragma("unroll") for (int k = 0; k < 2; ++k) \
        acc[ai][bj][m][n] = __builtin_amdgcn_mfma_f32_16x16x32_bf16(Bt[n][k], At[m][k], acc[ai][bj][m][n], 0, 0, 0); __builtin_amdgcn_s_setprio(0); } while (0)
#define PG8_WAIT_V(n) asm volatile("s_waitcnt vmcnt(" #n ")" ::: "memory")
#define PG8_WAIT_L(n) asm volatile("s_waitcnt lgkmcnt(" #n ")" ::: "memory")
#define PG8_BAR __builtin_amdgcn_s_barrier()
#define PG8_SCHED __builtin_amdgcn_sched_barrier(0)
    Unit cur, nxt; int ui = 0;
    if (!S.next(0, cur)) return;
    f32x4 acc[2][2][4][2];
#pragma unroll
    for (int a = 0; a < 2; ++a)
#pragma unroll
        for (int b = 0; b < 2; ++b)
#pragma unroll
            for (int m = 0; m < 4; ++m)
#pragma unroll
                for (int n = 0; n < 2; ++n) acc[a][b][m][n] = (f32x4){0.f, 0.f, 0.f, 0.f};
    bf16x8 At[4][2], B0[2][2], B1[2][2];
    const char* cA = cur.a; const char* cB = cur.b;
    PG8_STAGE(PG8_SB(0, 0), cB, voffB); PG8_STAGE(PG8_SB(0, 1), cB + hstep, voffB); PG8_STAGE(PG8_SA(0, 0), cA, voffA); PG8_STAGE(PG8_SA(0, 1), cA + hstep, voffA);
    if (wr == 1) PG8_BAR;
    PG8_WAIT_V(2); PG8_BAR;
    PG8_STAGE(PG8_SB(1, 0), cB + kstep, voffB); PG8_STAGE(PG8_SA(1, 0), cA + kstep, voffA); PG8_STAGE(PG8_SB(1, 1), cB + hstep + kstep, voffB);
    PG8_WAIT_V(6); PG8_BAR;
    for (;;) {
        const bool has_next = S.next(ui + 1, nxt);
        const char* nA = has_next ? nxt.a : cA; const char* nB = has_next ? nxt.b : cB;
        for (int t = 0; t < nt; t += 2) {
            const bool last = (t == nt - 2);
            const char* a1 = cA + (size_t)(t + 1) * kstep;
            const char* a2 = last ? nA : cA + (size_t)(t + 2) * kstep; const char* b2 = last ? nB : cB + (size_t)(t + 2) * kstep;
            const char* a3 = a2 + kstep; const char* b3 = b2 + kstep;
            PG8_LDB(B0, 0, 0); PG8_LDB(B1, 0, 1); PG8_SCHED; PG8_LDA(At, 0, 0); PG8_STAGE(PG8_SA(1, 1), a1 + hstep, voffA);
            PG8_WAIT_V(8); PG8_WAIT_L(0); PG8_BAR; PG8_MMA(0, 0, At, B0); PG8_MMA(0, 1, At, B1); PG8_BAR; PG8_SCHED;
            PG8_LDA(At, 0, 1); PG8_STAGE(PG8_SB(0, 0), b2, voffB); PG8_STAGE(PG8_SB(0, 1), b2 + hstep, voffB); PG8_STAGE(PG8_SA(0, 0), a2, voffA);
            PG8_WAIT_V(8); PG8_WAIT_L(0); PG8_BAR; PG8_MMA(1, 0, At, B0); PG8_MMA(1, 1, At, B1); PG8_BAR; PG8_SCHED;
            PG8_LDB(B0, 1, 0); PG8_LDB(B1, 1, 1); PG8_SCHED; PG8_LDA(At, 1, 0); PG8_STAGE(PG8_SA(0, 1), a2 + hstep, voffA);
            PG8_WAIT_V(8); PG8_WAIT_L(0); PG8_BAR; PG8_MMA(0, 0, At, B0); PG8_MMA(0, 1, At, B1); PG8_BAR; PG8_SCHED;
            PG8_LDA(At, 1, 1); PG8_STAGE(PG8_SB(1, 0), b3, voffB); PG8_STAGE(PG8_SB(1, 1), b3 + hstep, voffB); PG8_STAGE(PG8_SA(1, 0), a3, voffA);
            PG8_WAIT_V(8); PG8_WAIT_L(0); PG8_BAR; PG8_MMA(1, 0, At, B0); PG8_MMA(1, 1, At, B1); PG8_BAR; PG8_SCHED;
        }
        if (wr == 0) PG8_BAR;
        E(acc, cur, wr, wc, fr, fq);
        if (!has_next) break;
#pragma unroll
        for (int a = 0; a < 2; ++a)
#pragma unroll
            for (int b = 0; b < 2; ++b)
#pragma unroll
                for (int m = 0; m < 4; ++m)
#pragma unroll
                    for (int n = 0; n < 2; ++n) acc[a][b][m][n] = (f32x4){0.f, 0.f, 0.f, 0.f};
        cur = nxt; cA = nA; cB = nB; ++ui;
        if (wr == 1) PG8_BAR;
    }
    PG8_WAIT_V(0);
    PG8_BAR;
#undef PG8_SA
#undef PG8_SB
#undef PG8_STAGE
#undef PG8_LDA
#undef PG8_LDB
#undef PG8_MMA
#undef PG8_WAIT_V
#undef PG8_WAIT_L
#undef PG8_BAR
#undef PG8_SCHED
}
}

constexpr size_t WS_GL = 7 * MiB;
__device__ __forceinline__ float ldbf(const bf16_t* p) { return bf2f(*p); }
__device__ __forceinline__ void prep_phase(Frame& F, const Args& A, int layer) {
    const bf16_t* PX = (const bf16_t*)(F.ws + WS_PX);
    bf16_t* PXw = (bf16_t*)(F.ws + WS_PX);
    bf16_t* ACT = (bf16_t*)(F.ws + WS_ACT);
    bf16_t* QD = (bf16_t*)(F.ws + WS_QD); bf16_t* KD = (bf16_t*)(F.ws + WS_QD + QKV_STRIDE); bf16_t* VD = (bf16_t*)(F.ws + WS_QD + 2 * QKV_STRIDE);
    float* Gg = (float*)(F.ws + WS_G); float* Bt = (float*)(F.ws + WS_BETA);
    const float* rope = (const float*)(F.ws + WS_ROPE);
    const float* cw = A.in[I_CONVW] + layer * 3 * 256;
    const float* dw = A.in[I_DNCONVW] + layer * 3 * 1152;
    const int lane = F.lane;
    for (int m = F.gw; m < NT; m += F.NGW) {
        const bool hasp = (m != 0 && m != NL), hasn = (m != NL - 1 && m != NT - 1);
        const bf16_t* r0 = PX + (size_t)m * INP; const bf16_t* rp = r0 - INP; const bf16_t* rn = r0 + INP;
#pragma unroll
        for (int j = 0; j < 4; ++j) {
            const int c = lane + 64 * j;
            const float u0 = hasp ? ldbf(rp + C_CC + c) * ldbf(rp + C_CH + c) : 0.f;
            const float u1 = ldbf(r0 + C_CC + c) * ldbf(r0 + C_CH + c);
            const float u2 = hasn ? ldbf(rn + C_CC + c) * ldbf(rn + C_CH + c) : 0.f;
            const float cv = cw[c] * u0 + cw[256 + c] * u1 + cw[512 + c] * u2;
            ACT[(size_t)m * D + c] = (bf16_t)f2bf(ldbf(r0 + C_CB + c) * cv);
        }
#pragma unroll
        for (int p = 0; p < 3; ++p) {
#pragma unroll
            for (int h = 0; h < 6; ++h) {
                const int ch = p * 384 + h * 64 + lane;
                const float a0 = hasp ? ldbf(rp + C_DQ + ch) : 0.f, a1 = ldbf(r0 + C_DQ + ch), a2 = hasn ? ldbf(rn + C_DQ + ch) : 0.f;
                float v = silu_f(dw[ch] * a0 + dw[1152 + ch] * a1 + dw[2304 + ch] * a2);
                if (p < 2) { const float ss = wave_sum(v * v); v *= (1.0f / sqrtf(ss + 1e-6f)) * (p == 0 ? 0.125f : 1.0f); }
                bf16_t* dst = (p == 0 ? QD : (p == 1 ? KD : VD));
                dst[(size_t)m * 384 + h * 64 + lane] = (bf16_t)f2bf(v);
            }
        }
        if (lane < 12) {
            const float a = ldbf(r0 + C_DA + lane), b = ldbf(r0 + C_DB + lane);
            const float sp = a + A.in[I_DTB][layer * 12 + lane];
            const float softp = (sp > 20.f) ? sp : log1pf(expf(sp));
            Gg[(size_t)m * 12 + lane] = -expf(A.in[I_ALOG][layer * 12 + lane]) * softp;
            Bt[(size_t)m * 12 + lane] = 1.0f / (1.0f + expf(-b));
        }
        if (m < NL) {
            const int prow = m >> 6, pcol = m & 63;
#pragma unroll
            for (int j = 0; j < 4; ++j) {
                const int head = (lane >> 5) + 2 * j, pidx = lane & 31, axis = pidx >> 4, f = pidx & 15;
                const int cbase = (head < 6 ? C_AQ + head * 64 : C_AK + (head - 6) * 64) + axis * 32 + f;
                const int pos = axis == 0 ? prow : pcol;
                const float cs = rope[(pos * 16 + f) * 2], sn = rope[(pos * 16 + f) * 2 + 1];
                bf16_t* p1 = PXw + (size_t)m * INP + cbase; bf16_t* p2 = p1 + 16;
                const float x1 = bf2f(*p1), x2 = bf2f(*p2);
                *p1 = (bf16_t)f2bf(x1 * cs - x2 * sn); *p2 = (bf16_t)f2bf(x2 * cs + x1 * sn);
            }
        }
    }
}

constexpr int DN_NS = 260, DN_NU = 12 * DN_NS;
__device__ __forceinline__ int dn_row0(int d, int s) {
    if (s < 4) return NL + 64 * (d == 0 ? s : 3 - s);
    return 64 * (d == 0 ? (s - 4) : 255 - (s - 4));
}
__device__ __forceinline__ void dn_chunk_phase(Frame& F) {
    const bf16_t* KD = (const bf16_t*)(F.ws + WS_QD + QKV_STRIDE); const bf16_t* VD = (const bf16_t*)(F.ws + WS_QD + 2 * QKV_STRIDE);
    const float* Gg = (const float*)(F.ws + WS_G); const float* Bt = (const float*)(F.ws + WS_BETA);
    bf16_t* Wm = (bf16_t*)(F.ws + WS_DN); bf16_t* KDt = (bf16_t*)(F.ws + WS_DN + DN_STRIDE); bf16_t* Ut = (bf16_t*)(F.ws + WS_DN + 2 * DN_STRIDE);
    float* GL = (float*)(F.ws + WS_GL);
    const int gi = F.wave >> 1, wl = F.wave & 1;
    LAS float* Am = (LAS float*)(F.lds + gi * 18432);
    LAS float* gcs = Am + 64 * 68; LAS float* bts = gcs + 64;
    for (int base = blockIdx.x * 4; base < DN_NU; base += F.G * 4) {
        const int lane = opq(F.lane), r = lane & 15, g = lane >> 4;
        const int U = base + gi; const bool act = U < DN_NU;
        const int dh = act ? U / DN_NS : 0, s = act ? U % DN_NS : 0, d = dh / 6, h = dh % 6;
        const int row0 = dn_row0(d, s);
        if (act && wl == 0) {
            const int io = d ? 63 - lane : lane;
            float gv = Gg[(size_t)(row0 + io) * 12 + d * 6 + h];
#pragma unroll
            for (int o = 1; o < 64; o <<= 1) { const float t = __shfl_up(gv, o); if (lane >= o) gv += t; }
            gcs[lane] = gv; bts[lane] = Bt[(size_t)(row0 + io) * 12 + d * 6 + h];
            if (lane == 63) GL[U] = expf(gv);
        }
        __syncthreads();
        if (act) {
            bf16x8 kf[4][2];
#pragma unroll
            for (int jt = 0; jt < 4; ++jt)
#pragma unroll
                for (int ks = 0; ks < 2; ++ks) kf[jt][ks] = *(const bf16x8*)(KD + (size_t)(row0 + 16 * jt + r) * 384 + h * 64 + 32 * ks + 8 * g);
#pragma unroll
            for (int itl = 0; itl < 2; ++itl) {
                const int it = 2 * wl + itl;
#pragma unroll
                for (int jt = 0; jt < 4; ++jt) {
                    f32x4 c = (f32x4){0.f, 0.f, 0.f, 0.f};
                    const bf16x8 a0 = (it == 0 ? kf[0][0] : it == 1 ? kf[1][0] : it == 2 ? kf[2][0] : kf[3][0]);
                    const bf16x8 a1 = (it == 0 ? kf[0][1] : it == 1 ? kf[1][1] : it == 2 ? kf[2][1] : kf[3][1]);
                    c = __builtin_amdgcn_mfma_f32_16x16x32_bf16(a0, kf[jt][0], c, 0, 0, 0);
                    c = __builtin_amdgcn_mfma_f32_16x16x32_bf16(a1, kf[jt][1], c, 0, 0, 0);
                    const int jo = 16 * jt + r, jp = d ? 63 - jo : jo;
#pragma unroll
                    for (int e = 0; e < 4; ++e) {
                        const int io = 16 * it + 4 * g + e, ip = d ? 63 - io : io;
                        const float val = (jp < ip) ? bts[ip] * c[e] * __expf(gcs[ip] - gcs[jp]) : 0.f;
                        Am[ip * 68 + jp] = val;
                    }
                }
            }
        }
        __syncthreads();
        if (act) {
            const int col = lane;
            const bf16_t* src = (wl == 0 ? VD : KD) + (size_t)row0 * 384 + h * 64 + col;
            float x[64];
            const float gcl = gcs[63];
            const size_t ub = (size_t)U * 4096;
#pragma unroll
            for (int i = 0; i < 64; ++i) { const int io = d ? 63 - i : i; x[i] = bf2f(src[(size_t)io * 384]); }
            if (wl == 1) {
#pragma unroll
                for (int i8 = 0; i8 < 8; ++i8) { u32x4 o;
                    o.x = pk2(x[8 * i8 + 0] * __expf(gcl - gcs[8 * i8 + 0]), x[8 * i8 + 1] * __expf(gcl - gcs[8 * i8 + 1]));
                    o.y = pk2(x[8 * i8 + 2] * __expf(gcl - gcs[8 * i8 + 2]), x[8 * i8 + 3] * __expf(gcl - gcs[8 * i8 + 3]));
                    o.z = pk2(x[8 * i8 + 4] * __expf(gcl - gcs[8 * i8 + 4]), x[8 * i8 + 5] * __expf(gcl - gcs[8 * i8 + 5]));
                    o.w = pk2(x[8 * i8 + 6] * __expf(gcl - gcs[8 * i8 + 6]), x[8 * i8 + 7] * __expf(gcl - gcs[8 * i8 + 7]));
                    *(u32x4*)(KDt + ub + col * 64 + 8 * i8) = o; }
#pragma unroll
                for (int i = 0; i < 64; ++i) x[i] *= bts[i] * __expf(gcs[i]);
            } else {
#pragma unroll
                for (int i = 0; i < 64; ++i) x[i] *= bts[i];
            }
#pragma unroll
            for (int i = 1; i < 64; ++i) {
                float p0 = 0.f, p1 = 0.f, p2 = 0.f, p3 = 0.f;
#pragma unroll
                for (int j4 = 0; j4 < (i + 3) / 4; ++j4) {
                    const f32x4 a = *(const LAS f32x4*)(Am + i * 68 + 4 * j4);
                    p0 += a.x * x[4 * j4]; p1 += a.y * x[4 * j4 + 1]; p2 += a.z * x[4 * j4 + 2]; p3 += a.w * x[4 * j4 + 3];
                }
                x[i] -= (p0 + p1) + (p2 + p3);
                if ((i & 3) == 3) asm volatile("" ::: "memory");
            }
            if (wl == 0) {
#pragma unroll
                for (int i8 = 0; i8 < 8; ++i8) { u32x4 o; o.x = pk2(x[8 * i8], x[8 * i8 + 1]); o.y = pk2(x[8 * i8 + 2], x[8 * i8 + 3]); o.z = pk2(x[8 * i8 + 4], x[8 * i8 + 5]); o.w = pk2(x[8 * i8 + 6], x[8 * i8 + 7]);
                    *(u32x4*)(Ut + ub + col * 64 + 8 * i8) = o; }
            } else {
#pragma unroll
                for (int i = 0; i < 64; ++i) Wm[ub + i * 64 + col] = (bf16_t)f2bf(-x[i]);
            }
        }
        __syncthreads();
    }
}

constexpr int SC_D = 5, SC_STAGE = 24576;
__device__ __forceinline__ unsigned pkbf(float lo, float hi) { return pg8::cvt_pk_bf16(lo, hi); }
__device__ __forceinline__ int sc_off(int row, int col) {
    const int c = col >> 3; return row * 128 + ((c ^ ((row >> 1) & 7)) << 4) + ((col & 4) << 1);
}
__device__ __forceinline__ void dn_scan_phase(Frame& F) {
    const int dh = blockIdx.x, d = dh / 6, lane = F.lane, wave = F.wave, r = lane & 15, g = lane >> 4;
    const unsigned char* srcW = F.ws + WS_DN + (size_t)dh * DN_NS * 8192;
    const unsigned char* srcK = srcW + DN_STRIDE; const unsigned char* srcU = srcW + 2 * DN_STRIDE;
    bf16_t* VT = (bf16_t*)(F.ws + WS_DN + 3 * DN_STRIDE) + (size_t)dh * DN_NS * 4096;
    bf16_t* ST = (bf16_t*)(F.ws + WS_DN + 4 * DN_STRIDE) + (size_t)dh * DN_NS * 4096;
    LAS float* gls = (LAS float*)(F.lds + SC_D * SC_STAGE);
    { const float* GL = (const float*)(F.ws + WS_GL) + dh * DN_NS; for (int i = F.tid; i < DN_NS; i += NTHREADS) gls[i] = GL[i]; }
    __syncthreads();
#define SC_WAITV(n) asm volatile("s_waitcnt vmcnt(" #n ")" ::: "memory")
#define SC_BAR() do { asm volatile("" ::: "memory"); __builtin_amdgcn_s_barrier(); asm volatile("" ::: "memory"); } while (0)
    if (wave >= 4) {
        const int lw = wave - 4;
        const int lrow = lane >> 3, lc = lane & 7;
#define SC_ISSUE(st) do { const int slot_ = ((st) % SC_D) * SC_STAGE; \
            _Pragma("unroll") for (int e = 0; e < 6; ++e) { \
                const int q = lw * 6 + e, mi = q >> 3, n = q & 7, row = 8 * n + lrow; \
                const unsigned char* mb = (mi == 0 ? srcW : mi == 1 ? srcK : srcU) + (size_t)(st) * 8192; \
                const unsigned char* gp = mb + row * 128 + ((lc ^ ((row >> 1) & 7)) << 4); \
                __builtin_amdgcn_global_load_lds((const unsigned*)gp, (LAS unsigned*)(F.lds + slot_ + mi * 8192 + n * 1024), 16, 0, 0); } } while (0)
#ifdef SCAN_SYNC
        SC_BAR();
        for (int t = 0; t < DN_NS; ++t) { SC_ISSUE(t); SC_WAITV(0); SC_BAR(); SC_BAR(); }
#else
        SC_ISSUE(0); SC_ISSUE(1); SC_ISSUE(2); SC_ISSUE(3);
        SC_WAITV(18); SC_BAR();
        for (int t = 0; t < DN_NS; ++t) {
            if (t + SC_D - 1 < DN_NS) { SC_ISSUE(t + SC_D - 1); SC_WAITV(18); }
            else { SC_WAITV(0); }
            SC_BAR();
        }
#endif
    } else {
        f32x4 S[4];
#pragma unroll
        for (int t = 0; t < 4; ++t) S[t] = (f32x4){0.f, 0.f, 0.f, 0.f};
        const int dvrow = 16 * wave + r;
        SC_BAR();
        for (int t = 0; t < DN_NS; ++t) {
#ifdef SCAN_SYNC
            SC_BAR();
#endif
            const LAS unsigned char* sb = F.lds + (t % SC_D) * SC_STAGE;
            const float gl = gls[t];
            u32x4 bs[2];
#pragma unroll
            for (int ks = 0; ks < 2; ++ks) { bs[ks].x = pkbf(S[2 * ks][0], S[2 * ks][1]); bs[ks].y = pkbf(S[2 * ks][2], S[2 * ks][3]); bs[ks].z = pkbf(S[2 * ks + 1][0], S[2 * ks + 1][1]); bs[ks].w = pkbf(S[2 * ks + 1][2], S[2 * ks + 1][3]); }
            bf16_t* stp = ST + (size_t)t * 4096 + dvrow * 64 + 4 * g;
            *(u32x2*)(stp + 0) = (u32x2){bs[0].x, bs[0].y}; *(u32x2*)(stp + 16) = (u32x2){bs[0].z, bs[0].w};
            *(u32x2*)(stp + 32) = (u32x2){bs[1].x, bs[1].y}; *(u32x2*)(stp + 48) = (u32x2){bs[1].z, bs[1].w};
            f32x4 vn[4];
#pragma unroll
            for (int it = 0; it < 4; ++it) {
                const u32x2 uu = *(const LAS u32x2*)(sb + 16384 + sc_off(dvrow, 16 * it + 4 * g));
                f32x4 c = (f32x4){bf2f(uu.x & 0xffffu), bf2f(uu.x >> 16), bf2f(uu.y & 0xffffu), bf2f(uu.y >> 16)};
#pragma unroll
                for (int ks = 0; ks < 2; ++ks) {
                    const u32x2 lo = *(const LAS u32x2*)(sb + sc_off(16 * it + r, 32 * ks + 4 * g));
                    const u32x2 hi = *(const LAS u32x2*)(sb + sc_off(16 * it + r, 32 * ks + 16 + 4 * g));
                    const u32x4 a = (u32x4){lo.x, lo.y, hi.x, hi.y};
                    c = __builtin_amdgcn_mfma_f32_16x16x32_bf16(__builtin_bit_cast(bf16x8, a), __builtin_bit_cast(bf16x8, bs[ks]), c, 0, 0, 0);
                }
                vn[it] = c;
            }
            u32x4 bv[2];
#pragma unroll
            for (int ks = 0; ks < 2; ++ks) { bv[ks].x = pkbf(vn[2 * ks][0], vn[2 * ks][1]); bv[ks].y = pkbf(vn[2 * ks][2], vn[2 * ks][3]); bv[ks].z = pkbf(vn[2 * ks + 1][0], vn[2 * ks + 1][1]); bv[ks].w = pkbf(vn[2 * ks + 1][2], vn[2 * ks + 1][3]); }
            bf16_t* vtp = VT + (size_t)t * 4096 + dvrow * 64;
            if (d == 0) {
                *(u32x2*)(vtp + 4 * g + 0) = (u32x2){bv[0].x, bv[0].y}; *(u32x2*)(vtp + 4 * g + 16) = (u32x2){bv[0].z, bv[0].w};
                *(u32x2*)(vtp + 4 * g + 32) = (u32x2){bv[1].x, bv[1].y}; *(u32x2*)(vtp + 4 * g + 48) = (u32x2){bv[1].z, bv[1].w};
            } else {
#define SC_REV(a, b) (u32x2){ ((b) >> 16) | ((b) << 16), ((a) >> 16) | ((a) << 16) }
                *(u32x2*)(vtp + 60 - 4 * g - 0) = SC_REV(bv[0].x, bv[0].y); *(u32x2*)(vtp + 60 - 4 * g - 16) = SC_REV(bv[0].z, bv[0].w);
                *(u32x2*)(vtp + 60 - 4 * g - 32) = SC_REV(bv[1].x, bv[1].y); *(u32x2*)(vtp + 60 - 4 * g - 48) = SC_REV(bv[1].z, bv[1].w);
#undef SC_REV
            }
#pragma unroll
            for (int tt = 0; tt < 4; ++tt) {
                f32x4 c = S[tt] * gl;
#pragma unroll
                for (int ks = 0; ks < 2; ++ks) {
                    const u32x2 lo = *(const LAS u32x2*)(sb + 8192 + sc_off(16 * tt + r, 32 * ks + 4 * g));
                    const u32x2 hi = *(const LAS u32x2*)(sb + 8192 + sc_off(16 * tt + r, 32 * ks + 16 + 4 * g));
                    const u32x4 a = (u32x4){lo.x, lo.y, hi.x, hi.y};
                    c = __builtin_amdgcn_mfma_f32_16x16x32_bf16(__builtin_bit_cast(bf16x8, a), __builtin_bit_cast(bf16x8, bv[ks]), c, 0, 0, 0);
                }
                S[tt] = c;
            }
            asm volatile("s_waitcnt lgkmcnt(0)" ::: "memory");
            SC_BAR();
        }
    }
#undef SC_WAITV
#undef SC_BAR
#undef SC_ISSUE
    asm volatile("s_waitcnt vmcnt(0) lgkmcnt(0)" ::: "memory");
    __syncthreads();
}

__device__ __forceinline__ void attn_unit(Frame& F, const Args& A, int layer, int unit) {
    const bf16_t* PX = (const bf16_t*)(F.ws + WS_PX);
    bf16_t* ACT = (bf16_t*)(F.ws + WS_ACT);
    const int lane = F.lane, wave = F.wave, r = lane & 15, g = lane >> 4, tid = F.tid;
    const bool isctx = unit >= 256;
    const int qb = isctx ? (unit - 256) >> 1 : unit >> 1, hk = unit & 1;
    const int qrow0 = (isctx ? NL : 0) + 128 * qb + 16 * wave;
    const int qpos = 128 * qb + 16 * wave + r;
    LAS unsigned char* Kl = F.lds;
    LAS unsigned char* Vl = F.lds + 9216;
    const float SCL = 0.125f * 1.4426950408889634f;
    bf16x8 qf[3][2];
#pragma unroll
    for (int a = 0; a < 3; ++a)
#pragma unroll
        for (int ks = 0; ks < 2; ++ks) qf[a][ks] = *(const bf16x8*)(PX + (size_t)(qrow0 + r) * INP + C_AQ + (3 * hk + a) * 64 + 32 * ks + 8 * g);
    float mrun[3], lrun[3]; f32x4 o[3][4];
#pragma unroll
    for (int a = 0; a < 3; ++a) { mrun[a] = A.in[I_SINK][layer * 6 + 3 * hk + a] * 1.4426950408889634f; lrun[a] = 1.f;
#pragma unroll
        for (int dt = 0; dt < 4; ++dt) o[a][dt] = (f32x4){0.f, 0.f, 0.f, 0.f}; }
    const int ntile = isctx ? 4 : 10;
    for (int ti = 0; ti < ntile; ++ti) {
        int krow0; bool local = false;
        if (ti < 4) krow0 = NL + 64 * ti;
        else { krow0 = 128 * (qb - 1) + 64 * (ti - 4); local = true; if (krow0 < 0 || krow0 >= NL) continue; }
        __syncthreads();
        { const int key = tid >> 3, ch = tid & 7;
          const u32x4 kv = *(const u32x4*)(PX + (size_t)(krow0 + key) * INP + C_AK + hk * 64 + ch * 8);
          *(LAS u32x4*)(Kl + key * 144 + ch * 16) = kv;
          const u32x4 vv = *(const u32x4*)(PX + (size_t)(krow0 + key) * INP + C_AV + hk * 64 + ch * 8);
          LAS bf16_t* vt = (LAS bf16_t*)Vl;
          vt[(ch * 8 + 0) * 68 + key] = (bf16_t)(vv.x & 0xffffu); vt[(ch * 8 + 1) * 68 + key] = (bf16_t)(vv.x >> 16);
          vt[(ch * 8 + 2) * 68 + key] = (bf16_t)(vv.y & 0xffffu); vt[(ch * 8 + 3) * 68 + key] = (bf16_t)(vv.y >> 16);
          vt[(ch * 8 + 4) * 68 + key] = (bf16_t)(vv.z & 0xffffu); vt[(ch * 8 + 5) * 68 + key] = (bf16_t)(vv.z >> 16);
          vt[(ch * 8 + 6) * 68 + key] = (bf16_t)(vv.w & 0xffffu); vt[(ch * 8 + 7) * 68 + key] = (bf16_t)(vv.w >> 16); }
        __syncthreads();
        f32x4 st[3][4];
#pragma unroll
        for (int kt = 0; kt < 4; ++kt) {
            const bf16x8 k0 = *(const LAS bf16x8*)(Kl + (16 * kt + r) * 144 + (8 * g) * 2);
            const bf16x8 k1 = *(const LAS bf16x8*)(Kl + (16 * kt + r) * 144 + (32 + 8 * g) * 2);
#pragma unroll
            for (int a = 0; a < 3; ++a) {
                f32x4 c = (f32x4){0.f, 0.f, 0.f, 0.f};
                c = __builtin_amdgcn_mfma_f32_16x16x32_bf16(k0, qf[a][0], c, 0, 0, 0);
                c = __builtin_amdgcn_mfma_f32_16x16x32_bf16(k1, qf[a][1], c, 0, 0, 0);
                st[a][kt] = c;
            }
        }
        u32x4 bp[3][2];
#pragma unroll
        for (int a = 0; a < 3; ++a) {
            float tmax = -INFINITY;
#pragma unroll
            for (int kt = 0; kt < 4; ++kt)
#pragma unroll
                for (int e = 0; e < 4; ++e) {
                    float sv = st[a][kt][e] * SCL;
                    if (local) { const int kp = krow0 + 16 * kt + 4 * g + e; const int df = qpos - kp; if (df > 128 || df < -128) sv = -INFINITY; }
                    st[a][kt][e] = sv; tmax = fmaxf(tmax, sv);
                }
            tmax = fmaxf(tmax, __shfl_xor(tmax, 16)); tmax = fmaxf(tmax, __shfl_xor(tmax, 32));
            const float mnew = fmaxf(mrun[a], tmax);
            const float alpha = exp2f(mrun[a] - mnew);
            float ls = 0.f;
#pragma unroll
            for (int kt = 0; kt < 4; ++kt)
#pragma unroll
                for (int e = 0; e < 4; ++e) { const float p = exp2f(st[a][kt][e] - mnew); st[a][kt][e] = p; ls += p; }
            ls += __shfl_xor(ls, 16); ls += __shfl_xor(ls, 32);
            lrun[a] = lrun[a] * alpha + ls; mrun[a] = mnew;
#pragma unroll
            for (int dt = 0; dt < 4; ++dt) o[a][dt] = o[a][dt] * alpha;
#pragma unroll
            for (int k2 = 0; k2 < 2; ++k2) { bp[a][k2].x = pkbf(st[a][2 * k2][0], st[a][2 * k2][1]); bp[a][k2].y = pkbf(st[a][2 * k2][2], st[a][2 * k2][3]);
                bp[a][k2].z = pkbf(st[a][2 * k2 + 1][0], st[a][2 * k2 + 1][1]); bp[a][k2].w = pkbf(st[a][2 * k2 + 1][2], st[a][2 * k2 + 1][3]); }
        }
#pragma unroll
        for (int dt = 0; dt < 4; ++dt)
#pragma unroll
            for (int k2 = 0; k2 < 2; ++k2) {
                const u32x2 lo = *(const LAS u32x2*)(Vl + (16 * dt + r) * 136 + (32 * k2 + 4 * g) * 2);
                const u32x2 hi = *(const LAS u32x2*)(Vl + (16 * dt + r) * 136 + (32 * k2 + 16 + 4 * g) * 2);
                const u32x4 av = (u32x4){lo.x, lo.y, hi.x, hi.y};
#pragma unroll
                for (int a = 0; a < 3; ++a) o[a][dt] = __builtin_amdgcn_mfma_f32_16x16x32_bf16(__builtin_bit_cast(bf16x8, av), __builtin_bit_cast(bf16x8, bp[a][k2]), o[a][dt], 0, 0, 0);
            }
    }
#pragma unroll
    for (int a = 0; a < 3; ++a) {
        const float inv = 1.0f / lrun[a];
#pragma unroll
        for (int dt = 0; dt < 4; ++dt) {
            u32x2 w; w.x = pkbf(o[a][dt][0] * inv, o[a][dt][1] * inv); w.y = pkbf(o[a][dt][2] * inv, o[a][dt][3] * inv);
            *(u32x2*)(ACT + (size_t)(qrow0 + r) * D + 640 + (3 * hk + a) * 64 + 16 * dt + 4 * g) = w;
        }
    }
}

__device__ __forceinline__ void scan_attn_phase(Frame& F, const Args& A, int layer) {
    if (blockIdx.x < 12) { dn_scan_phase(F); return; }
    const int nunits = layer == 0 ? 260 : 256, nw = F.G - 12;
    for (int u = blockIdx.x - 12; u < nunits; u += nw) { attn_unit(F, A, layer, u); __syncthreads(); }
}

__device__ __forceinline__ void dn_out_phase(Frame& F, const Args& A, int layer) {
    const bf16_t* PX = (const bf16_t*)(F.ws + WS_PX);
    bf16_t* ACT = (bf16_t*)(F.ws + WS_ACT);
    const bf16_t* QD = (const bf16_t*)(F.ws + WS_QD); const bf16_t* KD = (const bf16_t*)(F.ws + WS_QD + QKV_STRIDE);
    const float* Gg = (const float*)(F.ws + WS_G);
    const bf16_t* VT = (const bf16_t*)(F.ws + WS_DN + 3 * DN_STRIDE); const bf16_t* ST = (const bf16_t*)(F.ws + WS_DN + 4 * DN_STRIDE);
    const float* ng = A.in[I_NORMG] + layer * 64;
    const int lane = F.lane, r = lane & 15, g = lane >> 4;
    const int nchunk = layer == 0 ? 260 : 256;
    for (int wu = F.gw; wu < nchunk * 6; wu += F.NGW) {
        const int oc = wu / 6, h = wu % 6;
        const int row0 = oc < 256 ? 64 * oc : NL + 64 * (oc - 256);
        const int s0 = oc < 256 ? 4 + oc : oc - 256, s1 = oc < 256 ? 4 + 255 - oc : 3 - (oc - 256);
        const size_t U0 = (size_t)(h * DN_NS + s0) * 4096, U1 = (size_t)((6 + h) * DN_NS + s1) * 4096;
        float gc0 = Gg[(size_t)(row0 + lane) * 12 + h], gc1 = Gg[(size_t)(row0 + lane) * 12 + 6 + h];
#pragma unroll
        for (int o = 1; o < 64; o <<= 1) { const float t0 = __shfl_up(gc0, o), t1 = __shfl_down(gc1, o); if (lane >= o) gc0 += t0; if (lane + o < 64) gc1 += t1; }
        float gj0[4][4], gj1[4][4];
#pragma unroll
        for (int jt = 0; jt < 4; ++jt)
#pragma unroll
            for (int e = 0; e < 4; ++e) { gj0[jt][e] = __shfl(gc0, 16 * jt + 4 * g + e); gj1[jt][e] = __shfl(gc1, 16 * jt + 4 * g + e); }
        bf16x8 kf[4][2];
#pragma unroll
        for (int jt = 0; jt < 4; ++jt)
#pragma unroll
            for (int ks = 0; ks < 2; ++ks) kf[jt][ks] = *(const bf16x8*)(KD + (size_t)(row0 + 16 * jt + r) * 384 + h * 64 + 32 * ks + 8 * g);
        f32x4 ngv[4];
#pragma unroll
        for (int dt = 0; dt < 4; ++dt) ngv[dt] = *(const f32x4*)(ng + 16 * dt + 4 * g);
#pragma unroll 1
        for (int it = 0; it < 4; ++it) {
            const int i = 16 * it + r;
            const float e0 = __shfl(gc0, i), e1 = __shfl(gc1, i);
            bf16x8 qf[2];
#pragma unroll
            for (int ks = 0; ks < 2; ++ks) qf[ks] = *(const bf16x8*)(QD + (size_t)(row0 + i) * 384 + h * 64 + 32 * ks + 8 * g);
            f32x4 o[4];
            const float x0 = __expf(e0), x1 = __expf(e1);
#pragma unroll
            for (int dt = 0; dt < 4; ++dt) {
                f32x4 c0 = (f32x4){0.f, 0.f, 0.f, 0.f}, c1 = (f32x4){0.f, 0.f, 0.f, 0.f};
#pragma unroll
                for (int ks = 0; ks < 2; ++ks) {
                    const bf16x8 a0 = *(const bf16x8*)(ST + U0 + (16 * dt + r) * 64 + 32 * ks + 8 * g);
                    const bf16x8 a1 = *(const bf16x8*)(ST + U1 + (16 * dt + r) * 64 + 32 * ks + 8 * g);
                    c0 = __builtin_amdgcn_mfma_f32_16x16x32_bf16(a0, qf[ks], c0, 0, 0, 0);
                    c1 = __builtin_amdgcn_mfma_f32_16x16x32_bf16(a1, qf[ks], c1, 0, 0, 0);
                }
                o[dt] = c0 * x0 + c1 * x1;
            }
            f32x4 pt[4];
#pragma unroll
            for (int jt = 0; jt < 4; ++jt) {
                f32x4 c = (f32x4){0.f, 0.f, 0.f, 0.f};
                c = __builtin_amdgcn_mfma_f32_16x16x32_bf16(kf[jt][0], qf[0], c, 0, 0, 0);
                c = __builtin_amdgcn_mfma_f32_16x16x32_bf16(kf[jt][1], qf[1], c, 0, 0, 0);
                pt[jt] = c;
            }
#pragma unroll
            for (int dir = 0; dir < 2; ++dir) {
                u32x4 bp[2];
                float pv[4][4];
#pragma unroll
                for (int jt = 0; jt < 4; ++jt)
#pragma unroll
                    for (int e = 0; e < 4; ++e) {
                        const int j = 16 * jt + 4 * g + e;
                        const bool ok = dir == 0 ? (j <= i) : (j >= i);
                        const float dl = dir == 0 ? (e0 - gj0[jt][e]) : (e1 - gj1[jt][e]);
                        pv[jt][e] = ok ? pt[jt][e] * __expf(dl) : 0.f;
                    }
#pragma unroll
                for (int k2 = 0; k2 < 2; ++k2) { bp[k2].x = pkbf(pv[2 * k2][0], pv[2 * k2][1]); bp[k2].y = pkbf(pv[2 * k2][2], pv[2 * k2][3]); bp[k2].z = pkbf(pv[2 * k2 + 1][0], pv[2 * k2 + 1][1]); bp[k2].w = pkbf(pv[2 * k2 + 1][2], pv[2 * k2 + 1][3]); }
                const bf16_t* vt = VT + (dir == 0 ? U0 : U1);
#pragma unroll
                for (int dt = 0; dt < 4; ++dt)
#pragma unroll
                    for (int k2 = 0; k2 < 2; ++k2) {
                        const u32x2 lo = *(const u32x2*)(vt + (16 * dt + r) * 64 + 32 * k2 + 4 * g);
                        const u32x2 hi = *(const u32x2*)(vt + (16 * dt + r) * 64 + 32 * k2 + 16 + 4 * g);
                        const u32x4 av = (u32x4){lo.x, lo.y, hi.x, hi.y};
                        o[dt] = __builtin_amdgcn_mfma_f32_16x16x32_bf16(__builtin_bit_cast(bf16x8, av), __builtin_bit_cast(bf16x8, bp[k2]), o[dt], 0, 0, 0);
                    }
            }
            float ss = 0.f;
#pragma unroll
            for (int dt = 0; dt < 4; ++dt) ss += (o[dt][0] * o[dt][0] + o[dt][1] * o[dt][1]) + (o[dt][2] * o[dt][2] + o[dt][3] * o[dt][3]);
            ss += __shfl_xor(ss, 16); ss += __shfl_xor(ss, 32);
            const float rstd = 1.0f / sqrtf(ss * (1.f / 64.f) + EPS);
#pragma unroll
            for (int dt = 0; dt < 4; ++dt) {
                const u32x2 zz = *(const u32x2*)(PX + (size_t)(row0 + i) * INP + C_DZ + h * 64 + 16 * dt + 4 * g);
                const float z0 = bf2f(zz.x & 0xffffu), z1 = bf2f(zz.x >> 16), z2 = bf2f(zz.y & 0xffffu), z3 = bf2f(zz.y >> 16);
                u32x2 w; w.x = pkbf(o[dt][0] * rstd * ngv[dt][0] * silu_f(z0), o[dt][1] * rstd * ngv[dt][1] * silu_f(z1));
                w.y = pkbf(o[dt][2] * rstd * ngv[dt][2] * silu_f(z2), o[dt][3] * rstd * ngv[dt][3] * silu_f(z3));
                *(u32x2*)(ACT + (size_t)(row0 + i) * D + 256 + h * 64 + 16 * dt + 4 * g) = w;
            }
        }
    }
}

constexpr size_t RT_EID = WS_ROUTE, RT_GATE = WS_ROUTE + 128 * 1024, RT_TSLOT = WS_ROUTE + 256 * 1024, RT_BCNT = WS_ROUTE + 384 * 1024, RT_TILEE = WS_ROUTE + 400 * 1024, RT_NT = WS_ROUTE + 404 * 1024;
constexpr size_t WS_XS = WS_BIG;
constexpr size_t WS_HM = 314 * MiB;
constexpr int MOE_CH = 112;
static_assert(WS_XS + (size_t)36864 * 2048 <= WS_HM && WS_HM + (size_t)MOE_CH * 256 * DFE * 2 <= WS_END, "moe map");

__device__ __forceinline__ void norm2_router_phase(Frame& F, const Args& A) {
    const float* mod = (const float*)(F.ws + WS_MOD) + (1 * 2 + 0) * 6144;
    const float* shift = mod + 3 * 1024; const float* scale = mod + 4 * 1024;
    bf16_t* act = (bf16_t*)(F.ws + WS_ACT);
    int* EID = (int*)(F.ws + RT_EID); float* GATE = (float*)(F.ws + RT_GATE); int* BCNT = (int*)(F.ws + RT_BCNT);
    const float* rw = A.in[I_ROUTER];
    LAS int* se = (LAS int*)F.lds;
    const int lane = F.lane;
    for (int k = 0; k < 8; ++k) {
        const int tl = F.wave * 8 + k, t = blockIdx.x * 64 + tl;
        const GAS f32x4* xr = (const GAS f32x4*)(A.out + (size_t)t * D) + lane;
        f32x4 v[4]; float s = 0.f;
#pragma unroll
        for (int j = 0; j < 4; ++j) { v[j] = xr[64 * j]; s += (v[j].x * v[j].x + v[j].y * v[j].y) + (v[j].z * v[j].z + v[j].w * v[j].w); }
        const float rstd = 1.0f / sqrtf(wave_sum(s) * (1.f / D) + EPS);
        float lg[8];
#pragma unroll
        for (int e = 0; e < 8; ++e) lg[e] = 0.f;
        GAS u32x2* o8 = (GAS u32x2*)(act + (size_t)t * D) + lane;
#pragma unroll
        for (int j = 0; j < 4; ++j) {
            const f32x4 sh = ((const GAS f32x4*)shift)[lane + 64 * j], sc = ((const GAS f32x4*)scale)[lane + 64 * j];
            const f32x4 y = v[j] * rstd * (sc + 1.0f) + sh;
            u32x2 w; w.x = pk2(y.x, y.y); w.y = pk2(y.z, y.w); o8[64 * j] = w;
            const int c0 = 4 * (lane + 64 * j);
#pragma unroll
            for (int q = 0; q < 4; ++q) {
                const f32x4 r0 = *(const GAS f32x4*)(rw + (size_t)(c0 + q) * 8), r1 = *(const GAS f32x4*)(rw + (size_t)(c0 + q) * 8 + 4);
                const float yy = y[q];
                lg[0] += yy * r0.x; lg[1] += yy * r0.y; lg[2] += yy * r0.z; lg[3] += yy * r0.w; lg[4] += yy * r1.x; lg[5] += yy * r1.y; lg[6] += yy * r1.z; lg[7] += yy * r1.w;
            }
        }
#pragma unroll
        for (int e = 0; e < 8; ++e) lg[e] = wave_sum(lg[e]);
        int e0 = 0; float l0 = lg[0];
#pragma unroll
        for (int e = 1; e < 8; ++e) if (lg[e] > l0) { l0 = lg[e]; e0 = e; }
        int e1 = -1; float l1 = -INFINITY;
#pragma unroll
        for (int e = 0; e < 8; ++e) if (e != e0 && lg[e] > l1) { l1 = lg[e]; e1 = e; }
        if (lane == 0) {
            const float g0 = 1.0f / (1.0f + expf(l1 - l0));
            EID[t * 2] = e0; EID[t * 2 + 1] = e1; GATE[t * 2] = g0; GATE[t * 2 + 1] = 1.0f - g0;
            se[tl * 2] = e0; se[tl * 2 + 1] = e1;
        }
    }
    __syncthreads();
    if (F.wave == 0) {
        const int a0 = se[lane * 2], a1 = se[lane * 2 + 1];
#pragma unroll
        for (int e = 0; e < 8; ++e) { const unsigned long long mk = __ballot(a0 == e || a1 == e); if (lane == e) BCNT[blockIdx.x * 8 + e] = __popcll(mk); }
    }
    __syncthreads();
}

__device__ __forceinline__ void moe_assign_phase(Frame& F) {
    const int* EID = (const int*)(F.ws + RT_EID); int* TSLOT = (int*)(F.ws + RT_TSLOT); const int* BCNT = (const int*)(F.ws + RT_BCNT);
    unsigned* TILEE = (unsigned*)(F.ws + RT_TILEE); unsigned* NTL = (unsigned*)(F.ws + RT_NT);
    const bf16_t* act = (const bf16_t*)(F.ws + WS_ACT); bf16_t* XS = (bf16_t*)(F.ws + WS_XS);
    LAS int* sm = (LAS int*)F.lds;
    const int b = blockIdx.x, lane = F.lane;
    if (F.tid < 8) {
        int tot = 0, mine = 0;
        for (int bb = 0; bb < 256; ++bb) { const int c = __hip_atomic_load(BCNT + bb * 8 + F.tid, RLX_AGENT); if (bb < b) mine += c; tot += c; }
        sm[F.tid] = tot; sm[8 + F.tid] = mine;
    }
    __syncthreads();
    if (F.tid == 0) {
        int ps = 0, nt = 0;
        for (int e = 0; e < 8; ++e) { const int tl = (sm[e] + 255) >> 8; sm[16 + e] = ps; sm[24 + e] = tl; if (b == 0) for (int q = 0; q < tl; ++q) TILEE[nt + q] = (unsigned)e; ps += tl * 256; nt += tl; }
        if (b == 0) *NTL = (unsigned)nt;
    }
    __syncthreads();
    if (F.wave == 0) {
        const int t = b * 64 + lane;
        const int a0 = EID[t * 2], a1 = EID[t * 2 + 1];
        int s0 = 0, s1 = 0;
        const unsigned long long lower = (1ull << lane) - 1ull;
#pragma unroll
        for (int e = 0; e < 8; ++e) {
            const unsigned long long mk = __ballot(a0 == e || a1 == e);
            const int rank = __popcll(mk & lower), slot = sm[16 + e] + sm[8 + e] + rank;
            if (a0 == e) s0 = slot; if (a1 == e) s1 = slot;
        }
        TSLOT[t * 2] = s0; TSLOT[t * 2 + 1] = s1; sm[32 + lane * 2] = s0; sm[33 + lane * 2] = s1;
    }
    __syncthreads();
    for (int q = F.wave; q < 128; q += NWAVES) {
        const int t = b * 64 + (q >> 1), slot = sm[32 + q];
        const GAS u32x4* srcp = (const GAS u32x4*)(act + (size_t)t * D); GAS u32x4* dstp = (GAS u32x4*)(XS + (size_t)slot * D);
        dstp[lane] = srcp[lane]; dstp[lane + 64] = srcp[lane + 64];
    }
    { const int e = b & 7, cnt = sm[e], first = sm[16 + e] + cnt, npad = sm[24 + e] * 256 - cnt;
      for (int p = (b >> 3) * NWAVES + F.wave; p < npad; p += 32 * NWAVES) { GAS u32x4* dstp = (GAS u32x4*)(XS + (size_t)(first + p) * D); const u32x4 z = (u32x4){0u, 0u, 0u, 0u}; dstp[lane] = z; dstp[lane + 64] = z; } }
}

__device__ __forceinline__ void moe_final_phase(Frame& F, const Args& A) {
    const float* mod5 = (const float*)(F.ws + WS_MOD) + (1 * 2 + 0) * 6144 + 5 * 1024;
    const int* TSLOT = (const int*)(F.ws + RT_TSLOT); const float* GATE = (const float*)(F.ws + RT_GATE);
    const bf16_t* Y = (const bf16_t*)(F.ws + WS_XS);
    const float* fng = A.in[I_FNG];
    const int lane = F.lane;
    for (int t = F.gw; t < NL; t += F.NGW) {
        const int s0 = TSLOT[t * 2], s1 = TSLOT[t * 2 + 1]; const float g0 = GATE[t * 2], g1 = GATE[t * 2 + 1];
        GAS f32x4* xr = (GAS f32x4*)(A.out + (size_t)t * D) + lane;
        const GAS u32x2* y0 = (const GAS u32x2*)(Y + (size_t)s0 * D) + lane; const GAS u32x2* y1 = (const GAS u32x2*)(Y + (size_t)s1 * D) + lane;
        f32x4 v[4]; float s = 0.f;
#pragma unroll
        for (int j = 0; j < 4; ++j) {
            const f32x4 x = xr[64 * j]; const u32x2 a = y0[64 * j], c = y1[64 * j];
            const f32x4 m5 = ((const GAS f32x4*)mod5)[lane + 64 * j];
            f32x4 f;
            f.x = g0 * bf2f(a.x & 0xffffu) + g1 * bf2f(c.x & 0xffffu); f.y = g0 * bf2f(a.x >> 16) + g1 * bf2f(c.x >> 16);
            f.z = g0 * bf2f(a.y & 0xffffu) + g1 * bf2f(c.y & 0xffffu); f.w = g0 * bf2f(a.y >> 16) + g1 * bf2f(c.y >> 16);
            v[j] = x + m5 * f;
            s += (v[j].x * v[j].x + v[j].y * v[j].y) + (v[j].z * v[j].z + v[j].w * v[j].w);
        }
        const float rstd = 1.0f / sqrtf(wave_sum(s) * (1.f / D) + EPS);
#pragma unroll
        for (int j = 0; j < 4; ++j) { const f32x4 gg = ((const GAS f32x4*)fng)[lane + 64 * j]; xr[64 * j] = v[j] * rstd * gg; }
    }
}

#define GRID_BAR() do { { unsigned* bp_ = (unsigned*)(F.ws + WS_CTL) + 4096; asm volatile("" : "+s"(bp_)); bar.bar = bp_; } xcd_barrier(bar); F.tid = opq((int)threadIdx.x); F.lane = F.tid & 63; } while (0)

#ifndef STOP_AFTER
#define STOP_AFTER 0
#endif
__device__ __forceinline__ void dump_bf16(Frame& F, float* out, const bf16_t* buf, int ld, int ncols) {
    for (int m = F.gw; m < NL; m += F.NGW)
        for (int j = 0; j < 16; ++j) { const int c = F.lane + 64 * j; float s = 0.f; for (int k = 0; c + 1024 * k < ncols; ++k) s += bf2f(buf[(size_t)m * ld + c + 1024 * k]); out[(size_t)m * D + c] = s; }
}
#define STOP_DUMP(n, buf, ld, nc) do { if (layer == 0 && STOP_AFTER == (n)) { dump_bf16(F, args.out, (const bf16_t*)(buf), (ld), (nc)); F.ws = nullptr; return; } } while (0)
template <int layer>
__device__ __forceinline__ void layer_body(Frame& F, const Args& args, XcdBarrier& bar) {
    unsigned char* ws = F.ws;
    float* HC = (float*)(ws + WS_HC);
    const float* MOD = (const float*)(ws + WS_MOD);
        F.tid = opq((int)threadIdx.x); F.lane = F.tid & 63;
        const float* xl = layer == 0 ? args.in[I_X] : args.out;
        const float* xc = layer == 0 ? args.in[I_CTX] : HC;
        const float* modx = MOD + (layer * 2 + 0) * 6144; const float* modc = MOD + (layer * 2 + 1) * 6144;
        norm_phase(F, xl, xc, layer, 0, 1, NT);
        GRID_BAR();
        { pg8::DenseSched S{NT / 256, INP / 256, F.G, (int)blockIdx.x, (const char*)(ws + WS_ACT), (const char*)(ws + WS_WIN) + (size_t)layer * INP * 1024 * 2, (size_t)256 * 1024 * 2};
          pg8::EpiStoreBf16 E{(bf16_t*)(ws + WS_PX), INP};
          pg8::gemm_phase(F.lds, 1024, S, E); }
        GRID_BAR();
        STOP_DUMP(2, ws + WS_PX, INP, INC);
        prep_phase(F, args, layer);
        GRID_BAR();
        STOP_DUMP(3, ws + WS_QD, 384, 384);
        STOP_DUMP(33, ws + WS_QD + QKV_STRIDE, 384, 384);
        dn_chunk_phase(F);
        GRID_BAR();
        STOP_DUMP(4, ws + WS_DN, 1024, 1024);
        STOP_DUMP(44, ws + WS_DN + DN_STRIDE, 1024, 1024);
        STOP_DUMP(45, ws + WS_DN + 2 * DN_STRIDE, 1024, 1024);
        scan_attn_phase(F, args, layer);
        GRID_BAR();
        STOP_DUMP(5, ws + WS_DN + 3 * DN_STRIDE, 1024, 1024);
        STOP_DUMP(55, ws + WS_DN + 4 * DN_STRIDE, 1024, 1024);
        STOP_DUMP(56, ws + WS_ACT, 1024, 1024);
        dn_out_phase(F, args, layer);
        GRID_BAR();
        STOP_DUMP(6, ws + WS_ACT, 1024, 1024);
        { pg8::DenseSched S{layer == 0 ? NT / 256 : NL / 256, 4, F.G, (int)blockIdx.x, (const char*)(ws + WS_ACT), (const char*)(ws + WS_WOUT) + (size_t)layer * 1024 * 1024 * 2, (size_t)256 * 1024 * 2};
          pg8::EpiResid E{xl, args.out, modx + 2 * 1024, xc, HC, modc + 2 * 1024, NL / 256};
          pg8::gemm_phase(F.lds, 1024, S, E); }
        GRID_BAR();
        if (layer == 0 && STOP_AFTER == 7) { F.ws = nullptr; return; }
        if (layer == 0) {
            norm_phase(F, args.out, HC, 0, 3, 4, NT);
            GRID_BAR();
            { pg8::DenseSched S{NT / 256, 2 * DFF / 256, F.G, (int)blockIdx.x, (const char*)(ws + WS_ACT), (const char*)(ws + WS_WGU), (size_t)256 * 1024 * 2};
              pg8::EpiSwiGLU E{(bf16_t*)(ws + WS_BIG), DFF};
              pg8::gemm_phase(F.lds, 1024, S, E); }
            GRID_BAR();
            { pg8::DenseSched S{NT / 256, 4, F.G, (int)blockIdx.x, (const char*)(ws + WS_BIG), (const char*)(ws + WS_WDN), (size_t)256 * DFF * 2};
              pg8::EpiResid E{args.out, args.out, modx + 5 * 1024, HC, HC, modc + 5 * 1024, NL / 256};
              pg8::gemm_phase(F.lds, DFF, S, E); }
            GRID_BAR();
            if (STOP_AFTER == 9) { F.ws = nullptr; return; }
        } else {
            norm2_router_phase(F, args);
            GRID_BAR();
            moe_assign_phase(F);
            GRID_BAR();
            const int ntl = (int)__builtin_amdgcn_readfirstlane(__hip_atomic_load((unsigned*)(ws + RT_NT), RLX_AGENT));
#pragma unroll 1
            for (int t0 = 0; t0 < ntl; t0 += MOE_CH) {
                const int nM = (ntl - t0) < MOE_CH ? (ntl - t0) : MOE_CH;
                { pg8::MoeSched S{nM, 2 * DFE / 256, F.G, (int)blockIdx.x, (const char*)(ws + WS_XS) + (size_t)t0 * 256 * 1024 * 2, (const char*)(ws + WS_MGU), (size_t)256 * 1024 * 2, (size_t)2 * DFE * 1024 * 2, (const unsigned*)(ws + RT_TILEE), t0, 0};
                  pg8::EpiSwiGLU E{(bf16_t*)(ws + WS_HM), DFE};
                  pg8::gemm_phase(F.lds, 1024, S, E); }
                GRID_BAR();
                { pg8::MoeSched S{nM, 4, F.G, (int)blockIdx.x, (const char*)(ws + WS_HM), (const char*)(ws + WS_MDN), (size_t)256 * DFE * 2, (size_t)1024 * DFE * 2, (const unsigned*)(ws + RT_TILEE), t0, t0};
                  pg8::EpiStoreBf16 E{(bf16_t*)(ws + WS_XS), 1024};
                  pg8::gemm_phase(F.lds, DFE, S, E); }
                GRID_BAR();
            }
            moe_final_phase(F, args);
        }
    }

__global__ void __launch_bounds__(NTHREADS, 2) fwd_kernel(Args args) {
    extern __shared__ __attribute__((aligned(16))) unsigned char lds[];
    Frame F;
    F.lds = (LAS unsigned char*)lds;
    F.tid = threadIdx.x; F.lane = F.tid & 63; F.wave = __builtin_amdgcn_readfirstlane(F.tid >> 6);
    F.G = gridDim.x; { const int bx = blockIdx.x; F.vcu = (F.G % 8 == 0) ? (bx % 8) * (F.G / 8) + bx / 8 : bx; }
    F.gw = F.vcu * NWAVES + F.wave; F.NGW = F.G * NWAVES;
    F.ws = args.ws;
    volatile LAS unsigned* MISC = (volatile LAS unsigned*)(F.lds + MISC_OFF);
    for (int u = F.tid; u < (LDS_BYTES - MISC_OFF) / 4; u += NTHREADS) ((LAS unsigned*)(F.lds + MISC_OFF))[u] = 0u;
    __syncthreads();
    XcdBarrier bar = xcd_barrier_post((unsigned*)(F.ws + WS_CTL) + 4096, MISC + 8);

    unsigned char* ws = F.ws;
    float* HC = (float*)(ws + WS_HC);
    const float* MOD = (const float*)(ws + WS_MOD);
#ifdef DIAG_ZERO
    { GAS u32x4* p = (GAS u32x4*)(F.ws + WS_MOD); const size_t n16 = (WS_END - WS_MOD) / 16; const u32x4 z = (u32x4){0u, 0u, 0u, 0u};
      for (size_t i = (size_t)blockIdx.x * NTHREADS + F.tid; i < n16; i += (size_t)F.G * NTHREADS) p[i] = z; }
    GRID_BAR();
#endif
    p0_prologue(F, args);
    GRID_BAR();
    layer_body<0>(F, args, bar);
    if (F.ws == nullptr) return;
    layer_body<1>(F, args, bar);
}

extern "C" void kernel_launch(void* const* d_in, const int* in_sizes, int n_in, void* d_out, int out_size, void* d_ws, size_t ws_size, hipStream_t stream) {
    static int grid = 0;
    if (grid == 0) {
        if (n_in != 22 || out_size != NL * D || ws_size < WS_END) { fprintf(stderr, "kernel_launch: unexpected shapes (n_in %d out %d ws %zu)\n", n_in, out_size, ws_size); grid = -1; return; }
        int dev = 0, cus = 0;
        if (hipGetDevice(&dev) != hipSuccess || hipDeviceGetAttribute(&cus, hipDeviceAttributeMultiprocessorCount, dev) != hipSuccess) { grid = -1; return; }
        if (hipFuncSetAttribute((const void*)fwd_kernel, hipFuncAttributeMaxDynamicSharedMemorySize, LDS_BYTES) != hipSuccess) { fprintf(stderr, "kernel_launch: hipFuncSetAttribute failed\n"); grid = -1; return; }
        int per_cu = 0;
        (void)hipOccupancyMaxActiveBlocksPerMultiprocessor(&per_cu, (const void*)fwd_kernel, NTHREADS, LDS_BYTES);
        (void)hipGetLastError();
        grid = cus;
    }
    if (grid < 0) return;
    (void)hipMemsetAsync((char*)d_ws + WS_CTL, 0, CTL_ZERO_BYTES, stream);
    Args a{};
    for (int i = 0; i < 22; ++i) a.in[i] = (const float*)d_in[i];
    a.out = (float*)d_out; a.ws = (unsigned char*)d_ws;
    hipLaunchKernelGGL(fwd_kernel, dim3(grid), dim3(NTHREADS), LDS_BYTES, stream, a);
}
```

```cpp
#define STOP_AFTER 0
#include <hip/hip_runtime.h>
#include <cstdint>
#include <cstdio>

#define GAS __attribute__((address_space(1)))
#define LAS __attribute__((address_space(3)))
typedef unsigned short bf16_t;
typedef short bf16x8 __attribute__((ext_vector_type(8)));
typedef short bf16x4 __attribute__((ext_vector_type(4)));
typedef float f32x4 __attribute__((ext_vector_type(4)));
typedef float f32x2 __attribute__((ext_vector_type(2)));
typedef unsigned u32x4 __attribute__((ext_vector_type(4)));
typedef unsigned u32x2 __attribute__((ext_vector_type(2)));
typedef GAS unsigned gu32;

constexpr int D = 1024, NL = 16384, NC = 256, NT = NL + NC;
constexpr int INC = 2968, INP = 3072;
constexpr int C_CB = 0, C_CC = 256, C_CH = 512, C_DQ = 768, C_DK = 1152, C_DV = 1536, C_DZ = 1920, C_DA = 2304, C_DB = 2316, C_AQ = 2328, C_AK = 2712, C_AV = 2840;
constexpr int DFF = 2816, NEXP = 8, DFE = 3584;
constexpr int NWAVES = 8, NTHREADS = 512;
constexpr float EPS = 1e-6f;

constexpr size_t MiB = 1u << 20;
constexpr size_t WS_CTL = 0, CTL_ZERO_BYTES = 1 * MiB;
constexpr size_t WS_MOD = 1 * MiB;
constexpr size_t WS_ROPE = 1 * MiB + 128 * 1024;
constexpr size_t WS_HC = 2 * MiB;
constexpr size_t WS_G = 3 * MiB;
constexpr size_t WS_BETA = 4 * MiB;
constexpr size_t WS_ROUTE = 5 * MiB;
constexpr size_t WS_WIN = 8 * MiB;
constexpr size_t WS_WOUT = 20 * MiB;
constexpr size_t WS_WGU = 24 * MiB;
constexpr size_t WS_WDN = 35 * MiB;
constexpr size_t WS_MGU = 41 * MiB;
constexpr size_t WS_MDN = 153 * MiB;
constexpr size_t WS_ACT = 209 * MiB;
constexpr size_t WS_BIG = 242 * MiB;
constexpr size_t WS_PX = WS_BIG;
constexpr size_t WS_QD = 340 * MiB;
constexpr size_t QKV_STRIDE = 12 * MiB + 512 * 1024;
constexpr size_t WS_DN = 378 * MiB;
constexpr size_t DN_STRIDE = 25 * MiB;
constexpr size_t WS_END = 512 * MiB;
static_assert(WS_QD + 3 * QKV_STRIDE <= WS_DN && WS_DN + 5 * DN_STRIDE <= WS_END, "ws map");
static_assert((size_t)NT * INP * 2 <= WS_QD - WS_PX && (size_t)NT * 384 * 2 <= QKV_STRIDE && (size_t)3120 * 8192 <= DN_STRIDE, "ws map 2");

constexpr int SCR_BYTES = 139264;
constexpr int MISC_OFF = SCR_BYTES;
constexpr int LDS_BYTES = 147456;

#define RLX_AGENT __ATOMIC_RELAXED, __HIP_MEMORY_SCOPE_AGENT
#define LDS_WAIT() asm volatile("s_waitcnt lgkmcnt(0)" ::: "memory")
#define VM_WAIT() asm volatile("s_waitcnt vmcnt(0)" ::: "memory")

__device__ __forceinline__ unsigned f2bf(float f) { unsigned u = __builtin_bit_cast(unsigned, f); return (u + 0x7fffu + ((u >> 16) & 1u)) >> 16; }
__device__ __forceinline__ unsigned pk2(float lo, float hi) { return f2bf(lo) | (f2bf(hi) << 16); }
__device__ __forceinline__ float bf2f(unsigned h) { return __builtin_bit_cast(float, h << 16); }
__device__ __forceinline__ unsigned pk_fp8x4(float a, float b, float c, float d) {
    a = __builtin_fminf(__builtin_fmaxf(a, -448.f), 448.f); b = __builtin_fminf(__builtin_fmaxf(b, -448.f), 448.f);
    c = __builtin_fminf(__builtin_fmaxf(c, -448.f), 448.f); d = __builtin_fminf(__builtin_fmaxf(d, -448.f), 448.f);
    int p = __builtin_amdgcn_cvt_pk_fp8_f32(a, b, 0, false); p = __builtin_amdgcn_cvt_pk_fp8_f32(c, d, p, true); return (unsigned)p;
}
__device__ __forceinline__ float silu_f(float x) { return x * __builtin_amdgcn_rcpf(1.f + __expf(-x)); }
__device__ __forceinline__ int opq(int v) { asm volatile("" : "+v"(v)); return v; }
__device__ __forceinline__ float wave_sum_l(float v, int lane) {
#pragma unroll
    for (int o = 1; o < 64; o <<= 1) v += __builtin_bit_cast(float, __builtin_amdgcn_ds_bpermute((lane ^ o) << 2, __builtin_bit_cast(int, v)));
    return v;
}
__device__ __forceinline__ float wave_sum(float v) {
#pragma unroll
    for (int o = 1; o < 64; o <<= 1) v += __shfl_xor(v, o);
    return v;
}

#define XB_TMO      128
#define XB_XCNT(j)  (256  + 64 * (j))
#define XB_XSUB(j)  (1280 + 64 * (j))
#define XB_XGEN(j)  (2304 + 64 * (j))
#define XB_TOP      3328
#define XB_TOPGEN   3392
#define XCD_BAR_WORDS 3456
#define XB_SPIN_CAP (1u << 22)
__device__ __forceinline__ unsigned xb_ld(unsigned* p)              { return __hip_atomic_load(p, __ATOMIC_RELAXED, __HIP_MEMORY_SCOPE_AGENT); }
__device__ __forceinline__ unsigned xb_add(unsigned* p, unsigned v) { return __hip_atomic_fetch_add(p, v, __ATOMIC_RELAXED, __HIP_MEMORY_SCOPE_AGENT); }
__device__ __forceinline__ unsigned xb_xcc_id() { return (unsigned)__builtin_amdgcn_s_getreg((3 << 11) | 20) & 0xFu; }
#define XB_SPIN(cond, bar) do { unsigned _sp = 0; while (cond) { __builtin_amdgcn_s_sleep(1); \
    if ((++_sp & 255u) == 0u) { if (xb_ld(&(bar)[XB_TMO])) break; if (_sp > XB_SPIN_CAP) { atomicAdd(&(bar)[XB_TMO], 1u); break; } } } } while (0)
struct XcdBarrier { unsigned* bar; unsigned x; volatile LAS unsigned* st; };
__device__ __forceinline__ XcdBarrier xcd_barrier_post(unsigned* bar, volatile LAS unsigned* st) {
    XcdBarrier b; b.bar = bar; b.x = xb_xcc_id(); b.st = st;
    if (threadIdx.x == 0) (void)xb_add(&bar[XB_XCNT(b.x)], 1u);
    return b;
}
__device__ __forceinline__ void xcd_barrier_complete(unsigned* bar, unsigned x, unsigned& nloc, unsigned& nx) {
    const unsigned G = gridDim.x * gridDim.y * gridDim.z;
    unsigned sum, cnt, mine, sp = 0u;
    for (;;) {
        sum = 0u; cnt = 0u; mine = 0u;
#pragma unroll
        for (unsigned j = 0; j < 16; ++j) { const unsigned c = xb_ld(&bar[XB_XCNT(j)]); sum += c; cnt += (c > 0u) ? 1u : 0u; mine = (j == x) ? c : mine; }
        if (sum == G) break;
        __builtin_amdgcn_s_sleep(1);
        if ((++sp & 255u) == 0u) { if (xb_ld(&bar[XB_TMO])) break; if (sp > XB_SPIN_CAP) { atomicAdd(&bar[XB_TMO], 1u); break; } }
    }
    nloc = mine > 0u ? mine : 1u; nx = cnt > 0u ? cnt : 1u;
}
__device__ __forceinline__ void xcd_barrier(const XcdBarrier& b) {
    asm volatile("s_waitcnt vmcnt(0)" ::: "memory");
    __syncthreads();
    if (threadIdx.x == 0) {
        unsigned* bar = b.bar;
        __builtin_amdgcn_s_waitcnt(0);
        unsigned nloc = b.st[0], nx = b.st[1];
        if (nloc == 0u) { xcd_barrier_complete(bar, b.x, nloc, nx); b.st[0] = nloc; b.st[1] = nx; }
        const unsigned old = xb_add(&bar[XB_XSUB(b.x)], 1u);
        const unsigned gen = old / nloc;
        if (old + 1u == (gen + 1u) * nloc) {
            __builtin_amdgcn_fence(__ATOMIC_RELEASE, "agent");
            asm volatile("s_waitcnt vmcnt(0)" ::: "memory");
            const unsigned og = xb_add(&bar[XB_TOP], 1u);
            const unsigned tg = og / nx;
            if (og + 1u == (tg + 1u) * nx) xb_add(&bar[XB_TOPGEN], 1u);
            else XB_SPIN(xb_ld(&bar[XB_TOPGEN]) == tg, bar);
            __builtin_amdgcn_fence(__ATOMIC_ACQUIRE, "agent");
            xb_add(&bar[XB_XGEN(b.x)], 1u);
            asm volatile("s_waitcnt vmcnt(0)" ::: "memory");
        } else {
            XB_SPIN(xb_ld(&bar[XB_XGEN(b.x)]) == gen, bar);
            __builtin_amdgcn_fence(__ATOMIC_ACQUIRE, "agent");
            asm volatile("s_waitcnt vmcnt(0)" ::: "memory");
        }
    }
    __syncthreads();
}

#ifdef TS_A
#define TS_STAMP() do { if (blockIdx.x == 0 && threadIdx.x == 0) { volatile LAS unsigned* M_ = (volatile LAS unsigned*)(F.lds + MISC_OFF); const unsigned k_ = M_[12]; const unsigned long long t_ = __builtin_amdgcn_s_memrealtime(); M_[16 + 2 * k_] = (unsigned)t_; M_[17 + 2 * k_] = (unsigned)(t_ >> 32); M_[12] = k_ + 1; } } while (0)
#else
#define TS_STAMP() do {} while (0)
#endif
struct Args { const float* in[22]; float* out; unsigned char* ws; };
enum { I_X = 0, I_C, I_CTX, I_CCTX, I_WMOD, I_BMOD, I_WIN, I_WOUT, I_CONVW, I_DNCONVW, I_ALOG, I_DTB, I_NORMG, I_SINK, I_FG, I_FU, I_FD, I_ROUTER, I_MG, I_MU, I_MD, I_FNG };
struct Frame {
    LAS unsigned char* lds;
    int tid, lane, wave, vcu, G, gw, NGW;
    unsigned char* ws;
};

__device__ __forceinline__ void transpose_item(const float* __restrict__ W, int K, int N, bf16_t* WT, int mode, LAS float* scr, int kb, int nb, int lane) {
    const int k0 = 64 * kb, n0 = 64 * nb;
    const int nn = n0 + lane; const bool ok = nn < N;
    const float* src = W + (size_t)k0 * N + (ok ? nn : 0);
#pragma unroll 8
    for (int i = 0; i < 64; ++i) { float v = src[(size_t)i * N]; scr[i * 65 + lane] = ok ? v : 0.f; }
    LDS_WAIT(); asm volatile("" ::: "memory");
    const int c = lane & 7;
#pragma unroll
    for (int j = 0; j < 8; ++j) {
        const int n = (lane >> 3) + 8 * j; const LAS float* s = scr + (8 * c) * 65 + n;
        u32x4 o; o.x = pk2(s[0 * 65], s[1 * 65]); o.y = pk2(s[2 * 65], s[3 * 65]); o.z = pk2(s[4 * 65], s[5 * 65]); o.w = pk2(s[6 * 65], s[7 * 65]);
        const int ng = n0 + n; int drow = ng;
        if (mode == 1) drow = (ng >> 2) * 8 + (ng & 3); else if (mode == 2) drow = (ng >> 2) * 8 + 4 + (ng & 3);
        *(GAS u32x4*)(WT + (size_t)drow * K + k0 + 8 * c) = o;
    }
    LDS_WAIT(); asm volatile("" ::: "memory");
}

__device__ __forceinline__ void transpose_item8(const float* __restrict__ W, int K, int N, unsigned char* WT, int mode, float wscale, LAS float* scr, int kb, int nb, int lane) {
    const int k0 = 64 * kb, n0 = 64 * nb;
    const float* src = W + (size_t)k0 * N + n0 + lane;
#pragma unroll 8
    for (int i = 0; i < 64; ++i) scr[i * 65 + lane] = src[(size_t)i * N];
    LDS_WAIT(); asm volatile("" ::: "memory");
    const int c = lane & 3;
#pragma unroll
    for (int j = 0; j < 4; ++j) {
        const int n = (lane >> 2) + 16 * j; const LAS float* s = scr + (16 * c) * 65 + n;
        u32x4 o;
        o.x = pk_fp8x4(s[0 * 65] * wscale, s[1 * 65] * wscale, s[2 * 65] * wscale, s[3 * 65] * wscale);
        o.y = pk_fp8x4(s[4 * 65] * wscale, s[5 * 65] * wscale, s[6 * 65] * wscale, s[7 * 65] * wscale);
        o.z = pk_fp8x4(s[8 * 65] * wscale, s[9 * 65] * wscale, s[10 * 65] * wscale, s[11 * 65] * wscale);
        o.w = pk_fp8x4(s[12 * 65] * wscale, s[13 * 65] * wscale, s[14 * 65] * wscale, s[15 * 65] * wscale);
        const int ng = n0 + n; int drow = ng;
        if (mode == 1) drow = (ng >> 2) * 8 + (ng & 3); else if (mode == 2) drow = (ng >> 2) * 8 + 4 + (ng & 3);
        *(GAS u32x4*)(WT + (size_t)drow * K + k0 + 16 * c) = o;
    }
    LDS_WAIT(); asm volatile("" ::: "memory");
}
constexpr float MOE_WSCALE = 64.0f, MOE_HSCALE = 8.0f;
__device__ __forceinline__ void p0_prologue(Frame& F, const Args& A) {
    if (blockIdx.x < 192) {
        LAS float* sc = (LAS float*)F.lds;
        for (int i = F.tid; i < 1024; i += NTHREADS) { sc[i] = silu_f(A.in[I_C][i]); sc[1024 + i] = silu_f(A.in[I_CCTX][i]); }
        __syncthreads();
        const int l = blockIdx.x / 96, cg = blockIdx.x % 96;
        const float* W = A.in[I_WMOD] + (size_t)l * 1024 * 6144 + cg * 64 + F.lane;
        float ax = 0.f, ac = 0.f;
        const int kb = F.wave * 128;
#pragma unroll 8
        for (int k = 0; k < 128; ++k) { const float wv = W[(size_t)(kb + k) * 6144]; ax += sc[kb + k] * wv; ac += sc[1024 + kb + k] * wv; }
        LAS float* red = sc + 2048;
        red[F.wave * 64 + F.lane] = ax; red[512 + F.wave * 64 + F.lane] = ac;
        __syncthreads();
        if (F.wave == 0) {
            float sx = 0.f, sc2 = 0.f;
#pragma unroll
            for (int w = 0; w < 8; ++w) { sx += red[w * 64 + F.lane]; sc2 += red[512 + w * 64 + F.lane]; }
            const float b = A.in[I_BMOD][l * 6144 + cg * 64 + F.lane];
            float* mod = (float*)(F.ws + WS_MOD);
            mod[(l * 2 + 0) * 6144 + cg * 64 + F.lane] = sx + b;
            mod[(l * 2 + 1) * 6144 + cg * 64 + F.lane] = sc2 + b;
        }
        __syncthreads();
    } else if (blockIdx.x == 192) {
        float* rope = (float*)(F.ws + WS_ROPE);
        for (int i = F.tid; i < 256 * 16; i += NTHREADS) {
            const int pos = i >> 4, f = i & 15;
            const float inv = powf(10000.0f, -(float)(2 * f) / 32.0f);
            const float ang = (float)pos * inv;
            rope[2 * i] = cosf(ang); rope[2 * i + 1] = sinf(ang);
        }
    }
    LAS float* scr = (LAS float*)(F.lds + F.wave * 16640);
    constexpr int N_WIN = 2 * 16 * 48, N_WOUT = 2 * 16 * 16, N_FG = 16 * 44, N_FD = 44 * 16, N_MG = 8 * 16 * 56, N_MD = 8 * 56 * 16;
    constexpr int NITEMS = N_WIN + N_WOUT + 2 * N_FG + N_FD + 2 * N_MG + N_MD;
    bf16_t* ws16 = (bf16_t*)F.ws;
    for (int it = F.gw; it < NITEMS; it += F.NGW) {
        int r = it;
        if (r < N_WIN) { const int l = r / (16 * 48), q = r % (16 * 48); transpose_item(A.in[I_WIN] + (size_t)l * 1024 * INC, 1024, INC, (bf16_t*)(F.ws + WS_WIN) + (size_t)l * INP * 1024, 0, scr, q / 48, q % 48, F.lane); continue; } r -= N_WIN;
        if (r < N_WOUT) { const int l = r / 256, q = r % 256; transpose_item(A.in[I_WOUT] + (size_t)l * 1024 * 1024, 1024, 1024, (bf16_t*)(F.ws + WS_WOUT) + (size_t)l * 1024 * 1024, 0, scr, q / 16, q % 16, F.lane); continue; } r -= N_WOUT;
        if (r < N_FG) { transpose_item(A.in[I_FG], 1024, DFF, (bf16_t*)(F.ws + WS_WGU), 1, scr, r / 44, r % 44, F.lane); continue; } r -= N_FG;
        if (r < N_FG) { transpose_item(A.in[I_FU], 1024, DFF, (bf16_t*)(F.ws + WS_WGU), 2, scr, r / 44, r % 44, F.lane); continue; } r -= N_FG;
        if (r < N_FD) { transpose_item(A.in[I_FD], DFF, 1024, (bf16_t*)(F.ws + WS_WDN), 0, scr, r / 16, r % 16, F.lane); continue; } r -= N_FD;
        if (r < N_MG) { const int e = r / (16 * 56), q = r % (16 * 56); transpose_item8(A.in[I_MG] + (size_t)e * 1024 * DFE, 1024, DFE, F.ws + WS_MGU + (size_t)e * 2 * DFE * 1024, 1, MOE_WSCALE, scr, q / 56, q % 56, F.lane); continue; } r -= N_MG;
        if (r < N_MG) { const int e = r / (16 * 56), q = r % (16 * 56); transpose_item8(A.in[I_MU] + (size_t)e * 1024 * DFE, 1024, DFE, F.ws + WS_MGU + (size_t)e * 2 * DFE * 1024, 2, MOE_WSCALE, scr, q / 56, q % 56, F.lane); continue; } r -= N_MG;
        { const int e = r / (56 * 16), q = r % (56 * 16); transpose_item8(A.in[I_MD] + (size_t)e * DFE * 1024, DFE, 1024, F.ws + WS_MDN + (size_t)e * 1024 * DFE, 0, MOE_WSCALE, scr, q / 16, q % 16, F.lane); }
    }
    (void)ws16;
}

__device__ __forceinline__ void norm_mod_row(const float* xrow, const float* shift, const float* scale, bf16_t* orow, int lane) {
    const GAS f32x4* xr = (const GAS f32x4*)xrow + lane;
    f32x4 v[4]; float s = 0.f;
#pragma unroll
    for (int j = 0; j < 4; ++j) { v[j] = xr[64 * j]; s += (v[j].x * v[j].x + v[j].y * v[j].y) + (v[j].z * v[j].z + v[j].w * v[j].w); }
    const float rstd = 1.0f / sqrtf(wave_sum(s) * (1.f / D) + EPS);
    GAS u32x2* o8 = (GAS u32x2*)orow + lane;
#pragma unroll
    for (int j = 0; j < 4; ++j) {
        const f32x4 sh = ((const GAS f32x4*)shift)[lane + 64 * j], sc = ((const GAS f32x4*)scale)[lane + 64 * j];
        const f32x4 y = v[j] * rstd * (sc + 1.0f) + sh;
        u32x2 w; w.x = pk2(y.x, y.y); w.y = pk2(y.z, y.w); o8[64 * j] = w;
    }
}
__device__ __forceinline__ void norm_phase(Frame& F, const float* xl, const float* xc, int layer, int s_shift, int s_scale, int nrows) {
    const float* mod = (const float*)(F.ws + WS_MOD);
    const float* mx = mod + (layer * 2 + 0) * 6144; const float* mc = mod + (layer * 2 + 1) * 6144;
    bf16_t* act = (bf16_t*)(F.ws + WS_ACT);
#pragma unroll 4
    for (int m = F.gw; m < nrows; m += F.NGW) {
        if (m < NL) norm_mod_row(xl + (size_t)m * D, mx + s_shift * 1024, mx + s_scale * 1024, act + (size_t)m * D, F.lane);
        else norm_mod_row(xc + (size_t)(m - NL) * D, mc + s_shift * 1024, mc + s_scale * 1024, act + (size_t)m * D, F.lane);
    }
}

namespace pg8 {
typedef int v8i __attribute__((ext_vector_type(8)));
constexpr int BM = 256, BK = 64, HALF = 128, HTB = HALF * BK * 2, STAGE_BYTES = 8 * HTB, NXCD = 8, WGM = 8;
__host__ __device__ __forceinline__ int lds_byte(int r, int c) { const int st = (r >> 4) * 2 + (c >> 5), rr = r & 15, cc = c & 31, ob = rr * 64 + cc * 2; return st * 1024 + (ob ^ (((ob >> 9) & 1) << 5)); }
__host__ __device__ __forceinline__ void stage_rc(int b, int& R, int& C) { const int st = b / 1024, sb = b % 1024, swz = sb ^ (((sb >> 9) & 1) << 5); R = (st >> 1) * 16 + swz / 64; C = (st & 1) * 32 + (swz % 64) / 2; }
__host__ __device__ __forceinline__ int perm32(int rho) { const int n = rho >> 4, i = rho & 15; return 8 * (i >> 2) + 4 * n + (i & 3); }
struct Unit { int pm, pn; const char* a; const char* b; };
typedef __bf16 bf16x2_t __attribute__((ext_vector_type(2)));
__device__ __forceinline__ unsigned cvt_pk_bf16(float lo, float hi) { f32x2 v = {lo, hi}; bf16x2_t b = __builtin_convertvector(v, bf16x2_t); return __builtin_bit_cast(unsigned, b); }

__device__ __forceinline__ bool tile_order(int i, int G, int c, int nM, int nN, int& pm, int& pn) {
    const int nwg = nM * nN; const long L = (long)i * G + c; if (L >= nwg) return false;
    int wgid = (int)L; { const int q = nwg / NXCD, r = nwg % NXCD, xcd = wgid % NXCD, off = wgid / NXCD; wgid = (xcd < r ? xcd * (q + 1) : r * (q + 1) + (xcd - r) * q) + off; }
    const int nig = WGM * nN, gid = wgid / nig, fm = gid * WGM, gsz = (nM - fm) < WGM ? (nM - fm) : WGM;
    pm = fm + ((wgid % nig) % gsz); pn = (wgid % nig) / gsz; return true;
}
struct DenseSched {
    int nM, nN, G, c; const char* A; const char* B; size_t tstep;
    __device__ __forceinline__ bool next(int i, Unit& u) const {
        int pm, pn; if (!tile_order(i, G, c, nM, nN, pm, pn)) return false;
        u.pm = pm; u.pn = pn; u.a = A + (size_t)pm * tstep; u.b = B + (size_t)pn * tstep; return true;
    }
};
struct MoeSched {
    int nM, nN, G, c; const char* A; const char* B; size_t tstep, estride; const unsigned* tile_e; int t0, pm_off;
    __device__ __forceinline__ bool next(int i, Unit& u) const {
        int pm, pn; if (!tile_order(i, G, c, nM, nN, pm, pn)) return false;
        const unsigned e = __builtin_amdgcn_readfirstlane(__hip_atomic_load(tile_e + t0 + pm, __ATOMIC_RELAXED, __HIP_MEMORY_SCOPE_AGENT)) & 7u;
        u.pm = pm + pm_off; u.pn = pn; u.a = A + (size_t)pm * tstep; u.b = B + (size_t)e * estride + (size_t)pn * tstep; return true;
    }
};

using ::pk_fp8x4;
struct EpiSwiGLU8 {
    static constexpr bool PERM = true;
    unsigned char* H; int ldh; float ascale, hs;
    __device__ __forceinline__ void operator()(const f32x4 (&acc)[2][2][4][2], const Unit& u, int wr, int wc, int fr, int fq) const {
        const int row0 = u.pm * BM + wr * 64 + fr, col0 = u.pn * 128 + wc * 16 + 4 * fq;
#pragma unroll
        for (int ai = 0; ai < 2; ++ai)
#pragma unroll
            for (int m = 0; m < 4; ++m) { unsigned char* rowp = H + (size_t)(row0 + ai * HALF + m * 16) * ldh + col0;
#pragma unroll
                for (int bj = 0; bj < 2; ++bj) { const f32x4 g = acc[ai][bj][m][0] * ascale, up = acc[ai][bj][m][1] * (ascale * hs);
                    float h[4];
#pragma unroll
                    for (int e = 0; e < 4; ++e) h[e] = g[e] * __builtin_amdgcn_rcpf(1.f + __expf(-g[e])) * up[e];
                    *(unsigned*)(rowp + bj * 64) = pk_fp8x4(h[0], h[1], h[2], h[3]); }
                asm volatile("" ::: "memory"); }
    }
};
struct EpiStoreBf16 {
    static constexpr bool PERM = true;
    bf16_t* O; int ldc; float scale = 1.0f;
    __device__ __forceinline__ void operator()(const f32x4 (&acc)[2][2][4][2], const Unit& u, int wr, int wc, int fr, int fq) const {
        const int row0 = u.pm * BM + wr * 64 + fr, col0 = u.pn * BM + wc * 32 + 8 * fq;
#pragma unroll
        for (int ai = 0; ai < 2; ++ai)
#pragma unroll
            for (int m = 0; m < 4; ++m) { bf16_t* rowp = O + (size_t)(row0 + ai * HALF + m * 16) * ldc + col0;
#pragma unroll
                for (int bj = 0; bj < 2; ++bj) { const f32x4 v0 = acc[ai][bj][m][0] * scale, v1 = acc[ai][bj][m][1] * scale;
                    u32x4 w; w.x = cvt_pk_bf16(v0[0], v0[1]); w.y = cvt_pk_bf16(v0[2], v0[3]); w.z = cvt_pk_bf16(v1[0], v1[1]); w.w = cvt_pk_bf16(v1[2], v1[3]);
                    *(u32x4*)(rowp + bj * HALF) = w; } }
    }
};
struct EpiSwiGLU {
    static constexpr bool PERM = true;
    bf16_t* H; int ldh;
    __device__ __forceinline__ void operator()(const f32x4 (&acc)[2][2][4][2], const Unit& u, int wr, int wc, int fr, int fq) const {
        const int row0 = u.pm * BM + wr * 64 + fr, col0 = u.pn * 128 + wc * 16 + 4 * fq;
#pragma unroll
        for (int ai = 0; ai < 2; ++ai)
#pragma unroll
            for (int m = 0; m < 4; ++m) { bf16_t* rowp = H + (size_t)(row0 + ai * HALF + m * 16) * ldh + col0;
#pragma unroll
                for (int bj = 0; bj < 2; ++bj) { const f32x4 g = acc[ai][bj][m][0], up = acc[ai][bj][m][1];
                    float h[4];
#pragma unroll
                    for (int e = 0; e < 4; ++e) h[e] = g[e] * __builtin_amdgcn_rcpf(1.f + __expf(-g[e])) * up[e];
                    u32x2 w; w.x = cvt_pk_bf16(h[0], h[1]); w.y = cvt_pk_bf16(h[2], h[3]);
                    *(u32x2*)(rowp + bj * 64) = w; }
                asm volatile("" ::: "memory"); }
    }
};
struct EpiResid {
    static constexpr bool PERM = false;
    const float* base_l; float* out_l; const float* gate_l; const float* base_c; float* out_c; const float* gate_c; int ctx_tile;
    __device__ __forceinline__ void operator()(const f32x4 (&acc)[2][2][4][2], const Unit& u, int wr, int wc, int fr, int fq) const {
        const bool isc = u.pm >= ctx_tile;
        const float* base = isc ? base_c : base_l; float* out = isc ? out_c : out_l; const float* gate = isc ? gate_c : gate_l;
        const int row0 = (isc ? (u.pm - ctx_tile) : u.pm) * BM + wr * 64 + fr, col0 = u.pn * BM + wc * 32 + 4 * fq;
        f32x4 gv[2][2];
#pragma unroll
        for (int bj = 0; bj < 2; ++bj)
#pragma unroll
            for (int n = 0; n < 2; ++n) gv[bj][n] = *(const f32x4*)(gate + col0 + bj * HALF + n * 16);
#pragma unroll
        for (int ai = 0; ai < 2; ++ai)
#pragma unroll
            for (int m = 0; m < 4; ++m) { const size_t off = (size_t)(row0 + ai * HALF + m * 16) * D + col0;
#pragma unroll
                for (int bj = 0; bj < 2; ++bj)
#pragma unroll
                    for (int n = 0; n < 2; ++n) { const f32x4 bs = *(const f32x4*)(base + off + bj * HALF + n * 16);
                        *(f32x4*)(out + off + bj * HALF + n * 16) = bs + gv[bj][n] * acc[ai][bj][m][n]; } }
    }
};

struct MoeTailSched {
    int ntail, G, c; const char* A; const char* B; size_t tstep, estride; const unsigned* tile_e; int tile0; size_t ksb;
    __device__ __forceinline__ bool next(int i, Unit& u) const {
        const long L = (long)i * G + c; if (L >= (long)ntail * 28) return false;
        const int ks = (int)(L % 7), q = (int)(L / 7), pn = q & 3, tt = q >> 2;
        const unsigned e = __builtin_amdgcn_readfirstlane(__hip_atomic_load(tile_e + tile0 + tt, __ATOMIC_RELAXED, __HIP_MEMORY_SCOPE_AGENT)) & 7u;
        u.pm = q * 7 + ks; u.pn = 0; u.a = A + (size_t)tt * tstep + (size_t)ks * ksb; u.b = B + (size_t)e * estride + (size_t)pn * tstep + (size_t)ks * ksb; return true;
    }
};
struct EpiSlab {
    static constexpr bool PERM = false;
    float* slab; float scale = 1.0f;
    __device__ __forceinline__ void operator()(const f32x4 (&acc)[2][2][4][2], const Unit& u, int wr, int wc, int fr, int fq) const {
        float* base = slab + (size_t)u.pm * 65536 + (size_t)(wr * 64 + fr) * 256 + wc * 32 + 4 * fq;
#pragma unroll
        for (int ai = 0; ai < 2; ++ai)
#pragma unroll
            for (int m = 0; m < 4; ++m)
#pragma unroll
                for (int bj = 0; bj < 2; ++bj)
#pragma unroll
                    for (int n = 0; n < 2; ++n) *(f32x4*)(base + (size_t)(ai * HALF + m * 16) * 256 + bj * HALF + n * 16) = acc[ai][bj][m][n] * scale;
    }
};

template <bool FP8 = false, class Epi, class Sched>
__device__ __forceinline__ void gemm_phase(LAS unsigned char* lds, const int K, const Sched& S, const Epi& E, const int ntk = 0) {
    int tid_ = threadIdx.x; asm volatile("" : "+v"(tid_));
    const int tid = tid_, wid = __builtin_amdgcn_readfirstlane(tid >> 6), lane = tid & 63, wr = wid >> 2, wc = wid & 3, fr = lane & 15, fq = lane >> 4;
    const int nt = ntk ? ntk : K / BK;
    unsigned voffA[2], voffB[2];
#pragma unroll
    for (int i = 0; i < 2; ++i) { int R, C; stage_rc(tid * 16 + i * 8192, R, C); const int Rb = Epi::PERM ? ((R & ~31) + perm32(R & 31)) : R;
        voffA[i] = (unsigned)(R * K + C) * 2u; voffB[i] = (unsigned)(Rb * K + C) * 2u; }
    const size_t kstep = (size_t)(BK * 2);
    const size_t hstep = (size_t)HALF * K * 2;
    const unsigned ldsw = (unsigned)wid * 1024u;
    const int aoff = lds_byte(wr * 64 + fr, fq * 8), boff = lds_byte(wc * 32 + fr, fq * 8);
#define PG8_SA(b, h) (((b) * 2 + (h)) * HTB)
#define PG8_SB(b, h) ((4 + (b) * 2 + (h)) * HTB)
#define PG8_STAGE(bufoff, gbase, voff) do { _Pragma("unroll") for (int _i = 0; _i < 2; ++_i) \
        __builtin_amdgcn_global_load_lds((const unsigned*)((const char*)(gbase) + (voff)[_i]), (LAS unsigned*)(lds + (bufoff) + ldsw + _i * 8192), 16, 0, 0); } while (0)
#define PG8_LDA(dst, b, h) do { _Pragma("unroll") for (int m = 0; m < 4; ++m) _Pragma("unroll") for (int k = 0; k < 2; ++k) dst[m].k[k] = *(const LAS bf16x8*)(lds + PG8_SA(b, h) + aoff + m * 2048 + k * 1024); } while (0)
#define PG8_LDB(dst, b, h) do { _Pragma("unroll") for (int n = 0; n < 2; ++n) _Pragma("unroll") for (int k = 0; k < 2; ++k) dst[n].k[k] = *(const LAS bf16x8*)(lds + PG8_SB(b, h) + boff + n * 2048 + k * 1024); } while (0)
#define PG8_MMA(ai, bj, At, Bt) do { if constexpr (FP8) __builtin_amdgcn_sched_barrier(0); __builtin_amdgcn_s_setprio(1); _Pragma("unroll") for (int m = 0; m < 4; ++m) _Pragma("unroll") for (int n = 0; n < 2; ++n) { \
        if constexpr (FP8) acc[ai][bj][m][n] = __builtin_amdgcn_mfma_scale_f32_16x16x128_f8f6f4(__builtin_bit_cast(v8i, Bt[n]), __builtin_bit_cast(v8i, At[m]), acc[ai][bj][m][n], 0, 0, 0, 127, 0, 127); \
        else { _Pragma("unroll") for (int k = 0; k < 2; ++k) acc[ai][bj][m][n] = __builtin_amdgcn_mfma_f32_16x16x32_bf16(Bt[n].k[k], At[m].k[k], acc[ai][bj][m][n], 0, 0, 0); } } \
        if constexpr (FP8) { _Pragma("unroll") for (int m = 0; m < 4; ++m) _Pragma("unroll") for (int n = 0; n < 2; ++n) asm volatile("" : "+v"(acc[ai][bj][m][n])); } \
        __builtin_amdgcn_s_setprio(0); if constexpr (FP8) __builtin_amdgcn_sched_barrier(0); } while (0)
#define PG8_WAIT_V(n) asm volatile("s_waitcnt vmcnt(" #n ")" ::: "memory")
#define PG8_WAIT_L(n) asm volatile("s_waitcnt lgkmcnt(" #n ")" ::: "memory")
#define PG8_BAR __builtin_amdgcn_s_barrier()
#define PG8_SCHED __builtin_amdgcn_sched_barrier(0)
    Unit cur, nxt; int ui = 0;
    if (!S.next(0, cur)) return;
    f32x4 acc[2][2][4][2];
#pragma unroll
    for (int a = 0; a < 2; ++a)
#pragma unroll
        for (int b = 0; b < 2; ++b)
#pragma unroll
            for (int m = 0; m < 4; ++m)
#pragma unroll
                for (int n = 0; n < 2; ++n) acc[a][b][m][n] = (f32x4){0.f, 0.f, 0.f, 0.f};
    struct Frag { bf16x8 k[2]; };
    Frag At[4], B0[2], B1[2];
    const char* cA = cur.a; const char* cB = cur.b;
    PG8_STAGE(PG8_SB(0, 0), cB, voffB); PG8_STAGE(PG8_SB(0, 1), cB + hstep, voffB); PG8_STAGE(PG8_SA(0, 0), cA, voffA); PG8_STAGE(PG8_SA(0, 1), cA + hstep, voffA);
    if (wr == 1) PG8_BAR;
    PG8_WAIT_V(2); PG8_BAR;
    PG8_STAGE(PG8_SB(1, 0), cB + kstep, voffB); PG8_STAGE(PG8_SA(1, 0), cA + kstep, voffA); PG8_STAGE(PG8_SB(1, 1), cB + hstep + kstep, voffB);
    PG8_WAIT_V(6); PG8_BAR;
    for (;;) {
        const bool has_next = S.next(ui + 1, nxt);
        const char* nA = has_next ? nxt.a : cA; const char* nB = has_next ? nxt.b : cB;
        for (int t = 0; t < nt; t += 2) {
            const bool last = (t == nt - 2);
            const char* a1 = cA + (size_t)(t + 1) * kstep;
            const char* a2 = last ? nA : cA + (size_t)(t + 2) * kstep; const char* b2 = last ? nB : cB + (size_t)(t + 2) * kstep;
            const char* a3 = a2 + kstep; const char* b3 = b2 + kstep;
            PG8_LDB(B0, 0, 0); PG8_LDB(B1, 0, 1); PG8_SCHED; PG8_LDA(At, 0, 0); PG8_STAGE(PG8_SA(1, 1), a1 + hstep, voffA);
            PG8_WAIT_V(8); PG8_WAIT_L(0); PG8_BAR; PG8_MMA(0, 0, At, B0); PG8_MMA(0, 1, At, B1); PG8_BAR; PG8_SCHED;
            PG8_LDA(At, 0, 1); PG8_STAGE(PG8_SB(0, 0), b2, voffB); PG8_STAGE(PG8_SB(0, 1), b2 + hstep, voffB); PG8_STAGE(PG8_SA(0, 0), a2, voffA);
            PG8_WAIT_V(8); PG8_WAIT_L(0); PG8_BAR; PG8_MMA(1, 0, At, B0); PG8_MMA(1, 1, At, B1); PG8_BAR; PG8_SCHED;
            PG8_LDB(B0, 1, 0); PG8_LDB(B1, 1, 1); PG8_SCHED; PG8_LDA(At, 1, 0); PG8_STAGE(PG8_SA(0, 1), a2 + hstep, voffA);
            PG8_WAIT_V(8); PG8_WAIT_L(0); PG8_BAR; PG8_MMA(0, 0, At, B0); PG8_MMA(0, 1, At, B1); PG8_BAR; PG8_SCHED;
            PG8_LDA(At, 1, 1); PG8_STAGE(PG8_SB(1, 0), b3, voffB); PG8_STAGE(PG8_SB(1, 1), b3 + hstep, voffB); PG8_STAGE(PG8_SA(1, 0), a3, voffA);
            PG8_WAIT_V(8); PG8_WAIT_L(0); PG8_BAR; PG8_MMA(1, 0, At, B0); PG8_MMA(1, 1, At, B1); PG8_BAR; PG8_SCHED;
        }
        if (wr == 0) PG8_BAR;
        E(acc, cur, wr, wc, fr, fq);
        if (!has_next) break;
#pragma unroll
        for (int a = 0; a < 2; ++a)
#pragma unroll
            for (int b = 0; b < 2; ++b)
#pragma unroll
                for (int m = 0; m < 4; ++m)
#pragma unroll
                    for (int n = 0; n < 2; ++n) acc[a][b][m][n] = (f32x4){0.f, 0.f, 0.f, 0.f};
        cur = nxt; cA = nA; cB = nB; ++ui;
        if (wr == 1) PG8_BAR;
    }
    PG8_WAIT_V(0);
    PG8_BAR;
#undef PG8_SA
#undef PG8_SB
#undef PG8_STAGE
#undef PG8_LDA
#undef PG8_LDB
#undef PG8_MMA
#undef PG8_WAIT_V
#undef PG8_WAIT_L
#undef PG8_BAR
#undef PG8_SCHED
}
}

constexpr size_t WS_GL = 7 * MiB;
__device__ __forceinline__ float ldbf(const bf16_t* p) { return bf2f(*p); }
__device__ __forceinline__ void unpk8(const u32x4 v, float (&f)[8]) {
    f[0] = bf2f(v.x & 0xffffu); f[1] = bf2f(v.x >> 16); f[2] = bf2f(v.y & 0xffffu); f[3] = bf2f(v.y >> 16);
    f[4] = bf2f(v.z & 0xffffu); f[5] = bf2f(v.z >> 16); f[6] = bf2f(v.w & 0xffffu); f[7] = bf2f(v.w >> 16);
}
__device__ __forceinline__ u32x4 pk8(const float (&f)[8]) { u32x4 o; o.x = pk2(f[0], f[1]); o.y = pk2(f[2], f[3]); o.z = pk2(f[4], f[5]); o.w = pk2(f[6], f[7]); return o; }
__device__ __forceinline__ void prep_phase(Frame& F, const Args& A, int layer) {
    bf16_t* PX = (bf16_t*)(F.ws + WS_PX);
    bf16_t* ACT = (bf16_t*)(F.ws + WS_ACT);
    bf16_t* QD = (bf16_t*)(F.ws + WS_QD); bf16_t* KD = (bf16_t*)(F.ws + WS_QD + QKV_STRIDE); bf16_t* VD = (bf16_t*)(F.ws + WS_QD + 2 * QKV_STRIDE);
    float* Gg = (float*)(F.ws + WS_G); float* Bt = (float*)(F.ws + WS_BETA);
    const float* rope = (const float*)(F.ws + WS_ROPE);
    LAS float* sdw = (LAS float*)F.lds;
    LAS float* scw = sdw + 3 * 1152;
    for (int i = F.tid; i < 3 * 1152; i += NTHREADS) sdw[i] = A.in[I_DNCONVW][layer * 3 * 1152 + i];
    for (int i = F.tid; i < 3 * 256; i += NTHREADS) scw[i] = A.in[I_CONVW][layer * 3 * 256 + i];
    __syncthreads();
    const int lane = F.lane;
    constexpr int RPW = (NT + 2047) / 2048;
    const int mlo = F.gw * RPW, mhi = (mlo + RPW) < NT ? (mlo + RPW) : NT;
    const u32x4 zero4 = (u32x4){0u, 0u, 0u, 0u};
#pragma unroll 3
    for (int m = mlo; m < mhi; ++m) {
        const bool hasp = (m != 0 && m != NL), hasn = (m != NL - 1 && m != NT - 1);
        const bf16_t* r0 = PX + (size_t)m * INP; const bf16_t* rp = r0 - INP; const bf16_t* rn = r0 + INP;
        if (lane < 32) {
            const int c0 = 8 * lane;
            float b[8], c1[8], h1[8], cp[8], hp[8], cn[8], hn[8], o[8];
            unpk8(*(const u32x4*)(r0 + C_CB + c0), b); unpk8(*(const u32x4*)(r0 + C_CC + c0), c1); unpk8(*(const u32x4*)(r0 + C_CH + c0), h1);
            unpk8(hasp ? *(const u32x4*)(rp + C_CC + c0) : zero4, cp); unpk8(hasp ? *(const u32x4*)(rp + C_CH + c0) : zero4, hp);
            unpk8(hasn ? *(const u32x4*)(rn + C_CC + c0) : zero4, cn); unpk8(hasn ? *(const u32x4*)(rn + C_CH + c0) : zero4, hn);
#pragma unroll
            for (int e = 0; e < 8; ++e) o[e] = b[e] * (scw[c0 + e] * (cp[e] * hp[e]) + scw[256 + c0 + e] * (c1[e] * h1[e]) + scw[512 + c0 + e] * (cn[e] * hn[e]));
            *(u32x4*)(ACT + (size_t)m * D + c0) = pk8(o);
        } else if (lane < 56) {
            const int q = lane - 32;
            const float a = bf2f(r0[C_DA + q]);
            if (q < 12) { const float sp = a + A.in[I_DTB][layer * 12 + q]; const float softp = (sp > 20.f) ? sp : __logf(1.0f + __expf(sp)); Gg[(size_t)m * 12 + q] = -__expf(A.in[I_ALOG][layer * 12 + q]) * softp; }
            else Bt[(size_t)m * 12 + (q - 12)] = __builtin_amdgcn_rcpf(1.0f + __expf(-a));
        }
#pragma unroll
        for (int ps = 0; ps < 3; ++ps) {
            const int v = 64 * ps + lane;
            if (ps < 2 || lane < 16) {
                const int c0 = 8 * v, p = c0 / 384;
                float x0[8], x1[8], x2[8], o[8];
                unpk8(hasp ? *(const u32x4*)(rp + C_DQ + c0) : zero4, x0); unpk8(*(const u32x4*)(r0 + C_DQ + c0), x1); unpk8(hasn ? *(const u32x4*)(rn + C_DQ + c0) : zero4, x2);
                float ss = 0.f;
#pragma unroll
                for (int e = 0; e < 8; ++e) { o[e] = silu_f(sdw[c0 + e] * x0[e] + sdw[1152 + c0 + e] * x1[e] + sdw[2304 + c0 + e] * x2[e]); ss += o[e] * o[e]; }
                ss += __shfl_xor(ss, 1); ss += __shfl_xor(ss, 2); ss += __shfl_xor(ss, 4);
                const float sc = p == 2 ? 1.0f : __builtin_amdgcn_rsqf(ss + 1e-6f) * (p == 0 ? 0.125f : 1.0f);
#pragma unroll
                for (int e = 0; e < 8; ++e) o[e] *= sc;
                bf16_t* dst = (p == 0 ? QD : (p == 1 ? KD : VD)) + (size_t)m * 384 + (c0 - p * 384);
                *(u32x4*)dst = pk8(o);
            }
        }
        if (m < NL) {
            const int head = lane >> 3, v8 = lane & 7, axis = v8 >> 2, vv = v8 & 3;
            bf16_t* px = PX + (size_t)m * INP + (head < 6 ? C_AQ + head * 64 : C_AK + (head - 6) * 64) + 8 * v8;
            const u32x4 own = *(const u32x4*)px;
            u32x4 oth; oth.x = __shfl_xor(own.x, 2); oth.y = __shfl_xor(own.y, 2); oth.z = __shfl_xor(own.z, 2); oth.w = __shfl_xor(own.w, 2);
            float a[8], b[8], o[8]; unpk8(own, a); unpk8(oth, b);
            const int pos = axis == 0 ? (m >> 6) : (m & 63);
            const float* rt = rope + (pos * 16 + 8 * (vv & 1)) * 2;
            const float sgn = (vv < 2) ? -1.0f : 1.0f;
#pragma unroll
            for (int e = 0; e < 8; ++e) o[e] = a[e] * rt[2 * e] + sgn * b[e] * rt[2 * e + 1];
            *(u32x4*)px = pk8(o);
        }
    }
    __syncthreads();
}

constexpr int DN_NS = 260, DN_NU = 12 * DN_NS;
__device__ __forceinline__ int dn_row0(int d, int s) {
    if (s < 4) return NL + 64 * (d == 0 ? s : 3 - s);
    return 64 * (d == 0 ? (s - 4) : 255 - (s - 4));
}
__device__ __forceinline__ void pair_bar(volatile LAS unsigned* cnt, unsigned& epoch, int lane) {
    epoch += 2u;
    asm volatile("s_waitcnt vmcnt(0) lgkmcnt(0)" ::: "memory");
    if (lane == 0) __hip_atomic_fetch_add((LAS unsigned*)cnt, 1u, __ATOMIC_RELAXED, __HIP_MEMORY_SCOPE_WORKGROUP);
    while (*cnt < epoch) __builtin_amdgcn_s_sleep(1);
    asm volatile("" ::: "memory");
}
__device__ __forceinline__ void dn_chunk_phase(Frame& F) {
    const bf16_t* KD = (const bf16_t*)(F.ws + WS_QD + QKV_STRIDE); const bf16_t* VD = (const bf16_t*)(F.ws + WS_QD + 2 * QKV_STRIDE);
    const float* Gg = (const float*)(F.ws + WS_G); const float* Bt = (const float*)(F.ws + WS_BETA);
    bf16_t* Wm = (bf16_t*)(F.ws + WS_DN); bf16_t* KDt = (bf16_t*)(F.ws + WS_DN + DN_STRIDE); bf16_t* Ut = (bf16_t*)(F.ws + WS_DN + 2 * DN_STRIDE);
    float* GL = (float*)(F.ws + WS_GL);
    const int gi = F.wave >> 1, wl = F.wave & 1;
    LAS unsigned char* R = F.lds + gi * 18432;
    LAS float* Am = (LAS float*)R;
    LAS float* gcs = Am + 64 * 68; LAS float* bts = gcs + 64;
    volatile LAS unsigned* pcnt = (volatile LAS unsigned*)(R + 17920);
    if (F.tid < 4) *(volatile LAS unsigned*)(F.lds + F.tid * 18432 + 17920) = 0u;
    __syncthreads();
    unsigned epoch = 0u;
#pragma unroll 1
    for (int base = blockIdx.x * 4; base + gi < DN_NU; base += F.G * 4) {
        const int lane = opq(F.lane), r = lane & 15, g = lane >> 4;
        const int U = base + gi; const bool act = U < DN_NU;
        const int dh = act ? U / DN_NS : 0, s = act ? U % DN_NS : 0, d = dh / 6, h = dh % 6;
        const int row0 = dn_row0(d, s);
        const size_t ub = (size_t)U * 4096;
        if (act) {
            if (wl == 0) {
                const int io = d ? 63 - lane : lane;
                float gv = Gg[(size_t)(row0 + io) * 12 + d * 6 + h];
#pragma unroll
                for (int o = 1; o < 64; o <<= 1) { const float t = __shfl_up(gv, o); if (lane >= o) gv += t; }
                gcs[lane] = gv; bts[lane] = Bt[(size_t)(row0 + io) * 12 + d * 6 + h];
                if (lane == 63) GL[U] = expf(gv);
            }
            const bf16_t* tsrc = (wl == 0 ? VD : KD) + (size_t)row0 * 384 + h * 64;
            u32x4 tv[8];
#pragma unroll
            for (int j = 0; j < 8; ++j) tv[j] = *(const u32x4*)(tsrc + (size_t)(8 * j + (lane >> 3)) * 384 + (lane & 7) * 8);
#pragma unroll
            for (int j = 0; j < 8; ++j) *(LAS u32x4*)(R + (1 - wl) * 8192 + (8 * j + (lane >> 3)) * 128 + (lane & 7) * 16) = tv[j];
        }
        pair_bar(pcnt, epoch, lane);
        float x[64];
        if (act) {
            const LAS unsigned char* tb = R + (1 - wl) * 8192 + lane * 2;
            const int rb = d ? 63 * 128 : 0, rs = d ? -128 : 128;
#pragma unroll
            for (int i = 0; i < 64; ++i) x[i] = bf2f(*(const LAS bf16_t*)(tb + rb + i * rs));
            if (wl == 1) {
                const float gcl = gcs[63];
#pragma unroll
                for (int q = 0; q < 8; ++q) { u32x4 o;
                    const int ia = 32 * (q >> 2) + 4 * (q & 3), ib = ia + 16;
                    o.x = pk2(x[ia + 0] * __expf(gcl - gcs[ia + 0]), x[ia + 1] * __expf(gcl - gcs[ia + 1]));
                    o.y = pk2(x[ia + 2] * __expf(gcl - gcs[ia + 2]), x[ia + 3] * __expf(gcl - gcs[ia + 3]));
                    o.z = pk2(x[ib + 0] * __expf(gcl - gcs[ib + 0]), x[ib + 1] * __expf(gcl - gcs[ib + 1]));
                    o.w = pk2(x[ib + 2] * __expf(gcl - gcs[ib + 2]), x[ib + 3] * __expf(gcl - gcs[ib + 3]));
                    *(LAS u32x4*)(R + lane * 128 + ((q ^ (lane & 7)) << 4)) = o; }
#pragma unroll
                for (int j = 0; j < 8; ++j) { const int row = 8 * j + (lane >> 3), c = lane & 7;
                    ((GAS u32x4*)(KDt + ub))[64 * j + lane] = *(const LAS u32x4*)(R + row * 128 + ((c ^ (row & 7)) << 4)); }
#pragma unroll
                for (int i = 0; i < 64; ++i) x[i] *= bts[i] * __expf(gcs[i]);
            } else {
#pragma unroll
                for (int i = 0; i < 64; ++i) x[i] *= bts[i];
            }
        }
        pair_bar(pcnt, epoch, lane);
        if (act) {
            bf16x8 kf[4][2];
#pragma unroll
            for (int jt = 0; jt < 4; ++jt)
#pragma unroll
                for (int ks = 0; ks < 2; ++ks) kf[jt][ks] = *(const bf16x8*)(KD + (size_t)(row0 + 16 * jt + r) * 384 + h * 64 + 32 * ks + 8 * g);
#pragma unroll
            for (int itl = 0; itl < 2; ++itl) {
                const int it = 2 * wl + itl;
#pragma unroll
                for (int jt = 0; jt < 4; ++jt) {
                    f32x4 c = (f32x4){0.f, 0.f, 0.f, 0.f};
                    const bf16x8 a0 = (it == 0 ? kf[0][0] : it == 1 ? kf[1][0] : it == 2 ? kf[2][0] : kf[3][0]);
                    const bf16x8 a1 = (it == 0 ? kf[0][1] : it == 1 ? kf[1][1] : it == 2 ? kf[2][1] : kf[3][1]);
                    c = __builtin_amdgcn_mfma_f32_16x16x32_bf16(a0, kf[jt][0], c, 0, 0, 0);
                    c = __builtin_amdgcn_mfma_f32_16x16x32_bf16(a1, kf[jt][1], c, 0, 0, 0);
                    const int jo = 16 * jt + r, jp = d ? 63 - jo : jo;
#pragma unroll
                    for (int e = 0; e < 4; ++e) {
                        const int io = 16 * it + 4 * g + e, ip = d ? 63 - io : io;
                        Am[ip * 68 + jp] = (jp < ip) ? bts[ip] * c[e] * __expf(gcs[ip] - gcs[jp]) : 0.f;
                    }
                }
            }
        }
        pair_bar(pcnt, epoch, lane);
        if (act) {
#pragma unroll
            for (int b = 0; b < 4; ++b) {
                float acc[16];
#pragma unroll
                for (int ii = 0; ii < 16; ++ii) acc[ii] = 0.f;
#pragma unroll
                for (int j4 = 0; j4 < 4 * b; ++j4) {
#pragma unroll
                    for (int ii = 0; ii < 16; ++ii) {
                        const f32x4 a = *(const LAS f32x4*)(Am + (16 * b + ii) * 68 + 4 * j4);
                        acc[ii] += a.x * x[4 * j4]; acc[ii] += a.y * x[4 * j4 + 1]; acc[ii] += a.z * x[4 * j4 + 2]; acc[ii] += a.w * x[4 * j4 + 3];
                    }
                    if ((j4 & 1) == 1) asm volatile("" ::: "memory");
                }
#pragma unroll
                for (int ii = 0; ii < 16; ++ii) {
                    const int i = 16 * b + ii;
                    float s0 = acc[ii], s1 = 0.f;
#pragma unroll
                    for (int j4 = 0; j4 < (ii + 3) / 4; ++j4) {
                        const f32x4 a = *(const LAS f32x4*)(Am + i * 68 + 16 * b + 4 * j4);
                        s0 += a.x * x[16 * b + 4 * j4]; s1 += a.y * x[16 * b + 4 * j4 + 1]; s0 += a.z * x[16 * b + 4 * j4 + 2]; s1 += a.w * x[16 * b + 4 * j4 + 3];
                    }
                    x[i] -= s0 + s1;
                    if ((ii & 3) == 3) asm volatile("" : "+v"(x[i]) :: "memory");
                }
            }
        }
        pair_bar(pcnt, epoch, lane);
        if (act) {
            if (wl == 0) {
#pragma unroll
                for (int q = 0; q < 8; ++q) { u32x4 o; o.x = pk2(x[8 * q], x[8 * q + 1]); o.y = pk2(x[8 * q + 2], x[8 * q + 3]); o.z = pk2(x[8 * q + 4], x[8 * q + 5]); o.w = pk2(x[8 * q + 6], x[8 * q + 7]);
                    *(LAS u32x4*)(R + lane * 128 + ((q ^ (lane & 7)) << 4)) = o; }
#pragma unroll
                for (int j = 0; j < 8; ++j) { const int row = 8 * j + (lane >> 3), c = lane & 7;
                    ((GAS u32x4*)(Ut + ub))[64 * j + lane] = *(const LAS u32x4*)(R + row * 128 + ((c ^ (row & 7)) << 4)); }
            } else {
                const int kk2 = lane & 31, pc = (lane & 32) + 8 * ((kk2 & 15) >> 2) + 4 * (kk2 >> 4) + (kk2 & 3);
#pragma unroll
                for (int i = 0; i < 64; ++i) *(LAS bf16_t*)(R + 8192 + i * 128 + ((((pc >> 3) ^ (i & 7)) << 4) | ((pc & 7) << 1))) = (bf16_t)f2bf(-x[i]);
#pragma unroll
                for (int j = 0; j < 8; ++j) { const int row = 8 * j + (lane >> 3), c = lane & 7;
                    ((GAS u32x4*)(Wm + ub))[64 * j + lane] = *(const LAS u32x4*)(R + 8192 + row * 128 + ((c ^ (row & 7)) << 4)); }
            }
        }
        pair_bar(pcnt, epoch, lane);
    }
}

constexpr int SC_D = 7, SC_STAGE = 16384, SC_P = 4;
__device__ __forceinline__ unsigned pkbf(float lo, float hi) { return pg8::cvt_pk_bf16(lo, hi); }
__device__ __forceinline__ int sc_off(int row, int col) {
    const int c = col >> 3; return row * 128 + ((c ^ ((row >> 1) & 7)) << 4) + ((col & 4) << 1);
}
constexpr int NSEG = 8;
constexpr size_t WS_SEG = 503 * MiB;
constexpr size_t WS_SST = 507 * MiB;
static_assert(WS_DN + 5 * DN_STRIDE <= WS_SEG && WS_SEG + (size_t)12 * NSEG * 2 * 16384 <= WS_SST && WS_SST + (size_t)12 * NSEG * 16384 <= WS_END, "seg map");
__host__ __device__ constexpr int seg_begin(int s) { return s == 0 ? 0 : 36 + 32 * (s - 1); }
__host__ __device__ constexpr int seg_len(int s) { return s == 0 ? 36 : 32; }
static_assert(seg_begin(NSEG - 1) + seg_len(NSEG - 1) == DN_NS, "segments cover the chain");
template <int MODE>
__device__ __forceinline__ void dn_scan_job(Frame& F, const int dh, const int sg) {
    const int d = dh / 6, lane = F.lane, wave = F.wave, r = lane & 15, g = lane >> 4;
    const int tb = seg_begin(sg), ns = seg_len(sg);
    const unsigned char* srcW = F.ws + WS_DN + ((size_t)dh * DN_NS + tb) * 8192;
    const unsigned char* srcK = srcW + DN_STRIDE; const unsigned char* srcU = srcW + 2 * DN_STRIDE;
    bf16_t* VT = (bf16_t*)(F.ws + WS_DN + 3 * DN_STRIDE) + ((size_t)dh * DN_NS + tb) * 4096;
    bf16_t* ST = (bf16_t*)(F.ws + WS_DN + 4 * DN_STRIDE) + ((size_t)dh * DN_NS + tb) * 4096;
    LAS float* gls = (LAS float*)(F.lds + MISC_OFF + 1024);
    LAS unsigned char* ost = F.lds + SC_D * SC_STAGE + (wave & 3) * 6144;
    { const float* GL = (const float*)(F.ws + WS_GL) + dh * DN_NS + tb; for (int i = F.tid; i < ns; i += NTHREADS) gls[i] = GL[i]; }
    __syncthreads();
#define SC_WAITV(n) asm volatile("s_waitcnt vmcnt(" #n ")" ::: "memory")
#define SC_BAR() do { asm volatile("" ::: "memory"); __builtin_amdgcn_s_barrier(); asm volatile("" ::: "memory"); } while (0)
    if (wave >= 4) {
        const int lw = wave - 4;
        const int lrow = lane >> 3, lc = lane & 7;
#define SC_ISSUE(st) do { const int slot_ = ((st) % SC_D) * SC_STAGE; \
            _Pragma("unroll") for (int e = 0; e < 4; ++e) { \
                const int q = lw * 4 + e, mi = q >> 3, n = q & 7, row = 8 * n + lrow; \
                const unsigned char* mb = (mi == 0 ? srcW : srcK) + (size_t)(st) * 8192; \
                const unsigned char* gp = mb + row * 128 + ((lc ^ ((row >> 1) & 7)) << 4); \
                __builtin_amdgcn_global_load_lds((const unsigned*)gp, (LAS unsigned*)(F.lds + slot_ + mi * 8192 + n * 1024), 16, 0, 0); } } while (0)
        SC_ISSUE(0); SC_ISSUE(1); SC_ISSUE(2); SC_ISSUE(3); SC_ISSUE(4); SC_ISSUE(5);
        SC_WAITV(20); SC_BAR();
        for (int t = 0; t < ns; ++t) {
            if (t + SC_D - 1 < ns) { SC_ISSUE(t + SC_D - 1); SC_WAITV(20); }
            else { SC_WAITV(0); }
            SC_BAR();
        }
    } else {
        f32x4 S[4];
        if (MODE == 0) {
            if (sg == 0) {
#pragma unroll
                for (int t = 0; t < 4; ++t) S[t] = (f32x4){0.f, 0.f, 0.f, 0.f};
            } else {
                const float* seg0 = (const float*)(F.ws + WS_SEG) + (size_t)dh * NSEG * 2 * 4096;
                { const float* q0 = seg0 + 4096 + 16 * wave + r;
#pragma unroll
                  for (int t = 0; t < 4; ++t)
#pragma unroll
                      for (int e2 = 0; e2 < 4; ++e2) S[t][e2] = q0[(16 * t + 4 * g + e2) * 64]; }
#pragma unroll 1
                for (int s = 1; s < sg; ++s) {
                    const float* Pm = seg0 + (size_t)s * 2 * 4096; const float* Qm = Pm + 4096 + 16 * wave + r;
                    u32x4 bsf[2];
#pragma unroll
                    for (int ks = 0; ks < 2; ++ks) { bsf[ks].x = pkbf(S[2 * ks][0], S[2 * ks][1]); bsf[ks].y = pkbf(S[2 * ks][2], S[2 * ks][3]); bsf[ks].z = pkbf(S[2 * ks + 1][0], S[2 * ks + 1][1]); bsf[ks].w = pkbf(S[2 * ks + 1][2], S[2 * ks + 1][3]); }
                    f32x4 Sn[4];
#pragma unroll
                    for (int t = 0; t < 4; ++t) {
                        f32x4 c;
#pragma unroll
                        for (int e2 = 0; e2 < 4; ++e2) c[e2] = Qm[(16 * t + 4 * g + e2) * 64];
#pragma unroll
                        for (int ks = 0; ks < 2; ++ks) {
                            const f32x4 lo = *(const f32x4*)(Pm + (16 * t + r) * 64 + 32 * ks + 4 * g), hi = *(const f32x4*)(Pm + (16 * t + r) * 64 + 32 * ks + 16 + 4 * g);
                            u32x4 a; a.x = pkbf(lo[0], lo[1]); a.y = pkbf(lo[2], lo[3]); a.z = pkbf(hi[0], hi[1]); a.w = pkbf(hi[2], hi[3]);
                            c = __builtin_amdgcn_mfma_f32_16x16x32_bf16(__builtin_bit_cast(bf16x8, a), __builtin_bit_cast(bf16x8, bsf[ks]), c, 0, 0, 0);
                        }
                        Sn[t] = c;
                    }
#pragma unroll
                    for (int t = 0; t < 4; ++t) S[t] = Sn[t];
                }
            }
        } else {
#pragma unroll
            for (int t = 0; t < 4; ++t)
#pragma unroll
                for (int e2 = 0; e2 < 4; ++e2) S[t][e2] = (MODE == 2 && (16 * t + 4 * g + e2) == 16 * wave + r) ? 1.f : 0.f;
        }
        const int dvrow = 16 * wave + r;
        const GAS u32x4* usrc = (const GAS u32x4*)(srcU + wave * 2048) + lane;
        u32x4 uq[SC_P][2];
        if (MODE != 2) {
#pragma unroll
            for (int p = 0; p < SC_P; ++p) { uq[p][0] = usrc[(size_t)p * 512]; uq[p][1] = usrc[(size_t)p * 512 + 64]; }
        }
        SC_BAR();
#define OST_W(base, t_, lo_, hi_) *(LAS u32x2*)(ost + (base) + r * 128 + (((2 * (t_) + (g >> 1)) ^ (r & 7)) << 4) + ((g & 1) << 3)) = (u32x2){lo_, hi_}
        for (int t4 = 0; t4 < ns; t4 += SC_P) {
#pragma unroll
          for (int tp = 0; tp < SC_P; ++tp) {
            const int t = t4 + tp;
            const LAS unsigned char* sb = F.lds + (t % SC_D) * SC_STAGE;
            const float gl = gls[t];
            if (MODE != 2) {
#pragma unroll
                for (int j = 0; j < 2; ++j) { const int row = 8 * j + (lane >> 3), c = lane & 7; *(LAS u32x4*)(ost + 4096 + row * 128 + ((c ^ (row & 7)) << 4)) = uq[tp][j]; }
                if (t + SC_P < ns) { uq[tp][0] = usrc[(size_t)(t + SC_P) * 512]; uq[tp][1] = usrc[(size_t)(t + SC_P) * 512 + 64]; }
            }
            u32x4 bs[2];
#pragma unroll
            for (int ks = 0; ks < 2; ++ks) { bs[ks].x = pkbf(S[2 * ks][0], S[2 * ks][1]); bs[ks].y = pkbf(S[2 * ks][2], S[2 * ks][3]); bs[ks].z = pkbf(S[2 * ks + 1][0], S[2 * ks + 1][1]); bs[ks].w = pkbf(S[2 * ks + 1][2], S[2 * ks + 1][3]); }
            if (MODE == 0) { OST_W(0, 0, bs[0].x, bs[0].y); OST_W(0, 1, bs[0].z, bs[0].w); OST_W(0, 2, bs[1].x, bs[1].y); OST_W(0, 3, bs[1].z, bs[1].w); }
            f32x4 vn[4];
#pragma unroll
            for (int it = 0; it < 4; ++it) {
                f32x4 c = (f32x4){0.f, 0.f, 0.f, 0.f};
                if (MODE != 2) { const u32x2 uu = *(const LAS u32x2*)(ost + 4096 + r * 128 + (((2 * it + (g >> 1)) ^ (r & 7)) << 4) + ((g & 1) << 3));
                    c = (f32x4){bf2f(uu.x & 0xffffu), bf2f(uu.x >> 16), bf2f(uu.y & 0xffffu), bf2f(uu.y >> 16)}; }
#pragma unroll
                for (int ks = 0; ks < 2; ++ks) {
                    const u32x4 a = *(const LAS u32x4*)(sb + sc_off(16 * it + r, 32 * ks + 8 * g));
                    c = __builtin_amdgcn_mfma_f32_16x16x32_bf16(__builtin_bit_cast(bf16x8, a), __builtin_bit_cast(bf16x8, bs[ks]), c, 0, 0, 0);
                }
                vn[it] = c;
            }
            u32x4 bv[2];
#pragma unroll
            for (int ks = 0; ks < 2; ++ks) { bv[ks].x = pkbf(vn[2 * ks][0], vn[2 * ks][1]); bv[ks].y = pkbf(vn[2 * ks][2], vn[2 * ks][3]); bv[ks].z = pkbf(vn[2 * ks + 1][0], vn[2 * ks + 1][1]); bv[ks].w = pkbf(vn[2 * ks + 1][2], vn[2 * ks + 1][3]); }
            if (MODE == 0) {
                if (d == 0) {
                    OST_W(2048, 0, bv[0].x, bv[0].y); OST_W(2048, 1, bv[0].z, bv[0].w); OST_W(2048, 2, bv[1].x, bv[1].y); OST_W(2048, 3, bv[1].z, bv[1].w);
                } else {
#define SC_ROT(a) (((a) >> 16) | ((a) << 16))
#define OST_WR(t_, lo_, hi_) *(LAS u32x2*)(ost + 2048 + r * 128 + (((2 * (3 - (t_)) + ((3 - g) >> 1)) ^ (r & 7)) << 4) + (((3 - g) & 1) << 3)) = (u32x2){SC_ROT(hi_), SC_ROT(lo_)}
                    OST_WR(0, bv[0].x, bv[0].y); OST_WR(1, bv[0].z, bv[0].w); OST_WR(2, bv[1].x, bv[1].y); OST_WR(3, bv[1].z, bv[1].w);
#undef OST_WR
#undef SC_ROT
                }
                GAS u32x4* gst = (GAS u32x4*)(ST + (size_t)t * 4096 + wave * 1024); GAS u32x4* gvt = (GAS u32x4*)(VT + (size_t)t * 4096 + wave * 1024);
#pragma unroll
                for (int j = 0; j < 2; ++j) {
                    const int row = 8 * j + (lane >> 3), c = lane & 7; const int off = row * 128 + ((c ^ (row & 7)) << 4);
                    gst[64 * j + lane] = *(const LAS u32x4*)(ost + off); gvt[64 * j + lane] = *(const LAS u32x4*)(ost + 2048 + off);
                }
            }
#pragma unroll
            for (int tt = 0; tt < 4; ++tt) {
                f32x4 c = S[tt] * gl;
#pragma unroll
                for (int ks = 0; ks < 2; ++ks) {
                    const u32x4 a = *(const LAS u32x4*)(sb + 8192 + sc_off(16 * tt + r, 32 * ks + 8 * g));
                    c = __builtin_amdgcn_mfma_f32_16x16x32_bf16(__builtin_bit_cast(bf16x8, a), __builtin_bit_cast(bf16x8, bv[ks]), c, 0, 0, 0);
                }
                S[tt] = c;
            }
            asm volatile("s_waitcnt lgkmcnt(0)" ::: "memory");
            SC_BAR();
          }
        }
        if (MODE != 0) {
            float* o = (float*)(F.ws + WS_SEG) + ((size_t)(dh * NSEG + sg) * 2 + (MODE == 2 ? 0 : 1)) * 4096 + 16 * wave + r;
#pragma unroll
            for (int t = 0; t < 4; ++t)
#pragma unroll
                for (int e2 = 0; e2 < 4; ++e2) o[(16 * t + 4 * g + e2) * 64] = S[t][e2];
        }
    }
#undef SC_WAITV
#undef OST_W
#undef SC_BAR
#undef SC_ISSUE
    asm volatile("s_waitcnt vmcnt(0) lgkmcnt(0)" ::: "memory");
    __syncthreads();
}
__device__ __forceinline__ void dn_combine(Frame& F, const int dh) {
    const float* SEG = (const float*)(F.ws + WS_SEG) + (size_t)dh * NSEG * 2 * 4096;
    float* SST = (float*)(F.ws + WS_SST) + (size_t)dh * NSEG * 4096;
    LAS float* Sl = (LAS float*)F.lds; LAS float* Pl = Sl + 4096;
    for (int i = F.tid; i < 4096; i += NTHREADS) { const float v = SEG[4096 + i]; Sl[i] = v; SST[4096 + i] = v; }
    __syncthreads();
    const int col = F.tid & 63, dk0 = F.tid >> 6;
    float pre[8], qre[8];
#pragma unroll
    for (int k = 0; k < 8; ++k) { pre[k] = SEG[(size_t)1 * 2 * 4096 + F.tid + NTHREADS * k]; qre[k] = SEG[(size_t)1 * 2 * 4096 + 4096 + (dk0 + 8 * k) * 64 + col]; }
#pragma unroll 1
    for (int sg = 1; sg <= NSEG - 2; ++sg) {
        float out[8];
#pragma unroll
        for (int k = 0; k < 8; ++k) { Pl[F.tid + NTHREADS * k] = pre[k]; out[k] = qre[k]; }
        if (sg + 1 <= NSEG - 2) {
#pragma unroll
            for (int k = 0; k < 8; ++k) { pre[k] = SEG[(size_t)(sg + 1) * 2 * 4096 + F.tid + NTHREADS * k]; qre[k] = SEG[(size_t)(sg + 1) * 2 * 4096 + 4096 + (dk0 + 8 * k) * 64 + col]; }
        }
        __syncthreads();
#pragma unroll 2
        for (int k4 = 0; k4 < 16; ++k4) {
            const float s0 = Sl[(4 * k4 + 0) * 64 + col], s1 = Sl[(4 * k4 + 1) * 64 + col], s2 = Sl[(4 * k4 + 2) * 64 + col], s3 = Sl[(4 * k4 + 3) * 64 + col];
#pragma unroll
            for (int k = 0; k < 8; ++k) { const f32x4 pv = *(const LAS f32x4*)(Pl + (dk0 + 8 * k) * 64 + 4 * k4); out[k] += (pv.x * s0 + pv.y * s1) + (pv.z * s2 + pv.w * s3); }
        }
        __syncthreads();
#pragma unroll
        for (int k = 0; k < 8; ++k) { Sl[(dk0 + 8 * k) * 64 + col] = out[k]; SST[(size_t)(sg + 1) * 4096 + (dk0 + 8 * k) * 64 + col] = out[k]; }
        __syncthreads();
    }
}

__device__ __forceinline__ void attn_unit(Frame& F, const Args& A, int layer, int unit) {
    const bf16_t* PX = (const bf16_t*)(F.ws + WS_PX);
    bf16_t* ACT = (bf16_t*)(F.ws + WS_ACT);
    const int lane = F.lane, wave = F.wave, r = lane & 15, g = lane >> 4, tid = F.tid;
    const bool isctx = unit >= 256;
    const int qb = isctx ? (unit - 256) >> 1 : unit >> 1, hk = unit & 1;
    const int qrow0 = (isctx ? NL : 0) + 128 * qb + 16 * wave;
    const int qpos = 128 * qb + 16 * wave + r;
    const float SCL = 0.125f * 1.4426950408889634f;
    bf16x8 qf[3][2];
#pragma unroll
    for (int a = 0; a < 3; ++a)
#pragma unroll
        for (int ks = 0; ks < 2; ++ks) qf[a][ks] = *(const bf16x8*)(PX + (size_t)(qrow0 + r) * INP + C_AQ + (3 * hk + a) * 64 + 32 * ks + 8 * g);
    float mrun[3], lrun[3]; f32x4 o[3][4];
#pragma unroll
    for (int a = 0; a < 3; ++a) { mrun[a] = A.in[I_SINK][layer * 6 + 3 * hk + a] * 1.4426950408889634f; lrun[a] = 1.f;
#pragma unroll
        for (int dt = 0; dt < 4; ++dt) o[a][dt] = (f32x4){0.f, 0.f, 0.f, 0.f}; }
    const int jlo = (!isctx && qb == 0) ? 2 : 0, jhi = isctx ? 0 : ((qb == 127) ? 4 : 6);
    const int ntile = 4 + (jhi - jlo);
    const int skey = tid >> 3, sch = tid & 7;
    const int spk = (skey & 32) + 8 * (((skey & 31) & 15) >> 2) + 4 * ((skey & 31) >> 4) + (skey & 3);
#define ATT_KROW(s_) ((s_) < 4 ? NL + 64 * (s_) : 128 * (qb - 1) + 64 * (jlo + (s_) - 4))
#define ATT_LOAD(s_) do { const size_t ro_ = (size_t)(ATT_KROW(s_) + skey) * INP; pkv = *(const u32x4*)(PX + ro_ + C_AK + hk * 64 + sch * 8); pvv = *(const u32x4*)(PX + ro_ + C_AV + hk * 64 + sch * 8); } while (0)
#define ATT_STAGE(buf_) do { LAS unsigned char* kb_ = F.lds + (buf_) * 18432; *(LAS u32x4*)(kb_ + skey * 144 + sch * 16) = pkv; LAS bf16_t* vt = (LAS bf16_t*)(kb_ + 9216); \
        vt[(sch * 8 + 0) * 72 + spk] = (bf16_t)(pvv.x & 0xffffu); vt[(sch * 8 + 1) * 72 + spk] = (bf16_t)(pvv.x >> 16); vt[(sch * 8 + 2) * 72 + spk] = (bf16_t)(pvv.y & 0xffffu); vt[(sch * 8 + 3) * 72 + spk] = (bf16_t)(pvv.y >> 16); \
        vt[(sch * 8 + 4) * 72 + spk] = (bf16_t)(pvv.z & 0xffffu); vt[(sch * 8 + 5) * 72 + spk] = (bf16_t)(pvv.z >> 16); vt[(sch * 8 + 6) * 72 + spk] = (bf16_t)(pvv.w & 0xffffu); vt[(sch * 8 + 7) * 72 + spk] = (bf16_t)(pvv.w >> 16); } while (0)
    u32x4 pkv, pvv;
    ATT_LOAD(0); ATT_STAGE(0);
    __syncthreads();
    for (int ti = 0; ti < ntile; ++ti) {
        const int krow0 = ATT_KROW(ti);
        const int q0w = 128 * qb + 16 * wave;
        const bool local = ti >= 4 && ((krow0 + 63 - q0w > 128) || (q0w + 15 - krow0 > 128));
        if (ti + 1 < ntile) ATT_LOAD(ti + 1);
        LAS unsigned char* Kl = F.lds + (ti & 1) * 18432;
        LAS unsigned char* Vl = Kl + 9216;
        f32x4 st[3][4];
#pragma unroll
        for (int kt = 0; kt < 4; ++kt) {
            const bf16x8 k0 = *(const LAS bf16x8*)(Kl + (16 * kt + r) * 144 + (8 * g) * 2);
            const bf16x8 k1 = *(const LAS bf16x8*)(Kl + (16 * kt + r) * 144 + (32 + 8 * g) * 2);
#pragma unroll
            for (int a = 0; a < 3; ++a) {
                f32x4 c = (f32x4){0.f, 0.f, 0.f, 0.f};
                c = __builtin_amdgcn_mfma_f32_16x16x32_bf16(k0, qf[a][0], c, 0, 0, 0);
                c = __builtin_amdgcn_mfma_f32_16x16x32_bf16(k1, qf[a][1], c, 0, 0, 0);
                st[a][kt] = c;
            }
        }
        u32x4 bp[3][2];
#pragma unroll
        for (int a = 0; a < 3; ++a) {
            float tmax = -INFINITY;
#pragma unroll
            for (int kt = 0; kt < 4; ++kt)
#pragma unroll
                for (int e = 0; e < 4; ++e) {
                    float sv = st[a][kt][e] * SCL;
                    if (local) { const int kp = krow0 + 16 * kt + 4 * g + e; const int df = qpos - kp; if (df > 128 || df < -128) sv = -INFINITY; }
                    st[a][kt][e] = sv; tmax = fmaxf(tmax, sv);
                }
            tmax = fmaxf(tmax, __shfl_xor(tmax, 16)); tmax = fmaxf(tmax, __shfl_xor(tmax, 32));
            const float mnew = fmaxf(mrun[a], tmax);
            const float alpha = __builtin_amdgcn_exp2f(mrun[a] - mnew);
            float ls = 0.f;
#pragma unroll
            for (int kt = 0; kt < 4; ++kt)
#pragma unroll
                for (int e = 0; e < 4; ++e) { const float p = __builtin_amdgcn_exp2f(st[a][kt][e] - mnew); st[a][kt][e] = p; ls += p; }
            ls += __shfl_xor(ls, 16); ls += __shfl_xor(ls, 32);
            lrun[a] = lrun[a] * alpha + ls; mrun[a] = mnew;
#pragma unroll
            for (int dt = 0; dt < 4; ++dt) o[a][dt] = o[a][dt] * alpha;
#pragma unroll
            for (int k2 = 0; k2 < 2; ++k2) { bp[a][k2].x = pkbf(st[a][2 * k2][0], st[a][2 * k2][1]); bp[a][k2].y = pkbf(st[a][2 * k2][2], st[a][2 * k2][3]);
                bp[a][k2].z = pkbf(st[a][2 * k2 + 1][0], st[a][2 * k2 + 1][1]); bp[a][k2].w = pkbf(st[a][2 * k2 + 1][2], st[a][2 * k2 + 1][3]); }
        }
#pragma unroll
        for (int dt = 0; dt < 4; ++dt)
#pragma unroll
            for (int k2 = 0; k2 < 2; ++k2) {
                const u32x4 av = *(const LAS u32x4*)(Vl + (16 * dt + r) * 144 + (32 * k2 + 8 * g) * 2);
#pragma unroll
                for (int a = 0; a < 3; ++a) o[a][dt] = __builtin_amdgcn_mfma_f32_16x16x32_bf16(__builtin_bit_cast(bf16x8, av), __builtin_bit_cast(bf16x8, bp[a][k2]), o[a][dt], 0, 0, 0);
            }
        if (ti + 1 < ntile) ATT_STAGE((ti + 1) & 1);
        __syncthreads();
    }
#undef ATT_KROW
#undef ATT_LOAD
#undef ATT_STAGE
#pragma unroll
    for (int a = 0; a < 3; ++a) {
        const float inv = 1.0f / lrun[a];
#pragma unroll
        for (int dt = 0; dt < 4; ++dt) {
            u32x2 w; w.x = pkbf(o[a][dt][0] * inv, o[a][dt][1] * inv); w.y = pkbf(o[a][dt][2] * inv, o[a][dt][3] * inv);
            *(u32x2*)(ACT + (size_t)(qrow0 + r) * D + 640 + (3 * hk + a) * 64 + 16 * dt + 4 * g) = w;
        }
    }
}

constexpr int X1_JOBS = 12 * (2 * (NSEG - 1) - 1);
__device__ __forceinline__ void scan_x1_phase(Frame& F, const Args& A, int layer) {
    const int b = blockIdx.x;
    if (b < X1_JOBS) {
        const int dh = b / (2 * (NSEG - 1) - 1), k = b % (2 * (NSEG - 1) - 1);
        if (k == 0) dn_scan_job<1>(F, dh, 0);
        else { const int sg = 1 + ((k - 1) >> 1); if ((k - 1) & 1) dn_scan_job<1>(F, dh, sg); else dn_scan_job<2>(F, dh, sg); }
        return;
    }
    const int nw = F.G - X1_JOBS;
    for (int u = b - X1_JOBS; u < 100; u += nw) { attn_unit(F, A, layer, u); __syncthreads(); }
}
__device__ __forceinline__ void scan_x2_phase(Frame& F) {
    if (blockIdx.x < 12) dn_combine(F, blockIdx.x);
}
__device__ __forceinline__ void scan_x3_phase(Frame& F, const Args& A, int layer) {
    if (blockIdx.x < 12 * NSEG) { dn_scan_job<0>(F, blockIdx.x / NSEG, blockIdx.x % NSEG); return; }
    const int nunits = layer == 0 ? 260 : 256, nw = F.G - 12 * NSEG;
    for (int u = 100 + blockIdx.x - 12 * NSEG; u < nunits; u += nw) { attn_unit(F, A, layer, u); __syncthreads(); }
}

constexpr int DO_BUF = 58880;
__device__ __forceinline__ void dn_out_phase(Frame& F, const Args& A, int layer) {
    const bf16_t* PX = (const bf16_t*)(F.ws + WS_PX);
    bf16_t* ACT = (bf16_t*)(F.ws + WS_ACT);
    const bf16_t* QD = (const bf16_t*)(F.ws + WS_QD); const bf16_t* KD = (const bf16_t*)(F.ws + WS_QD + QKV_STRIDE);
    const float* Gg = (const float*)(F.ws + WS_G);
    const bf16_t* VT = (const bf16_t*)(F.ws + WS_DN + 3 * DN_STRIDE); const bf16_t* ST = (const bf16_t*)(F.ws + WS_DN + 4 * DN_STRIDE);
    const float* ng = A.in[I_NORMG] + layer * 64;
    const int tid = F.tid, lane = F.lane, wave = F.wave, r = lane & 15, g = lane >> 4;
    const int it = wave & 3, hf = wave >> 2;
    const int nunits = (layer == 0 ? 260 : 256) * 6;
    const int srow = tid >> 3, sc = tid & 7;
    const int soff = srow * 128 + ((sc ^ ((srow >> 1) & 7)) << 4);
    u32x4 pre[7]; float gpre = 0.f;
#define DO_ROW0(u_) (((u_) / 6) < 256 ? 64 * ((u_) / 6) : NL + 64 * (((u_) / 6) - 256))
#define DO_LOAD(u_) do { const int oc_ = (u_) / 6, h_ = (u_) % 6, row0_ = DO_ROW0(u_); \
        const int s0_ = oc_ < 256 ? 4 + oc_ : oc_ - 256, s1_ = oc_ < 256 ? 4 + 255 - oc_ : 3 - (oc_ - 256); \
        const size_t U0_ = (size_t)(h_ * DN_NS + s0_) * 4096, U1_ = (size_t)((6 + h_) * DN_NS + s1_) * 4096; \
        pre[0] = *(const u32x4*)(QD + (size_t)(row0_ + srow) * 384 + h_ * 64 + sc * 8); pre[1] = *(const u32x4*)(KD + (size_t)(row0_ + srow) * 384 + h_ * 64 + sc * 8); \
        pre[2] = *(const u32x4*)(ST + U0_ + srow * 64 + sc * 8); pre[3] = *(const u32x4*)(ST + U1_ + srow * 64 + sc * 8); \
        pre[4] = *(const u32x4*)(VT + U0_ + srow * 64 + sc * 8); pre[5] = *(const u32x4*)(VT + U1_ + srow * 64 + sc * 8); \
        pre[6] = *(const u32x4*)(PX + (size_t)(row0_ + srow) * INP + C_DZ + h_ * 64 + sc * 8); \
        if (wave < 2) gpre = Gg[(size_t)(row0_ + lane) * 12 + wave * 6 + h_]; } while (0)
#define DO_STAGE(b_) do { LAS unsigned char* bb_ = F.lds + (b_) * DO_BUF; \
        _Pragma("unroll") for (int q_ = 0; q_ < 7; ++q_) *(LAS u32x4*)(bb_ + q_ * 8192 + soff) = pre[q_]; \
        if (wave < 2) { float gv_ = gpre; \
            _Pragma("unroll") for (int o_ = 1; o_ < 64; o_ <<= 1) { const float t_ = wave ? __shfl_down(gv_, o_) : __shfl_up(gv_, o_); if (wave ? (lane + o_ < 64) : (lane >= o_)) gv_ += t_; } \
            ((LAS float*)(bb_ + 57344))[wave * 64 + lane] = gv_; } } while (0)
    int u = blockIdx.x, cur = 0;
    if (u < nunits) { DO_LOAD(u); DO_STAGE(0); }
    __syncthreads();
    f32x4 ngv[2];
#pragma unroll
    for (int dtl = 0; dtl < 2; ++dtl) ngv[dtl] = *(const f32x4*)(ng + 16 * (2 * hf + dtl) + 4 * g);
#pragma unroll 1
    for (; u < nunits; u += F.G) {
        const int un = u + F.G;
        if (un < nunits) DO_LOAD(un);
        const int h = u % 6, row0 = DO_ROW0(u);
        LAS unsigned char* bb = F.lds + cur * DO_BUF;
        const LAS float* gc0 = (const LAS float*)(bb + 57344); const LAS float* gc1 = gc0 + 64;
        LAS float* ssx = (LAS float*)(bb + 57344 + 512);
        const int i = 16 * it + r;
        const float e0 = gc0[i], e1 = gc1[i];
        bf16x8 qf[2];
#pragma unroll
        for (int ks = 0; ks < 2; ++ks) qf[ks] = *(const LAS bf16x8*)(bb + sc_off(16 * it + r, 32 * ks + 8 * g));
        f32x4 pt[4];
#pragma unroll
        for (int jt = 0; jt < 4; ++jt) {
            f32x4 c = (f32x4){0.f, 0.f, 0.f, 0.f};
#pragma unroll
            for (int ks = 0; ks < 2; ++ks) c = __builtin_amdgcn_mfma_f32_16x16x32_bf16(*(const LAS bf16x8*)(bb + 8192 + sc_off(16 * jt + r, 32 * ks + 8 * g)), qf[ks], c, 0, 0, 0);
            pt[jt] = c;
        }
        f32x4 o[2];
#pragma unroll
        for (int dtl = 0; dtl < 2; ++dtl) o[dtl] = (f32x4){0.f, 0.f, 0.f, 0.f};
#pragma unroll
        for (int dir = 0; dir < 2; ++dir) {
            const LAS float* gcd = dir == 0 ? gc0 : gc1; const float ei = dir == 0 ? e0 : e1;
            const float xi = __expf(ei);
            u32x4 bp[2]; float pv[4][4];
#pragma unroll
            for (int jt = 0; jt < 4; ++jt)
#pragma unroll
                for (int e = 0; e < 4; ++e) {
                    const int j = 16 * jt + 4 * g + e;
                    const bool ok = dir == 0 ? (j <= i) : (j >= i);
                    pv[jt][e] = ok ? pt[jt][e] * __expf(ei - gcd[j]) : 0.f;
                }
#pragma unroll
            for (int k2 = 0; k2 < 2; ++k2) { bp[k2].x = pkbf(pv[2 * k2][0], pv[2 * k2][1]); bp[k2].y = pkbf(pv[2 * k2][2], pv[2 * k2][3]); bp[k2].z = pkbf(pv[2 * k2 + 1][0], pv[2 * k2 + 1][1]); bp[k2].w = pkbf(pv[2 * k2 + 1][2], pv[2 * k2 + 1][3]); }
            const LAS unsigned char* stt = bb + (2 + dir) * 8192; const LAS unsigned char* vtt = bb + (4 + dir) * 8192;
#pragma unroll
            for (int dtl = 0; dtl < 2; ++dtl) {
                const int dt = 2 * hf + dtl;
                f32x4 c = (f32x4){0.f, 0.f, 0.f, 0.f};
#pragma unroll
                for (int ks = 0; ks < 2; ++ks) c = __builtin_amdgcn_mfma_f32_16x16x32_bf16(*(const LAS bf16x8*)(stt + sc_off(16 * dt + r, 32 * ks + 8 * g)), qf[ks], c, 0, 0, 0);
                f32x4 acc = o[dtl] + c * xi;
#pragma unroll
                for (int k2 = 0; k2 < 2; ++k2) {
                    const u32x2 lo = *(const LAS u32x2*)(vtt + sc_off(16 * dt + r, 32 * k2 + 4 * g)), hi = *(const LAS u32x2*)(vtt + sc_off(16 * dt + r, 32 * k2 + 16 + 4 * g));
                    const u32x4 av = (u32x4){lo.x, lo.y, hi.x, hi.y};
                    acc = __builtin_amdgcn_mfma_f32_16x16x32_bf16(__builtin_bit_cast(bf16x8, av), __builtin_bit_cast(bf16x8, bp[k2]), acc, 0, 0, 0);
                }
                o[dtl] = acc;
            }
        }
        float ss = 0.f;
#pragma unroll
        for (int dtl = 0; dtl < 2; ++dtl) ss += (o[dtl][0] * o[dtl][0] + o[dtl][1] * o[dtl][1]) + (o[dtl][2] * o[dtl][2] + o[dtl][3] * o[dtl][3]);
        ss += __shfl_xor(ss, 16); ss += __shfl_xor(ss, 32);
        if (g == 0) ssx[wave * 16 + r] = ss;
        __syncthreads();
        const float rstd = 1.0f / sqrtf((ssx[wave * 16 + r] + ssx[(wave ^ 4) * 16 + r]) * (1.f / 64.f) + EPS);
#pragma unroll
        for (int dtl = 0; dtl < 2; ++dtl) {
            const int dt = 2 * hf + dtl;
            const u32x2 zz = *(const LAS u32x2*)(bb + 6 * 8192 + sc_off(i, 16 * dt + 4 * g));
            const float z0 = bf2f(zz.x & 0xffffu), z1 = bf2f(zz.x >> 16), z2 = bf2f(zz.y & 0xffffu), z3 = bf2f(zz.y >> 16);
            u32x2 w; w.x = pkbf(o[dtl][0] * rstd * ngv[dtl][0] * silu_f(z0), o[dtl][1] * rstd * ngv[dtl][1] * silu_f(z1));
            w.y = pkbf(o[dtl][2] * rstd * ngv[dtl][2] * silu_f(z2), o[dtl][3] * rstd * ngv[dtl][3] * silu_f(z3));
            *(LAS u32x2*)(bb + 8192 + sc_off(i, 16 * dt + 4 * g)) = w;
        }
        __syncthreads();
        *(u32x4*)(ACT + (size_t)(row0 + srow) * D + 256 + h * 64 + sc * 8) = *(const LAS u32x4*)(bb + 8192 + soff);
        if (un < nunits) DO_STAGE(cur ^ 1);
        __syncthreads();
        cur ^= 1;
    }
#undef DO_ROW0
#undef DO_LOAD
#undef DO_STAGE
}

constexpr size_t RT_EID = WS_ROUTE, RT_GATE = WS_ROUTE + 128 * 1024, RT_TSLOT = WS_ROUTE + 256 * 1024, RT_BCNT = WS_ROUTE + 384 * 1024, RT_TILEE = WS_ROUTE + 400 * 1024, RT_NT = WS_ROUTE + 404 * 1024;
constexpr size_t WS_XS = WS_BIG;
constexpr size_t WS_Y = 278 * MiB;
constexpr size_t WS_HM = 350 * MiB;
constexpr int MOE_CH = 72;
constexpr size_t WS_SLAB = 440 * MiB;
static_assert(WS_HM + (size_t)72 * 256 * DFE <= WS_SLAB && WS_SLAB + (size_t)8 * 28 * 65536 * 4 <= WS_END, "slab map");
static_assert(WS_XS + (size_t)36864 * 1024 <= WS_Y && WS_Y + (size_t)36864 * 2048 <= WS_HM, "moe map");

__device__ __forceinline__ void norm2_router_phase(Frame& F, const Args& A) {
    const float* mod = (const float*)(F.ws + WS_MOD) + (1 * 2 + 0) * 6144;
    const float* shift = mod + 3 * 1024; const float* scale = mod + 4 * 1024;
    unsigned char* act8 = F.ws + WS_ACT;
    int* EID = (int*)(F.ws + RT_EID); float* GATE = (float*)(F.ws + RT_GATE); int* BCNT = (int*)(F.ws + RT_BCNT);
    const float* rw = A.in[I_ROUTER];
    LAS int* se = (LAS int*)F.lds;
    const int lane = F.lane;
    for (int k = 0; k < 8; ++k) {
        const int tl = F.wave * 8 + k, t = blockIdx.x * 64 + tl;
        const GAS f32x4* xr = (const GAS f32x4*)(A.out + (size_t)t * D) + lane;
        f32x4 v[4]; float s = 0.f;
#pragma unroll
        for (int j = 0; j < 4; ++j) { v[j] = xr[64 * j]; s += (v[j].x * v[j].x + v[j].y * v[j].y) + (v[j].z * v[j].z + v[j].w * v[j].w); }
        const float rstd = 1.0f / sqrtf(wave_sum(s) * (1.f / D) + EPS);
        float lg[8];
#pragma unroll
        for (int e = 0; e < 8; ++e) lg[e] = 0.f;
        GAS unsigned* o8 = (GAS unsigned*)(act8 + (size_t)t * D) + lane;
#pragma unroll
        for (int j = 0; j < 4; ++j) {
            const f32x4 sh = ((const GAS f32x4*)shift)[lane + 64 * j], sc = ((const GAS f32x4*)scale)[lane + 64 * j];
            const f32x4 y = v[j] * rstd * (sc + 1.0f) + sh;
            o8[64 * j] = pk_fp8x4(y.x, y.y, y.z, y.w);
            const int c0 = 4 * (lane + 64 * j);
#pragma unroll
            for (int q = 0; q < 4; ++q) {
                const f32x4 r0 = *(const GAS f32x4*)(rw + (size_t)(c0 + q) * 8), r1 = *(const GAS f32x4*)(rw + (size_t)(c0 + q) * 8 + 4);
                const float yy = y[q];
                lg[0] += yy * r0.x; lg[1] += yy * r0.y; lg[2] += yy * r0.z; lg[3] += yy * r0.w; lg[4] += yy * r1.x; lg[5] += yy * r1.y; lg[6] += yy * r1.z; lg[7] += yy * r1.w;
            }
        }
#pragma unroll
        for (int e = 0; e < 8; ++e) lg[e] = wave_sum(lg[e]);
        int e0 = 0; float l0 = lg[0];
#pragma unroll
        for (int e = 1; e < 8; ++e) if (lg[e] > l0) { l0 = lg[e]; e0 = e; }
        int e1 = -1; float l1 = -INFINITY;
#pragma unroll
        for (int e = 0; e < 8; ++e) if (e != e0 && lg[e] > l1) { l1 = lg[e]; e1 = e; }
        if (lane == 0) {
            const float g0 = 1.0f / (1.0f + expf(l1 - l0));
            EID[t * 2] = e0; EID[t * 2 + 1] = e1; GATE[t * 2] = g0; GATE[t * 2 + 1] = 1.0f - g0;
            se[tl * 2] = e0; se[tl * 2 + 1] = e1;
        }
    }
    __syncthreads();
    if (F.wave == 0) {
        const int a0 = se[lane * 2], a1 = se[lane * 2 + 1];
#pragma unroll
        for (int e = 0; e < 8; ++e) { const unsigned long long mk = __ballot(a0 == e || a1 == e); if (lane == e) BCNT[blockIdx.x * 8 + e] = __popcll(mk); }
    }
    __syncthreads();
}

__device__ __forceinline__ void moe_assign_phase(Frame& F) {
    const int* EID = (const int*)(F.ws + RT_EID); int* TSLOT = (int*)(F.ws + RT_TSLOT); const int* BCNT = (const int*)(F.ws + RT_BCNT);
    unsigned* TILEE = (unsigned*)(F.ws + RT_TILEE); unsigned* NTL = (unsigned*)(F.ws + RT_NT);
    const unsigned char* act8 = F.ws + WS_ACT; unsigned char* XS = F.ws + WS_XS;
    LAS int* sm = (LAS int*)F.lds;
    const int b = blockIdx.x, lane = F.lane;
    if (F.tid < 8) {
        int tot = 0, mine = 0;
        for (int bb = 0; bb < 256; ++bb) { const int c = __hip_atomic_load(BCNT + bb * 8 + F.tid, RLX_AGENT); if (bb < b) mine += c; tot += c; }
        sm[F.tid] = tot; sm[8 + F.tid] = mine;
    }
    __syncthreads();
    if (F.tid == 0) {
        int ps = 0, nt = 0;
        for (int e = 0; e < 8; ++e) { const int tl = (sm[e] + 255) >> 8; sm[16 + e] = ps; sm[24 + e] = tl; if (b == 0) for (int q = 0; q < tl; ++q) TILEE[nt + q] = (unsigned)e; ps += tl * 256; nt += tl; }
        if (b == 0) *NTL = (unsigned)nt;
    }
    __syncthreads();
    if (F.wave == 0) {
        const int t = b * 64 + lane;
        const int a0 = EID[t * 2], a1 = EID[t * 2 + 1];
        int s0 = 0, s1 = 0;
        const unsigned long long lower = (1ull << lane) - 1ull;
#pragma unroll
        for (int e = 0; e < 8; ++e) {
            const unsigned long long mk = __ballot(a0 == e || a1 == e);
            const int rank = __popcll(mk & lower), slot = sm[16 + e] + sm[8 + e] + rank;
            if (a0 == e) s0 = slot; if (a1 == e) s1 = slot;
        }
        TSLOT[t * 2] = s0; TSLOT[t * 2 + 1] = s1; sm[32 + lane * 2] = s0; sm[33 + lane * 2] = s1;
    }
    __syncthreads();
    for (int q = F.wave; q < 128; q += NWAVES) {
        const int t = b * 64 + (q >> 1), slot = sm[32 + q];
        const GAS u32x4* srcp = (const GAS u32x4*)(act8 + (size_t)t * D); GAS u32x4* dstp = (GAS u32x4*)(XS + (size_t)slot * D);
        dstp[lane] = srcp[lane];
    }
    { const int e = b & 7, cnt = sm[e], first = sm[16 + e] + cnt, npad = sm[24 + e] * 256 - cnt;
      for (int p = (b >> 3) * NWAVES + F.wave; p < npad; p += 32 * NWAVES) { GAS u32x4* dstp = (GAS u32x4*)(XS + (size_t)(first + p) * D); const u32x4 z = (u32x4){0u, 0u, 0u, 0u}; dstp[lane] = z; } }
}

__device__ __forceinline__ f32x4 moe_yrow(const bf16_t* Y, const float* SLAB, int slot, int tail0, int j, int lane) {
    const int tile = slot >> 8;
    if (tile < tail0) { const u32x2 a = ((const GAS u32x2*)(Y + (size_t)slot * D))[lane + 64 * j];
        return (f32x4){bf2f(a.x & 0xffffu), bf2f(a.x >> 16), bf2f(a.y & 0xffffu), bf2f(a.y >> 16)}; }
    const float* p = SLAB + (size_t)(((tile - tail0) * 4 + j) * 7) * 65536 + (size_t)(slot & 255) * 256 + 4 * lane;
    f32x4 s = *(const f32x4*)p;
#pragma unroll
    for (int ks = 1; ks < 7; ++ks) s = s + *(const f32x4*)(p + (size_t)ks * 65536);
    return s;
}
__device__ __forceinline__ void moe_final_phase(Frame& F, const Args& A) {
    const float* mod5 = (const float*)(F.ws + WS_MOD) + (1 * 2 + 0) * 6144 + 5 * 1024;
    const int* TSLOT = (const int*)(F.ws + RT_TSLOT); const float* GATE = (const float*)(F.ws + RT_GATE);
    const bf16_t* Y = (const bf16_t*)(F.ws + WS_Y); const float* SLAB = (const float*)(F.ws + WS_SLAB);
    const float* fng = A.in[I_FNG];
    const int lane = F.lane;
    const int ntl = (int)__builtin_amdgcn_readfirstlane(__hip_atomic_load((unsigned*)(F.ws + RT_NT), RLX_AGENT));
    const int tail0 = (ntl > 128 && ntl - 128 <= 8) ? 128 : (1 << 20);
    for (int t = F.gw; t < NL; t += F.NGW) {
        const int s0 = TSLOT[t * 2], s1 = TSLOT[t * 2 + 1]; const float g0 = GATE[t * 2], g1 = GATE[t * 2 + 1];
        GAS f32x4* xr = (GAS f32x4*)(A.out + (size_t)t * D) + lane;
        f32x4 v[4]; float s = 0.f;
        if (((s0 >> 8) < tail0) && ((s1 >> 8) < tail0)) {
            const GAS u32x2* y0 = (const GAS u32x2*)(Y + (size_t)s0 * D) + lane; const GAS u32x2* y1 = (const GAS u32x2*)(Y + (size_t)s1 * D) + lane;
#pragma unroll
            for (int j = 0; j < 4; ++j) {
                const f32x4 x = xr[64 * j]; const u32x2 a = y0[64 * j], c = y1[64 * j];
                const f32x4 m5 = ((const GAS f32x4*)mod5)[lane + 64 * j];
                f32x4 f;
                f.x = g0 * bf2f(a.x & 0xffffu) + g1 * bf2f(c.x & 0xffffu); f.y = g0 * bf2f(a.x >> 16) + g1 * bf2f(c.x >> 16);
                f.z = g0 * bf2f(a.y & 0xffffu) + g1 * bf2f(c.y & 0xffffu); f.w = g0 * bf2f(a.y >> 16) + g1 * bf2f(c.y >> 16);
                v[j] = x + m5 * f;
                s += (v[j].x * v[j].x + v[j].y * v[j].y) + (v[j].z * v[j].z + v[j].w * v[j].w);
            }
        } else {
#pragma unroll
            for (int j = 0; j < 4; ++j) {
                const f32x4 x = xr[64 * j];
                const f32x4 m5 = ((const GAS f32x4*)mod5)[lane + 64 * j];
                const f32x4 f = moe_yrow(Y, SLAB, s0, tail0, j, lane) * g0 + moe_yrow(Y, SLAB, s1, tail0, j, lane) * g1;
                v[j] = x + m5 * f;
                s += (v[j].x * v[j].x + v[j].y * v[j].y) + (v[j].z * v[j].z + v[j].w * v[j].w);
            }
        }
        const float rstd = 1.0f / sqrtf(wave_sum_l(s, lane) * (1.f / D) + EPS);
#pragma unroll
        for (int j = 0; j < 4; ++j) { const f32x4 gg = ((const GAS f32x4*)fng)[lane + 64 * j]; xr[64 * j] = v[j] * rstd * gg; }
    }
}

#define GRID_BAR() do { { unsigned* bp_ = (unsigned*)(F.ws + WS_CTL) + 4096; asm volatile("" : "+s"(bp_)); bar.bar = bp_; } xcd_barrier(bar); TS_STAMP(); F.tid = opq((int)threadIdx.x); F.lane = F.tid & 63; } while (0)

template <int MODE>
__device__ __forceinline__ void ctx_pieces(Frame& F, const bf16_t* A, const bf16_t* Bt, int K, int ncg, void* O, int ldo, const float* base, const float* gate,
                                           int nrg = 16, const unsigned* tile_e = nullptr, int tile0 = 0, size_t estride = 0) {
    const int lane = F.lane, r = lane & 15, g = lane >> 4, wave = F.wave;
    LAS float* red = (LAS float*)F.lds;
    const int npieces = nrg * ncg, kw = K >> 3;
    for (int p = blockIdx.x; p < npieces; p += F.G) {
        const int rg = p % nrg, cg = p / nrg;
        f32x4 acc[4];
#pragma unroll
        for (int n = 0; n < 4; ++n) acc[n] = (f32x4){0.f, 0.f, 0.f, 0.f};
        const bf16_t* ap = A + (size_t)(16 * rg + r) * K + wave * kw + 8 * g;
        size_t eoff = 0;
        if (tile_e) eoff = (size_t)(__builtin_amdgcn_readfirstlane(__hip_atomic_load(tile_e + tile0 + (rg >> 4), __ATOMIC_RELAXED, __HIP_MEMORY_SCOPE_AGENT)) & 7u) * estride;
        const bf16_t* bp = Bt + eoff + (size_t)(64 * cg + r) * K + wave * kw + 8 * g;
        for (int k = 0; k < kw; k += 32) {
            const bf16x8 a = *(const bf16x8*)(ap + k);
#pragma unroll
            for (int n = 0; n < 4; ++n) { const bf16x8 b = *(const bf16x8*)(bp + (size_t)(16 * n) * K + k); acc[n] = __builtin_amdgcn_mfma_f32_16x16x32_bf16(a, b, acc[n], 0, 0, 0); }
        }
#pragma unroll
        for (int n = 0; n < 4; ++n)
#pragma unroll
            for (int e = 0; e < 4; ++e) red[wave * 1024 + (4 * g + e) * 64 + 16 * n + r] = acc[n][e];
        __syncthreads();
        for (int idx = F.tid; idx < 1024; idx += NTHREADS) {
            float s = 0.f;
#pragma unroll
            for (int w = 0; w < 8; ++w) s += red[w * 1024 + idx];
            const int row = 16 * rg + (idx >> 6), col = 64 * cg + (idx & 63);
            if (MODE == 0) ((bf16_t*)O)[(size_t)row * ldo + col] = (bf16_t)f2bf(s);
            else ((float*)O)[(size_t)row * 1024 + col] = base[(size_t)row * 1024 + col] + gate[col] * s;
        }
        __syncthreads();
    }
}

#ifndef STOP_AFTER
#define STOP_AFTER 0
#endif
__device__ __forceinline__ void dump_bf16(Frame& F, float* out, const bf16_t* buf, int ld, int ncols) {
    for (int m = F.gw; m < NL; m += F.NGW)
        for (int j = 0; j < 16; ++j) { const int c = F.lane + 64 * j; float s = 0.f; for (int k = 0; c + 1024 * k < ncols; ++k) s += bf2f(buf[(size_t)m * ld + c + 1024 * k]); out[(size_t)m * D + c] = s; }
}
#define STOP_DUMP(n, buf, ld, nc) do { if (layer == 0 && STOP_AFTER == (n)) { dump_bf16(F, args.out, (const bf16_t*)(buf), (ld), (nc)); F.ws = nullptr; return; } } while (0)
template <int layer>
__device__ __forceinline__ void layer_body(Frame& F, const Args& args, XcdBarrier& bar) {
    unsigned char* ws = F.ws;
    float* HC = (float*)(ws + WS_HC);
    const float* MOD = (const float*)(ws + WS_MOD);
        F.tid = opq((int)threadIdx.x); F.lane = F.tid & 63;
        const float* xl = layer == 0 ? args.in[I_X] : args.out;
        const float* xc = layer == 0 ? args.in[I_CTX] : HC;
        const float* modx = MOD + (layer * 2 + 0) * 6144; const float* modc = MOD + (layer * 2 + 1) * 6144;
        norm_phase(F, xl, xc, layer, 0, 1, NT);
        GRID_BAR();
        ctx_pieces<0>(F, (const bf16_t*)(ws + WS_ACT) + (size_t)NL * 1024, (const bf16_t*)(ws + WS_WIN) + (size_t)layer * INP * 1024, 1024, INP / 64, (bf16_t*)(ws + WS_PX) + (size_t)NL * INP, INP, nullptr, nullptr);
        { pg8::DenseSched S{NL / 256, INP / 256, F.G, (int)blockIdx.x, (const char*)(ws + WS_ACT), (const char*)(ws + WS_WIN) + (size_t)layer * INP * 1024 * 2, (size_t)256 * 1024 * 2};
          pg8::EpiStoreBf16 E{(bf16_t*)(ws + WS_PX), INP};
          pg8::gemm_phase(F.lds, 1024, S, E); }
        GRID_BAR();
        STOP_DUMP(2, ws + WS_PX, INP, INC);
        prep_phase(F, args, layer);
        GRID_BAR();
        STOP_DUMP(3, ws + WS_QD, 384, 384);
        STOP_DUMP(33, ws + WS_QD + QKV_STRIDE, 384, 384);
        dn_chunk_phase(F);
        GRID_BAR();
        STOP_DUMP(4, ws + WS_DN, 1024, 1024);
        STOP_DUMP(44, ws + WS_DN + DN_STRIDE, 1024, 1024);
        STOP_DUMP(45, ws + WS_DN + 2 * DN_STRIDE, 1024, 1024);
        scan_x1_phase(F, args, layer);
        GRID_BAR();
        scan_x3_phase(F, args, layer);
        GRID_BAR();
        STOP_DUMP(5, ws + WS_DN + 3 * DN_STRIDE, 1024, 1024);
        STOP_DUMP(55, ws + WS_DN + 4 * DN_STRIDE, 1024, 1024);
        STOP_DUMP(56, ws + WS_ACT, 1024, 1024);
        dn_out_phase(F, args, layer);
        GRID_BAR();
        STOP_DUMP(6, ws + WS_ACT, 1024, 1024);
        if (layer == 0) ctx_pieces<1>(F, (const bf16_t*)(ws + WS_ACT) + (size_t)NL * 1024, (const bf16_t*)(ws + WS_WOUT), 1024, 16, HC, 1024, xc, modc + 2 * 1024);
        { pg8::DenseSched S{NL / 256, 4, F.G, (int)blockIdx.x, (const char*)(ws + WS_ACT), (const char*)(ws + WS_WOUT) + (size_t)layer * 1024 * 1024 * 2, (size_t)256 * 1024 * 2};
          pg8::EpiResid E{xl, args.out, modx + 2 * 1024, xc, HC, modc + 2 * 1024, NL / 256};
          pg8::gemm_phase(F.lds, 1024, S, E); }
        GRID_BAR();
        if (layer == 0 && STOP_AFTER == 7) { F.ws = nullptr; return; }
        if (layer == 0) {
            norm_phase(F, args.out, HC, 0, 3, 4, NT);
            GRID_BAR();
            { pg8::DenseSched S{NT / 256, 2 * DFF / 256, F.G, (int)blockIdx.x, (const char*)(ws + WS_ACT), (const char*)(ws + WS_WGU), (size_t)256 * 1024 * 2};
              pg8::EpiSwiGLU E{(bf16_t*)(ws + WS_BIG), DFF};
              pg8::gemm_phase(F.lds, 1024, S, E); }
            GRID_BAR();
            ctx_pieces<1>(F, (const bf16_t*)(ws + WS_BIG) + (size_t)NL * DFF, (const bf16_t*)(ws + WS_WDN), DFF, 16, HC, 1024, HC, modc + 5 * 1024);
            { pg8::DenseSched S{NL / 256, 4, F.G, (int)blockIdx.x, (const char*)(ws + WS_BIG), (const char*)(ws + WS_WDN), (size_t)256 * DFF * 2};
              pg8::EpiResid E{args.out, args.out, modx + 5 * 1024, HC, HC, modc + 5 * 1024, NL / 256};
              pg8::gemm_phase(F.lds, DFF, S, E); }
            GRID_BAR();
            if (STOP_AFTER == 9) { F.ws = nullptr; return; }
        } else {
            norm2_router_phase(F, args);
            GRID_BAR();
            moe_assign_phase(F);
            GRID_BAR();
            const int ntl = (int)__builtin_amdgcn_readfirstlane(__hip_atomic_load((unsigned*)(ws + RT_NT), RLX_AGENT));
#pragma unroll 1
            for (int t0 = 0; t0 < ntl; t0 += 64) {
                const int left = ntl - t0; const int nM = left > MOE_CH ? 64 : left;
                const int ntail = (nM > 64 && nM - 64 <= 8) ? nM - 64 : 0, nG2 = nM - ntail;
                { pg8::MoeSched S{nM, 2 * DFE / 256, F.G, (int)blockIdx.x, (const char*)(ws + WS_XS) + (size_t)t0 * 256 * 1024, (const char*)(ws + WS_MGU), (size_t)256 * 1024, (size_t)2 * DFE * 1024, (const unsigned*)(ws + RT_TILEE), t0, 0};
                  pg8::EpiSwiGLU8 E{ws + WS_HM, DFE, 1.0f / MOE_WSCALE, MOE_HSCALE};
                  pg8::gemm_phase<true>(F.lds, 512, S, E); }
                GRID_BAR();
                { pg8::MoeSched S{nG2, 4, F.G, (int)blockIdx.x, (const char*)(ws + WS_HM), (const char*)(ws + WS_MDN), (size_t)256 * DFE, (size_t)1024 * DFE, (const unsigned*)(ws + RT_TILEE), t0, t0};
                  pg8::EpiStoreBf16 E{(bf16_t*)(ws + WS_Y), 1024, 1.0f / (MOE_WSCALE * MOE_HSCALE)};
                  pg8::gemm_phase<true>(F.lds, DFE / 2, S, E); }
                if (ntail > 0) {
                    pg8::MoeTailSched S{ntail, F.G, (int)((blockIdx.x + 128) % F.G), (const char*)(ws + WS_HM) + (size_t)nG2 * 256 * DFE, (const char*)(ws + WS_MDN), (size_t)256 * DFE, (size_t)1024 * DFE, (const unsigned*)(ws + RT_TILEE), t0 + nG2, (size_t)512};
                    pg8::EpiSlab E{(float*)(ws + WS_SLAB), 1.0f / (MOE_WSCALE * MOE_HSCALE)};
                    pg8::gemm_phase<true>(F.lds, DFE / 2, S, E, 4);
                }
                GRID_BAR();
                if (left <= MOE_CH) break;
            }
            moe_final_phase(F, args);
        }
    }

__global__ void __launch_bounds__(NTHREADS, 2) fwd_kernel(Args args) {
    extern __shared__ __attribute__((aligned(16))) unsigned char lds[];
    Frame F;
    F.lds = (LAS unsigned char*)lds;
    F.tid = threadIdx.x; F.lane = F.tid & 63; F.wave = __builtin_amdgcn_readfirstlane(F.tid >> 6);
    F.G = gridDim.x; { const int bx = blockIdx.x; F.vcu = (F.G % 8 == 0) ? (bx % 8) * (F.G / 8) + bx / 8 : bx; }
    F.gw = F.vcu * NWAVES + F.wave; F.NGW = F.G * NWAVES;
    F.ws = args.ws;
    volatile LAS unsigned* MISC = (volatile LAS unsigned*)(F.lds + MISC_OFF);
    for (int u = F.tid; u < (LDS_BYTES - MISC_OFF) / 4; u += NTHREADS) ((LAS unsigned*)(F.lds + MISC_OFF))[u] = 0u;
    __syncthreads();
    XcdBarrier bar = xcd_barrier_post((unsigned*)(F.ws + WS_CTL) + 4096, MISC + 8);
    TS_STAMP();

    unsigned char* ws = F.ws;
    float* HC = (float*)(ws + WS_HC);
    const float* MOD = (const float*)(ws + WS_MOD);
#ifdef DIAG_ZERO
    { GAS u32x4* p = (GAS u32x4*)(F.ws + WS_MOD); const size_t n16 = (WS_END - WS_MOD) / 16; const u32x4 z = (u32x4){0u, 0u, 0u, 0u};
      for (size_t i = (size_t)blockIdx.x * NTHREADS + F.tid; i < n16; i += (size_t)F.G * NTHREADS) p[i] = z; }
    GRID_BAR();
#endif
    p0_prologue(F, args);
    GRID_BAR();
    layer_body<0>(F, args, bar);
    if (F.ws == nullptr) return;
    layer_body<1>(F, args, bar);
#ifdef TS_A
    TS_STAMP();
    if (blockIdx.x == 0 && threadIdx.x == 0) {
        volatile LAS unsigned* M_ = (volatile LAS unsigned*)(F.lds + MISC_OFF);
        const unsigned long long ta = ((unsigned long long)M_[17 + 2 * (TS_A)] << 32) | M_[16 + 2 * (TS_A)], tb = ((unsigned long long)M_[17 + 2 * (TS_B)] << 32) | M_[16 + 2 * (TS_B)];
        const unsigned long long dl = (tb - ta) * (TS_MUL), t0 = __builtin_amdgcn_s_memrealtime();
        while (__builtin_amdgcn_s_memrealtime() - t0 < dl) __builtin_amdgcn_s_sleep(8);
    }
#endif
}

extern "C" void kernel_launch(void* const* d_in, const int* in_sizes, int n_in, void* d_out, int out_size, void* d_ws, size_t ws_size, hipStream_t stream) {
    static int grid = 0;
    if (grid == 0) {
        if (n_in != 22 || out_size != NL * D || ws_size < WS_END) { fprintf(stderr, "kernel_launch: unexpected shapes (n_in %d out %d ws %zu)\n", n_in, out_size, ws_size); grid = -1; return; }
        int dev = 0, cus = 0;
        if (hipGetDevice(&dev) != hipSuccess || hipDeviceGetAttribute(&cus, hipDeviceAttributeMultiprocessorCount, dev) != hipSuccess) { grid = -1; return; }
        if (hipFuncSetAttribute((const void*)fwd_kernel, hipFuncAttributeMaxDynamicSharedMemorySize, LDS_BYTES) != hipSuccess) { fprintf(stderr, "kernel_launch: hipFuncSetAttribute failed\n"); grid = -1; return; }
        int per_cu = 0;
        (void)hipOccupancyMaxActiveBlocksPerMultiprocessor(&per_cu, (const void*)fwd_kernel, NTHREADS, LDS_BYTES);
        (void)hipGetLastError();
        grid = cus;
    }
    if (grid < 0) return;
    (void)hipMemsetAsync((char*)d_ws + WS_CTL, 0, CTL_ZERO_BYTES, stream);
    Args a{};
    for (int i = 0; i < 22; ++i) a.in[i] = (const float*)d_in[i];
    a.out = (float*)d_out; a.ws = (unsigned char*)d_ws;
    hipLaunchKernelGGL(fwd_kernel, dim3(grid), dim3(NTHREADS), LDS_BYTES, stream, a);
}
```

```cpp
#define STOP_AFTER 0
#include <hip/hip_runtime.h>
#include <cstdint>
#include <cstdio>

#define GAS __attribute__((address_space(1)))
#define LAS __attribute__((address_space(3)))
typedef unsigned short bf16_t;
typedef short bf16x8 __attribute__((ext_vector_type(8)));
typedef short bf16x4 __attribute__((ext_vector_type(4)));
typedef float f32x4 __attribute__((ext_vector_type(4)));
typedef float f32x2 __attribute__((ext_vector_type(2)));
typedef unsigned u32x4 __attribute__((ext_vector_type(4)));
typedef unsigned u32x2 __attribute__((ext_vector_type(2)));
typedef GAS unsigned gu32;

constexpr int D = 1024, NL = 16384, NC = 256, NT = NL + NC;
constexpr int INC = 2968, INP = 3072;
constexpr int C_CB = 0, C_CC = 256, C_CH = 512, C_DQ = 768, C_DK = 1152, C_DV = 1536, C_DZ = 1920, C_DA = 2304, C_DB = 2316, C_AQ = 2328, C_AK = 2712, C_AV = 2840;
constexpr int DFF = 2816, NEXP = 8, DFE = 3584;
constexpr int NWAVES = 8, NTHREADS = 512;
constexpr float EPS = 1e-6f;

constexpr size_t MiB = 1u << 20;
constexpr size_t WS_CTL = 0, CTL_ZERO_BYTES = 1 * MiB;
constexpr size_t WS_MOD = 1 * MiB;
constexpr size_t WS_ROPE = 1 * MiB + 128 * 1024;
constexpr size_t WS_HC = 2 * MiB;
constexpr size_t WS_G = 3 * MiB;
constexpr size_t WS_BETA = 4 * MiB;
constexpr size_t WS_ROUTE = 5 * MiB;
constexpr size_t WS_WIN = 8 * MiB;
constexpr size_t WS_WOUT = 20 * MiB;
constexpr size_t WS_WGU = 24 * MiB;
constexpr size_t WS_WDN = 35 * MiB;
constexpr size_t WS_MGU = 41 * MiB;
constexpr size_t WS_MDN = 153 * MiB;
constexpr size_t WS_ACT = 209 * MiB;
constexpr size_t WS_BIG = 242 * MiB;
constexpr size_t WS_PX = WS_BIG;
constexpr size_t WS_QD = 340 * MiB;
constexpr size_t QKV_STRIDE = 12 * MiB + 512 * 1024;
constexpr size_t WS_DN = 378 * MiB;
constexpr size_t DN_STRIDE = 25 * MiB;
constexpr size_t WS_END = 512 * MiB;
static_assert(WS_QD + 3 * QKV_STRIDE <= WS_DN && WS_DN + 5 * DN_STRIDE <= WS_END, "ws map");
static_assert((size_t)NT * INP * 2 <= WS_QD - WS_PX && (size_t)NT * 384 * 2 <= QKV_STRIDE && (size_t)3120 * 8192 <= DN_STRIDE, "ws map 2");

constexpr int SCR_BYTES = 139264;
constexpr int MISC_OFF = SCR_BYTES;
constexpr int LDS_BYTES = 147456;

#define RLX_AGENT __ATOMIC_RELAXED, __HIP_MEMORY_SCOPE_AGENT
#define LDS_WAIT() asm volatile("s_waitcnt lgkmcnt(0)" ::: "memory")
#define VM_WAIT() asm volatile("s_waitcnt vmcnt(0)" ::: "memory")

__device__ __forceinline__ unsigned f2bf(float f) { unsigned u = __builtin_bit_cast(unsigned, f); return (u + 0x7fffu + ((u >> 16) & 1u)) >> 16; }
__device__ __forceinline__ unsigned pk2(float lo, float hi) { return f2bf(lo) | (f2bf(hi) << 16); }
__device__ __forceinline__ float bf2f(unsigned h) { return __builtin_bit_cast(float, h << 16); }
__device__ __forceinline__ unsigned pk_fp8x4(float a, float b, float c, float d) {
    a = __builtin_fminf(__builtin_fmaxf(a, -448.f), 448.f); b = __builtin_fminf(__builtin_fmaxf(b, -448.f), 448.f);
    c = __builtin_fminf(__builtin_fmaxf(c, -448.f), 448.f); d = __builtin_fminf(__builtin_fmaxf(d, -448.f), 448.f);
    int p = __builtin_amdgcn_cvt_pk_fp8_f32(a, b, 0, false); p = __builtin_amdgcn_cvt_pk_fp8_f32(c, d, p, true); return (unsigned)p;
}
__device__ __forceinline__ float silu_f(float x) { return x * __builtin_amdgcn_rcpf(1.f + __expf(-x)); }
__device__ __forceinline__ int opq(int v) { asm volatile("" : "+v"(v)); return v; }
template <int CTRL> __device__ __forceinline__ float dpp_all(float v) { return __builtin_bit_cast(float, __builtin_amdgcn_update_dpp(0, __builtin_bit_cast(int, v), CTRL, 0xF, 0xF, true)); }
template <int CTRL, int RM> __device__ __forceinline__ float dpp_rows(float v) { return __builtin_bit_cast(float, __builtin_amdgcn_update_dpp(0, __builtin_bit_cast(int, v), CTRL, RM, 0xF, false)); }
__device__ __forceinline__ float sum8(float v) { v += dpp_all<0xB1>(v); v += dpp_all<0x4E>(v); v += dpp_all<0x141>(v); return v; }
__device__ __forceinline__ float wave_sum(float v) {
    v = sum8(v); v += dpp_all<0x140>(v);
    v += dpp_rows<0x142, 0xA>(v);
    v += dpp_rows<0x143, 0xC>(v);
    return __builtin_bit_cast(float, __builtin_amdgcn_readlane(__builtin_bit_cast(int, v), 63));
}
__device__ __forceinline__ float wave_sum_l(float v, int) { return wave_sum(v); }

#define XB_TMO      128
#define XB_XCNT(j)  (256  + 64 * (j))
#define XB_XSUB(j)  (1280 + 64 * (j))
#define XB_XGEN(j)  (2304 + 64 * (j))
#define XB_TOP      3328
#define XB_TOPGEN   3392
#define XCD_BAR_WORDS 3456
#define XB_SPIN_CAP (1u << 22)
__device__ __forceinline__ unsigned xb_ld(unsigned* p)              { return __hip_atomic_load(p, __ATOMIC_RELAXED, __HIP_MEMORY_SCOPE_AGENT); }
__device__ __forceinline__ unsigned xb_add(unsigned* p, unsigned v) { return __hip_atomic_fetch_add(p, v, __ATOMIC_RELAXED, __HIP_MEMORY_SCOPE_AGENT); }
__device__ __forceinline__ unsigned xb_xcc_id() { return (unsigned)__builtin_amdgcn_s_getreg((3 << 11) | 20) & 0xFu; }
#define XB_SPIN(cond, bar) do { unsigned _sp = 0; while (cond) { __builtin_amdgcn_s_sleep(1); \
    if ((++_sp & 255u) == 0u) { if (xb_ld(&(bar)[XB_TMO])) break; if (_sp > XB_SPIN_CAP) { atomicAdd(&(bar)[XB_TMO], 1u); break; } } } } while (0)
struct XcdBarrier { unsigned* bar; unsigned x; volatile LAS unsigned* st; };
__device__ __forceinline__ XcdBarrier xcd_barrier_post(unsigned* bar, volatile LAS unsigned* st) {
    XcdBarrier b; b.bar = bar; b.x = xb_xcc_id(); b.st = st;
    if (threadIdx.x == 0) (void)xb_add(&bar[XB_XCNT(b.x)], 1u);
    return b;
}
__device__ __forceinline__ void xcd_barrier_complete(unsigned* bar, unsigned x, unsigned& nloc, unsigned& nx) {
    const unsigned G = gridDim.x * gridDim.y * gridDim.z;
    unsigned sum, cnt, mine, sp = 0u;
    for (;;) {
        sum = 0u; cnt = 0u; mine = 0u;
#pragma unroll
        for (unsigned j = 0; j < 16; ++j) { const unsigned c = xb_ld(&bar[XB_XCNT(j)]); sum += c; cnt += (c > 0u) ? 1u : 0u; mine = (j == x) ? c : mine; }
        if (sum == G) break;
        __builtin_amdgcn_s_sleep(1);
        if ((++sp & 255u) == 0u) { if (xb_ld(&bar[XB_TMO])) break; if (sp > XB_SPIN_CAP) { atomicAdd(&bar[XB_TMO], 1u); break; } }
    }
    nloc = mine > 0u ? mine : 1u; nx = cnt > 0u ? cnt : 1u;
}
__device__ __forceinline__ void xcd_barrier(const XcdBarrier& b) {
    asm volatile("s_waitcnt vmcnt(0)" ::: "memory");
    __syncthreads();
    if (threadIdx.x == 0) {
        unsigned* bar = b.bar;
        __builtin_amdgcn_s_waitcnt(0);
        unsigned nloc = b.st[0], nx = b.st[1];
        if (nloc == 0u) { xcd_barrier_complete(bar, b.x, nloc, nx); b.st[0] = nloc; b.st[1] = nx; }
        const unsigned old = xb_add(&bar[XB_XSUB(b.x)], 1u);
        const unsigned gen = old / nloc;
        if (old + 1u == (gen + 1u) * nloc) {
            __builtin_amdgcn_fence(__ATOMIC_RELEASE, "agent");
            asm volatile("s_waitcnt vmcnt(0)" ::: "memory");
            const unsigned og = xb_add(&bar[XB_TOP], 1u);
            const unsigned tg = og / nx;
            if (og + 1u == (tg + 1u) * nx) xb_add(&bar[XB_TOPGEN], 1u);
            else XB_SPIN(xb_ld(&bar[XB_TOPGEN]) == tg, bar);
            __builtin_amdgcn_fence(__ATOMIC_ACQUIRE, "agent");
            xb_add(&bar[XB_XGEN(b.x)], 1u);
            asm volatile("s_waitcnt vmcnt(0)" ::: "memory");
        } else {
            XB_SPIN(xb_ld(&bar[XB_XGEN(b.x)]) == gen, bar);
            __builtin_amdgcn_fence(__ATOMIC_ACQUIRE, "agent");
            asm volatile("s_waitcnt vmcnt(0)" ::: "memory");
        }
    }
    __syncthreads();
}

#ifdef TS_A
#define TS_STAMP() do { if (blockIdx.x == 0 && threadIdx.x == 0) { volatile LAS unsigned* M_ = (volatile LAS unsigned*)(F.lds + MISC_OFF); const unsigned k_ = M_[12]; const unsigned long long t_ = __builtin_amdgcn_s_memrealtime(); M_[16 + 2 * k_] = (unsigned)t_; M_[17 + 2 * k_] = (unsigned)(t_ >> 32); M_[12] = k_ + 1; } } while (0)
#else
#define TS_STAMP() do {} while (0)
#endif
struct Args { const float* in[22]; float* out; unsigned char* ws; };
enum { I_X = 0, I_C, I_CTX, I_CCTX, I_WMOD, I_BMOD, I_WIN, I_WOUT, I_CONVW, I_DNCONVW, I_ALOG, I_DTB, I_NORMG, I_SINK, I_FG, I_FU, I_FD, I_ROUTER, I_MG, I_MU, I_MD, I_FNG };
struct Frame {
    LAS unsigned char* lds;
    int tid, lane, wave, vcu, G, gw, NGW;
    unsigned char* ws;
};

__device__ __forceinline__ void transpose_item(const float* __restrict__ W, int K, int N, bf16_t* WT, int mode, LAS float* scr, int kb, int nb, int lane) {
    const int k0 = 64 * kb, n0 = 64 * nb;
    const int nn = n0 + lane; const bool ok = nn < N;
    const float* src = W + (size_t)k0 * N + (ok ? nn : 0);
#pragma unroll 8
    for (int i = 0; i < 64; ++i) { float v = src[(size_t)i * N]; scr[i * 65 + lane] = ok ? v : 0.f; }
    LDS_WAIT(); asm volatile("" ::: "memory");
    const int c = lane & 7;
#pragma unroll
    for (int j = 0; j < 8; ++j) {
        const int n = (lane >> 3) + 8 * j; const LAS float* s = scr + (8 * c) * 65 + n;
        u32x4 o; o.x = pk2(s[0 * 65], s[1 * 65]); o.y = pk2(s[2 * 65], s[3 * 65]); o.z = pk2(s[4 * 65], s[5 * 65]); o.w = pk2(s[6 * 65], s[7 * 65]);
        const int ng = n0 + n; int drow = ng;
        if (mode == 1) drow = (ng >> 2) * 8 + (ng & 3); else if (mode == 2) drow = (ng >> 2) * 8 + 4 + (ng & 3);
        *(GAS u32x4*)(WT + (size_t)drow * K + k0 + 8 * c) = o;
    }
    LDS_WAIT(); asm volatile("" ::: "memory");
}

__device__ __forceinline__ void transpose_item8(const float* __restrict__ W, int K, int N, unsigned char* WT, int mode, float wscale, LAS float* scr, int kb, int nb, int lane) {
    const int k0 = 64 * kb, n0 = 64 * nb;
    const float* src = W + (size_t)k0 * N + n0 + lane;
#pragma unroll 8
    for (int i = 0; i < 64; ++i) scr[i * 65 + lane] = src[(size_t)i * N];
    LDS_WAIT(); asm volatile("" ::: "memory");
    const int c = lane & 3;
#pragma unroll
    for (int j = 0; j < 4; ++j) {
        const int n = (lane >> 2) + 16 * j; const LAS float* s = scr + (16 * c) * 65 + n;
        u32x4 o;
        o.x = pk_fp8x4(s[0 * 65] * wscale, s[1 * 65] * wscale, s[2 * 65] * wscale, s[3 * 65] * wscale);
        o.y = pk_fp8x4(s[4 * 65] * wscale, s[5 * 65] * wscale, s[6 * 65] * wscale, s[7 * 65] * wscale);
        o.z = pk_fp8x4(s[8 * 65] * wscale, s[9 * 65] * wscale, s[10 * 65] * wscale, s[11 * 65] * wscale);
        o.w = pk_fp8x4(s[12 * 65] * wscale, s[13 * 65] * wscale, s[14 * 65] * wscale, s[15 * 65] * wscale);
        const int ng = n0 + n; int drow = ng;
        if (mode == 1) drow = (ng >> 2) * 8 + (ng & 3); else if (mode == 2) drow = (ng >> 2) * 8 + 4 + (ng & 3);
        *(GAS u32x4*)(WT + (size_t)drow * K + k0 + 16 * c) = o;
    }
    LDS_WAIT(); asm volatile("" ::: "memory");
}
constexpr float MOE_WSCALE = 64.0f, MOE_HSCALE = 8.0f;
__device__ __forceinline__ void p0_prologue(Frame& F, const Args& A) {
    if (blockIdx.x < 192) {
        LAS float* sc = (LAS float*)F.lds;
        for (int i = F.tid; i < 1024; i += NTHREADS) { sc[i] = silu_f(A.in[I_C][i]); sc[1024 + i] = silu_f(A.in[I_CCTX][i]); }
        __syncthreads();
        const int l = blockIdx.x / 96, cg = blockIdx.x % 96;
        const float* W = A.in[I_WMOD] + (size_t)l * 1024 * 6144 + cg * 64 + F.lane;
        float ax = 0.f, ac = 0.f;
        const int kb = F.wave * 128;
#pragma unroll 8
        for (int k = 0; k < 128; ++k) { const float wv = W[(size_t)(kb + k) * 6144]; ax += sc[kb + k] * wv; ac += sc[1024 + kb + k] * wv; }
        LAS float* red = sc + 2048;
        red[F.wave * 64 + F.lane] = ax; red[512 + F.wave * 64 + F.lane] = ac;
        __syncthreads();
        if (F.wave == 0) {
            float sx = 0.f, sc2 = 0.f;
#pragma unroll
            for (int w = 0; w < 8; ++w) { sx += red[w * 64 + F.lane]; sc2 += red[512 + w * 64 + F.lane]; }
            const float b = A.in[I_BMOD][l * 6144 + cg * 64 + F.lane];
            float* mod = (float*)(F.ws + WS_MOD);
            mod[(l * 2 + 0) * 6144 + cg * 64 + F.lane] = sx + b;
            mod[(l * 2 + 1) * 6144 + cg * 64 + F.lane] = sc2 + b;
        }
        __syncthreads();
    } else if (blockIdx.x == 192) {
        float* rope = (float*)(F.ws + WS_ROPE);
        for (int i = F.tid; i < 256 * 16; i += NTHREADS) {
            const int pos = i >> 4, f = i & 15;
            const float inv = powf(10000.0f, -(float)(2 * f) / 32.0f);
            const float ang = (float)pos * inv;
            rope[2 * i] = cosf(ang); rope[2 * i + 1] = sinf(ang);
        }
    }
    LAS float* scr = (LAS float*)(F.lds + F.wave * 16640);
    constexpr int N_WIN = 2 * 16 * 48, N_WOUT = 2 * 16 * 16, N_FG = 16 * 44, N_FD = 44 * 16, N_MG = 8 * 16 * 56, N_MD = 8 * 56 * 16;
    constexpr int NITEMS = N_WIN + N_WOUT + 2 * N_FG + N_FD + 2 * N_MG + N_MD;
    bf16_t* ws16 = (bf16_t*)F.ws;
    for (int it = F.gw; it < NITEMS; it += F.NGW) {
        int r = it;
        if (r < N_WIN) { const int l = r / (16 * 48), q = r % (16 * 48); transpose_item(A.in[I_WIN] + (size_t)l * 1024 * INC, 1024, INC, (bf16_t*)(F.ws + WS_WIN) + (size_t)l * INP * 1024, 0, scr, q / 48, q % 48, F.lane); continue; } r -= N_WIN;
        if (r < N_WOUT) { const int l = r / 256, q = r % 256; transpose_item(A.in[I_WOUT] + (size_t)l * 1024 * 1024, 1024, 1024, (bf16_t*)(F.ws + WS_WOUT) + (size_t)l * 1024 * 1024, 0, scr, q / 16, q % 16, F.lane); continue; } r -= N_WOUT;
        if (r < N_FG) { transpose_item(A.in[I_FG], 1024, DFF, (bf16_t*)(F.ws + WS_WGU), 1, scr, r / 44, r % 44, F.lane); continue; } r -= N_FG;
        if (r < N_FG) { transpose_item(A.in[I_FU], 1024, DFF, (bf16_t*)(F.ws + WS_WGU), 2, scr, r / 44, r % 44, F.lane); continue; } r -= N_FG;
        if (r < N_FD) { transpose_item(A.in[I_FD], DFF, 1024, (bf16_t*)(F.ws + WS_WDN), 0, scr, r / 16, r % 16, F.lane); continue; } r -= N_FD;
        if (r < N_MG) { const int e = r / (16 * 56), q = r % (16 * 56); transpose_item8(A.in[I_MG] + (size_t)e * 1024 * DFE, 1024, DFE, F.ws + WS_MGU + (size_t)e * 2 * DFE * 1024, 1, MOE_WSCALE, scr, q / 56, q % 56, F.lane); continue; } r -= N_MG;
        if (r < N_MG) { const int e = r / (16 * 56), q = r % (16 * 56); transpose_item8(A.in[I_MU] + (size_t)e * 1024 * DFE, 1024, DFE, F.ws + WS_MGU + (size_t)e * 2 * DFE * 1024, 2, MOE_WSCALE, scr, q / 56, q % 56, F.lane); continue; } r -= N_MG;
        { const int e = r / (56 * 16), q = r % (56 * 16); transpose_item8(A.in[I_MD] + (size_t)e * DFE * 1024, DFE, 1024, F.ws + WS_MDN + (size_t)e * 1024 * DFE, 0, MOE_WSCALE, scr, q / 16, q % 16, F.lane); }
    }
    (void)ws16;
}

__device__ __forceinline__ void norm_mod_row(const float* xrow, const f32x4 (&sh)[4], const f32x4 (&sc1)[4], bf16_t* orow, int lane) {
    const GAS f32x4* xr = (const GAS f32x4*)xrow + lane;
    f32x4 v[4]; float s = 0.f;
#pragma unroll
    for (int j = 0; j < 4; ++j) { v[j] = xr[64 * j]; s += (v[j].x * v[j].x + v[j].y * v[j].y) + (v[j].z * v[j].z + v[j].w * v[j].w); }
    const float rstd = 1.0f / sqrtf(wave_sum(s) * (1.f / D) + EPS);
    GAS u32x2* o8 = (GAS u32x2*)orow + lane;
#pragma unroll
    for (int j = 0; j < 4; ++j) {
        const f32x4 y = v[j] * rstd * sc1[j] + sh[j];
        u32x2 w; w.x = pk2(y.x, y.y); w.y = pk2(y.z, y.w); o8[64 * j] = w;
    }
}
__device__ __forceinline__ void norm_phase(Frame& F, const float* xl, const float* xc, int layer, int s_shift, int s_scale, int nrows) {
    const float* mod = (const float*)(F.ws + WS_MOD);
    const float* mx = mod + (layer * 2 + 0) * 6144; const float* mc = mod + (layer * 2 + 1) * 6144;
    bf16_t* act = (bf16_t*)(F.ws + WS_ACT);
    f32x4 shl[4], scl[4];
#pragma unroll
    for (int j = 0; j < 4; ++j) { shl[j] = ((const GAS f32x4*)(mx + s_shift * 1024))[F.lane + 64 * j]; scl[j] = ((const GAS f32x4*)(mx + s_scale * 1024))[F.lane + 64 * j] + 1.0f; }
    for (int m = F.gw; m < nrows; m += F.NGW) {
        if (m < NL) norm_mod_row(xl + (size_t)m * D, shl, scl, act + (size_t)m * D, F.lane);
        else { f32x4 shc[4], scc[4];
#pragma unroll
            for (int j = 0; j < 4; ++j) { shc[j] = ((const GAS f32x4*)(mc + s_shift * 1024))[F.lane + 64 * j]; scc[j] = ((const GAS f32x4*)(mc + s_scale * 1024))[F.lane + 64 * j] + 1.0f; }
            norm_mod_row(xc + (size_t)(m - NL) * D, shc, scc, act + (size_t)m * D, F.lane); }
    }
}

namespace pg8 {
typedef int v8i __attribute__((ext_vector_type(8)));
constexpr int BM = 256, BK = 64, HALF = 128, HTB = HALF * BK * 2, STAGE_BYTES = 8 * HTB, NXCD = 8, WGM = 8;
__host__ __device__ __forceinline__ int lds_byte(int r, int c) { const int st = (r >> 4) * 2 + (c >> 5), rr = r & 15, cc = c & 31, ob = rr * 64 + cc * 2; return st * 1024 + (ob ^ (((ob >> 9) & 1) << 5)); }
__host__ __device__ __forceinline__ void stage_rc(int b, int& R, int& C) { const int st = b / 1024, sb = b % 1024, swz = sb ^ (((sb >> 9) & 1) << 5); R = (st >> 1) * 16 + swz / 64; C = (st & 1) * 32 + (swz % 64) / 2; }
__host__ __device__ __forceinline__ int perm32(int rho) { const int n = rho >> 4, i = rho & 15; return 8 * (i >> 2) + 4 * n + (i & 3); }
struct Unit { int pm, pn; const char* a; const char* b; };
typedef __bf16 bf16x2_t __attribute__((ext_vector_type(2)));
__device__ __forceinline__ unsigned cvt_pk_bf16(float lo, float hi) { f32x2 v = {lo, hi}; bf16x2_t b = __builtin_convertvector(v, bf16x2_t); return __builtin_bit_cast(unsigned, b); }

__device__ __forceinline__ bool tile_order(int i, int G, int c, int nM, int nN, int& pm, int& pn) {
    const int nwg = nM * nN; const long L = (long)i * G + c; if (L >= nwg) return false;
    int wgid = (int)L; { const int q = nwg / NXCD, r = nwg % NXCD, xcd = wgid % NXCD, off = wgid / NXCD; wgid = (xcd < r ? xcd * (q + 1) : r * (q + 1) + (xcd - r) * q) + off; }
    const int nig = WGM * nN, gid = wgid / nig, fm = gid * WGM, gsz = (nM - fm) < WGM ? (nM - fm) : WGM;
    pm = fm + ((wgid % nig) % gsz); pn = (wgid % nig) / gsz; return true;
}
struct DenseSched {
    int nM, nN, G, c; const char* A; const char* B; size_t tstep;
    __device__ __forceinline__ bool next(int i, Unit& u) const {
        int pm, pn; if (!tile_order(i, G, c, nM, nN, pm, pn)) return false;
        u.pm = pm; u.pn = pn; u.a = A + (size_t)pm * tstep; u.b = B + (size_t)pn * tstep; return true;
    }
};
struct MoeSched {
    int nM, nN, G, c; const char* A; const char* B; size_t tstep, estride; const unsigned* tile_e; int t0, pm_off;
    __device__ __forceinline__ bool next(int i, Unit& u) const {
        int pm, pn; if (!tile_order(i, G, c, nM, nN, pm, pn)) return false;
        const unsigned e = __builtin_amdgcn_readfirstlane(__hip_atomic_load(tile_e + t0 + pm, __ATOMIC_RELAXED, __HIP_MEMORY_SCOPE_AGENT)) & 7u;
        u.pm = pm + pm_off; u.pn = pn; u.a = A + (size_t)pm * tstep; u.b = B + (size_t)e * estride + (size_t)pn * tstep; return true;
    }
};

using ::pk_fp8x4;
struct EpiSwiGLU8 {
    static constexpr bool PERM = true;
    unsigned char* H; int ldh; float ascale, hs;
    __device__ __forceinline__ void operator()(const f32x4 (&acc)[2][2][4][2], const Unit& u, int wr, int wc, int fr, int fq) const {
        const int row0 = u.pm * BM + wr * 64 + fr, col0 = u.pn * 128 + wc * 16 + 4 * fq;
#pragma unroll
        for (int ai = 0; ai < 2; ++ai)
#pragma unroll
            for (int m = 0; m < 4; ++m) { unsigned char* rowp = H + (size_t)(row0 + ai * HALF + m * 16) * ldh + col0;
#pragma unroll
                for (int bj = 0; bj < 2; ++bj) { const f32x4 g = acc[ai][bj][m][0] * ascale, up = acc[ai][bj][m][1] * (ascale * hs);
                    float h[4];
#pragma unroll
                    for (int e = 0; e < 4; ++e) h[e] = g[e] * __builtin_amdgcn_rcpf(1.f + __expf(-g[e])) * up[e];
                    *(unsigned*)(rowp + bj * 64) = pk_fp8x4(h[0], h[1], h[2], h[3]); }
                asm volatile("" ::: "memory"); }
    }
};
struct EpiStoreBf16 {
    static constexpr bool PERM = true;
    bf16_t* O; int ldc; float scale = 1.0f;
    __device__ __forceinline__ void operator()(const f32x4 (&acc)[2][2][4][2], const Unit& u, int wr, int wc, int fr, int fq) const {
        const int row0 = u.pm * BM + wr * 64 + fr, col0 = u.pn * BM + wc * 32 + 8 * fq;
#pragma unroll
        for (int ai = 0; ai < 2; ++ai)
#pragma unroll
            for (int m = 0; m < 4; ++m) { bf16_t* rowp = O + (size_t)(row0 + ai * HALF + m * 16) * ldc + col0;
#pragma unroll
                for (int bj = 0; bj < 2; ++bj) { const f32x4 v0 = acc[ai][bj][m][0] * scale, v1 = acc[ai][bj][m][1] * scale;
                    u32x4 w; w.x = cvt_pk_bf16(v0[0], v0[1]); w.y = cvt_pk_bf16(v0[2], v0[3]); w.z = cvt_pk_bf16(v1[0], v1[1]); w.w = cvt_pk_bf16(v1[2], v1[3]);
                    *(u32x4*)(rowp + bj * HALF) = w; } }
    }
};
struct EpiSwiGLU {
    static constexpr bool PERM = true;
    bf16_t* H; int ldh;
    __device__ __forceinline__ void operator()(const f32x4 (&acc)[2][2][4][2], const Unit& u, int wr, int wc, int fr, int fq) const {
        const int row0 = u.pm * BM + wr * 64 + fr, col0 = u.pn * 128 + wc * 16 + 4 * fq;
#pragma unroll
        for (int ai = 0; ai < 2; ++ai)
#pragma unroll
            for (int m = 0; m < 4; ++m) { bf16_t* rowp = H + (size_t)(row0 + ai * HALF + m * 16) * ldh + col0;
#pragma unroll
                for (int bj = 0; bj < 2; ++bj) { const f32x4 g = acc[ai][bj][m][0], up = acc[ai][bj][m][1];
                    float h[4];
#pragma unroll
                    for (int e = 0; e < 4; ++e) h[e] = g[e] * __builtin_amdgcn_rcpf(1.f + __expf(-g[e])) * up[e];
                    u32x2 w; w.x = cvt_pk_bf16(h[0], h[1]); w.y = cvt_pk_bf16(h[2], h[3]);
                    *(u32x2*)(rowp + bj * 64) = w; }
                asm volatile("" ::: "memory"); }
    }
};
struct EpiResid {
    static constexpr bool PERM = false;
    const float* base_l; float* out_l; const float* gate_l; const float* base_c; float* out_c; const float* gate_c; int ctx_tile;
    __device__ __forceinline__ void operator()(const f32x4 (&acc)[2][2][4][2], const Unit& u, int wr, int wc, int fr, int fq) const {
        const bool isc = u.pm >= ctx_tile;
        const float* base = isc ? base_c : base_l; float* out = isc ? out_c : out_l; const float* gate = isc ? gate_c : gate_l;
        const int row0 = (isc ? (u.pm - ctx_tile) : u.pm) * BM + wr * 64 + fr, col0 = u.pn * BM + wc * 32 + 4 * fq;
        f32x4 gv[2][2];
#pragma unroll
        for (int bj = 0; bj < 2; ++bj)
#pragma unroll
            for (int n = 0; n < 2; ++n) gv[bj][n] = *(const f32x4*)(gate + col0 + bj * HALF + n * 16);
#pragma unroll
        for (int ai = 0; ai < 2; ++ai)
#pragma unroll
            for (int m = 0; m < 4; ++m) { const size_t off = (size_t)(row0 + ai * HALF + m * 16) * D + col0;
#pragma unroll
                for (int bj = 0; bj < 2; ++bj)
#pragma unroll
                    for (int n = 0; n < 2; ++n) { const f32x4 bs = *(const f32x4*)(base + off + bj * HALF + n * 16);
                        *(f32x4*)(out + off + bj * HALF + n * 16) = bs + gv[bj][n] * acc[ai][bj][m][n]; } }
    }
};

struct MoeTailSched {
    int ntail, G, c; const char* A; const char* B; size_t tstep, estride; const unsigned* tile_e; int tile0; size_t ksb;
    __device__ __forceinline__ bool next(int i, Unit& u) const {
        const long L = (long)i * G + c; if (L >= (long)ntail * 28) return false;
        const int ks = (int)(L % 7), q = (int)(L / 7), pn = q & 3, tt = q >> 2;
        const unsigned e = __builtin_amdgcn_readfirstlane(__hip_atomic_load(tile_e + tile0 + tt, __ATOMIC_RELAXED, __HIP_MEMORY_SCOPE_AGENT)) & 7u;
        u.pm = q * 7 + ks; u.pn = 0; u.a = A + (size_t)tt * tstep + (size_t)ks * ksb; u.b = B + (size_t)e * estride + (size_t)pn * tstep + (size_t)ks * ksb; return true;
    }
};
struct EpiSlab {
    static constexpr bool PERM = false;
    float* slab; float scale = 1.0f;
    __device__ __forceinline__ void operator()(const f32x4 (&acc)[2][2][4][2], const Unit& u, int wr, int wc, int fr, int fq) const {
        float* base = slab + (size_t)u.pm * 65536 + (size_t)(wr * 64 + fr) * 256 + wc * 32 + 4 * fq;
#pragma unroll
        for (int ai = 0; ai < 2; ++ai)
#pragma unroll
            for (int m = 0; m < 4; ++m)
#pragma unroll
                for (int bj = 0; bj < 2; ++bj)
#pragma unroll
                    for (int n = 0; n < 2; ++n) *(f32x4*)(base + (size_t)(ai * HALF + m * 16) * 256 + bj * HALF + n * 16) = acc[ai][bj][m][n] * scale;
    }
};

template <bool FP8 = false, class Epi, class Sched>
__device__ __forceinline__ void gemm_phase(LAS unsigned char* lds, const int K, const Sched& S, const Epi& E, const int ntk = 0) {
    int tid_ = threadIdx.x; asm volatile("" : "+v"(tid_));
    const int tid = tid_, wid = __builtin_amdgcn_readfirstlane(tid >> 6), lane = tid & 63, wr = wid >> 2, wc = wid & 3, fr = lane & 15, fq = lane >> 4;
    const int nt = ntk ? ntk : K / BK;
    unsigned voffA[2], voffB[2];
#pragma unroll
    for (int i = 0; i < 2; ++i) { int R, C; stage_rc(tid * 16 + i * 8192, R, C); const int Rb = Epi::PERM ? ((R & ~31) + perm32(R & 31)) : R;
        voffA[i] = (unsigned)(R * K + C) * 2u; voffB[i] = (unsigned)(Rb * K + C) * 2u; }
    const size_t kstep = (size_t)(BK * 2);
    const size_t hstep = (size_t)HALF * K * 2;
    const unsigned ldsw = (unsigned)wid * 1024u;
    const int aoff = lds_byte(wr * 64 + fr, fq * 8), boff = lds_byte(wc * 32 + fr, fq * 8);
#define PG8_SA(b, h) (((b) * 2 + (h)) * HTB)
#define PG8_SB(b, h) ((4 + (b) * 2 + (h)) * HTB)
#define PG8_STAGE(bufoff, gbase, voff) do { _Pragma("unroll") for (int _i = 0; _i < 2; ++_i) \
        __builtin_amdgcn_global_load_lds((const unsigned*)((const char*)(gbase) + (voff)[_i]), (LAS unsigned*)(lds + (bufoff) + ldsw + _i * 8192), 16, 0, 0); } while (0)
#define PG8_LDA(dst, b, h) do { _Pragma("unroll") for (int m = 0; m < 4; ++m) _Pragma("unroll") for (int k = 0; k < 2; ++k) dst[m].k[k] = *(const LAS bf16x8*)(lds + PG8_SA(b, h) + aoff + m * 2048 + k * 1024); } while (0)
#define PG8_LDB(dst, b, h) do { _Pragma("unroll") for (int n = 0; n < 2; ++n) _Pragma("unroll") for (int k = 0; k < 2; ++k) dst[n].k[k] = *(const LAS bf16x8*)(lds + PG8_SB(b, h) + boff + n * 2048 + k * 1024); } while (0)
#define PG8_MMA(ai, bj, At, Bt) do { if constexpr (FP8) __builtin_amdgcn_sched_barrier(0); __builtin_amdgcn_s_setprio(1); _Pragma("unroll") for (int m = 0; m < 4; ++m) _Pragma("unroll") for (int n = 0; n < 2; ++n) { \
        if constexpr (FP8) acc[ai][bj][m][n] = __builtin_amdgcn_mfma_scale_f32_16x16x128_f8f6f4(__builtin_bit_cast(v8i, Bt[n]), __builtin_bit_cast(v8i, At[m]), acc[ai][bj][m][n], 0, 0, 0, 127, 0, 127); \
        else { _Pragma("unroll") for (int k = 0; k < 2; ++k) acc[ai][bj][m][n] = __builtin_amdgcn_mfma_f32_16x16x32_bf16(Bt[n].k[k], At[m].k[k], acc[ai][bj][m][n], 0, 0, 0); } } \
        if constexpr (FP8) { _Pragma("unroll") for (int m = 0; m < 4; ++m) _Pragma("unroll") for (int n = 0; n < 2; ++n) asm volatile("" : "+v"(acc[ai][bj][m][n])); } \
        __builtin_amdgcn_s_setprio(0); if constexpr (FP8) __builtin_amdgcn_sched_barrier(0); } while (0)
#define PG8_WAIT_V(n) asm volatile("s_waitcnt vmcnt(" #n ")" ::: "memory")
#define PG8_WAIT_L(n) asm volatile("s_waitcnt lgkmcnt(" #n ")" ::: "memory")
#define PG8_BAR __builtin_amdgcn_s_barrier()
#define PG8_SCHED __builtin_amdgcn_sched_barrier(0)
    Unit cur, nxt; int ui = 0;
    if (!S.next(0, cur)) return;
    f32x4 acc[2][2][4][2];
#pragma unroll
    for (int a = 0; a < 2; ++a)
#pragma unroll
        for (int b = 0; b < 2; ++b)
#pragma unroll
            for (int m = 0; m < 4; ++m)
#pragma unroll
                for (int n = 0; n < 2; ++n) acc[a][b][m][n] = (f32x4){0.f, 0.f, 0.f, 0.f};
    struct Frag { bf16x8 k[2]; };
    Frag At[4], B0[2], B1[2];
    const char* cA = cur.a; const char* cB = cur.b;
    PG8_STAGE(PG8_SB(0, 0), cB, voffB); PG8_STAGE(PG8_SB(0, 1), cB + hstep, voffB); PG8_STAGE(PG8_SA(0, 0), cA, voffA); PG8_STAGE(PG8_SA(0, 1), cA + hstep, voffA);
    if (wr == 1) PG8_BAR;
    PG8_WAIT_V(2); PG8_BAR;
    PG8_STAGE(PG8_SB(1, 0), cB + kstep, voffB); PG8_STAGE(PG8_SA(1, 0), cA + kstep, voffA); PG8_STAGE(PG8_SB(1, 1), cB + hstep + kstep, voffB);
    PG8_WAIT_V(6); PG8_BAR;
    for (;;) {
        const bool has_next = S.next(ui + 1, nxt);
        const char* nA = has_next ? nxt.a : cA; const char* nB = has_next ? nxt.b : cB;
        for (int t = 0; t < nt; t += 2) {
            const bool last = (t == nt - 2);
            const char* a1 = cA + (size_t)(t + 1) * kstep;
            const char* a2 = last ? nA : cA + (size_t)(t + 2) * kstep; const char* b2 = last ? nB : cB + (size_t)(t + 2) * kstep;
            const char* a3 = a2 + kstep; const char* b3 = b2 + kstep;
            PG8_LDB(B0, 0, 0); PG8_LDB(B1, 0, 1); PG8_SCHED; PG8_LDA(At, 0, 0); PG8_STAGE(PG8_SA(1, 1), a1 + hstep, voffA);
            PG8_WAIT_V(8); PG8_WAIT_L(0); PG8_BAR; PG8_MMA(0, 0, At, B0); PG8_MMA(0, 1, At, B1); PG8_BAR; PG8_SCHED;
            PG8_LDA(At, 0, 1); PG8_STAGE(PG8_SB(0, 0), b2, voffB); PG8_STAGE(PG8_SB(0, 1), b2 + hstep, voffB); PG8_STAGE(PG8_SA(0, 0), a2, voffA);
            PG8_WAIT_V(8); PG8_WAIT_L(0); PG8_BAR; PG8_MMA(1, 0, At, B0); PG8_MMA(1, 1, At, B1); PG8_BAR; PG8_SCHED;
            PG8_LDB(B0, 1, 0); PG8_LDB(B1, 1, 1); PG8_SCHED; PG8_LDA(At, 1, 0); PG8_STAGE(PG8_SA(0, 1), a2 + hstep, voffA);
            PG8_WAIT_V(8); PG8_WAIT_L(0); PG8_BAR; PG8_MMA(0, 0, At, B0); PG8_MMA(0, 1, At, B1); PG8_BAR; PG8_SCHED;
            PG8_LDA(At, 1, 1); PG8_STAGE(PG8_SB(1, 0), b3, voffB); PG8_STAGE(PG8_SB(1, 1), b3 + hstep, voffB); PG8_STAGE(PG8_SA(1, 0), a3, voffA);
            PG8_WAIT_V(8); PG8_WAIT_L(0); PG8_BAR; PG8_MMA(1, 0, At, B0); PG8_MMA(1, 1, At, B1); PG8_BAR; PG8_SCHED;
        }
        if (wr == 0) PG8_BAR;
        E(acc, cur, wr, wc, fr, fq);
        if (!has_next) break;
#pragma unroll
        for (int a = 0; a < 2; ++a)
#pragma unroll
            for (int b = 0; b < 2; ++b)
#pragma unroll
                for (int m = 0; m < 4; ++m)
#pragma unroll
                    for (int n = 0; n < 2; ++n) acc[a][b][m][n] = (f32x4){0.f, 0.f, 0.f, 0.f};
        cur = nxt; cA = nA; cB = nB; ++ui;
        if (wr == 1) PG8_BAR;
    }
    PG8_WAIT_V(0);
    PG8_BAR;
#undef PG8_SA
#undef PG8_SB
#undef PG8_STAGE
#undef PG8_LDA
#undef PG8_LDB
#undef PG8_MMA
#undef PG8_WAIT_V
#undef PG8_WAIT_L
#undef PG8_BAR
#undef PG8_SCHED
}
}

constexpr size_t WS_GL = 7 * MiB;
__device__ __forceinline__ float ldbf(const bf16_t* p) { return bf2f(*p); }
__device__ __forceinline__ void unpk8(const u32x4 v, float (&f)[8]) {
    f[0] = bf2f(v.x & 0xffffu); f[1] = bf2f(v.x >> 16); f[2] = bf2f(v.y & 0xffffu); f[3] = bf2f(v.y >> 16);
    f[4] = bf2f(v.z & 0xffffu); f[5] = bf2f(v.z >> 16); f[6] = bf2f(v.w & 0xffffu); f[7] = bf2f(v.w >> 16);
}
__device__ __forceinline__ u32x4 pk8(const float (&f)[8]) { u32x4 o; o.x = pk2(f[0], f[1]); o.y = pk2(f[2], f[3]); o.z = pk2(f[4], f[5]); o.w = pk2(f[6], f[7]); return o; }
__device__ __forceinline__ void prep_phase(Frame& F, const Args& A, int layer) {
    bf16_t* PX = (bf16_t*)(F.ws + WS_PX);
    bf16_t* ACT = (bf16_t*)(F.ws + WS_ACT);
    bf16_t* QD = (bf16_t*)(F.ws + WS_QD); bf16_t* KD = (bf16_t*)(F.ws + WS_QD + QKV_STRIDE); bf16_t* VD = (bf16_t*)(F.ws + WS_QD + 2 * QKV_STRIDE);
    float* Gg = (float*)(F.ws + WS_G); float* Bt = (float*)(F.ws + WS_BETA);
    const float* rope = (const float*)(F.ws + WS_ROPE);
    LAS float* sdw = (LAS float*)F.lds;
    LAS float* scw = sdw + 3 * 1152;
    for (int i = F.tid; i < 3 * 1152; i += NTHREADS) sdw[i] = A.in[I_DNCONVW][layer * 3 * 1152 + i];
    for (int i = F.tid; i < 3 * 256; i += NTHREADS) scw[i] = A.in[I_CONVW][layer * 3 * 256 + i];
    __syncthreads();
    const int lane = F.lane;
    constexpr int RPW = (NT + 2047) / 2048;
    const int mlo = F.gw * RPW, mhi = (mlo + RPW) < NT ? (mlo + RPW) : NT;
    const u32x4 zero4 = (u32x4){0u, 0u, 0u, 0u};
#pragma unroll 3
    for (int m = mlo; m < mhi; ++m) {
        const bool hasp = (m != 0 && m != NL), hasn = (m != NL - 1 && m != NT - 1);
        const bf16_t* r0 = PX + (size_t)m * INP; const bf16_t* rp = r0 - INP; const bf16_t* rn = r0 + INP;
        if (lane < 32) {
            const int c0 = 8 * lane;
            float b[8], c1[8], h1[8], cp[8], hp[8], cn[8], hn[8], o[8];
            unpk8(*(const u32x4*)(r0 + C_CB + c0), b); unpk8(*(const u32x4*)(r0 + C_CC + c0), c1); unpk8(*(const u32x4*)(r0 + C_CH + c0), h1);
            unpk8(hasp ? *(const u32x4*)(rp + C_CC + c0) : zero4, cp); unpk8(hasp ? *(const u32x4*)(rp + C_CH + c0) : zero4, hp);
            unpk8(hasn ? *(const u32x4*)(rn + C_CC + c0) : zero4, cn); unpk8(hasn ? *(const u32x4*)(rn + C_CH + c0) : zero4, hn);
#pragma unroll
            for (int e = 0; e < 8; ++e) o[e] = b[e] * (scw[c0 + e] * (cp[e] * hp[e]) + scw[256 + c0 + e] * (c1[e] * h1[e]) + scw[512 + c0 + e] * (cn[e] * hn[e]));
            *(u32x4*)(ACT + (size_t)m * D + c0) = pk8(o);
        } else if (lane < 56) {
            const int q = lane - 32;
            const float a = bf2f(r0[C_DA + q]);
            if (q < 12) { const float sp = a + A.in[I_DTB][layer * 12 + q]; const float softp = (sp > 20.f) ? sp : __logf(1.0f + __expf(sp)); Gg[(size_t)m * 12 + q] = -__expf(A.in[I_ALOG][layer * 12 + q]) * softp; }
            else Bt[(size_t)m * 12 + (q - 12)] = __builtin_amdgcn_rcpf(1.0f + __expf(-a));
        }
#pragma unroll
        for (int ps = 0; ps < 3; ++ps) {
            const int v = 64 * ps + lane;
            if (ps < 2 || lane < 16) {
                const int c0 = 8 * v, p = c0 / 384;
                float x0[8], x1[8], x2[8], o[8];
                unpk8(hasp ? *(const u32x4*)(rp + C_DQ + c0) : zero4, x0); unpk8(*(const u32x4*)(r0 + C_DQ + c0), x1); unpk8(hasn ? *(const u32x4*)(rn + C_DQ + c0) : zero4, x2);
                float ss = 0.f;
#pragma unroll
                for (int e = 0; e < 8; ++e) { o[e] = silu_f(sdw[c0 + e] * x0[e] + sdw[1152 + c0 + e] * x1[e] + sdw[2304 + c0 + e] * x2[e]); ss += o[e] * o[e]; }
                ss = sum8(ss);
                const float sc = p == 2 ? 1.0f : __builtin_amdgcn_rsqf(ss + 1e-6f) * (p == 0 ? 0.125f : 1.0f);
#pragma unroll
                for (int e = 0; e < 8; ++e) o[e] *= sc;
                bf16_t* dst = (p == 0 ? QD : (p == 1 ? KD : VD)) + (size_t)m * 384 + (c0 - p * 384);
                *(u32x4*)dst = pk8(o);
            }
        }
        if (m < NL) {
            const int head = lane >> 3, v8 = lane & 7, axis = v8 >> 2, vv = v8 & 3;
            bf16_t* px = PX + (size_t)m * INP + (head < 6 ? C_AQ + head * 64 : C_AK + (head - 6) * 64) + 8 * v8;
            const u32x4 own = *(const u32x4*)px;
            u32x4 oth;
            oth.x = (unsigned)__builtin_amdgcn_update_dpp(0, (int)own.x, 0x4E, 0xF, 0xF, true); oth.y = (unsigned)__builtin_amdgcn_update_dpp(0, (int)own.y, 0x4E, 0xF, 0xF, true);
            oth.z = (unsigned)__builtin_amdgcn_update_dpp(0, (int)own.z, 0x4E, 0xF, 0xF, true); oth.w = (unsigned)__builtin_amdgcn_update_dpp(0, (int)own.w, 0x4E, 0xF, 0xF, true);
            float a[8], b[8], o[8]; unpk8(own, a); unpk8(oth, b);
            const int pos = axis == 0 ? (m >> 6) : (m & 63);
            const float* rt = rope + (pos * 16 + 8 * (vv & 1)) * 2;
            const float sgn = (vv < 2) ? -1.0f : 1.0f;
#pragma unroll
            for (int e = 0; e < 8; ++e) o[e] = a[e] * rt[2 * e] + sgn * b[e] * rt[2 * e + 1];
            *(u32x4*)px = pk8(o);
        }
    }
    __syncthreads();
}

constexpr int DN_NS = 260, DN_NU = 12 * DN_NS;
__device__ __forceinline__ int dn_row0(int d, int s) {
    if (s < 4) return NL + 64 * (d == 0 ? s : 3 - s);
    return 64 * (d == 0 ? (s - 4) : 255 - (s - 4));
}
__device__ __forceinline__ void pair_bar(volatile LAS unsigned* cnt, unsigned& epoch, int lane) {
    epoch += 2u;
    asm volatile("s_waitcnt vmcnt(0) lgkmcnt(0)" ::: "memory");
    if (lane == 0) __hip_atomic_fetch_add((LAS unsigned*)cnt, 1u, __ATOMIC_RELAXED, __HIP_MEMORY_SCOPE_WORKGROUP);
    while (*cnt < epoch) __builtin_amdgcn_s_sleep(1);
    asm volatile("" ::: "memory");
}
__device__ __forceinline__ void dn_chunk_phase(Frame& F) {
    const bf16_t* KD = (const bf16_t*)(F.ws + WS_QD + QKV_STRIDE); const bf16_t* VD = (const bf16_t*)(F.ws + WS_QD + 2 * QKV_STRIDE);
    const float* Gg = (const float*)(F.ws + WS_G); const float* Bt = (const float*)(F.ws + WS_BETA);
    bf16_t* Wm = (bf16_t*)(F.ws + WS_DN); bf16_t* KDt = (bf16_t*)(F.ws + WS_DN + DN_STRIDE); bf16_t* Ut = (bf16_t*)(F.ws + WS_DN + 2 * DN_STRIDE);
    float* GL = (float*)(F.ws + WS_GL);
    const int gi = F.wave >> 1, wl = F.wave & 1;
    LAS unsigned char* R = F.lds + gi * 18432;
    LAS float* Am = (LAS float*)R;
    LAS float* gcs = Am + 64 * 68; LAS float* bts = gcs + 64;
    volatile LAS unsigned* pcnt = (volatile LAS unsigned*)(R + 17920);
    if (F.tid < 4) *(volatile LAS unsigned*)(F.lds + F.tid * 18432 + 17920) = 0u;
    __syncthreads();
    unsigned epoch = 0u;
#pragma unroll 1
    for (int base = blockIdx.x * 4; base + gi < DN_NU; base += F.G * 4) {
        const int lane = opq(F.lane), r = lane & 15, g = lane >> 4;
        const int U = base + gi; const bool act = U < DN_NU;
        const int dh = act ? U / DN_NS : 0, s = act ? U % DN_NS : 0, d = dh / 6, h = dh % 6;
        const int row0 = dn_row0(d, s);
        const size_t ub = (size_t)U * 4096;
        if (act) {
            if (wl == 0) {
                const int io = d ? 63 - lane : lane;
                float gv = Gg[(size_t)(row0 + io) * 12 + d * 6 + h];
#pragma unroll
                for (int o = 1; o < 64; o <<= 1) { const float t = __shfl_up(gv, o); if (lane >= o) gv += t; }
                gcs[lane] = gv; bts[lane] = Bt[(size_t)(row0 + io) * 12 + d * 6 + h];
                if (lane == 63) GL[U] = expf(gv);
            }
            const bf16_t* tsrc = (wl == 0 ? VD : KD) + (size_t)row0 * 384 + h * 64;
            u32x4 tv[8];
#pragma unroll
            for (int j = 0; j < 8; ++j) tv[j] = *(const u32x4*)(tsrc + (size_t)(8 * j + (lane >> 3)) * 384 + (lane & 7) * 8);
#pragma unroll
            for (int j = 0; j < 8; ++j) *(LAS u32x4*)(R + (1 - wl) * 8192 + (8 * j + (lane >> 3)) * 128 + (lane & 7) * 16) = tv[j];
        }
        pair_bar(pcnt, epoch, lane);
        float x[64];
        if (act) {
            const LAS unsigned char* tb = R + (1 - wl) * 8192 + lane * 2;
            const int rb = d ? 63 * 128 : 0, rs = d ? -128 : 128;
#pragma unroll
            for (int i = 0; i < 64; ++i) x[i] = bf2f(*(const LAS bf16_t*)(tb + rb + i * rs));
            if (wl == 1) {
                const float gcl = gcs[63];
#pragma unroll
                for (int q = 0; q < 8; ++q) { u32x4 o;
                    const int ia = 32 * (q >> 2) + 4 * (q & 3), ib = ia + 16;
                    o.x = pk2(x[ia + 0] * __expf(gcl - gcs[ia + 0]), x[ia + 1] * __expf(gcl - gcs[ia + 1]));
                    o.y = pk2(x[ia + 2] * __expf(gcl - gcs[ia + 2]), x[ia + 3] * __expf(gcl - gcs[ia + 3]));
                    o.z = pk2(x[ib + 0] * __expf(gcl - gcs[ib + 0]), x[ib + 1] * __expf(gcl - gcs[ib + 1]));
                    o.w = pk2(x[ib + 2] * __expf(gcl - gcs[ib + 2]), x[ib + 3] * __expf(gcl - gcs[ib + 3]));
                    *(LAS u32x4*)(R + lane * 128 + ((q ^ (lane & 7)) << 4)) = o; }
#pragma unroll
                for (int j = 0; j < 8; ++j) { const int row = 8 * j + (lane >> 3), c = lane & 7;
                    ((GAS u32x4*)(KDt + ub))[64 * j + lane] = *(const LAS u32x4*)(R + row * 128 + ((c ^ (row & 7)) << 4)); }
#pragma unroll
                for (int i = 0; i < 64; ++i) x[i] *= bts[i] * __expf(gcs[i]);
            } else {
#pragma unroll
                for (int i = 0; i < 64; ++i) x[i] *= bts[i];
            }
        }
        pair_bar(pcnt, epoch, lane);
        if (act) {
            bf16x8 kf[4][2];
#pragma unroll
            for (int jt = 0; jt < 4; ++jt)
#pragma unroll
                for (int ks = 0; ks < 2; ++ks) kf[jt][ks] = *(const bf16x8*)(KD + (size_t)(row0 + 16 * jt + r) * 384 + h * 64 + 32 * ks + 8 * g);
#pragma unroll
            for (int itl = 0; itl < 2; ++itl) {
                const int it = 2 * wl + itl;
#pragma unroll
                for (int jt = 0; jt < 4; ++jt) {
                    f32x4 c = (f32x4){0.f, 0.f, 0.f, 0.f};
                    const bf16x8 a0 = (it == 0 ? kf[0][0] : it == 1 ? kf[1][0] : it == 2 ? kf[2][0] : kf[3][0]);
                    const bf16x8 a1 = (it == 0 ? kf[0][1] : it == 1 ? kf[1][1] : it == 2 ? kf[2][1] : kf[3][1]);
                    c = __builtin_amdgcn_mfma_f32_16x16x32_bf16(a0, kf[jt][0], c, 0, 0, 0);
                    c = __builtin_amdgcn_mfma_f32_16x16x32_bf16(a1, kf[jt][1], c, 0, 0, 0);
                    const int jo = 16 * jt + r, jp = d ? 63 - jo : jo;
#pragma unroll
                    for (int e = 0; e < 4; ++e) {
                        const int io = 16 * it + 4 * g + e, ip = d ? 63 - io : io;
                        Am[ip * 68 + jp] = (jp < ip) ? bts[ip] * c[e] * __expf(gcs[ip] - gcs[jp]) : 0.f;
                    }
                }
            }
        }
        pair_bar(pcnt, epoch, lane);
        if (act) {
#pragma unroll
            for (int b = 0; b < 4; ++b) {
                float acc[16];
#pragma unroll
                for (int ii = 0; ii < 16; ++ii) acc[ii] = 0.f;
#pragma unroll
                for (int j4 = 0; j4 < 4 * b; ++j4) {
#pragma unroll
                    for (int ii = 0; ii < 16; ++ii) {
                        const f32x4 a = *(const LAS f32x4*)(Am + (16 * b + ii) * 68 + 4 * j4);
                        acc[ii] += a.x * x[4 * j4]; acc[ii] += a.y * x[4 * j4 + 1]; acc[ii] += a.z * x[4 * j4 + 2]; acc[ii] += a.w * x[4 * j4 + 3];
                    }
                    if ((j4 & 1) == 1) asm volatile("" ::: "memory");
                }
#pragma unroll
                for (int ii = 0; ii < 16; ++ii) {
                    const int i = 16 * b + ii;
                    float s0 = acc[ii], s1 = 0.f;
#pragma unroll
                    for (int j4 = 0; j4 < (ii + 3) / 4; ++j4) {
                        const f32x4 a = *(const LAS f32x4*)(Am + i * 68 + 16 * b + 4 * j4);
                        s0 += a.x * x[16 * b + 4 * j4]; s1 += a.y * x[16 * b + 4 * j4 + 1]; s0 += a.z * x[16 * b + 4 * j4 + 2]; s1 += a.w * x[16 * b + 4 * j4 + 3];
                    }
                    x[i] -= s0 + s1;
                    if ((ii & 3) == 3) asm volatile("" : "+v"(x[i]) :: "memory");
                }
            }
        }
        pair_bar(pcnt, epoch, lane);
        if (act) {
            if (wl == 0) {
#pragma unroll
                for (int q = 0; q < 8; ++q) { u32x4 o; o.x = pk2(x[8 * q], x[8 * q + 1]); o.y = pk2(x[8 * q + 2], x[8 * q + 3]); o.z = pk2(x[8 * q + 4], x[8 * q + 5]); o.w = pk2(x[8 * q + 6], x[8 * q + 7]);
                    *(LAS u32x4*)(R + lane * 128 + ((q ^ (lane & 7)) << 4)) = o; }
#pragma unroll
                for (int j = 0; j < 8; ++j) { const int row = 8 * j + (lane >> 3), c = lane & 7;
                    ((GAS u32x4*)(Ut + ub))[64 * j + lane] = *(const LAS u32x4*)(R + row * 128 + ((c ^ (row & 7)) << 4)); }
            } else {
                const int kk2 = lane & 31, pc = (lane & 32) + 8 * ((kk2 & 15) >> 2) + 4 * (kk2 >> 4) + (kk2 & 3);
#pragma unroll
                for (int i = 0; i < 64; ++i) *(LAS bf16_t*)(R + 8192 + i * 128 + ((((pc >> 3) ^ (i & 7)) << 4) | ((pc & 7) << 1))) = (bf16_t)f2bf(-x[i]);
#pragma unroll
                for (int j = 0; j < 8; ++j) { const int row = 8 * j + (lane >> 3), c = lane & 7;
                    ((GAS u32x4*)(Wm + ub))[64 * j + lane] = *(const LAS u32x4*)(R + 8192 + row * 128 + ((c ^ (row & 7)) << 4)); }
            }
        }
        pair_bar(pcnt, epoch, lane);
    }
}

constexpr int SC_D = 7, SC_STAGE = 16384, SC_P = 4;
__device__ __forceinline__ unsigned pkbf(float lo, float hi) { return pg8::cvt_pk_bf16(lo, hi); }
__device__ __forceinline__ int sc_off(int row, int col) {
    const int c = col >> 3; return row * 128 + ((c ^ ((row >> 1) & 7)) << 4) + ((col & 4) << 1);
}
constexpr int NSEG = 8;
constexpr size_t WS_SEG = 503 * MiB;
constexpr size_t WS_SST = 507 * MiB;
static_assert(WS_DN + 5 * DN_STRIDE <= WS_SEG && WS_SEG + (size_t)12 * NSEG * 2 * 16384 <= WS_SST && WS_SST + (size_t)12 * NSEG * 16384 <= WS_END, "seg map");
__host__ __device__ constexpr int seg_begin(int s) { return s == 0 ? 0 : 36 + 32 * (s - 1); }
__host__ __device__ constexpr int seg_len(int s) { return s == 0 ? 36 : 32; }
static_assert(seg_begin(NSEG - 1) + seg_len(NSEG - 1) == DN_NS, "segments cover the chain");
template <int MODE>
__device__ __forceinline__ void dn_scan_job(Frame& F, const int dh, const int sg) {
    const int d = dh / 6, lane = F.lane, wave = F.wave, r = lane & 15, g = lane >> 4;
    const int tb = seg_begin(sg), ns = seg_len(sg);
    const unsigned char* srcW = F.ws + WS_DN + ((size_t)dh * DN_NS + tb) * 8192;
    const unsigned char* srcK = srcW + DN_STRIDE; const unsigned char* srcU = srcW + 2 * DN_STRIDE;
    bf16_t* VT = (bf16_t*)(F.ws + WS_DN + 3 * DN_STRIDE) + ((size_t)dh * DN_NS + tb) * 4096;
    bf16_t* ST = (bf16_t*)(F.ws + WS_DN + 4 * DN_STRIDE) + ((size_t)dh * DN_NS + tb) * 4096;
    LAS float* gls = (LAS float*)(F.lds + MISC_OFF + 1024);
    LAS unsigned char* ost = F.lds + SC_D * SC_STAGE + (wave & 3) * 6144;
    { const float* GL = (const float*)(F.ws + WS_GL) + dh * DN_NS + tb; for (int i = F.tid; i < ns; i += NTHREADS) gls[i] = GL[i]; }
    __syncthreads();
#define SC_WAITV(n) asm volatile("s_waitcnt vmcnt(" #n ")" ::: "memory")
#define SC_BAR() do { asm volatile("" ::: "memory"); __builtin_amdgcn_s_barrier(); asm volatile("" ::: "memory"); } while (0)
    if (wave >= 4) {
        const int lw = wave - 4;
        const int lrow = lane >> 3, lc = lane & 7;
#define SC_ISSUE(st) do { const int slot_ = ((st) % SC_D) * SC_STAGE; \
            _Pragma("unroll") for (int e = 0; e < 4; ++e) { \
                const int q = lw * 4 + e, mi = q >> 3, n = q & 7, row = 8 * n + lrow; \
                const unsigned char* mb = (mi == 0 ? srcW : srcK) + (size_t)(st) * 8192; \
                const unsigned char* gp = mb + row * 128 + ((lc ^ ((row >> 1) & 7)) << 4); \
                __builtin_amdgcn_global_load_lds((const unsigned*)gp, (LAS unsigned*)(F.lds + slot_ + mi * 8192 + n * 1024), 16, 0, 0); } } while (0)
        SC_ISSUE(0); SC_ISSUE(1); SC_ISSUE(2); SC_ISSUE(3); SC_ISSUE(4); SC_ISSUE(5);
        SC_WAITV(20); SC_BAR();
        for (int t = 0; t < ns; ++t) {
            if (t + SC_D - 1 < ns) { SC_ISSUE(t + SC_D - 1); SC_WAITV(20); }
            else { SC_WAITV(0); }
            SC_BAR();
        }
    } else {
        f32x4 S[4];
        if (MODE == 0) {
            if (sg == 0) {
#pragma unroll
                for (int t = 0; t < 4; ++t) S[t] = (f32x4){0.f, 0.f, 0.f, 0.f};
            } else {
                const float* seg0 = (const float*)(F.ws + WS_SEG) + (size_t)dh * NSEG * 2 * 4096;
                { const float* q0 = seg0 + 4096 + 16 * wave + r;
#pragma unroll
                  for (int t = 0; t < 4; ++t)
#pragma unroll
                      for (int e2 = 0; e2 < 4; ++e2) S[t][e2] = q0[(16 * t + 4 * g + e2) * 64]; }
#pragma unroll 1
                for (int s = 1; s < sg; ++s) {
                    const float* Pm = seg0 + (size_t)s * 2 * 4096; const float* Qm = Pm + 4096 + 16 * wave + r;
                    u32x4 bsf[2];
#pragma unroll
                    for (int ks = 0; ks < 2; ++ks) { bsf[ks].x = pkbf(S[2 * ks][0], S[2 * ks][1]); bsf[ks].y = pkbf(S[2 * ks][2], S[2 * ks][3]); bsf[ks].z = pkbf(S[2 * ks + 1][0], S[2 * ks + 1][1]); bsf[ks].w = pkbf(S[2 * ks + 1][2], S[2 * ks + 1][3]); }
                    f32x4 Sn[4];
#pragma unroll
                    for (int t = 0; t < 4; ++t) {
                        f32x4 c;
#pragma unroll
                        for (int e2 = 0; e2 < 4; ++e2) c[e2] = Qm[(16 * t + 4 * g + e2) * 64];
#pragma unroll
                        for (int ks = 0; ks < 2; ++ks) {
                            const f32x4 lo = *(const f32x4*)(Pm + (16 * t + r) * 64 + 32 * ks + 4 * g), hi = *(const f32x4*)(Pm + (16 * t + r) * 64 + 32 * ks + 16 + 4 * g);
                            u32x4 a; a.x = pkbf(lo[0], lo[1]); a.y = pkbf(lo[2], lo[3]); a.z = pkbf(hi[0], hi[1]); a.w = pkbf(hi[2], hi[3]);
                            c = __builtin_amdgcn_mfma_f32_16x16x32_bf16(__builtin_bit_cast(bf16x8, a), __builtin_bit_cast(bf16x8, bsf[ks]), c, 0, 0, 0);
                        }
                        Sn[t] = c;
                    }
#pragma unroll
                    for (int t = 0; t < 4; ++t) S[t] = Sn[t];
                }
            }
        } else {
#pragma unroll
            for (int t = 0; t < 4; ++t)
#pragma unroll
                for (int e2 = 0; e2 < 4; ++e2) S[t][e2] = (MODE == 2 && (16 * t + 4 * g + e2) == 16 * wave + r) ? 1.f : 0.f;
        }
        const int dvrow = 16 * wave + r;
        const GAS u32x4* usrc = (const GAS u32x4*)(srcU + wave * 2048) + lane;
        u32x4 uq[SC_P][2];
        if (MODE != 2) {
#pragma unroll
            for (int p = 0; p < SC_P; ++p) { uq[p][0] = usrc[(size_t)p * 512]; uq[p][1] = usrc[(size_t)p * 512 + 64]; }
        }
        SC_BAR();
#define OST_W(base, t_, lo_, hi_) *(LAS u32x2*)(ost + (base) + r * 128 + (((2 * (t_) + (g >> 1)) ^ (r & 7)) << 4) + ((g & 1) << 3)) = (u32x2){lo_, hi_}
        for (int t4 = 0; t4 < ns; t4 += SC_P) {
#pragma unroll
          for (int tp = 0; tp < SC_P; ++tp) {
            const int t = t4 + tp;
            const LAS unsigned char* sb = F.lds + (t % SC_D) * SC_STAGE;
            const float gl = gls[t];
            if (MODE != 2) {
#pragma unroll
                for (int j = 0; j < 2; ++j) { const int row = 8 * j + (lane >> 3), c = lane & 7; *(LAS u32x4*)(ost + 4096 + row * 128 + ((c ^ (row & 7)) << 4)) = uq[tp][j]; }
                if (t + SC_P < ns) { uq[tp][0] = usrc[(size_t)(t + SC_P) * 512]; uq[tp][1] = usrc[(size_t)(t + SC_P) * 512 + 64]; }
            }
            u32x4 bs[2];
#pragma unroll
            for (int ks = 0; ks < 2; ++ks) { bs[ks].x = pkbf(S[2 * ks][0], S[2 * ks][1]); bs[ks].y = pkbf(S[2 * ks][2], S[2 * ks][3]); bs[ks].z = pkbf(S[2 * ks + 1][0], S[2 * ks + 1][1]); bs[ks].w = pkbf(S[2 * ks + 1][2], S[2 * ks + 1][3]); }
            if (MODE == 0) { OST_W(0, 0, bs[0].x, bs[0].y); OST_W(0, 1, bs[0].z, bs[0].w); OST_W(0, 2, bs[1].x, bs[1].y); OST_W(0, 3, bs[1].z, bs[1].w); }
            f32x4 vn[4];
#pragma unroll
            for (int it = 0; it < 4; ++it) {
                f32x4 c = (f32x4){0.f, 0.f, 0.f, 0.f};
                if (MODE != 2) { const u32x2 uu = *(const LAS u32x2*)(ost + 4096 + r * 128 + (((2 * it + (g >> 1)) ^ (r & 7)) << 4) + ((g & 1) << 3));
                    c = (f32x4){bf2f(uu.x & 0xffffu), bf2f(uu.x >> 16), bf2f(uu.y & 0xffffu), bf2f(uu.y >> 16)}; }
#pragma unroll
                for (int ks = 0; ks < 2; ++ks) {
                    const u32x4 a = *(const LAS u32x4*)(sb + sc_off(16 * it + r, 32 * ks + 8 * g));
                    c = __builtin_amdgcn_mfma_f32_16x16x32_bf16(__builtin_bit_cast(bf16x8, a), __builtin_bit_cast(bf16x8, bs[ks]), c, 0, 0, 0);
                }
                vn[it] = c;
            }
            u32x4 bv[2];
#pragma unroll
            for (int ks = 0; ks < 2; ++ks) { bv[ks].x = pkbf(vn[2 * ks][0], vn[2 * ks][1]); bv[ks].y = pkbf(vn[2 * ks][2], vn[2 * ks][3]); bv[ks].z = pkbf(vn[2 * ks + 1][0], vn[2 * ks + 1][1]); bv[ks].w = pkbf(vn[2 * ks + 1][2], vn[2 * ks + 1][3]); }
            if (MODE == 0) {
                if (d == 0) {
                    OST_W(2048, 0, bv[0].x, bv[0].y); OST_W(2048, 1, bv[0].z, bv[0].w); OST_W(2048, 2, bv[1].x, bv[1].y); OST_W(2048, 3, bv[1].z, bv[1].w);
                } else {
#define SC_ROT(a) (((a) >> 16) | ((a) << 16))
#define OST_WR(t_, lo_, hi_) *(LAS u32x2*)(ost + 2048 + r * 128 + (((2 * (3 - (t_)) + ((3 - g) >> 1)) ^ (r & 7)) << 4) + (((3 - g) & 1) << 3)) = (u32x2){SC_ROT(hi_), SC_ROT(lo_)}
                    OST_WR(0, bv[0].x, bv[0].y); OST_WR(1, bv[0].z, bv[0].w); OST_WR(2, bv[1].x, bv[1].y); OST_WR(3, bv[1].z, bv[1].w);
#undef OST_WR
#undef SC_ROT
                }
                GAS u32x4* gst = (GAS u32x4*)(ST + (size_t)t * 4096 + wave * 1024); GAS u32x4* gvt = (GAS u32x4*)(VT + (size_t)t * 4096 + wave * 1024);
#pragma unroll
                for (int j = 0; j < 2; ++j) {
                    const int row = 8 * j + (lane >> 3), c = lane & 7; const int off = row * 128 + ((c ^ (row & 7)) << 4);
                    gst[64 * j + lane] = *(const LAS u32x4*)(ost + off); gvt[64 * j + lane] = *(const LAS u32x4*)(ost + 2048 + off);
                }
            }
#pragma unroll
            for (int tt = 0; tt < 4; ++tt) {
                f32x4 c = S[tt] * gl;
#pragma unroll
                for (int ks = 0; ks < 2; ++ks) {
                    const u32x4 a = *(const LAS u32x4*)(sb + 8192 + sc_off(16 * tt + r, 32 * ks + 8 * g));
                    c = __builtin_amdgcn_mfma_f32_16x16x32_bf16(__builtin_bit_cast(bf16x8, a), __builtin_bit_cast(bf16x8, bv[ks]), c, 0, 0, 0);
                }
                S[tt] = c;
            }
            asm volatile("s_waitcnt lgkmcnt(0)" ::: "memory");
            SC_BAR();
          }
        }
        if (MODE != 0) {
            float* o = (float*)(F.ws + WS_SEG) + ((size_t)(dh * NSEG + sg) * 2 + (MODE == 2 ? 0 : 1)) * 4096 + 16 * wave + r;
#pragma unroll
            for (int t = 0; t < 4; ++t)
#pragma unroll
                for (int e2 = 0; e2 < 4; ++e2) o[(16 * t + 4 * g + e2) * 64] = S[t][e2];
        }
    }
#undef SC_WAITV
#undef OST_W
#undef SC_BAR
#undef SC_ISSUE
    asm volatile("s_waitcnt vmcnt(0) lgkmcnt(0)" ::: "memory");
    __syncthreads();
}
__device__ __forceinline__ void dn_combine(Frame& F, const int dh) {
    const float* SEG = (const float*)(F.ws + WS_SEG) + (size_t)dh * NSEG * 2 * 4096;
    float* SST = (float*)(F.ws + WS_SST) + (size_t)dh * NSEG * 4096;
    LAS float* Sl = (LAS float*)F.lds; LAS float* Pl = Sl + 4096;
    for (int i = F.tid; i < 4096; i += NTHREADS) { const float v = SEG[4096 + i]; Sl[i] = v; SST[4096 + i] = v; }
    __syncthreads();
    const int col = F.tid & 63, dk0 = F.tid >> 6;
    float pre[8], qre[8];
#pragma unroll
    for (int k = 0; k < 8; ++k) { pre[k] = SEG[(size_t)1 * 2 * 4096 + F.tid + NTHREADS * k]; qre[k] = SEG[(size_t)1 * 2 * 4096 + 4096 + (dk0 + 8 * k) * 64 + col]; }
#pragma unroll 1
    for (int sg = 1; sg <= NSEG - 2; ++sg) {
        float out[8];
#pragma unroll
        for (int k = 0; k < 8; ++k) { Pl[F.tid + NTHREADS * k] = pre[k]; out[k] = qre[k]; }
        if (sg + 1 <= NSEG - 2) {
#pragma unroll
            for (int k = 0; k < 8; ++k) { pre[k] = SEG[(size_t)(sg + 1) * 2 * 4096 + F.tid + NTHREADS * k]; qre[k] = SEG[(size_t)(sg + 1) * 2 * 4096 + 4096 + (dk0 + 8 * k) * 64 + col]; }
        }
        __syncthreads();
#pragma unroll 2
        for (int k4 = 0; k4 < 16; ++k4) {
            const float s0 = Sl[(4 * k4 + 0) * 64 + col], s1 = Sl[(4 * k4 + 1) * 64 + col], s2 = Sl[(4 * k4 + 2) * 64 + col], s3 = Sl[(4 * k4 + 3) * 64 + col];
#pragma unroll
            for (int k = 0; k < 8; ++k) { const f32x4 pv = *(const LAS f32x4*)(Pl + (dk0 + 8 * k) * 64 + 4 * k4); out[k] += (pv.x * s0 + pv.y * s1) + (pv.z * s2 + pv.w * s3); }
        }
        __syncthreads();
#pragma unroll
        for (int k = 0; k < 8; ++k) { Sl[(dk0 + 8 * k) * 64 + col] = out[k]; SST[(size_t)(sg + 1) * 4096 + (dk0 + 8 * k) * 64 + col] = out[k]; }
        __syncthreads();
    }
}

__device__ __forceinline__ void attn_unit(Frame& F, const Args& A, int layer, int unit) {
    const bf16_t* PX = (const bf16_t*)(F.ws + WS_PX);
    bf16_t* ACT = (bf16_t*)(F.ws + WS_ACT);
    const int lane = F.lane, wave = F.wave, r = lane & 15, g = lane >> 4, tid = F.tid;
    const bool isctx = unit >= 256;
    const int qb = isctx ? (unit - 256) >> 1 : unit >> 1, hk = unit & 1;
    const int qrow0 = (isctx ? NL : 0) + 128 * qb + 16 * wave;
    const int qpos = 128 * qb + 16 * wave + r;
    const float SCL = 0.125f * 1.4426950408889634f;
    bf16x8 qf[3][2];
#pragma unroll
    for (int a = 0; a < 3; ++a)
#pragma unroll
        for (int ks = 0; ks < 2; ++ks) qf[a][ks] = *(const bf16x8*)(PX + (size_t)(qrow0 + r) * INP + C_AQ + (3 * hk + a) * 64 + 32 * ks + 8 * g);
    float mrun[3], lrun[3]; f32x4 o[3][4];
#pragma unroll
    for (int a = 0; a < 3; ++a) { mrun[a] = A.in[I_SINK][layer * 6 + 3 * hk + a] * 1.4426950408889634f; lrun[a] = 1.f;
#pragma unroll
        for (int dt = 0; dt < 4; ++dt) o[a][dt] = (f32x4){0.f, 0.f, 0.f, 0.f}; }
    const int jlo = (!isctx && qb == 0) ? 2 : 0, jhi = isctx ? 0 : ((qb == 127) ? 4 : 6);
    const int ntile = 4 + (jhi - jlo);
    const int skey = tid >> 3, sch = tid & 7;
    const int spk = (skey & 32) + 8 * (((skey & 31) & 15) >> 2) + 4 * ((skey & 31) >> 4) + (skey & 3);
#define ATT_KROW(s_) ((s_) < 4 ? NL + 64 * (s_) : 128 * (qb - 1) + 64 * (jlo + (s_) - 4))
#define ATT_LOAD(s_) do { const size_t ro_ = (size_t)(ATT_KROW(s_) + skey) * INP; pkv = *(const u32x4*)(PX + ro_ + C_AK + hk * 64 + sch * 8); pvv = *(const u32x4*)(PX + ro_ + C_AV + hk * 64 + sch * 8); } while (0)
#define ATT_STAGE(buf_) do { LAS unsigned char* kb_ = F.lds + (buf_) * 18432; *(LAS u32x4*)(kb_ + skey * 144 + sch * 16) = pkv; LAS bf16_t* vt = (LAS bf16_t*)(kb_ + 9216); \
        vt[(sch * 8 + 0) * 72 + spk] = (bf16_t)(pvv.x & 0xffffu); vt[(sch * 8 + 1) * 72 + spk] = (bf16_t)(pvv.x >> 16); vt[(sch * 8 + 2) * 72 + spk] = (bf16_t)(pvv.y & 0xffffu); vt[(sch * 8 + 3) * 72 + spk] = (bf16_t)(pvv.y >> 16); \
        vt[(sch * 8 + 4) * 72 + spk] = (bf16_t)(pvv.z & 0xffffu); vt[(sch * 8 + 5) * 72 + spk] = (bf16_t)(pvv.z >> 16); vt[(sch * 8 + 6) * 72 + spk] = (bf16_t)(pvv.w & 0xffffu); vt[(sch * 8 + 7) * 72 + spk] = (bf16_t)(pvv.w >> 16); } while (0)
    u32x4 pkv, pvv;
    ATT_LOAD(0); ATT_STAGE(0);
    __syncthreads();
    for (int ti = 0; ti < ntile; ++ti) {
        const int krow0 = ATT_KROW(ti);
        const int q0w = 128 * qb + 16 * wave;
        const bool local = ti >= 4 && ((krow0 + 63 - q0w > 128) || (q0w + 15 - krow0 > 128));
        if (ti + 1 < ntile) ATT_LOAD(ti + 1);
        LAS unsigned char* Kl = F.lds + (ti & 1) * 18432;
        LAS unsigned char* Vl = Kl + 9216;
        f32x4 st[3][4];
#pragma unroll
        for (int kt = 0; kt < 4; ++kt) {
            const bf16x8 k0 = *(const LAS bf16x8*)(Kl + (16 * kt + r) * 144 + (8 * g) * 2);
            const bf16x8 k1 = *(const LAS bf16x8*)(Kl + (16 * kt + r) * 144 + (32 + 8 * g) * 2);
#pragma unroll
            for (int a = 0; a < 3; ++a) {
                f32x4 c = (f32x4){0.f, 0.f, 0.f, 0.f};
                c = __builtin_amdgcn_mfma_f32_16x16x32_bf16(k0, qf[a][0], c, 0, 0, 0);
                c = __builtin_amdgcn_mfma_f32_16x16x32_bf16(k1, qf[a][1], c, 0, 0, 0);
                st[a][kt] = c;
            }
        }
        u32x4 bp[3][2];
#pragma unroll
        for (int a = 0; a < 3; ++a) {
            float tmax = -INFINITY;
#pragma unroll
            for (int kt = 0; kt < 4; ++kt)
#pragma unroll
                for (int e = 0; e < 4; ++e) {
                    float sv = st[a][kt][e] * SCL;
                    if (local) { const int kp = krow0 + 16 * kt + 4 * g + e; const int df = qpos - kp; if (df > 128 || df < -128) sv = -INFINITY; }
                    st[a][kt][e] = sv; tmax = fmaxf(tmax, sv);
                }
            tmax = fmaxf(tmax, __shfl_xor(tmax, 16)); tmax = fmaxf(tmax, __shfl_xor(tmax, 32));
            const float mnew = fmaxf(mrun[a], tmax);
            const float alpha = __builtin_amdgcn_exp2f(mrun[a] - mnew);
            float ls = 0.f;
#pragma unroll
            for (int kt = 0; kt < 4; ++kt)
#pragma unroll
                for (int e = 0; e < 4; ++e) { const float p = __builtin_amdgcn_exp2f(st[a][kt][e] - mnew); st[a][kt][e] = p; ls += p; }
            ls += __shfl_xor(ls, 16); ls += __shfl_xor(ls, 32);
            lrun[a] = lrun[a] * alpha + ls; mrun[a] = mnew;
#pragma unroll
            for (int dt = 0; dt < 4; ++dt) o[a][dt] = o[a][dt] * alpha;
#pragma unroll
            for (int k2 = 0; k2 < 2; ++k2) { bp[a][k2].x = pkbf(st[a][2 * k2][0], st[a][2 * k2][1]); bp[a][k2].y = pkbf(st[a][2 * k2][2], st[a][2 * k2][3]);
                bp[a][k2].z = pkbf(st[a][2 * k2 + 1][0], st[a][2 * k2 + 1][1]); bp[a][k2].w = pkbf(st[a][2 * k2 + 1][2], st[a][2 * k2 + 1][3]); }
        }
#pragma unroll
        for (int dt = 0; dt < 4; ++dt)
#pragma unroll
            for (int k2 = 0; k2 < 2; ++k2) {
                const u32x4 av = *(const LAS u32x4*)(Vl + (16 * dt + r) * 144 + (32 * k2 + 8 * g) * 2);
#pragma unroll
                for (int a = 0; a < 3; ++a) o[a][dt] = __builtin_amdgcn_mfma_f32_16x16x32_bf16(__builtin_bit_cast(bf16x8, av), __builtin_bit_cast(bf16x8, bp[a][k2]), o[a][dt], 0, 0, 0);
            }
        if (ti + 1 < ntile) ATT_STAGE((ti + 1) & 1);
        __syncthreads();
    }
#undef ATT_KROW
#undef ATT_LOAD
#undef ATT_STAGE
#pragma unroll
    for (int a = 0; a < 3; ++a) {
        const float inv = 1.0f / lrun[a];
#pragma unroll
        for (int dt = 0; dt < 4; ++dt) {
            u32x2 w; w.x = pkbf(o[a][dt][0] * inv, o[a][dt][1] * inv); w.y = pkbf(o[a][dt][2] * inv, o[a][dt][3] * inv);
            *(u32x2*)(ACT + (size_t)(qrow0 + r) * D + 640 + (3 * hk + a) * 64 + 16 * dt + 4 * g) = w;
        }
    }
}

constexpr int X1_JOBS = 12 * (2 * (NSEG - 1) - 1);
__device__ __forceinline__ void scan_x1_phase(Frame& F, const Args& A, int layer) {
    const int b = blockIdx.x;
    if (b < X1_JOBS) {
        const int dh = b / (2 * (NSEG - 1) - 1), k = b % (2 * (NSEG - 1) - 1);
        if (k == 0) dn_scan_job<1>(F, dh, 0);
        else { const int sg = 1 + ((k - 1) >> 1); if ((k - 1) & 1) dn_scan_job<1>(F, dh, sg); else dn_scan_job<2>(F, dh, sg); }
        return;
    }
    const int nw = F.G - X1_JOBS;
    for (int u = b - X1_JOBS; u < 100; u += nw) { attn_unit(F, A, layer, u); __syncthreads(); }
}
__device__ __forceinline__ void scan_x2_phase(Frame& F) {
    if (blockIdx.x < 12) dn_combine(F, blockIdx.x);
}
__device__ __forceinline__ void scan_x3_phase(Frame& F, const Args& A, int layer) {
    if (blockIdx.x < 12 * NSEG) { dn_scan_job<0>(F, blockIdx.x / NSEG, blockIdx.x % NSEG); return; }
    const int nunits = layer == 0 ? 260 : 256, nw = F.G - 12 * NSEG;
    for (int u = 100 + blockIdx.x - 12 * NSEG; u < nunits; u += nw) { attn_unit(F, A, layer, u); __syncthreads(); }
}

constexpr int DO_BUF = 58880;
__device__ __forceinline__ void dn_out_phase(Frame& F, const Args& A, int layer) {
    const bf16_t* PX = (const bf16_t*)(F.ws + WS_PX);
    bf16_t* ACT = (bf16_t*)(F.ws + WS_ACT);
    const bf16_t* QD = (const bf16_t*)(F.ws + WS_QD); const bf16_t* KD = (const bf16_t*)(F.ws + WS_QD + QKV_STRIDE);
    const float* Gg = (const float*)(F.ws + WS_G);
    const bf16_t* VT = (const bf16_t*)(F.ws + WS_DN + 3 * DN_STRIDE); const bf16_t* ST = (const bf16_t*)(F.ws + WS_DN + 4 * DN_STRIDE);
    const float* ng = A.in[I_NORMG] + layer * 64;
    const int tid = F.tid, lane = F.lane, wave = F.wave, r = lane & 15, g = lane >> 4;
    const int it = wave & 3, hf = wave >> 2;
    const int nunits = (layer == 0 ? 260 : 256) * 6;
    const int srow = tid >> 3, sc = tid & 7;
    const int soff = srow * 128 + ((sc ^ ((srow >> 1) & 7)) << 4);
    u32x4 pre[7]; float gpre = 0.f;
#define DO_ROW0(u_) (((u_) / 6) < 256 ? 64 * ((u_) / 6) : NL + 64 * (((u_) / 6) - 256))
#define DO_LOAD(u_) do { const int oc_ = (u_) / 6, h_ = (u_) % 6, row0_ = DO_ROW0(u_); \
        const int s0_ = oc_ < 256 ? 4 + oc_ : oc_ - 256, s1_ = oc_ < 256 ? 4 + 255 - oc_ : 3 - (oc_ - 256); \
        const size_t U0_ = (size_t)(h_ * DN_NS + s0_) * 4096, U1_ = (size_t)((6 + h_) * DN_NS + s1_) * 4096; \
        pre[0] = *(const u32x4*)(QD + (size_t)(row0_ + srow) * 384 + h_ * 64 + sc * 8); pre[1] = *(const u32x4*)(KD + (size_t)(row0_ + srow) * 384 + h_ * 64 + sc * 8); \
        pre[2] = *(const u32x4*)(ST + U0_ + srow * 64 + sc * 8); pre[3] = *(const u32x4*)(ST + U1_ + srow * 64 + sc * 8); \
        pre[4] = *(const u32x4*)(VT + U0_ + srow * 64 + sc * 8); pre[5] = *(const u32x4*)(VT + U1_ + srow * 64 + sc * 8); \
        pre[6] = *(const u32x4*)(PX + (size_t)(row0_ + srow) * INP + C_DZ + h_ * 64 + sc * 8); \
        if (wave < 2) gpre = Gg[(size_t)(row0_ + lane) * 12 + wave * 6 + h_]; } while (0)
#define DO_STAGE(b_) do { LAS unsigned char* bb_ = F.lds + (b_) * DO_BUF; \
        _Pragma("unroll") for (int q_ = 0; q_ < 7; ++q_) *(LAS u32x4*)(bb_ + q_ * 8192 + soff) = pre[q_]; \
        if (wave < 2) { float gv_ = gpre; \
            _Pragma("unroll") for (int o_ = 1; o_ < 64; o_ <<= 1) { const float t_ = wave ? __shfl_down(gv_, o_) : __shfl_up(gv_, o_); if (wave ? (lane + o_ < 64) : (lane >= o_)) gv_ += t_; } \
            ((LAS float*)(bb_ + 57344))[wave * 64 + lane] = gv_; } } while (0)
    int u = blockIdx.x, cur = 0;
    if (u < nunits) { DO_LOAD(u); DO_STAGE(0); }
    __syncthreads();
    f32x4 ngv[2];
#pragma unroll
    for (int dtl = 0; dtl < 2; ++dtl) ngv[dtl] = *(const f32x4*)(ng + 16 * (2 * hf + dtl) + 4 * g);
#pragma unroll 1
    for (; u < nunits; u += F.G) {
        const int un = u + F.G;
        if (un < nunits) DO_LOAD(un);
        const int h = u % 6, row0 = DO_ROW0(u);
        LAS unsigned char* bb = F.lds + cur * DO_BUF;
        const LAS float* gc0 = (const LAS float*)(bb + 57344); const LAS float* gc1 = gc0 + 64;
        LAS float* ssx = (LAS float*)(bb + 57344 + 512);
        const int i = 16 * it + r;
        const float e0 = gc0[i], e1 = gc1[i];
        bf16x8 qf[2];
#pragma unroll
        for (int ks = 0; ks < 2; ++ks) qf[ks] = *(const LAS bf16x8*)(bb + sc_off(16 * it + r, 32 * ks + 8 * g));
        f32x4 pt[4];
#pragma unroll
        for (int jt = 0; jt < 4; ++jt) {
            f32x4 c = (f32x4){0.f, 0.f, 0.f, 0.f};
#pragma unroll
            for (int ks = 0; ks < 2; ++ks) c = __builtin_amdgcn_mfma_f32_16x16x32_bf16(*(const LAS bf16x8*)(bb + 8192 + sc_off(16 * jt + r, 32 * ks + 8 * g)), qf[ks], c, 0, 0, 0);
            pt[jt] = c;
        }
        f32x4 o[2];
#pragma unroll
        for (int dtl = 0; dtl < 2; ++dtl) o[dtl] = (f32x4){0.f, 0.f, 0.f, 0.f};
#pragma unroll
        for (int dir = 0; dir < 2; ++dir) {
            const LAS float* gcd = dir == 0 ? gc0 : gc1; const float ei = dir == 0 ? e0 : e1;
            const float xi = __expf(ei);
            u32x4 bp[2]; float pv[4][4];
#pragma unroll
            for (int jt = 0; jt < 4; ++jt)
#pragma unroll
                for (int e = 0; e < 4; ++e) {
                    const int j = 16 * jt + 4 * g + e;
                    const bool ok = dir == 0 ? (j <= i) : (j >= i);
                    pv[jt][e] = ok ? pt[jt][e] * __expf(ei - gcd[j]) : 0.f;
                }
#pragma unroll
            for (int k2 = 0; k2 < 2; ++k2) { bp[k2].x = pkbf(pv[2 * k2][0], pv[2 * k2][1]); bp[k2].y = pkbf(pv[2 * k2][2], pv[2 * k2][3]); bp[k2].z = pkbf(pv[2 * k2 + 1][0], pv[2 * k2 + 1][1]); bp[k2].w = pkbf(pv[2 * k2 + 1][2], pv[2 * k2 + 1][3]); }
            const LAS unsigned char* stt = bb + (2 + dir) * 8192; const LAS unsigned char* vtt = bb + (4 + dir) * 8192;
#pragma unroll
            for (int dtl = 0; dtl < 2; ++dtl) {
                const int dt = 2 * hf + dtl;
                f32x4 c = (f32x4){0.f, 0.f, 0.f, 0.f};
#pragma unroll
                for (int ks = 0; ks < 2; ++ks) c = __builtin_amdgcn_mfma_f32_16x16x32_bf16(*(const LAS bf16x8*)(stt + sc_off(16 * dt + r, 32 * ks + 8 * g)), qf[ks], c, 0, 0, 0);
                f32x4 acc = o[dtl] + c * xi;
#pragma unroll
                for (int k2 = 0; k2 < 2; ++k2) {
                    const u32x2 lo = *(const LAS u32x2*)(vtt + sc_off(16 * dt + r, 32 * k2 + 4 * g)), hi = *(const LAS u32x2*)(vtt + sc_off(16 * dt + r, 32 * k2 + 16 + 4 * g));
                    const u32x4 av = (u32x4){lo.x, lo.y, hi.x, hi.y};
                    acc = __builtin_amdgcn_mfma_f32_16x16x32_bf16(__builtin_bit_cast(bf16x8, av), __builtin_bit_cast(bf16x8, bp[k2]), acc, 0, 0, 0);
                }
                o[dtl] = acc;
            }
        }
        float ss = 0.f;
#pragma unroll
        for (int dtl = 0; dtl < 2; ++dtl) ss += (o[dtl][0] * o[dtl][0] + o[dtl][1] * o[dtl][1]) + (o[dtl][2] * o[dtl][2] + o[dtl][3] * o[dtl][3]);
        ss += __shfl_xor(ss, 16); ss += __shfl_xor(ss, 32);
        if (g == 0) ssx[wave * 16 + r] = ss;
        __syncthreads();
        const float rstd = 1.0f / sqrtf((ssx[wave * 16 + r] + ssx[(wave ^ 4) * 16 + r]) * (1.f / 64.f) + EPS);
#pragma unroll
        for (int dtl = 0; dtl < 2; ++dtl) {
            const int dt = 2 * hf + dtl;
            const u32x2 zz = *(const LAS u32x2*)(bb + 6 * 8192 + sc_off(i, 16 * dt + 4 * g));
            const float z0 = bf2f(zz.x & 0xffffu), z1 = bf2f(zz.x >> 16), z2 = bf2f(zz.y & 0xffffu), z3 = bf2f(zz.y >> 16);
            u32x2 w; w.x = pkbf(o[dtl][0] * rstd * ngv[dtl][0] * silu_f(z0), o[dtl][1] * rstd * ngv[dtl][1] * silu_f(z1));
            w.y = pkbf(o[dtl][2] * rstd * ngv[dtl][2] * silu_f(z2), o[dtl][3] * rstd * ngv[dtl][3] * silu_f(z3));
            *(LAS u32x2*)(bb + 8192 + sc_off(i, 16 * dt + 4 * g)) = w;
        }
        __syncthreads();
        *(u32x4*)(ACT + (size_t)(row0 + srow) * D + 256 + h * 64 + sc * 8) = *(const LAS u32x4*)(bb + 8192 + soff);
        if (un < nunits) DO_STAGE(cur ^ 1);
        __syncthreads();
        cur ^= 1;
    }
#undef DO_ROW0
#undef DO_LOAD
#undef DO_STAGE
}

constexpr size_t RT_EID = WS_ROUTE, RT_GATE = WS_ROUTE + 128 * 1024, RT_TSLOT = WS_ROUTE + 256 * 1024, RT_BCNT = WS_ROUTE + 384 * 1024, RT_TILEE = WS_ROUTE + 400 * 1024, RT_NT = WS_ROUTE + 404 * 1024;
constexpr size_t WS_XS = WS_BIG;
constexpr size_t WS_Y = 278 * MiB;
constexpr size_t WS_HM = 350 * MiB;
constexpr int MOE_CH = 72;
constexpr size_t WS_SLAB = 440 * MiB;
static_assert(WS_HM + (size_t)72 * 256 * DFE <= WS_SLAB && WS_SLAB + (size_t)8 * 28 * 65536 * 4 <= WS_END, "slab map");
static_assert(WS_XS + (size_t)36864 * 1024 <= WS_Y && WS_Y + (size_t)36864 * 2048 <= WS_HM, "moe map");

__device__ __forceinline__ void norm2_router_phase(Frame& F, const Args& A) {
    const float* mod = (const float*)(F.ws + WS_MOD) + (1 * 2 + 0) * 6144;
    const float* shift = mod + 3 * 1024; const float* scale = mod + 4 * 1024;
    unsigned char* act8 = F.ws + WS_ACT;
    int* EID = (int*)(F.ws + RT_EID); float* GATE = (float*)(F.ws + RT_GATE); int* BCNT = (int*)(F.ws + RT_BCNT);
    LAS int* se = (LAS int*)F.lds;
    LAS float* rw = (LAS float*)(F.lds + 1024);
    for (int i = F.tid; i < 2048; i += NTHREADS) ((LAS f32x4*)rw)[i] = ((const GAS f32x4*)A.in[I_ROUTER])[i];
    __syncthreads();
    const int lane = F.lane;
    f32x4 shl[4], scl[4];
#pragma unroll
    for (int j = 0; j < 4; ++j) { shl[j] = ((const GAS f32x4*)shift)[lane + 64 * j]; scl[j] = ((const GAS f32x4*)scale)[lane + 64 * j] + 1.0f; }
    for (int k = 0; k < 8; ++k) {
        const int tl = F.wave * 8 + k, t = blockIdx.x * 64 + tl;
        const GAS f32x4* xr = (const GAS f32x4*)(A.out + (size_t)t * D) + lane;
        f32x4 v[4]; float s = 0.f;
#pragma unroll
        for (int j = 0; j < 4; ++j) { v[j] = xr[64 * j]; s += (v[j].x * v[j].x + v[j].y * v[j].y) + (v[j].z * v[j].z + v[j].w * v[j].w); }
        const float rstd = 1.0f / sqrtf(wave_sum(s) * (1.f / D) + EPS);
        float lg[8];
#pragma unroll
        for (int e = 0; e < 8; ++e) lg[e] = 0.f;
        GAS unsigned* o8 = (GAS unsigned*)(act8 + (size_t)t * D) + lane;
#pragma unroll
        for (int j = 0; j < 4; ++j) {
            const f32x4 y = v[j] * rstd * scl[j] + shl[j];
            o8[64 * j] = pk_fp8x4(y.x, y.y, y.z, y.w);
            const int c0 = 4 * (lane + 64 * j);
#pragma unroll
            for (int q = 0; q < 4; ++q) {
                const f32x4 r0 = *(const LAS f32x4*)(rw + (c0 + q) * 8), r1 = *(const LAS f32x4*)(rw + (c0 + q) * 8 + 4);
                const float yy = y[q];
                lg[0] += yy * r0.x; lg[1] += yy * r0.y; lg[2] += yy * r0.z; lg[3] += yy * r0.w; lg[4] += yy * r1.x; lg[5] += yy * r1.y; lg[6] += yy * r1.z; lg[7] += yy * r1.w;
            }
        }
#pragma unroll
        for (int e = 0; e < 8; ++e) lg[e] = wave_sum(lg[e]);
        int e0 = 0; float l0 = lg[0];
#pragma unroll
        for (int e = 1; e < 8; ++e) if (lg[e] > l0) { l0 = lg[e]; e0 = e; }
        int e1 = -1; float l1 = -INFINITY;
#pragma unroll
        for (int e = 0; e < 8; ++e) if (e != e0 && lg[e] > l1) { l1 = lg[e]; e1 = e; }
        if (lane == 0) {
            const float g0 = 1.0f / (1.0f + expf(l1 - l0));
            EID[t * 2] = e0; EID[t * 2 + 1] = e1; GATE[t * 2] = g0; GATE[t * 2 + 1] = 1.0f - g0;
            se[tl * 2] = e0; se[tl * 2 + 1] = e1;
        }
    }
    __syncthreads();
    if (F.wave == 0) {
        const int a0 = se[lane * 2], a1 = se[lane * 2 + 1];
#pragma unroll
        for (int e = 0; e < 8; ++e) { const unsigned long long mk = __ballot(a0 == e || a1 == e); if (lane == e) BCNT[blockIdx.x * 8 + e] = __popcll(mk); }
    }
    __syncthreads();
}

__device__ __forceinline__ void moe_assign_phase(Frame& F) {
    const int* EID = (const int*)(F.ws + RT_EID); int* TSLOT = (int*)(F.ws + RT_TSLOT); const int* BCNT = (const int*)(F.ws + RT_BCNT);
    unsigned* TILEE = (unsigned*)(F.ws + RT_TILEE); unsigned* NTL = (unsigned*)(F.ws + RT_NT);
    const unsigned char* act8 = F.ws + WS_ACT; unsigned char* XS = F.ws + WS_XS;
    LAS int* sm = (LAS int*)F.lds;
    const int b = blockIdx.x, lane = F.lane;
    if (F.tid < 8) {
        int tot = 0, mine = 0;
        for (int bb = 0; bb < 256; ++bb) { const int c = __hip_atomic_load(BCNT + bb * 8 + F.tid, RLX_AGENT); if (bb < b) mine += c; tot += c; }
        sm[F.tid] = tot; sm[8 + F.tid] = mine;
    }
    __syncthreads();
    if (F.tid == 0) {
        int ps = 0, nt = 0;
        for (int e = 0; e < 8; ++e) { const int tl = (sm[e] + 255) >> 8; sm[16 + e] = ps; sm[24 + e] = tl; if (b == 0) for (int q = 0; q < tl; ++q) TILEE[nt + q] = (unsigned)e; ps += tl * 256; nt += tl; }
        if (b == 0) *NTL = (unsigned)nt;
    }
    __syncthreads();
    if (F.wave == 0) {
        const int t = b * 64 + lane;
        const int a0 = EID[t * 2], a1 = EID[t * 2 + 1];
        int s0 = 0, s1 = 0;
        const unsigned long long lower = (1ull << lane) - 1ull;
#pragma unroll
        for (int e = 0; e < 8; ++e) {
            const unsigned long long mk = __ballot(a0 == e || a1 == e);
            const int rank = __popcll(mk & lower), slot = sm[16 + e] + sm[8 + e] + rank;
            if (a0 == e) s0 = slot; if (a1 == e) s1 = slot;
        }
        TSLOT[t * 2] = s0; TSLOT[t * 2 + 1] = s1; sm[32 + lane * 2] = s0; sm[33 + lane * 2] = s1;
    }
    __syncthreads();
    for (int q = F.wave; q < 128; q += NWAVES) {
        const int t = b * 64 + (q >> 1), slot = sm[32 + q];
        const GAS u32x4* srcp = (const GAS u32x4*)(act8 + (size_t)t * D); GAS u32x4* dstp = (GAS u32x4*)(XS + (size_t)slot * D);
        dstp[lane] = srcp[lane];
    }
    { const int e = b & 7, cnt = sm[e], first = sm[16 + e] + cnt, npad = sm[24 + e] * 256 - cnt;
      for (int p = (b >> 3) * NWAVES + F.wave; p < npad; p += 32 * NWAVES) { GAS u32x4* dstp = (GAS u32x4*)(XS + (size_t)(first + p) * D); const u32x4 z = (u32x4){0u, 0u, 0u, 0u}; dstp[lane] = z; } }
}

__device__ __forceinline__ f32x4 moe_yrow(const bf16_t* Y, const float* SLAB, int slot, int tail0, int j, int lane) {
    const int tile = slot >> 8;
    if (tile < tail0) { const u32x2 a = ((const GAS u32x2*)(Y + (size_t)slot * D))[lane + 64 * j];
        return (f32x4){bf2f(a.x & 0xffffu), bf2f(a.x >> 16), bf2f(a.y & 0xffffu), bf2f(a.y >> 16)}; }
    const float* p = SLAB + (size_t)(((tile - tail0) * 4 + j) * 7) * 65536 + (size_t)(slot & 255) * 256 + 4 * lane;
    f32x4 s = *(const f32x4*)p;
#pragma unroll
    for (int ks = 1; ks < 7; ++ks) s = s + *(const f32x4*)(p + (size_t)ks * 65536);
    return s;
}
__device__ __forceinline__ void moe_final_phase(Frame& F, const Args& A) {
    const float* mod5 = (const float*)(F.ws + WS_MOD) + (1 * 2 + 0) * 6144 + 5 * 1024;
    const int* TSLOT = (const int*)(F.ws + RT_TSLOT); const float* GATE = (const float*)(F.ws + RT_GATE);
    const bf16_t* Y = (const bf16_t*)(F.ws + WS_Y); const float* SLAB = (const float*)(F.ws + WS_SLAB);
    const float* fng = A.in[I_FNG];
    const int lane = F.lane;
    const int ntl = (int)__builtin_amdgcn_readfirstlane(__hip_atomic_load((unsigned*)(F.ws + RT_NT), RLX_AGENT));
    const int tail0 = (ntl > 128 && ntl - 128 <= 8) ? 128 : (1 << 20);
    f32x4 m5v[4], fgv[4];
#pragma unroll
    for (int j = 0; j < 4; ++j) { m5v[j] = ((const GAS f32x4*)mod5)[lane + 64 * j]; fgv[j] = ((const GAS f32x4*)fng)[lane + 64 * j]; }
    for (int t = F.gw; t < NL; t += F.NGW) {
        const int s0 = TSLOT[t * 2], s1 = TSLOT[t * 2 + 1]; const float g0 = GATE[t * 2], g1 = GATE[t * 2 + 1];
        GAS f32x4* xr = (GAS f32x4*)(A.out + (size_t)t * D) + lane;
        f32x4 v[4]; float s = 0.f;
        if (((s0 >> 8) < tail0) && ((s1 >> 8) < tail0)) {
            const GAS u32x2* y0 = (const GAS u32x2*)(Y + (size_t)s0 * D) + lane; const GAS u32x2* y1 = (const GAS u32x2*)(Y + (size_t)s1 * D) + lane;
#pragma unroll
            for (int j = 0; j < 4; ++j) {
                const f32x4 x = xr[64 * j]; const u32x2 a = y0[64 * j], c = y1[64 * j];
                const f32x4 m5 = m5v[j];
                f32x4 f;
                f.x = g0 * bf2f(a.x & 0xffffu) + g1 * bf2f(c.x & 0xffffu); f.y = g0 * bf2f(a.x >> 16) + g1 * bf2f(c.x >> 16);
                f.z = g0 * bf2f(a.y & 0xffffu) + g1 * bf2f(c.y & 0xffffu); f.w = g0 * bf2f(a.y >> 16) + g1 * bf2f(c.y >> 16);
                v[j] = x + m5 * f;
                s += (v[j].x * v[j].x + v[j].y * v[j].y) + (v[j].z * v[j].z + v[j].w * v[j].w);
            }
        } else {
#pragma unroll
            for (int j = 0; j < 4; ++j) {
                const f32x4 x = xr[64 * j];
                const f32x4 m5 = m5v[j];
                const f32x4 f = moe_yrow(Y, SLAB, s0, tail0, j, lane) * g0 + moe_yrow(Y, SLAB, s1, tail0, j, lane) * g1;
                v[j] = x + m5 * f;
                s += (v[j].x * v[j].x + v[j].y * v[j].y) + (v[j].z * v[j].z + v[j].w * v[j].w);
            }
        }
        const float rstd = 1.0f / sqrtf(wave_sum_l(s, lane) * (1.f / D) + EPS);
#pragma unroll
        for (int j = 0; j < 4; ++j) xr[64 * j] = v[j] * rstd * fgv[j];
    }
}

#define GRID_BAR() do { { unsigned* bp_ = (unsigned*)(F.ws + WS_CTL) + 4096; asm volatile("" : "+s"(bp_)); bar.bar = bp_; } xcd_barrier(bar); TS_STAMP(); F.tid = opq((int)threadIdx.x); F.lane = F.tid & 63; } while (0)

template <int MODE>
__device__ __forceinline__ void ctx_pieces(Frame& F, const bf16_t* A, const bf16_t* Bt, int K, int ncg, void* O, int ldo, const float* base, const float* gate,
                                           int nrg = 16, const unsigned* tile_e = nullptr, int tile0 = 0, size_t estride = 0) {
    const int lane = F.lane, r = lane & 15, g = lane >> 4, wave = F.wave;
    LAS float* red = (LAS float*)F.lds;
    const int npieces = nrg * ncg, kw = K >> 3;
    for (int p = blockIdx.x; p < npieces; p += F.G) {
        const int rg = p % nrg, cg = p / nrg;
        f32x4 acc[4];
#pragma unroll
        for (int n = 0; n < 4; ++n) acc[n] = (f32x4){0.f, 0.f, 0.f, 0.f};
        const bf16_t* ap = A + (size_t)(16 * rg + r) * K + wave * kw + 8 * g;
        size_t eoff = 0;
        if (tile_e) eoff = (size_t)(__builtin_amdgcn_readfirstlane(__hip_atomic_load(tile_e + tile0 + (rg >> 4), __ATOMIC_RELAXED, __HIP_MEMORY_SCOPE_AGENT)) & 7u) * estride;
        const bf16_t* bp = Bt + eoff + (size_t)(64 * cg + r) * K + wave * kw + 8 * g;
        for (int k = 0; k < kw; k += 32) {
            const bf16x8 a = *(const bf16x8*)(ap + k);
#pragma unroll
            for (int n = 0; n < 4; ++n) { const bf16x8 b = *(const bf16x8*)(bp + (size_t)(16 * n) * K + k); acc[n] = __builtin_amdgcn_mfma_f32_16x16x32_bf16(a, b, acc[n], 0, 0, 0); }
        }
#pragma unroll
        for (int n = 0; n < 4; ++n)
#pragma unroll
            for (int e = 0; e < 4; ++e) red[wave * 1024 + (4 * g + e) * 64 + 16 * n + r] = acc[n][e];
        __syncthreads();
        for (int idx = F.tid; idx < 1024; idx += NTHREADS) {
            float s = 0.f;
#pragma unroll
            for (int w = 0; w < 8; ++w) s += red[w * 1024 + idx];
            const int row = 16 * rg + (idx >> 6), col = 64 * cg + (idx & 63);
            if (MODE == 0) ((bf16_t*)O)[(size_t)row * ldo + col] = (bf16_t)f2bf(s);
            else ((float*)O)[(size_t)row * 1024 + col] = base[(size_t)row * 1024 + col] + gate[col] * s;
        }
        __syncthreads();
    }
}

#ifndef STOP_AFTER
#define STOP_AFTER 0
#endif
__device__ __forceinline__ void dump_bf16(Frame& F, float* out, const bf16_t* buf, int ld, int ncols) {
    for (int m = F.gw; m < NL; m += F.NGW)
        for (int j = 0; j < 16; ++j) { const int c = F.lane + 64 * j; float s = 0.f; for (int k = 0; c + 1024 * k < ncols; ++k) s += bf2f(buf[(size_t)m * ld + c + 1024 * k]); out[(size_t)m * D + c] = s; }
}
#define STOP_DUMP(n, buf, ld, nc) do { if (layer == 0 && STOP_AFTER == (n)) { dump_bf16(F, args.out, (const bf16_t*)(buf), (ld), (nc)); F.ws = nullptr; return; } } while (0)
template <int layer>
__device__ __forceinline__ void layer_body(Frame& F, const Args& args, XcdBarrier& bar) {
    unsigned char* ws = F.ws;
    float* HC = (float*)(ws + WS_HC);
    const float* MOD = (const float*)(ws + WS_MOD);
        F.tid = opq((int)threadIdx.x); F.lane = F.tid & 63;
        const float* xl = layer == 0 ? args.in[I_X] : args.out;
        const float* xc = layer == 0 ? args.in[I_CTX] : HC;
        const float* modx = MOD + (layer * 2 + 0) * 6144; const float* modc = MOD + (layer * 2 + 1) * 6144;
        norm_phase(F, xl, xc, layer, 0, 1, NT);
        GRID_BAR();
        ctx_pieces<0>(F, (const bf16_t*)(ws + WS_ACT) + (size_t)NL * 1024, (const bf16_t*)(ws + WS_WIN) + (size_t)layer * INP * 1024, 1024, INP / 64, (bf16_t*)(ws + WS_PX) + (size_t)NL * INP, INP, nullptr, nullptr);
        { pg8::DenseSched S{NL / 256, INP / 256, F.G, (int)blockIdx.x, (const char*)(ws + WS_ACT), (const char*)(ws + WS_WIN) + (size_t)layer * INP * 1024 * 2, (size_t)256 * 1024 * 2};
          pg8::EpiStoreBf16 E{(bf16_t*)(ws + WS_PX), INP};
          pg8::gemm_phase(F.lds, 1024, S, E); }
        GRID_BAR();
        STOP_DUMP(2, ws + WS_PX, INP, INC);
        prep_phase(F, args, layer);
        GRID_BAR();
        STOP_DUMP(3, ws + WS_QD, 384, 384);
        STOP_DUMP(33, ws + WS_QD + QKV_STRIDE, 384, 384);
        dn_chunk_phase(F);
        GRID_BAR();
        STOP_DUMP(4, ws + WS_DN, 1024, 1024);
        STOP_DUMP(44, ws + WS_DN + DN_STRIDE, 1024, 1024);
        STOP_DUMP(45, ws + WS_DN + 2 * DN_STRIDE, 1024, 1024);
        scan_x1_phase(F, args, layer);
        GRID_BAR();
        scan_x3_phase(F, args, layer);
        GRID_BAR();
        STOP_DUMP(5, ws + WS_DN + 3 * DN_STRIDE, 1024, 1024);
        STOP_DUMP(55, ws + WS_DN + 4 * DN_STRIDE, 1024, 1024);
        STOP_DUMP(56, ws + WS_ACT, 1024, 1024);
        dn_out_phase(F, args, layer);
        GRID_BAR();
        STOP_DUMP(6, ws + WS_ACT, 1024, 1024);
        if (layer == 0) ctx_pieces<1>(F, (const bf16_t*)(ws + WS_ACT) + (size_t)NL * 1024, (const bf16_t*)(ws + WS_WOUT), 1024, 16, HC, 1024, xc, modc + 2 * 1024);
        { pg8::DenseSched S{NL / 256, 4, F.G, (int)blockIdx.x, (const char*)(ws + WS_ACT), (const char*)(ws + WS_WOUT) + (size_t)layer * 1024 * 1024 * 2, (size_t)256 * 1024 * 2};
          pg8::EpiResid E{xl, args.out, modx + 2 * 1024, xc, HC, modc + 2 * 1024, NL / 256};
          pg8::gemm_phase(F.lds, 1024, S, E); }
        GRID_BAR();
        if (layer == 0 && STOP_AFTER == 7) { F.ws = nullptr; return; }
        if (layer == 0) {
            norm_phase(F, args.out, HC, 0, 3, 4, NT);
            GRID_BAR();
            { pg8::DenseSched S{NT / 256, 2 * DFF / 256, F.G, (int)blockIdx.x, (const char*)(ws + WS_ACT), (const char*)(ws + WS_WGU), (size_t)256 * 1024 * 2};
              pg8::EpiSwiGLU E{(bf16_t*)(ws + WS_BIG), DFF};
              pg8::gemm_phase(F.lds, 1024, S, E); }
            GRID_BAR();
            ctx_pieces<1>(F, (const bf16_t*)(ws + WS_BIG) + (size_t)NL * DFF, (const bf16_t*)(ws + WS_WDN), DFF, 16, HC, 1024, HC, modc + 5 * 1024);
            { pg8::DenseSched S{NL / 256, 4, F.G, (int)blockIdx.x, (const char*)(ws + WS_BIG), (const char*)(ws + WS_WDN), (size_t)256 * DFF * 2};
              pg8::EpiResid E{args.out, args.out, modx + 5 * 1024, HC, HC, modc + 5 * 1024, NL / 256};
              pg8::gemm_phase(F.lds, DFF, S, E); }
            GRID_BAR();
            if (STOP_AFTER == 9) { F.ws = nullptr; return; }
        } else {
            norm2_router_phase(F, args);
            GRID_BAR();
            moe_assign_phase(F);
            GRID_BAR();
            const int ntl = (int)__builtin_amdgcn_readfirstlane(__hip_atomic_load((unsigned*)(ws + RT_NT), RLX_AGENT));
#pragma unroll 1
            for (int t0 = 0; t0 < ntl; t0 += 64) {
                const int left = ntl - t0; const int nM = left > MOE_CH ? 64 : left;
                const int ntail = (nM > 64 && nM - 64 <= 8) ? nM - 64 : 0, nG2 = nM - ntail;
                { pg8::MoeSched S{nM, 2 * DFE / 256, F.G, (int)blockIdx.x, (const char*)(ws + WS_XS) + (size_t)t0 * 256 * 1024, (const char*)(ws + WS_MGU), (size_t)256 * 1024, (size_t)2 * DFE * 1024, (const unsigned*)(ws + RT_TILEE), t0, 0};
                  pg8::EpiSwiGLU8 E{ws + WS_HM, DFE, 1.0f / MOE_WSCALE, MOE_HSCALE};
                  pg8::gemm_phase<true>(F.lds, 512, S, E); }
                GRID_BAR();
                { pg8::MoeSched S{nG2, 4, F.G, (int)blockIdx.x, (const char*)(ws + WS_HM), (const char*)(ws + WS_MDN), (size_t)256 * DFE, (size_t)1024 * DFE, (const unsigned*)(ws + RT_TILEE), t0, t0};
                  pg8::EpiStoreBf16 E{(bf16_t*)(ws + WS_Y), 1024, 1.0f / (MOE_WSCALE * MOE_HSCALE)};
                  pg8::gemm_phase<true>(F.lds, DFE / 2, S, E); }
                if (ntail > 0) {
                    pg8::MoeTailSched S{ntail, F.G, (int)((blockIdx.x + 128) % F.G), (const char*)(ws + WS_HM) + (size_t)nG2 * 256 * DFE, (const char*)(ws + WS_MDN), (size_t)256 * DFE, (size_t)1024 * DFE, (const unsigned*)(ws + RT_TILEE), t0 + nG2, (size_t)512};
                    pg8::EpiSlab E{(float*)(ws + WS_SLAB), 1.0f / (MOE_WSCALE * MOE_HSCALE)};
                    pg8::gemm_phase<true>(F.lds, DFE / 2, S, E, 4);
                }
                GRID_BAR();
                if (left <= MOE_CH) break;
            }
            moe_final_phase(F, args);
        }
    }

__global__ void __launch_bounds__(NTHREADS, 2) fwd_kernel(Args args) {
    extern __shared__ __attribute__((aligned(16))) unsigned char lds[];
    Frame F;
    F.lds = (LAS unsigned char*)lds;
    F.tid = threadIdx.x; F.lane = F.tid & 63; F.wave = __builtin_amdgcn_readfirstlane(F.tid >> 6);
    F.G = gridDim.x; { const int bx = blockIdx.x; F.vcu = (F.G % 8 == 0) ? (bx % 8) * (F.G / 8) + bx / 8 : bx; }
    F.gw = F.vcu * NWAVES + F.wave; F.NGW = F.G * NWAVES;
    F.ws = args.ws;
    volatile LAS unsigned* MISC = (volatile LAS unsigned*)(F.lds + MISC_OFF);
    for (int u = F.tid; u < (LDS_BYTES - MISC_OFF) / 4; u += NTHREADS) ((LAS unsigned*)(F.lds + MISC_OFF))[u] = 0u;
    __syncthreads();
    XcdBarrier bar = xcd_barrier_post((unsigned*)(F.ws + WS_CTL) + 4096, MISC + 8);
    TS_STAMP();

    unsigned char* ws = F.ws;
    float* HC = (float*)(ws + WS_HC);
    const float* MOD = (const float*)(ws + WS_MOD);
#ifdef DIAG_ZERO
    { GAS u32x4* p = (GAS u32x4*)(F.ws + WS_MOD); const size_t n16 = (WS_END - WS_MOD) / 16; const u32x4 z = (u32x4){0u, 0u, 0u, 0u};
      for (size_t i = (size_t)blockIdx.x * NTHREADS + F.tid; i < n16; i += (size_t)F.G * NTHREADS) p[i] = z; }
    GRID_BAR();
#endif
    p0_prologue(F, args);
    GRID_BAR();
    layer_body<0>(F, args, bar);
    if (F.ws == nullptr) return;
    layer_body<1>(F, args, bar);
#ifdef TS_A
    TS_STAMP();
    if (blockIdx.x == 0 && threadIdx.x == 0) {
        volatile LAS unsigned* M_ = (volatile LAS unsigned*)(F.lds + MISC_OFF);
        const unsigned long long ta = ((unsigned long long)M_[17 + 2 * (TS_A)] << 32) | M_[16 + 2 * (TS_A)], tb = ((unsigned long long)M_[17 + 2 * (TS_B)] << 32) | M_[16 + 2 * (TS_B)];
        const unsigned long long dl = (tb - ta) * (TS_MUL), t0 = __builtin_amdgcn_s_memrealtime();
        while (__builtin_amdgcn_s_memrealtime() - t0 < dl) __builtin_amdgcn_s_sleep(8);
    }
#endif
}

extern "C" void kernel_launch(void* const* d_in, const int* in_sizes, int n_in, void* d_out, int out_size, void* d_ws, size_t ws_size, hipStream_t stream) {
    static int grid = 0;
    if (grid == 0) {
        if (n_in != 22 || out_size != NL * D || ws_size < WS_END) { fprintf(stderr, "kernel_launch: unexpected shapes (n_in %d out %d ws %zu)\n", n_in, out_size, ws_size); grid = -1; return; }
        int dev = 0, cus = 0;
        if (hipGetDevice(&dev) != hipSuccess || hipDeviceGetAttribute(&cus, hipDeviceAttributeMultiprocessorCount, dev) != hipSuccess) { grid = -1; return; }
        if (hipFuncSetAttribute((const void*)fwd_kernel, hipFuncAttributeMaxDynamicSharedMemorySize, LDS_BYTES) != hipSuccess) { fprintf(stderr, "kernel_launch: hipFuncSetAttribute failed\n"); grid = -1; return; }
        int per_cu = 0;
        (void)hipOccupancyMaxActiveBlocksPerMultiprocessor(&per_cu, (const void*)fwd_kernel, NTHREADS, LDS_BYTES);
        (void)hipGetLastError();
        grid = cus;
    }
    if (grid < 0) return;
    (void)hipMemsetAsync((char*)d_ws + WS_CTL, 0, CTL_ZERO_BYTES, stream);
    Args a{};
    for (int i = 0; i < 22; ++i) a.in[i] = (const float*)d_in[i];
    a.out = (float*)d_out; a.ws = (unsigned char*)d_ws;
    hipLaunchKernelGGL(fwd_kernel, dim3(grid), dim3(NTHREADS), LDS_BYTES, stream, a);
}
```

```cpp
#define STOP_AFTER 0
#include <hip/hip_runtime.h>
#include <cstdint>
#include <cstdio>

#define GAS __attribute__((address_space(1)))
#define LAS __attribute__((address_space(3)))
typedef unsigned short bf16_t;
typedef short bf16x8 __attribute__((ext_vector_type(8)));
typedef short bf16x4 __attribute__((ext_vector_type(4)));
typedef float f32x4 __attribute__((ext_vector_type(4)));
typedef float f32x2 __attribute__((ext_vector_type(2)));
typedef unsigned u32x4 __attribute__((ext_vector_type(4)));
typedef unsigned u32x2 __attribute__((ext_vector_type(2)));
typedef GAS unsigned gu32;

constexpr int D = 1024, NL = 16384, NC = 256, NT = NL + NC;
constexpr int INC = 2968, INP = 3072;
constexpr int C_CB = 0, C_CC = 256, C_CH = 512, C_DQ = 768, C_DK = 1152, C_DV = 1536, C_DZ = 1920, C_DA = 2304, C_DB = 2316, C_AQ = 2328, C_AK = 2712, C_AV = 2840;
constexpr int DFF = 2816, NEXP = 8, DFE = 3584;
constexpr int NWAVES = 8, NTHREADS = 512;
constexpr float EPS = 1e-6f;

constexpr size_t MiB = 1u << 20;
constexpr size_t WS_CTL = 0, CTL_ZERO_BYTES = 1 * MiB;
constexpr size_t WS_MOD = 1 * MiB;
constexpr size_t WS_ROPE = 1 * MiB + 128 * 1024;
constexpr size_t WS_HC = 2 * MiB;
constexpr size_t WS_G = 3 * MiB;
constexpr size_t WS_BETA = 4 * MiB;
constexpr size_t WS_ROUTE = 5 * MiB;
constexpr size_t WS_WIN = 8 * MiB;
constexpr size_t WS_WOUT = 20 * MiB;
constexpr size_t WS_WGU = 24 * MiB;
constexpr size_t WS_WDN = 35 * MiB;
constexpr size_t WS_MGU = 41 * MiB;
constexpr size_t WS_MDN = 153 * MiB;
constexpr size_t WS_ACT = 209 * MiB;
constexpr size_t WS_BIG = 242 * MiB;
constexpr size_t WS_PX = WS_BIG;
constexpr size_t WS_QD = 340 * MiB;
constexpr size_t QKV_STRIDE = 12 * MiB + 512 * 1024;
constexpr size_t WS_DN = 378 * MiB;
constexpr size_t DN_STRIDE = 25 * MiB;
constexpr size_t WS_END = 512 * MiB;
static_assert(WS_QD + 3 * QKV_STRIDE <= WS_DN && WS_DN + 5 * DN_STRIDE <= WS_END, "ws map");
static_assert((size_t)NT * INP * 2 <= WS_QD - WS_PX && (size_t)NT * 384 * 2 <= QKV_STRIDE && (size_t)3120 * 8192 <= DN_STRIDE, "ws map 2");

constexpr int SCR_BYTES = 139264;
constexpr int MISC_OFF = SCR_BYTES;
constexpr int LDS_BYTES = 147456;

#define RLX_AGENT __ATOMIC_RELAXED, __HIP_MEMORY_SCOPE_AGENT
#define LDS_WAIT() asm volatile("s_waitcnt lgkmcnt(0)" ::: "memory")
#define VM_WAIT() asm volatile("s_waitcnt vmcnt(0)" ::: "memory")

__device__ __forceinline__ unsigned f2bf(float f) { unsigned u = __builtin_bit_cast(unsigned, f); return (u + 0x7fffu + ((u >> 16) & 1u)) >> 16; }
__device__ __forceinline__ unsigned pk2(float lo, float hi) { return f2bf(lo) | (f2bf(hi) << 16); }
__device__ __forceinline__ float bf2f(unsigned h) { return __builtin_bit_cast(float, h << 16); }
__device__ __forceinline__ unsigned pk_fp8x4(float a, float b, float c, float d) {
    a = __builtin_fminf(__builtin_fmaxf(a, -448.f), 448.f); b = __builtin_fminf(__builtin_fmaxf(b, -448.f), 448.f);
    c = __builtin_fminf(__builtin_fmaxf(c, -448.f), 448.f); d = __builtin_fminf(__builtin_fmaxf(d, -448.f), 448.f);
    int p = __builtin_amdgcn_cvt_pk_fp8_f32(a, b, 0, false); p = __builtin_amdgcn_cvt_pk_fp8_f32(c, d, p, true); return (unsigned)p;
}
__device__ __forceinline__ float silu_f(float x) { return x * __builtin_amdgcn_rcpf(1.f + __expf(-x)); }
__device__ __forceinline__ int opq(int v) { asm volatile("" : "+v"(v)); return v; }
template <int CTRL> __device__ __forceinline__ float dpp_all(float v) { return __builtin_bit_cast(float, __builtin_amdgcn_update_dpp(0, __builtin_bit_cast(int, v), CTRL, 0xF, 0xF, true)); }
template <int CTRL, int RM> __device__ __forceinline__ float dpp_rows(float v) { return __builtin_bit_cast(float, __builtin_amdgcn_update_dpp(0, __builtin_bit_cast(int, v), CTRL, RM, 0xF, false)); }
__device__ __forceinline__ float sum8(float v) { v += dpp_all<0xB1>(v); v += dpp_all<0x4E>(v); v += dpp_all<0x141>(v); return v; }
__device__ __forceinline__ float wave_sum(float v) {
    v = sum8(v); v += dpp_all<0x140>(v);
    v += dpp_rows<0x142, 0xA>(v);
    v += dpp_rows<0x143, 0xC>(v);
    return __builtin_bit_cast(float, __builtin_amdgcn_readlane(__builtin_bit_cast(int, v), 63));
}
__device__ __forceinline__ float wave_sum_l(float v, int) { return wave_sum(v); }

#define XB_TMO      128
#define XB_XCNT(j)  (256  + 64 * (j))
#define XB_XSUB(j)  (1280 + 64 * (j))
#define XB_XGEN(j)  (2304 + 64 * (j))
#define XB_TOP      3328
#define XB_TOPGEN   3392
#define XCD_BAR_WORDS 3456
#define XB_SPIN_CAP (1u << 22)
__device__ __forceinline__ unsigned xb_ld(unsigned* p)              { return __hip_atomic_load(p, __ATOMIC_RELAXED, __HIP_MEMORY_SCOPE_AGENT); }
__device__ __forceinline__ unsigned xb_add(unsigned* p, unsigned v) { return __hip_atomic_fetch_add(p, v, __ATOMIC_RELAXED, __HIP_MEMORY_SCOPE_AGENT); }
__device__ __forceinline__ unsigned xb_xcc_id() { return (unsigned)__builtin_amdgcn_s_getreg((3 << 11) | 20) & 0xFu; }
#define XB_SPIN(cond, bar) do { unsigned _sp = 0; while (cond) { __builtin_amdgcn_s_sleep(1); \
    if ((++_sp & 255u) == 0u) { if (xb_ld(&(bar)[XB_TMO])) break; if (_sp > XB_SPIN_CAP) { atomicAdd(&(bar)[XB_TMO], 1u); break; } } } } while (0)
struct XcdBarrier { unsigned* bar; unsigned x; volatile LAS unsigned* st; };
__device__ __forceinline__ XcdBarrier xcd_barrier_post(unsigned* bar, volatile LAS unsigned* st) {
    XcdBarrier b; b.bar = bar; b.x = xb_xcc_id(); b.st = st;
    if (threadIdx.x == 0) (void)xb_add(&bar[XB_XCNT(b.x)], 1u);
    return b;
}
__device__ __forceinline__ void xcd_barrier_complete(unsigned* bar, unsigned x, unsigned& nloc, unsigned& nx) {
    const unsigned G = gridDim.x * gridDim.y * gridDim.z;
    unsigned sum, cnt, mine, sp = 0u;
    for (;;) {
        sum = 0u; cnt = 0u; mine = 0u;
#pragma unroll
        for (unsigned j = 0; j < 16; ++j) { const unsigned c = xb_ld(&bar[XB_XCNT(j)]); sum += c; cnt += (c > 0u) ? 1u : 0u; mine = (j == x) ? c : mine; }
        if (sum == G) break;
        __builtin_amdgcn_s_sleep(1);
        if ((++sp & 255u) == 0u) { if (xb_ld(&bar[XB_TMO])) break; if (sp > XB_SPIN_CAP) { atomicAdd(&bar[XB_TMO], 1u); break; } }
    }
    nloc = mine > 0u ? mine : 1u; nx = cnt > 0u ? cnt : 1u;
}
__device__ __forceinline__ void xcd_barrier(const XcdBarrier& b) {
    asm volatile("s_waitcnt vmcnt(0)" ::: "memory");
    __syncthreads();
    if (threadIdx.x == 0) {
        unsigned* bar = b.bar;
        __builtin_amdgcn_s_waitcnt(0);
        unsigned nloc = b.st[0], nx = b.st[1];
        if (nloc == 0u) { xcd_barrier_complete(bar, b.x, nloc, nx); b.st[0] = nloc; b.st[1] = nx; }
        const unsigned old = xb_add(&bar[XB_XSUB(b.x)], 1u);
        const unsigned gen = old / nloc;
        if (old + 1u == (gen + 1u) * nloc) {
            __builtin_amdgcn_fence(__ATOMIC_RELEASE, "agent");
            asm volatile("s_waitcnt vmcnt(0)" ::: "memory");
            const unsigned og = xb_add(&bar[XB_TOP], 1u);
            const unsigned tg = og / nx;
            if (og + 1u == (tg + 1u) * nx) xb_add(&bar[XB_TOPGEN], 1u);
            else XB_SPIN(xb_ld(&bar[XB_TOPGEN]) == tg, bar);
            __builtin_amdgcn_fence(__ATOMIC_ACQUIRE, "agent");
            xb_add(&bar[XB_XGEN(b.x)], 1u);
            asm volatile("s_waitcnt vmcnt(0)" ::: "memory");
        } else {
            XB_SPIN(xb_ld(&bar[XB_XGEN(b.x)]) == gen, bar);
            __builtin_amdgcn_fence(__ATOMIC_ACQUIRE, "agent");
            asm volatile("s_waitcnt vmcnt(0)" ::: "memory");
        }
    }
    __syncthreads();
}

#ifdef TS_A
#define TS_STAMP() do { if (blockIdx.x == 0 && threadIdx.x == 0) { volatile LAS unsigned* M_ = (volatile LAS unsigned*)(F.lds + MISC_OFF); const unsigned k_ = M_[12]; const unsigned long long t_ = __builtin_amdgcn_s_memrealtime(); M_[16 + 2 * k_] = (unsigned)t_; M_[17 + 2 * k_] = (unsigned)(t_ >> 32); M_[12] = k_ + 1; } } while (0)
#else
#define TS_STAMP() do {} while (0)
#endif
struct Args { const float* in[22]; float* out; unsigned char* ws; };
enum { I_X = 0, I_C, I_CTX, I_CCTX, I_WMOD, I_BMOD, I_WIN, I_WOUT, I_CONVW, I_DNCONVW, I_ALOG, I_DTB, I_NORMG, I_SINK, I_FG, I_FU, I_FD, I_ROUTER, I_MG, I_MU, I_MD, I_FNG };
struct Frame {
    LAS unsigned char* lds;
    int tid, lane, wave, vcu, G, gw, NGW;
    unsigned char* ws;
};

__device__ __forceinline__ void transpose_item(const float* __restrict__ W, int K, int N, bf16_t* WT, int mode, LAS float* scr, int kb, int nb, int lane) {
    const int k0 = 64 * kb, n0 = 64 * nb;
    const int nn = n0 + lane; const bool ok = nn < N;
    const float* src = W + (size_t)k0 * N + (ok ? nn : 0);
#pragma unroll 8
    for (int i = 0; i < 64; ++i) { float v = src[(size_t)i * N]; scr[i * 65 + lane] = ok ? v : 0.f; }
    LDS_WAIT(); asm volatile("" ::: "memory");
    const int c = lane & 7;
#pragma unroll
    for (int j = 0; j < 8; ++j) {
        const int n = (lane >> 3) + 8 * j; const LAS float* s = scr + (8 * c) * 65 + n;
        u32x4 o; o.x = pk2(s[0 * 65], s[1 * 65]); o.y = pk2(s[2 * 65], s[3 * 65]); o.z = pk2(s[4 * 65], s[5 * 65]); o.w = pk2(s[6 * 65], s[7 * 65]);
        const int ng = n0 + n; int drow = ng;
        if (mode == 1) drow = (ng >> 2) * 8 + (ng & 3); else if (mode == 2) drow = (ng >> 2) * 8 + 4 + (ng & 3);
        *(GAS u32x4*)(WT + (size_t)drow * K + k0 + 8 * c) = o;
    }
    LDS_WAIT(); asm volatile("" ::: "memory");
}

__device__ __forceinline__ void transpose_item8(const float* __restrict__ W, int K, int N, unsigned char* WT, int mode, float wscale, LAS float* scr, int kb, int nb, int lane) {
    const int k0 = 64 * kb, n0 = 64 * nb;
    const float* src = W + (size_t)k0 * N + n0 + lane;
#pragma unroll 8
    for (int i = 0; i < 64; ++i) scr[i * 65 + lane] = src[(size_t)i * N];
    LDS_WAIT(); asm volatile("" ::: "memory");
    const int c = lane & 3;
#pragma unroll
    for (int j = 0; j < 4; ++j) {
        const int n = (lane >> 2) + 16 * j; const LAS float* s = scr + (16 * c) * 65 + n;
        u32x4 o;
        o.x = pk_fp8x4(s[0 * 65] * wscale, s[1 * 65] * wscale, s[2 * 65] * wscale, s[3 * 65] * wscale);
        o.y = pk_fp8x4(s[4 * 65] * wscale, s[5 * 65] * wscale, s[6 * 65] * wscale, s[7 * 65] * wscale);
        o.z = pk_fp8x4(s[8 * 65] * wscale, s[9 * 65] * wscale, s[10 * 65] * wscale, s[11 * 65] * wscale);
        o.w = pk_fp8x4(s[12 * 65] * wscale, s[13 * 65] * wscale, s[14 * 65] * wscale, s[15 * 65] * wscale);
        const int ng = n0 + n; int drow = ng;
        if (mode == 1) drow = (ng >> 2) * 8 + (ng & 3); else if (mode == 2) drow = (ng >> 2) * 8 + 4 + (ng & 3);
        *(GAS u32x4*)(WT + (size_t)drow * K + k0 + 16 * c) = o;
    }
    LDS_WAIT(); asm volatile("" ::: "memory");
}
constexpr float MOE_WSCALE = 64.0f, MOE_HSCALE = 8.0f;
__device__ __forceinline__ void p0_prologue(Frame& F, const Args& A) {
    if (blockIdx.x < 192) {
        LAS float* sc = (LAS float*)F.lds;
        for (int i = F.tid; i < 1024; i += NTHREADS) { sc[i] = silu_f(A.in[I_C][i]); sc[1024 + i] = silu_f(A.in[I_CCTX][i]); }
        __syncthreads();
        const int l = blockIdx.x / 96, cg = blockIdx.x % 96;
        const float* W = A.in[I_WMOD] + (size_t)l * 1024 * 6144 + cg * 64 + F.lane;
        float ax = 0.f, ac = 0.f;
        const int kb = F.wave * 128;
#pragma unroll 8
        for (int k = 0; k < 128; ++k) { const float wv = W[(size_t)(kb + k) * 6144]; ax += sc[kb + k] * wv; ac += sc[1024 + kb + k] * wv; }
        LAS float* red = sc + 2048;
        red[F.wave * 64 + F.lane] = ax; red[512 + F.wave * 64 + F.lane] = ac;
        __syncthreads();
        if (F.wave == 0) {
            float sx = 0.f, sc2 = 0.f;
#pragma unroll
            for (int w = 0; w < 8; ++w) { sx += red[w * 64 + F.lane]; sc2 += red[512 + w * 64 + F.lane]; }
            const float b = A.in[I_BMOD][l * 6144 + cg * 64 + F.lane];
            float* mod = (float*)(F.ws + WS_MOD);
            mod[(l * 2 + 0) * 6144 + cg * 64 + F.lane] = sx + b;
            mod[(l * 2 + 1) * 6144 + cg * 64 + F.lane] = sc2 + b;
        }
        __syncthreads();
    } else if (blockIdx.x == 192) {
        float* rope = (float*)(F.ws + WS_ROPE);
        for (int i = F.tid; i < 256 * 16; i += NTHREADS) {
            const int pos = i >> 4, f = i & 15;
            const float inv = powf(10000.0f, -(float)(2 * f) / 32.0f);
            const float ang = (float)pos * inv;
            rope[2 * i] = cosf(ang); rope[2 * i + 1] = sinf(ang);
        }
    }
    LAS float* scr = (LAS float*)(F.lds + F.wave * 16640);
    constexpr int N_WIN = 2 * 16 * 48, N_WOUT = 2 * 16 * 16, N_FG = 16 * 44, N_FD = 44 * 16, N_MG = 8 * 16 * 56, N_MD = 8 * 56 * 16;
    constexpr int NITEMS = N_WIN + N_WOUT + 2 * N_FG + N_FD + 2 * N_MG + N_MD;
    bf16_t* ws16 = (bf16_t*)F.ws;
    for (int it = F.gw; it < NITEMS; it += F.NGW) {
        int r = it;
        if (r < N_WIN) { const int l = r / (16 * 48), q = r % (16 * 48); transpose_item(A.in[I_WIN] + (size_t)l * 1024 * INC, 1024, INC, (bf16_t*)(F.ws + WS_WIN) + (size_t)l * INP * 1024, 0, scr, q / 48, q % 48, F.lane); continue; } r -= N_WIN;
        if (r < N_WOUT) { const int l = r / 256, q = r % 256; transpose_item(A.in[I_WOUT] + (size_t)l * 1024 * 1024, 1024, 1024, (bf16_t*)(F.ws + WS_WOUT) + (size_t)l * 1024 * 1024, 0, scr, q / 16, q % 16, F.lane); continue; } r -= N_WOUT;
        if (r < N_FG) { transpose_item(A.in[I_FG], 1024, DFF, (bf16_t*)(F.ws + WS_WGU), 1, scr, r / 44, r % 44, F.lane); continue; } r -= N_FG;
        if (r < N_FG) { transpose_item(A.in[I_FU], 1024, DFF, (bf16_t*)(F.ws + WS_WGU), 2, scr, r / 44, r % 44, F.lane); continue; } r -= N_FG;
        if (r < N_FD) { transpose_item(A.in[I_FD], DFF, 1024, (bf16_t*)(F.ws + WS_WDN), 0, scr, r / 16, r % 16, F.lane); continue; } r -= N_FD;
        if (r < N_MG) { const int e = r / (16 * 56), q = r % (16 * 56); transpose_item8(A.in[I_MG] + (size_t)e * 1024 * DFE, 1024, DFE, F.ws + WS_MGU + (size_t)e * 2 * DFE * 1024, 1, MOE_WSCALE, scr, q / 56, q % 56, F.lane); continue; } r -= N_MG;
        if (r < N_MG) { const int e = r / (16 * 56), q = r % (16 * 56); transpose_item8(A.in[I_MU] + (size_t)e * 1024 * DFE, 1024, DFE, F.ws + WS_MGU + (size_t)e * 2 * DFE * 1024, 2, MOE_WSCALE, scr, q / 56, q % 56, F.lane); continue; } r -= N_MG;
        { const int e = r / (56 * 16), q = r % (56 * 16); transpose_item8(A.in[I_MD] + (size_t)e * DFE * 1024, DFE, 1024, F.ws + WS_MDN + (size_t)e * 1024 * DFE, 0, MOE_WSCALE, scr, q / 16, q % 16, F.lane); }
    }
    (void)ws16;
}

__device__ __forceinline__ void norm_mod_row(const float* xrow, const f32x4 (&sh)[4], const f32x4 (&sc1)[4], bf16_t* orow, int lane) {
    const GAS f32x4* xr = (const GAS f32x4*)xrow + lane;
    f32x4 v[4]; float s = 0.f;
#pragma unroll
    for (int j = 0; j < 4; ++j) { v[j] = xr[64 * j]; s += (v[j].x * v[j].x + v[j].y * v[j].y) + (v[j].z * v[j].z + v[j].w * v[j].w); }
    const float rstd = 1.0f / sqrtf(wave_sum(s) * (1.f / D) + EPS);
    GAS u32x2* o8 = (GAS u32x2*)orow + lane;
#pragma unroll
    for (int j = 0; j < 4; ++j) {
        const f32x4 y = v[j] * rstd * sc1[j] + sh[j];
        u32x2 w; w.x = pk2(y.x, y.y); w.y = pk2(y.z, y.w); o8[64 * j] = w;
    }
}
__device__ __forceinline__ void norm_phase(Frame& F, const float* xl, const float* xc, int layer, int s_shift, int s_scale, int nrows) {
    const float* mod = (const float*)(F.ws + WS_MOD);
    const float* mx = mod + (layer * 2 + 0) * 6144; const float* mc = mod + (layer * 2 + 1) * 6144;
    bf16_t* act = (bf16_t*)(F.ws + WS_ACT);
    f32x4 shl[4], scl[4];
#pragma unroll
    for (int j = 0; j < 4; ++j) { shl[j] = ((const GAS f32x4*)(mx + s_shift * 1024))[F.lane + 64 * j]; scl[j] = ((const GAS f32x4*)(mx + s_scale * 1024))[F.lane + 64 * j] + 1.0f; }
    for (int m = F.gw; m < nrows; m += F.NGW) {
        if (m < NL) norm_mod_row(xl + (size_t)m * D, shl, scl, act + (size_t)m * D, F.lane);
        else { f32x4 shc[4], scc[4];
#pragma unroll
            for (int j = 0; j < 4; ++j) { shc[j] = ((const GAS f32x4*)(mc + s_shift * 1024))[F.lane + 64 * j]; scc[j] = ((const GAS f32x4*)(mc + s_scale * 1024))[F.lane + 64 * j] + 1.0f; }
            norm_mod_row(xc + (size_t)(m - NL) * D, shc, scc, act + (size_t)m * D, F.lane); }
    }
}

namespace pg8 {
typedef int v8i __attribute__((ext_vector_type(8)));
constexpr int BM = 256, BK = 64, HALF = 128, HTB = HALF * BK * 2, STAGE_BYTES = 8 * HTB, NXCD = 8, WGM = 8;
__host__ __device__ __forceinline__ int lds_byte(int r, int c) { const int st = (r >> 4) * 2 + (c >> 5), rr = r & 15, cc = c & 31, ob = rr * 64 + cc * 2; return st * 1024 + (ob ^ (((ob >> 9) & 1) << 5)); }
__host__ __device__ __forceinline__ void stage_rc(int b, int& R, int& C) { const int st = b / 1024, sb = b % 1024, swz = sb ^ (((sb >> 9) & 1) << 5); R = (st >> 1) * 16 + swz / 64; C = (st & 1) * 32 + (swz % 64) / 2; }
__host__ __device__ __forceinline__ int perm32(int rho) { const int n = rho >> 4, i = rho & 15; return 8 * (i >> 2) + 4 * n + (i & 3); }
struct Unit { int pm, pn; const char* a; const char* b; };
typedef __bf16 bf16x2_t __attribute__((ext_vector_type(2)));
__device__ __forceinline__ unsigned cvt_pk_bf16(float lo, float hi) { f32x2 v = {lo, hi}; bf16x2_t b = __builtin_convertvector(v, bf16x2_t); return __builtin_bit_cast(unsigned, b); }

__device__ __forceinline__ bool tile_order(int i, int G, int c, int nM, int nN, int& pm, int& pn) {
    const int nwg = nM * nN; const long L = (long)i * G + c; if (L >= nwg) return false;
    int wgid = (int)L; { const int q = nwg / NXCD, r = nwg % NXCD, xcd = wgid % NXCD, off = wgid / NXCD; wgid = (xcd < r ? xcd * (q + 1) : r * (q + 1) + (xcd - r) * q) + off; }
    const int nig = WGM * nN, gid = wgid / nig, fm = gid * WGM, gsz = (nM - fm) < WGM ? (nM - fm) : WGM;
    pm = fm + ((wgid % nig) % gsz); pn = (wgid % nig) / gsz; return true;
}
struct DenseSched {
    int nM, nN, G, c; const char* A; const char* B; size_t tstep;
    __device__ __forceinline__ bool next(int i, Unit& u) const {
        int pm, pn; if (!tile_order(i, G, c, nM, nN, pm, pn)) return false;
        u.pm = pm; u.pn = pn; u.a = A + (size_t)pm * tstep; u.b = B + (size_t)pn * tstep; return true;
    }
};
struct MoeSched {
    int nM, nN, G, c; const char* A; const char* B; size_t tstep, estride; const unsigned* tile_e; int t0, pm_off;
    __device__ __forceinline__ bool next(int i, Unit& u) const {
        int pm, pn; if (!tile_order(i, G, c, nM, nN, pm, pn)) return false;
        const unsigned e = __builtin_amdgcn_readfirstlane(__hip_atomic_load(tile_e + t0 + pm, __ATOMIC_RELAXED, __HIP_MEMORY_SCOPE_AGENT)) & 7u;
        u.pm = pm + pm_off; u.pn = pn; u.a = A + (size_t)pm * tstep; u.b = B + (size_t)e * estride + (size_t)pn * tstep; return true;
    }
};

using ::pk_fp8x4;
struct EpiSwiGLU8 {
    static constexpr bool PERM = true;
    unsigned char* H; int ldh; float ascale, hs;
    __device__ __forceinline__ void operator()(const f32x4 (&acc)[2][2][4][2], const Unit& u, int wr, int wc, int fr, int fq) const {
        const int row0 = u.pm * BM + wr * 64 + fr, col0 = u.pn * 128 + wc * 16 + 4 * fq;
#pragma unroll
        for (int ai = 0; ai < 2; ++ai)
#pragma unroll
            for (int m = 0; m < 4; ++m) { unsigned char* rowp = H + (size_t)(row0 + ai * HALF + m * 16) * ldh + col0;
#pragma unroll
                for (int bj = 0; bj < 2; ++bj) { const f32x4 g = acc[ai][bj][m][0] * ascale, up = acc[ai][bj][m][1] * (ascale * hs);
                    float h[4];
#pragma unroll
                    for (int e = 0; e < 4; ++e) h[e] = g[e] * __builtin_amdgcn_rcpf(1.f + __expf(-g[e])) * up[e];
                    *(unsigned*)(rowp + bj * 64) = pk_fp8x4(h[0], h[1], h[2], h[3]); }
                asm volatile("" ::: "memory"); }
    }
};
struct EpiStoreBf16 {
    static constexpr bool PERM = true;
    bf16_t* O; int ldc; float scale = 1.0f;
    __device__ __forceinline__ void operator()(const f32x4 (&acc)[2][2][4][2], const Unit& u, int wr, int wc, int fr, int fq) const {
        const int row0 = u.pm * BM + wr * 64 + fr, col0 = u.pn * BM + wc * 32 + 8 * fq;
#pragma unroll
        for (int ai = 0; ai < 2; ++ai)
#pragma unroll
            for (int m = 0; m < 4; ++m) { bf16_t* rowp = O + (size_t)(row0 + ai * HALF + m * 16) * ldc + col0;
#pragma unroll
                for (int bj = 0; bj < 2; ++bj) { const f32x4 v0 = acc[ai][bj][m][0] * scale, v1 = acc[ai][bj][m][1] * scale;
                    u32x4 w; w.x = cvt_pk_bf16(v0[0], v0[1]); w.y = cvt_pk_bf16(v0[2], v0[3]); w.z = cvt_pk_bf16(v1[0], v1[1]); w.w = cvt_pk_bf16(v1[2], v1[3]);
                    *(u32x4*)(rowp + bj * HALF) = w; } }
    }
};
struct EpiSwiGLU {
    static constexpr bool PERM = true;
    bf16_t* H; int ldh;
    __device__ __forceinline__ void operator()(const f32x4 (&acc)[2][2][4][2], const Unit& u, int wr, int wc, int fr, int fq) const {
        const int row0 = u.pm * BM + wr * 64 + fr, col0 = u.pn * 128 + wc * 16 + 4 * fq;
#pragma unroll
        for (int ai = 0; ai < 2; ++ai)
#pragma unroll
            for (int m = 0; m < 4; ++m) { bf16_t* rowp = H + (size_t)(row0 + ai * HALF + m * 16) * ldh + col0;
#pragma unroll
                for (int bj = 0; bj < 2; ++bj) { const f32x4 g = acc[ai][bj][m][0], up = acc[ai][bj][m][1];
                    float h[4];
#pragma unroll
                    for (int e = 0; e < 4; ++e) h[e] = g[e] * __builtin_amdgcn_rcpf(1.f + __expf(-g[e])) * up[e];
                    u32x2 w; w.x = cvt_pk_bf16(h[0], h[1]); w.y = cvt_pk_bf16(h[2], h[3]);
                    *(u32x2*)(rowp + bj * 64) = w; }
                asm volatile("" ::: "memory"); }
    }
};
struct EpiResid {
    static constexpr bool PERM = false;
    const float* base_l; float* out_l; const float* gate_l; const float* base_c; float* out_c; const float* gate_c; int ctx_tile;
    __device__ __forceinline__ void operator()(const f32x4 (&acc)[2][2][4][2], const Unit& u, int wr, int wc, int fr, int fq) const {
        const bool isc = u.pm >= ctx_tile;
        const float* base = isc ? base_c : base_l; float* out = isc ? out_c : out_l; const float* gate = isc ? gate_c : gate_l;
        const int row0 = (isc ? (u.pm - ctx_tile) : u.pm) * BM + wr * 64 + fr, col0 = u.pn * BM + wc * 32 + 4 * fq;
        f32x4 gv[2][2];
#pragma unroll
        for (int bj = 0; bj < 2; ++bj)
#pragma unroll
            for (int n = 0; n < 2; ++n) gv[bj][n] = *(const f32x4*)(gate + col0 + bj * HALF + n * 16);
#pragma unroll
        for (int ai = 0; ai < 2; ++ai)
#pragma unroll
            for (int m = 0; m < 4; ++m) { const size_t off = (size_t)(row0 + ai * HALF + m * 16) * D + col0;
#pragma unroll
                for (int bj = 0; bj < 2; ++bj)
#pragma unroll
                    for (int n = 0; n < 2; ++n) { const f32x4 bs = *(const f32x4*)(base + off + bj * HALF + n * 16);
                        *(f32x4*)(out + off + bj * HALF + n * 16) = bs + gv[bj][n] * acc[ai][bj][m][n]; } }
    }
};

struct MoeTailSched {
    int ntail, G, c; const char* A; const char* B; size_t tstep, estride; const unsigned* tile_e; int tile0; size_t ksb;
    __device__ __forceinline__ bool next(int i, Unit& u) const {
        const long L = (long)i * G + c; if (L >= (long)ntail * 28) return false;
        const int ks = (int)(L % 7), q = (int)(L / 7), pn = q & 3, tt = q >> 2;
        const unsigned e = __builtin_amdgcn_readfirstlane(__hip_atomic_load(tile_e + tile0 + tt, __ATOMIC_RELAXED, __HIP_MEMORY_SCOPE_AGENT)) & 7u;
        u.pm = q * 7 + ks; u.pn = 0; u.a = A + (size_t)tt * tstep + (size_t)ks * ksb; u.b = B + (size_t)e * estride + (size_t)pn * tstep + (size_t)ks * ksb; return true;
    }
};
struct EpiSlab {
    static constexpr bool PERM = false;
    float* slab; float scale = 1.0f;
    __device__ __forceinline__ void operator()(const f32x4 (&acc)[2][2][4][2], const Unit& u, int wr, int wc, int fr, int fq) const {
        float* base = slab + (size_t)u.pm * 65536 + (size_t)(wr * 64 + fr) * 256 + wc * 32 + 4 * fq;
#pragma unroll
        for (int ai = 0; ai < 2; ++ai)
#pragma unroll
            for (int m = 0; m < 4; ++m)
#pragma unroll
                for (int bj = 0; bj < 2; ++bj)
#pragma unroll
                    for (int n = 0; n < 2; ++n) *(f32x4*)(base + (size_t)(ai * HALF + m * 16) * 256 + bj * HALF + n * 16) = acc[ai][bj][m][n] * scale;
    }
};

template <bool FP8 = false, class Epi, class Sched>
__device__ __forceinline__ void gemm_phase(LAS unsigned char* lds, const int K, const Sched& S, const Epi& E, const int ntk = 0) {
    int tid_ = threadIdx.x; asm volatile("" : "+v"(tid_));
    const int tid = tid_, wid = __builtin_amdgcn_readfirstlane(tid >> 6), lane = tid & 63, wr = wid >> 2, wc = wid & 3, fr = lane & 15, fq = lane >> 4;
    const int nt = ntk ? ntk : K / BK;
    unsigned voffA[2], voffB[2];
#pragma unroll
    for (int i = 0; i < 2; ++i) { int R, C; stage_rc(tid * 16 + i * 8192, R, C); const int Rb = Epi::PERM ? ((R & ~31) + perm32(R & 31)) : R;
        voffA[i] = (unsigned)(R * K + C) * 2u; voffB[i] = (unsigned)(Rb * K + C) * 2u; }
    const size_t kstep = (size_t)(BK * 2);
    const size_t hstep = (size_t)HALF * K * 2;
    const unsigned ldsw = (unsigned)wid * 1024u;
    const int aoff = lds_byte(wr * 64 + fr, fq * 8), boff = lds_byte(wc * 32 + fr, fq * 8);
#define PG8_SA(b, h) (((b) * 2 + (h)) * HTB)
#define PG8_SB(b, h) ((4 + (b) * 2 + (h)) * HTB)
#define PG8_STAGE(bufoff, gbase, voff) do { _Pragma("unroll") for (int _i = 0; _i < 2; ++_i) \
        __builtin_amdgcn_global_load_lds((const unsigned*)((const char*)(gbase) + (voff)[_i]), (LAS unsigned*)(lds + (bufoff) + ldsw + _i * 8192), 16, 0, 0); } while (0)
#define PG8_LDA(dst, b, h) do { _Pragma("unroll") for (int m = 0; m < 4; ++m) _Pragma("unroll") for (int k = 0; k < 2; ++k) dst[m].k[k] = *(const LAS bf16x8*)(lds + PG8_SA(b, h) + aoff + m * 2048 + k * 1024); } while (0)
#define PG8_LDB(dst, b, h) do { _Pragma("unroll") for (int n = 0; n < 2; ++n) _Pragma("unroll") for (int k = 0; k < 2; ++k) dst[n].k[k] = *(const LAS bf16x8*)(lds + PG8_SB(b, h) + boff + n * 2048 + k * 1024); } while (0)
#define PG8_MMA(ai, bj, At, Bt) do { if constexpr (FP8) __builtin_amdgcn_sched_barrier(0); __builtin_amdgcn_s_setprio(1); _Pragma("unroll") for (int m = 0; m < 4; ++m) _Pragma("unroll") for (int n = 0; n < 2; ++n) { \
        if constexpr (FP8) acc[ai][bj][m][n] = __builtin_amdgcn_mfma_scale_f32_16x16x128_f8f6f4(__builtin_bit_cast(v8i, Bt[n]), __builtin_bit_cast(v8i, At[m]), acc[ai][bj][m][n], 0, 0, 0, 127, 0, 127); \
        else { _Pragma("unroll") for (int k = 0; k < 2; ++k) acc[ai][bj][m][n] = __builtin_amdgcn_mfma_f32_16x16x32_bf16(Bt[n].k[k], At[m].k[k], acc[ai][bj][m][n], 0, 0, 0); } } \
        if constexpr (FP8) { _Pragma("unroll") for (int m = 0; m < 4; ++m) _Pragma("unroll") for (int n = 0; n < 2; ++n) asm volatile("" : "+v"(acc[ai][bj][m][n])); } \
        __builtin_amdgcn_s_setprio(0); if constexpr (FP8) __builtin_amdgcn_sched_barrier(0); } while (0)
#define PG8_WAIT_V(n) asm volatile("s_waitcnt vmcnt(" #n ")" ::: "memory")
#define PG8_WAIT_L(n) asm volatile("s_waitcnt lgkmcnt(" #n ")" ::: "memory")
#define PG8_BAR __builtin_amdgcn_s_barrier()
#define PG8_SCHED __builtin_amdgcn_sched_barrier(0)
    Unit cur, nxt; int ui = 0;
    if (!S.next(0, cur)) return;
    f32x4 acc[2][2][4][2];
#pragma unroll
    for (int a = 0; a < 2; ++a)
#pragma unroll
        for (int b = 0; b < 2; ++b)
#pragma unroll
            for (int m = 0; m < 4; ++m)
#pragma unroll
                for (int n = 0; n < 2; ++n) acc[a][b][m][n] = (f32x4){0.f, 0.f, 0.f, 0.f};
    struct Frag { bf16x8 k[2]; };
    Frag At[4], B0[2], B1[2];
    const char* cA = cur.a; const char* cB = cur.b;
    PG8_STAGE(PG8_SB(0, 0), cB, voffB); PG8_STAGE(PG8_SB(0, 1), cB + hstep, voffB); PG8_STAGE(PG8_SA(0, 0), cA, voffA); PG8_STAGE(PG8_SA(0, 1), cA + hstep, voffA);
    if (wr == 1) PG8_BAR;
    PG8_WAIT_V(2); PG8_BAR;
    PG8_STAGE(PG8_SB(1, 0), cB + kstep, voffB); PG8_STAGE(PG8_SA(1, 0), cA + kstep, voffA); PG8_STAGE(PG8_SB(1, 1), cB + hstep + kstep, voffB);
    PG8_WAIT_V(6); PG8_BAR;
    for (;;) {
        const bool has_next = S.next(ui + 1, nxt);
        const char* nA = has_next ? nxt.a : cA; const char* nB = has_next ? nxt.b : cB;
        for (int t = 0; t < nt; t += 2) {
            const bool last = (t == nt - 2);
            const char* a1 = cA + (size_t)(t + 1) * kstep;
            const char* a2 = last ? nA : cA + (size_t)(t + 2) * kstep; const char* b2 = last ? nB : cB + (size_t)(t + 2) * kstep;
            const char* a3 = a2 + kstep; const char* b3 = b2 + kstep;
            PG8_LDB(B0, 0, 0); PG8_LDB(B1, 0, 1); PG8_SCHED; PG8_LDA(At, 0, 0); PG8_STAGE(PG8_SA(1, 1), a1 + hstep, voffA);
            PG8_WAIT_V(8); PG8_WAIT_L(0); PG8_BAR; PG8_MMA(0, 0, At, B0); PG8_MMA(0, 1, At, B1); PG8_BAR; PG8_SCHED;
            PG8_LDA(At, 0, 1); PG8_STAGE(PG8_SB(0, 0), b2, voffB); PG8_STAGE(PG8_SB(0, 1), b2 + hstep, voffB); PG8_STAGE(PG8_SA(0, 0), a2, voffA);
            PG8_WAIT_V(8); PG8_WAIT_L(0); PG8_BAR; PG8_MMA(1, 0, At, B0); PG8_MMA(1, 1, At, B1); PG8_BAR; PG8_SCHED;
            PG8_LDB(B0, 1, 0); PG8_LDB(B1, 1, 1); PG8_SCHED; PG8_LDA(At, 1, 0); PG8_STAGE(PG8_SA(0, 1), a2 + hstep, voffA);
            PG8_WAIT_V(8); PG8_WAIT_L(0); PG8_BAR; PG8_MMA(0, 0, At, B0); PG8_MMA(0, 1, At, B1); PG8_BAR; PG8_SCHED;
            PG8_LDA(At, 1, 1); PG8_STAGE(PG8_SB(1, 0), b3, voffB); PG8_STAGE(PG8_SB(1, 1), b3 + hstep, voffB); PG8_STAGE(PG8_SA(1, 0), a3, voffA);
            PG8_WAIT_V(8); PG8_WAIT_L(0); PG8_BAR; PG8_MMA(1, 0, At, B0); PG8_MMA(1, 1, At, B1); PG8_BAR; PG8_SCHED;
        }
        if (wr == 0) PG8_BAR;
        E(acc, cur, wr, wc, fr, fq);
        if (!has_next) break;
#pragma unroll
        for (int a = 0; a < 2; ++a)
#pragma unroll
            for (int b = 0; b < 2; ++b)
#pragma unroll
                for (int m = 0; m < 4; ++m)
#pragma unroll
                    for (int n = 0; n < 2; ++n) acc[a][b][m][n] = (f32x4){0.f, 0.f, 0.f, 0.f};
        cur = nxt; cA = nA; cB = nB; ++ui;
        if (wr == 1) PG8_BAR;
    }
    PG8_WAIT_V(0);
    PG8_BAR;
#undef PG8_SA
#undef PG8_SB
#undef PG8_STAGE
#undef PG8_LDA
#undef PG8_LDB
#undef PG8_MMA
#undef PG8_WAIT_V
#undef PG8_WAIT_L
#undef PG8_BAR
#undef PG8_SCHED
}
}

constexpr size_t WS_GL = 7 * MiB;
__device__ __forceinline__ float ldbf(const bf16_t* p) { return bf2f(*p); }
__device__ __forceinline__ void unpk8(const u32x4 v, float (&f)[8]) {
    f[0] = bf2f(v.x & 0xffffu); f[1] = bf2f(v.x >> 16); f[2] = bf2f(v.y & 0xffffu); f[3] = bf2f(v.y >> 16);
    f[4] = bf2f(v.z & 0xffffu); f[5] = bf2f(v.z >> 16); f[6] = bf2f(v.w & 0xffffu); f[7] = bf2f(v.w >> 16);
}
__device__ __forceinline__ u32x4 pk8(const float (&f)[8]) { u32x4 o; o.x = pk2(f[0], f[1]); o.y = pk2(f[2], f[3]); o.z = pk2(f[4], f[5]); o.w = pk2(f[6], f[7]); return o; }
struct PrepRow { u32x4 cc, hh, bb, dq0, dq1, dq2, ro; float ab; };
__device__ __forceinline__ PrepRow prep_load(const bf16_t* PX, int m, int lane) {
    PrepRow R; const bf16_t* r0 = PX + (size_t)m * INP;
    const int c0 = 8 * (lane & 31);
    R.cc = *(const u32x4*)(r0 + C_CC + c0); R.hh = *(const u32x4*)(r0 + C_CH + c0); R.bb = *(const u32x4*)(r0 + C_CB + c0);
    R.dq0 = *(const u32x4*)(r0 + C_DQ + 8 * lane); R.dq1 = *(const u32x4*)(r0 + C_DQ + 8 * (64 + lane)); R.dq2 = *(const u32x4*)(r0 + C_DQ + 8 * (128 + (lane & 15)));
    const int head = lane >> 3, v8 = lane & 7;
    R.ro = *(const u32x4*)(r0 + (head < 6 ? C_AQ + head * 64 : C_AK + (head - 6) * 64) + 8 * v8);
    const int q = (lane - 32) & 31; R.ab = bf2f(r0[C_DA + (q < 24 ? q : 23)]);
    return R;
}
__device__ __forceinline__ void prep_phase(Frame& F, const Args& A, int layer) {
    bf16_t* PX = (bf16_t*)(F.ws + WS_PX);
    bf16_t* ACT = (bf16_t*)(F.ws + WS_ACT);
    bf16_t* QD = (bf16_t*)(F.ws + WS_QD); bf16_t* KD = (bf16_t*)(F.ws + WS_QD + QKV_STRIDE); bf16_t* VD = (bf16_t*)(F.ws + WS_QD + 2 * QKV_STRIDE);
    float* Gg = (float*)(F.ws + WS_G); float* Bt = (float*)(F.ws + WS_BETA);
    const float* rope = (const float*)(F.ws + WS_ROPE);
    LAS float* sdw = (LAS float*)F.lds;
    LAS float* scw = sdw + 3 * 1152;
    for (int i = F.tid; i < 3 * 1152; i += NTHREADS) sdw[i] = A.in[I_DNCONVW][layer * 3 * 1152 + i];
    for (int i = F.tid; i < 3 * 256; i += NTHREADS) scw[i] = A.in[I_CONVW][layer * 3 * 256 + i];
    __syncthreads();
    const int lane = F.lane;
    constexpr int RPW = (NT + 2047) / 2048;
    const int mlo = F.gw * RPW, mhi = (mlo + RPW) < NT ? (mlo + RPW) : NT;
    const int qgb = lane - 32;
    const float dtb = (qgb >= 0 && qgb < 12) ? A.in[I_DTB][layer * 12 + qgb] : 0.f;
    const float nalog = (qgb >= 0 && qgb < 12) ? -__expf(A.in[I_ALOG][layer * 12 + qgb]) : 0.f;
    if (mlo < mhi) {
        PrepRow prv = prep_load(PX, mlo > 0 ? mlo - 1 : 0, lane), cur = prep_load(PX, mlo, lane), nxt = prep_load(PX, (mlo + 1) < NT ? mlo + 1 : mlo, lane);
#pragma unroll 1
        for (int m = mlo; m < mhi; ++m) {
            const PrepRow nn = prep_load(PX, (m + 2) < NT ? m + 2 : m, lane);
            const bool hasp = (m != 0 && m != NL), hasn = (m != NL - 1 && m != NT - 1);
            const float fp = hasp ? 1.f : 0.f, fn = hasn ? 1.f : 0.f;
            if (lane < 32) {
                const int c0 = 8 * lane;
                float b[8], c1[8], h1[8], cp[8], hp[8], cn[8], hn[8], o[8];
                unpk8(cur.bb, b); unpk8(cur.cc, c1); unpk8(cur.hh, h1); unpk8(prv.cc, cp); unpk8(prv.hh, hp); unpk8(nxt.cc, cn); unpk8(nxt.hh, hn);
#pragma unroll
                for (int e = 0; e < 8; ++e) o[e] = b[e] * (scw[c0 + e] * (cp[e] * hp[e]) * fp + scw[256 + c0 + e] * (c1[e] * h1[e]) + scw[512 + c0 + e] * (cn[e] * hn[e]) * fn);
                *(u32x4*)(ACT + (size_t)m * D + c0) = pk8(o);
            } else if (lane < 56) {
                if (qgb < 12) { const float sp = cur.ab + dtb; const float softp = (sp > 20.f) ? sp : __logf(1.0f + __expf(sp)); Gg[(size_t)m * 12 + qgb] = nalog * softp; }
                else Bt[(size_t)m * 12 + (qgb - 12)] = __builtin_amdgcn_rcpf(1.0f + __expf(-cur.ab));
            }
            __builtin_amdgcn_sched_barrier(0);
#pragma unroll
            for (int ps = 0; ps < 3; ++ps) {
                __builtin_amdgcn_sched_barrier(0);
                const int v = ps < 2 ? 64 * ps + lane : 128 + (lane & 15);
                const int c0 = 8 * v, p = c0 / 384;
                float x0[8], x1[8], x2[8], o[8];
                unpk8(ps == 0 ? prv.dq0 : ps == 1 ? prv.dq1 : prv.dq2, x0); unpk8(ps == 0 ? cur.dq0 : ps == 1 ? cur.dq1 : cur.dq2, x1); unpk8(ps == 0 ? nxt.dq0 : ps == 1 ? nxt.dq1 : nxt.dq2, x2);
                float ss = 0.f;
#pragma unroll
                for (int e = 0; e < 8; ++e) { o[e] = silu_f(sdw[c0 + e] * x0[e] * fp + sdw[1152 + c0 + e] * x1[e] + sdw[2304 + c0 + e] * x2[e] * fn); ss += o[e] * o[e]; }
                ss = sum8(ss);
                const float sc = p == 2 ? 1.0f : __builtin_amdgcn_rsqf(ss + 1e-6f) * (p == 0 ? 0.125f : 1.0f);
#pragma unroll
                for (int e = 0; e < 8; ++e) o[e] *= sc;
                if (ps < 2 || lane < 16) { bf16_t* dst = (p == 0 ? QD : (p == 1 ? KD : VD)) + (size_t)m * 384 + (c0 - p * 384); *(u32x4*)dst = pk8(o); }
            }
            __builtin_amdgcn_sched_barrier(0);
            if (m < NL) {
                const int head = lane >> 3, v8 = lane & 7, axis = v8 >> 2, vv = v8 & 3;
                bf16_t* px = PX + (size_t)m * INP + (head < 6 ? C_AQ + head * 64 : C_AK + (head - 6) * 64) + 8 * v8;
                const u32x4 own = cur.ro;
                u32x4 oth;
                oth.x = (unsigned)__builtin_amdgcn_update_dpp(0, (int)own.x, 0x4E, 0xF, 0xF, true); oth.y = (unsigned)__builtin_amdgcn_update_dpp(0, (int)own.y, 0x4E, 0xF, 0xF, true);
                oth.z = (unsigned)__builtin_amdgcn_update_dpp(0, (int)own.z, 0x4E, 0xF, 0xF, true); oth.w = (unsigned)__builtin_amdgcn_update_dpp(0, (int)own.w, 0x4E, 0xF, 0xF, true);
                float a[8], b[8], o[8]; unpk8(own, a); unpk8(oth, b);
                const int pos = axis == 0 ? (m >> 6) : (m & 63);
                const float* rt = rope + (pos * 16 + 8 * (vv & 1)) * 2;
                const float sgn = (vv < 2) ? -1.0f : 1.0f;
#pragma unroll
                for (int e = 0; e < 8; ++e) o[e] = a[e] * rt[2 * e] + sgn * b[e] * rt[2 * e + 1];
                *(u32x4*)px = pk8(o);
            }
            prv = cur; cur = nxt; nxt = nn;
        }
    }
    __syncthreads();
}

constexpr int DN_NS = 260, DN_NU = 12 * DN_NS;
__device__ __forceinline__ int dn_row0(int d, int s) {
    if (s < 4) return NL + 64 * (d == 0 ? s : 3 - s);
    return 64 * (d == 0 ? (s - 4) : 255 - (s - 4));
}
__device__ __forceinline__ void pair_bar(volatile LAS unsigned* cnt, unsigned& epoch, int lane) {
    epoch += 2u;
    asm volatile("s_waitcnt vmcnt(0) lgkmcnt(0)" ::: "memory");
    if (lane == 0) __hip_atomic_fetch_add((LAS unsigned*)cnt, 1u, __ATOMIC_RELAXED, __HIP_MEMORY_SCOPE_WORKGROUP);
    while (*cnt < epoch) __builtin_amdgcn_s_sleep(1);
    asm volatile("" ::: "memory");
}
__device__ __forceinline__ void dn_chunk_phase(Frame& F) {
    const bf16_t* KD = (const bf16_t*)(F.ws + WS_QD + QKV_STRIDE); const bf16_t* VD = (const bf16_t*)(F.ws + WS_QD + 2 * QKV_STRIDE);
    const float* Gg = (const float*)(F.ws + WS_G); const float* Bt = (const float*)(F.ws + WS_BETA);
    bf16_t* Wm = (bf16_t*)(F.ws + WS_DN); bf16_t* KDt = (bf16_t*)(F.ws + WS_DN + DN_STRIDE); bf16_t* Ut = (bf16_t*)(F.ws + WS_DN + 2 * DN_STRIDE);
    float* GL = (float*)(F.ws + WS_GL);
    const int gi = F.wave >> 1, wl = F.wave & 1;
    LAS unsigned char* R = F.lds + gi * 18432;
    LAS float* Am = (LAS float*)R;
    LAS float* gcs = Am + 64 * 68; LAS float* bts = gcs + 64;
    volatile LAS unsigned* pcnt = (volatile LAS unsigned*)(R + 17920);
    if (F.tid < 4) *(volatile LAS unsigned*)(F.lds + F.tid * 18432 + 17920) = 0u;
    __syncthreads();
    unsigned epoch = 0u;
#pragma unroll 1
    for (int base = blockIdx.x * 4; base + gi < DN_NU; base += F.G * 4) {
        const int lane = opq(F.lane), r = lane & 15, g = lane >> 4;
        const int U = base + gi; const bool act = U < DN_NU;
        const int dh = act ? U / DN_NS : 0, s = act ? U % DN_NS : 0, d = dh / 6, h = dh % 6;
        const int row0 = dn_row0(d, s);
        const size_t ub = (size_t)U * 4096;
        if (act) {
            if (wl == 0) {
                const int io = d ? 63 - lane : lane;
                float gv = Gg[(size_t)(row0 + io) * 12 + d * 6 + h];
#pragma unroll
                for (int o = 1; o < 64; o <<= 1) { const float t = __shfl_up(gv, o); if (lane >= o) gv += t; }
                gcs[lane] = gv; bts[lane] = Bt[(size_t)(row0 + io) * 12 + d * 6 + h];
                if (lane == 63) GL[U] = expf(gv);
            }
            const bf16_t* tsrc = (wl == 0 ? VD : KD) + (size_t)row0 * 384 + h * 64;
            u32x4 tv[8];
#pragma unroll
            for (int j = 0; j < 8; ++j) tv[j] = *(const u32x4*)(tsrc + (size_t)(8 * j + (lane >> 3)) * 384 + (lane & 7) * 8);
#pragma unroll
            for (int j = 0; j < 8; ++j) *(LAS u32x4*)(R + (1 - wl) * 8192 + (8 * j + (lane >> 3)) * 128 + (lane & 7) * 16) = tv[j];
        }
        pair_bar(pcnt, epoch, lane);
        float x[64];
        if (act) {
            const LAS unsigned char* tb = R + (1 - wl) * 8192 + lane * 2;
            const int rb = d ? 63 * 128 : 0, rs = d ? -128 : 128;
#pragma unroll
            for (int i = 0; i < 64; ++i) x[i] = bf2f(*(const LAS bf16_t*)(tb + rb + i * rs));
            if (wl == 1) {
                const float gcl = gcs[63];
#pragma unroll
                for (int q = 0; q < 8; ++q) { u32x4 o;
                    const int ia = 32 * (q >> 2) + 4 * (q & 3), ib = ia + 16;
                    o.x = pk2(x[ia + 0] * __expf(gcl - gcs[ia + 0]), x[ia + 1] * __expf(gcl - gcs[ia + 1]));
                    o.y = pk2(x[ia + 2] * __expf(gcl - gcs[ia + 2]), x[ia + 3] * __expf(gcl - gcs[ia + 3]));
                    o.z = pk2(x[ib + 0] * __expf(gcl - gcs[ib + 0]), x[ib + 1] * __expf(gcl - gcs[ib + 1]));
                    o.w = pk2(x[ib + 2] * __expf(gcl - gcs[ib + 2]), x[ib + 3] * __expf(gcl - gcs[ib + 3]));
                    *(LAS u32x4*)(R + lane * 128 + ((q ^ (lane & 7)) << 4)) = o; }
#pragma unroll
                for (int j = 0; j < 8; ++j) { const int row = 8 * j + (lane >> 3), c = lane & 7;
                    ((GAS u32x4*)(KDt + ub))[64 * j + lane] = *(const LAS u32x4*)(R + row * 128 + ((c ^ (row & 7)) << 4)); }
#pragma unroll
                for (int i = 0; i < 64; ++i) x[i] *= bts[i] * __expf(gcs[i]);
            } else {
#pragma unroll
                for (int i = 0; i < 64; ++i) x[i] *= bts[i];
            }
        }
        pair_bar(pcnt, epoch, lane);
        if (act) {
            bf16x8 kf[4][2];
#pragma unroll
            for (int jt = 0; jt < 4; ++jt)
#pragma unroll
                for (int ks = 0; ks < 2; ++ks) kf[jt][ks] = *(const bf16x8*)(KD + (size_t)(row0 + 16 * jt + r) * 384 + h * 64 + 32 * ks + 8 * g);
#pragma unroll
            for (int itl = 0; itl < 2; ++itl) {
                const int it = 2 * wl + itl;
#pragma unroll
                for (int jt = 0; jt < 4; ++jt) {
                    f32x4 c = (f32x4){0.f, 0.f, 0.f, 0.f};
                    const bf16x8 a0 = (it == 0 ? kf[0][0] : it == 1 ? kf[1][0] : it == 2 ? kf[2][0] : kf[3][0]);
                    const bf16x8 a1 = (it == 0 ? kf[0][1] : it == 1 ? kf[1][1] : it == 2 ? kf[2][1] : kf[3][1]);
                    c = __builtin_amdgcn_mfma_f32_16x16x32_bf16(a0, kf[jt][0], c, 0, 0, 0);
                    c = __builtin_amdgcn_mfma_f32_16x16x32_bf16(a1, kf[jt][1], c, 0, 0, 0);
                    const int jo = 16 * jt + r, jp = d ? 63 - jo : jo;
#pragma unroll
                    for (int e = 0; e < 4; ++e) {
                        const int io = 16 * it + 4 * g + e, ip = d ? 63 - io : io;
                        Am[ip * 68 + jp] = (jp < ip) ? bts[ip] * c[e] * __expf(gcs[ip] - gcs[jp]) : 0.f;
                    }
                }
            }
        }
        pair_bar(pcnt, epoch, lane);
        if (act) {
#pragma unroll
            for (int b = 0; b < 4; ++b) {
                float acc[16];
#pragma unroll
                for (int ii = 0; ii < 16; ++ii) acc[ii] = 0.f;
#pragma unroll
                for (int j4 = 0; j4 < 4 * b; ++j4) {
#pragma unroll
                    for (int ii = 0; ii < 16; ++ii) {
                        const f32x4 a = *(const LAS f32x4*)(Am + (16 * b + ii) * 68 + 4 * j4);
                        acc[ii] += a.x * x[4 * j4]; acc[ii] += a.y * x[4 * j4 + 1]; acc[ii] += a.z * x[4 * j4 + 2]; acc[ii] += a.w * x[4 * j4 + 3];
                    }
                    if ((j4 & 1) == 1) asm volatile("" ::: "memory");
                }
#pragma unroll
                for (int ii = 0; ii < 16; ++ii) {
                    const int i = 16 * b + ii;
                    float s0 = acc[ii], s1 = 0.f;
#pragma unroll
                    for (int j4 = 0; j4 < (ii + 3) / 4; ++j4) {
                        const f32x4 a = *(const LAS f32x4*)(Am + i * 68 + 16 * b + 4 * j4);
                        s0 += a.x * x[16 * b + 4 * j4]; s1 += a.y * x[16 * b + 4 * j4 + 1]; s0 += a.z * x[16 * b + 4 * j4 + 2]; s1 += a.w * x[16 * b + 4 * j4 + 3];
                    }
                    x[i] -= s0 + s1;
                    if ((ii & 3) == 3) asm volatile("" : "+v"(x[i]) :: "memory");
                }
            }
        }
        pair_bar(pcnt, epoch, lane);
        if (act) {
            if (wl == 0) {
#pragma unroll
                for (int q = 0; q < 8; ++q) { u32x4 o; o.x = pk2(x[8 * q], x[8 * q + 1]); o.y = pk2(x[8 * q + 2], x[8 * q + 3]); o.z = pk2(x[8 * q + 4], x[8 * q + 5]); o.w = pk2(x[8 * q + 6], x[8 * q + 7]);
                    *(LAS u32x4*)(R + lane * 128 + ((q ^ (lane & 7)) << 4)) = o; }
#pragma unroll
                for (int j = 0; j < 8; ++j) { const int row = 8 * j + (lane >> 3), c = lane & 7;
                    ((GAS u32x4*)(Ut + ub))[64 * j + lane] = *(const LAS u32x4*)(R + row * 128 + ((c ^ (row & 7)) << 4)); }
            } else {
                const int kk2 = lane & 31, pc = (lane & 32) + 8 * ((kk2 & 15) >> 2) + 4 * (kk2 >> 4) + (kk2 & 3);
#pragma unroll
                for (int i = 0; i < 64; ++i) *(LAS bf16_t*)(R + 8192 + i * 128 + ((((pc >> 3) ^ (i & 7)) << 4) | ((pc & 7) << 1))) = (bf16_t)f2bf(-x[i]);
#pragma unroll
                for (int j = 0; j < 8; ++j) { const int row = 8 * j + (lane >> 3), c = lane & 7;
                    ((GAS u32x4*)(Wm + ub))[64 * j + lane] = *(const LAS u32x4*)(R + 8192 + row * 128 + ((c ^ (row & 7)) << 4)); }
            }
        }
        pair_bar(pcnt, epoch, lane);
    }
}

constexpr int SC_D = 7, SC_STAGE = 16384, SC_P = 4;
__device__ __forceinline__ unsigned pkbf(float lo, float hi) { return pg8::cvt_pk_bf16(lo, hi); }
__device__ __forceinline__ int sc_off(int row, int col) {
    const int c = col >> 3; return row * 128 + ((c ^ ((row >> 1) & 7)) << 4) + ((col & 4) << 1);
}
constexpr int NSEG = 8;
constexpr size_t WS_SEG = 503 * MiB;
constexpr size_t WS_SST = 507 * MiB;
static_assert(WS_DN + 5 * DN_STRIDE <= WS_SEG && WS_SEG + (size_t)12 * NSEG * 2 * 16384 <= WS_SST && WS_SST + (size_t)12 * NSEG * 16384 <= WS_END, "seg map");
__host__ __device__ constexpr int seg_begin(int s) { return s == 0 ? 0 : 36 + 32 * (s - 1); }
__host__ __device__ constexpr int seg_len(int s) { return s == 0 ? 36 : 32; }
static_assert(seg_begin(NSEG - 1) + seg_len(NSEG - 1) == DN_NS, "segments cover the chain");
template <int MODE>
__device__ __forceinline__ void dn_scan_job(Frame& F, const int dh, const int sg) {
    const int d = dh / 6, lane = F.lane, wave = F.wave, r = lane & 15, g = lane >> 4;
    const int tb = seg_begin(sg), ns = seg_len(sg);
    const unsigned char* srcW = F.ws + WS_DN + ((size_t)dh * DN_NS + tb) * 8192;
    const unsigned char* srcK = srcW + DN_STRIDE; const unsigned char* srcU = srcW + 2 * DN_STRIDE;
    bf16_t* VT = (bf16_t*)(F.ws + WS_DN + 3 * DN_STRIDE) + ((size_t)dh * DN_NS + tb) * 4096;
    bf16_t* ST = (bf16_t*)(F.ws + WS_DN + 4 * DN_STRIDE) + ((size_t)dh * DN_NS + tb) * 4096;
    LAS float* gls = (LAS float*)(F.lds + MISC_OFF + 1024);
    LAS unsigned char* ost = F.lds + SC_D * SC_STAGE + (wave & 3) * 6144;
    { const float* GL = (const float*)(F.ws + WS_GL) + dh * DN_NS + tb; for (int i = F.tid; i < ns; i += NTHREADS) gls[i] = GL[i]; }
    __syncthreads();
#define SC_WAITV(n) asm volatile("s_waitcnt vmcnt(" #n ")" ::: "memory")
#define SC_BAR() do { asm volatile("" ::: "memory"); __builtin_amdgcn_s_barrier(); asm volatile("" ::: "memory"); } while (0)
    if (wave >= 4) {
        const int lw = wave - 4;
        const int lrow = lane >> 3, lc = lane & 7;
#define SC_ISSUE(st) do { const int slot_ = ((st) % SC_D) * SC_STAGE; \
            _Pragma("unroll") for (int e = 0; e < 4; ++e) { \
                const int q = lw * 4 + e, mi = q >> 3, n = q & 7, row = 8 * n + lrow; \
                const unsigned char* mb = (mi == 0 ? srcW : srcK) + (size_t)(st) * 8192; \
                const unsigned char* gp = mb + row * 128 + ((lc ^ ((row >> 1) & 7)) << 4); \
                __builtin_amdgcn_global_load_lds((const unsigned*)gp, (LAS unsigned*)(F.lds + slot_ + mi * 8192 + n * 1024), 16, 0, 0); } } while (0)
        SC_ISSUE(0); SC_ISSUE(1); SC_ISSUE(2); SC_ISSUE(3); SC_ISSUE(4); SC_ISSUE(5);
        SC_WAITV(20); SC_BAR();
        for (int t = 0; t < ns; ++t) {
            if (t + SC_D - 1 < ns) { SC_ISSUE(t + SC_D - 1); SC_WAITV(20); }
            else { SC_WAITV(0); }
            SC_BAR();
        }
    } else {
        f32x4 S[4];
        if (MODE == 0) {
            if (sg == 0) {
#pragma unroll
                for (int t = 0; t < 4; ++t) S[t] = (f32x4){0.f, 0.f, 0.f, 0.f};
            } else {
                const float* seg0 = (const float*)(F.ws + WS_SEG) + (size_t)dh * NSEG * 2 * 4096;
                { const float* q0 = seg0 + 4096 + 16 * wave + r;
#pragma unroll
                  for (int t = 0; t < 4; ++t)
#pragma unroll
                      for (int e2 = 0; e2 < 4; ++e2) S[t][e2] = q0[(16 * t + 4 * g + e2) * 64]; }
#pragma unroll 1
                for (int s = 1; s < sg; ++s) {
                    const float* Pm = seg0 + (size_t)s * 2 * 4096; const float* Qm = Pm + 4096 + 16 * wave + r;
                    u32x4 bsf[2];
#pragma unroll
                    for (int ks = 0; ks < 2; ++ks) { bsf[ks].x = pkbf(S[2 * ks][0], S[2 * ks][1]); bsf[ks].y = pkbf(S[2 * ks][2], S[2 * ks][3]); bsf[ks].z = pkbf(S[2 * ks + 1][0], S[2 * ks + 1][1]); bsf[ks].w = pkbf(S[2 * ks + 1][2], S[2 * ks + 1][3]); }
                    f32x4 Sn[4];
#pragma unroll
                    for (int t = 0; t < 4; ++t) {
                        f32x4 c;
#pragma unroll
                        for (int e2 = 0; e2 < 4; ++e2) c[e2] = Qm[(16 * t + 4 * g + e2) * 64];
#pragma unroll
                        for (int ks = 0; ks < 2; ++ks) {
                            const f32x4 lo = *(const f32x4*)(Pm + (16 * t + r) * 64 + 32 * ks + 4 * g), hi = *(const f32x4*)(Pm + (16 * t + r) * 64 + 32 * ks + 16 + 4 * g);
                            u32x4 a; a.x = pkbf(lo[0], lo[1]); a.y = pkbf(lo[2], lo[3]); a.z = pkbf(hi[0], hi[1]); a.w = pkbf(hi[2], hi[3]);
                            c = __builtin_amdgcn_mfma_f32_16x16x32_bf16(__builtin_bit_cast(bf16x8, a), __builtin_bit_cast(bf16x8, bsf[ks]), c, 0, 0, 0);
                        }
                        Sn[t] = c;
                    }
#pragma unroll
                    for (int t = 0; t < 4; ++t) S[t] = Sn[t];
                }
            }
        } else {
#pragma unroll
            for (int t = 0; t < 4; ++t)
#pragma unroll
                for (int e2 = 0; e2 < 4; ++e2) S[t][e2] = (MODE == 2 && (16 * t + 4 * g + e2) == 16 * wave + r) ? 1.f : 0.f;
        }
        const int dvrow = 16 * wave + r;
        const GAS u32x4* usrc = (const GAS u32x4*)(srcU + wave * 2048) + lane;
        u32x4 uq[SC_P][2];
        if (MODE != 2) {
#pragma unroll
            for (int p = 0; p < SC_P; ++p) { uq[p][0] = usrc[(size_t)p * 512]; uq[p][1] = usrc[(size_t)p * 512 + 64]; }
        }
        SC_BAR();
#define OST_W(base, t_, lo_, hi_) *(LAS u32x2*)(ost + (base) + r * 128 + (((2 * (t_) + (g >> 1)) ^ (r & 7)) << 4) + ((g & 1) << 3)) = (u32x2){lo_, hi_}
        for (int t4 = 0; t4 < ns; t4 += SC_P) {
#pragma unroll
          for (int tp = 0; tp < SC_P; ++tp) {
            const int t = t4 + tp;
            const LAS unsigned char* sb = F.lds + (t % SC_D) * SC_STAGE;
            const float gl = gls[t];
            if (MODE != 2) {
#pragma unroll
                for (int j = 0; j < 2; ++j) { const int row = 8 * j + (lane >> 3), c = lane & 7; *(LAS u32x4*)(ost + 4096 + row * 128 + ((c ^ (row & 7)) << 4)) = uq[tp][j]; }
                if (t + SC_P < ns) { uq[tp][0] = usrc[(size_t)(t + SC_P) * 512]; uq[tp][1] = usrc[(size_t)(t + SC_P) * 512 + 64]; }
            }
            u32x4 bs[2];
#pragma unroll
            for (int ks = 0; ks < 2; ++ks) { bs[ks].x = pkbf(S[2 * ks][0], S[2 * ks][1]); bs[ks].y = pkbf(S[2 * ks][2], S[2 * ks][3]); bs[ks].z = pkbf(S[2 * ks + 1][0], S[2 * ks + 1][1]); bs[ks].w = pkbf(S[2 * ks + 1][2], S[2 * ks + 1][3]); }
            if (MODE == 0) { OST_W(0, 0, bs[0].x, bs[0].y); OST_W(0, 1, bs[0].z, bs[0].w); OST_W(0, 2, bs[1].x, bs[1].y); OST_W(0, 3, bs[1].z, bs[1].w); }
            f32x4 vn[4];
#pragma unroll
            for (int it = 0; it < 4; ++it) {
                f32x4 c = (f32x4){0.f, 0.f, 0.f, 0.f};
                if (MODE != 2) { const u32x2 uu = *(const LAS u32x2*)(ost + 4096 + r * 128 + (((2 * it + (g >> 1)) ^ (r & 7)) << 4) + ((g & 1) << 3));
                    c = (f32x4){bf2f(uu.x & 0xffffu), bf2f(uu.x >> 16), bf2f(uu.y & 0xffffu), bf2f(uu.y >> 16)}; }
#pragma unroll
                for (int ks = 0; ks < 2; ++ks) {
                    const u32x4 a = *(const LAS u32x4*)(sb + sc_off(16 * it + r, 32 * ks + 8 * g));
                    c = __builtin_amdgcn_mfma_f32_16x16x32_bf16(__builtin_bit_cast(bf16x8, a), __builtin_bit_cast(bf16x8, bs[ks]), c, 0, 0, 0);
                }
                vn[it] = c;
            }
            u32x4 bv[2];
#pragma unroll
            for (int ks = 0; ks < 2; ++ks) { bv[ks].x = pkbf(vn[2 * ks][0], vn[2 * ks][1]); bv[ks].y = pkbf(vn[2 * ks][2], vn[2 * ks][3]); bv[ks].z = pkbf(vn[2 * ks + 1][0], vn[2 * ks + 1][1]); bv[ks].w = pkbf(vn[2 * ks + 1][2], vn[2 * ks + 1][3]); }
            if (MODE == 0) {
                if (d == 0) {
                    OST_W(2048, 0, bv[0].x, bv[0].y); OST_W(2048, 1, bv[0].z, bv[0].w); OST_W(2048, 2, bv[1].x, bv[1].y); OST_W(2048, 3, bv[1].z, bv[1].w);
                } else {
#define SC_ROT(a) (((a) >> 16) | ((a) << 16))
#define OST_WR(t_, lo_, hi_) *(LAS u32x2*)(ost + 2048 + r * 128 + (((2 * (3 - (t_)) + ((3 - g) >> 1)) ^ (r & 7)) << 4) + (((3 - g) & 1) << 3)) = (u32x2){SC_ROT(hi_), SC_ROT(lo_)}
                    OST_WR(0, bv[0].x, bv[0].y); OST_WR(1, bv[0].z, bv[0].w); OST_WR(2, bv[1].x, bv[1].y); OST_WR(3, bv[1].z, bv[1].w);
#undef OST_WR
#undef SC_ROT
                }
                GAS u32x4* gst = (GAS u32x4*)(ST + (size_t)t * 4096 + wave * 1024); GAS u32x4* gvt = (GAS u32x4*)(VT + (size_t)t * 4096 + wave * 1024);
#pragma unroll
                for (int j = 0; j < 2; ++j) {
                    const int row = 8 * j + (lane >> 3), c = lane & 7; const int off = row * 128 + ((c ^ (row & 7)) << 4);
                    gst[64 * j + lane] = *(const LAS u32x4*)(ost + off); gvt[64 * j + lane] = *(const LAS u32x4*)(ost + 2048 + off);
                }
            }
#pragma unroll
            for (int tt = 0; tt < 4; ++tt) {
                f32x4 c = S[tt] * gl;
#pragma unroll
                for (int ks = 0; ks < 2; ++ks) {
                    const u32x4 a = *(const LAS u32x4*)(sb + 8192 + sc_off(16 * tt + r, 32 * ks + 8 * g));
                    c = __builtin_amdgcn_mfma_f32_16x16x32_bf16(__builtin_bit_cast(bf16x8, a), __builtin_bit_cast(bf16x8, bv[ks]), c, 0, 0, 0);
                }
                S[tt] = c;
            }
            asm volatile("s_waitcnt lgkmcnt(0)" ::: "memory");
            SC_BAR();
          }
        }
        if (MODE != 0) {
            float* o = (float*)(F.ws + WS_SEG) + ((size_t)(dh * NSEG + sg) * 2 + (MODE == 2 ? 0 : 1)) * 4096 + 16 * wave + r;
#pragma unroll
            for (int t = 0; t < 4; ++t)
#pragma unroll
                for (int e2 = 0; e2 < 4; ++e2) o[(16 * t + 4 * g + e2) * 64] = S[t][e2];
        }
    }
#undef SC_WAITV
#undef OST_W
#undef SC_BAR
#undef SC_ISSUE
    asm volatile("s_waitcnt vmcnt(0) lgkmcnt(0)" ::: "memory");
    __syncthreads();
}
__device__ __forceinline__ void dn_combine(Frame& F, const int dh) {
    const float* SEG = (const float*)(F.ws + WS_SEG) + (size_t)dh * NSEG * 2 * 4096;
    float* SST = (float*)(F.ws + WS_SST) + (size_t)dh * NSEG * 4096;
    LAS float* Sl = (LAS float*)F.lds; LAS float* Pl = Sl + 4096;
    for (int i = F.tid; i < 4096; i += NTHREADS) { const float v = SEG[4096 + i]; Sl[i] = v; SST[4096 + i] = v; }
    __syncthreads();
    const int col = F.tid & 63, dk0 = F.tid >> 6;
    float pre[8], qre[8];
#pragma unroll
    for (int k = 0; k < 8; ++k) { pre[k] = SEG[(size_t)1 * 2 * 4096 + F.tid + NTHREADS * k]; qre[k] = SEG[(size_t)1 * 2 * 4096 + 4096 + (dk0 + 8 * k) * 64 + col]; }
#pragma unroll 1
    for (int sg = 1; sg <= NSEG - 2; ++sg) {
        float out[8];
#pragma unroll
        for (int k = 0; k < 8; ++k) { Pl[F.tid + NTHREADS * k] = pre[k]; out[k] = qre[k]; }
        if (sg + 1 <= NSEG - 2) {
#pragma unroll
            for (int k = 0; k < 8; ++k) { pre[k] = SEG[(size_t)(sg + 1) * 2 * 4096 + F.tid + NTHREADS * k]; qre[k] = SEG[(size_t)(sg + 1) * 2 * 4096 + 4096 + (dk0 + 8 * k) * 64 + col]; }
        }
        __syncthreads();
#pragma unroll 2
        for (int k4 = 0; k4 < 16; ++k4) {
            const float s0 = Sl[(4 * k4 + 0) * 64 + col], s1 = Sl[(4 * k4 + 1) * 64 + col], s2 = Sl[(4 * k4 + 2) * 64 + col], s3 = Sl[(4 * k4 + 3) * 64 + col];
#pragma unroll
            for (int k = 0; k < 8; ++k) { const f32x4 pv = *(const LAS f32x4*)(Pl + (dk0 + 8 * k) * 64 + 4 * k4); out[k] += (pv.x * s0 + pv.y * s1) + (pv.z * s2 + pv.w * s3); }
        }
        __syncthreads();
#pragma unroll
        for (int k = 0; k < 8; ++k) { Sl[(dk0 + 8 * k) * 64 + col] = out[k]; SST[(size_t)(sg + 1) * 4096 + (dk0 + 8 * k) * 64 + col] = out[k]; }
        __syncthreads();
    }
}

__device__ __forceinline__ void attn_unit(Frame& F, const Args& A, int layer, int unit) {
    const bf16_t* PX = (const bf16_t*)(F.ws + WS_PX);
    bf16_t* ACT = (bf16_t*)(F.ws + WS_ACT);
    const int lane = F.lane, wave = F.wave, r = lane & 15, g = lane >> 4, tid = F.tid;
    const bool isctx = unit >= 256;
    const int qb = isctx ? (unit - 256) >> 1 : unit >> 1, hk = unit & 1;
    const int qrow0 = (isctx ? NL : 0) + 128 * qb + 16 * wave;
    const int qpos = 128 * qb + 16 * wave + r;
    const float SCL = 0.125f * 1.4426950408889634f;
    bf16x8 qf[3][2];
#pragma unroll
    for (int a = 0; a < 3; ++a)
#pragma unroll
        for (int ks = 0; ks < 2; ++ks) qf[a][ks] = *(const bf16x8*)(PX + (size_t)(qrow0 + r) * INP + C_AQ + (3 * hk + a) * 64 + 32 * ks + 8 * g);
    float mrun[3], lrun[3]; f32x4 o[3][4];
#pragma unroll
    for (int a = 0; a < 3; ++a) { mrun[a] = A.in[I_SINK][layer * 6 + 3 * hk + a] * 1.4426950408889634f; lrun[a] = 1.f;
#pragma unroll
        for (int dt = 0; dt < 4; ++dt) o[a][dt] = (f32x4){0.f, 0.f, 0.f, 0.f}; }
    const int jlo = (!isctx && qb == 0) ? 2 : 0, jhi = isctx ? 0 : ((qb == 127) ? 4 : 6);
    const int ntile = 4 + (jhi - jlo);
    const int skey = tid >> 3, sch = tid & 7;
    const int spk = (skey & 32) + 8 * (((skey & 31) & 15) >> 2) + 4 * ((skey & 31) >> 4) + (skey & 3);
#define ATT_KROW(s_) ((s_) < 4 ? NL + 64 * (s_) : 128 * (qb - 1) + 64 * (jlo + (s_) - 4))
#define ATT_LOAD(s_) do { const size_t ro_ = (size_t)(ATT_KROW(s_) + skey) * INP; pkv = *(const u32x4*)(PX + ro_ + C_AK + hk * 64 + sch * 8); pvv = *(const u32x4*)(PX + ro_ + C_AV + hk * 64 + sch * 8); } while (0)
#define ATT_STAGE(buf_) do { LAS unsigned char* kb_ = F.lds + (buf_) * 18432; *(LAS u32x4*)(kb_ + skey * 144 + sch * 16) = pkv; LAS bf16_t* vt = (LAS bf16_t*)(kb_ + 9216); \
        vt[(sch * 8 + 0) * 72 + spk] = (bf16_t)(pvv.x & 0xffffu); vt[(sch * 8 + 1) * 72 + spk] = (bf16_t)(pvv.x >> 16); vt[(sch * 8 + 2) * 72 + spk] = (bf16_t)(pvv.y & 0xffffu); vt[(sch * 8 + 3) * 72 + spk] = (bf16_t)(pvv.y >> 16); \
        vt[(sch * 8 + 4) * 72 + spk] = (bf16_t)(pvv.z & 0xffffu); vt[(sch * 8 + 5) * 72 + spk] = (bf16_t)(pvv.z >> 16); vt[(sch * 8 + 6) * 72 + spk] = (bf16_t)(pvv.w & 0xffffu); vt[(sch * 8 + 7) * 72 + spk] = (bf16_t)(pvv.w >> 16); } while (0)
    u32x4 pkv, pvv;
    ATT_LOAD(0); ATT_STAGE(0);
    __syncthreads();
    for (int ti = 0; ti < ntile; ++ti) {
        const int krow0 = ATT_KROW(ti);
        const int q0w = 128 * qb + 16 * wave;
        const bool local = ti >= 4 && ((krow0 + 63 - q0w > 128) || (q0w + 15 - krow0 > 128));
        if (ti + 1 < ntile) ATT_LOAD(ti + 1);
        LAS unsigned char* Kl = F.lds + (ti & 1) * 18432;
        LAS unsigned char* Vl = Kl + 9216;
        f32x4 st[3][4];
#pragma unroll
        for (int kt = 0; kt < 4; ++kt) {
            const bf16x8 k0 = *(const LAS bf16x8*)(Kl + (16 * kt + r) * 144 + (8 * g) * 2);
            const bf16x8 k1 = *(const LAS bf16x8*)(Kl + (16 * kt + r) * 144 + (32 + 8 * g) * 2);
#pragma unroll
            for (int a = 0; a < 3; ++a) {
                f32x4 c = (f32x4){0.f, 0.f, 0.f, 0.f};
                c = __builtin_amdgcn_mfma_f32_16x16x32_bf16(k0, qf[a][0], c, 0, 0, 0);
                c = __builtin_amdgcn_mfma_f32_16x16x32_bf16(k1, qf[a][1], c, 0, 0, 0);
                st[a][kt] = c;
            }
        }
        u32x4 bp[3][2];
#pragma unroll
        for (int a = 0; a < 3; ++a) {
            float tmax = -INFINITY;
#pragma unroll
            for (int kt = 0; kt < 4; ++kt)
#pragma unroll
                for (int e = 0; e < 4; ++e) {
                    float sv = st[a][kt][e] * SCL;
                    if (local) { const int kp = krow0 + 16 * kt + 4 * g + e; const int df = qpos - kp; if (df > 128 || df < -128) sv = -INFINITY; }
                    st[a][kt][e] = sv; tmax = fmaxf(tmax, sv);
                }
            tmax = fmaxf(tmax, __shfl_xor(tmax, 16)); tmax = fmaxf(tmax, __shfl_xor(tmax, 32));
            const float mnew = fmaxf(mrun[a], tmax);
            const float alpha = __builtin_amdgcn_exp2f(mrun[a] - mnew);
            float ls = 0.f;
#pragma unroll
            for (int kt = 0; kt < 4; ++kt)
#pragma unroll
                for (int e = 0; e < 4; ++e) { const float p = __builtin_amdgcn_exp2f(st[a][kt][e] - mnew); st[a][kt][e] = p; ls += p; }
            ls += __shfl_xor(ls, 16); ls += __shfl_xor(ls, 32);
            lrun[a] = lrun[a] * alpha + ls; mrun[a] = mnew;
#pragma unroll
            for (int dt = 0; dt < 4; ++dt) o[a][dt] = o[a][dt] * alpha;
#pragma unroll
            for (int k2 = 0; k2 < 2; ++k2) { bp[a][k2].x = pkbf(st[a][2 * k2][0], st[a][2 * k2][1]); bp[a][k2].y = pkbf(st[a][2 * k2][2], st[a][2 * k2][3]);
                bp[a][k2].z = pkbf(st[a][2 * k2 + 1][0], st[a][2 * k2 + 1][1]); bp[a][k2].w = pkbf(st[a][2 * k2 + 1][2], st[a][2 * k2 + 1][3]); }
        }
#pragma unroll
        for (int dt = 0; dt < 4; ++dt)
#pragma unroll
            for (int k2 = 0; k2 < 2; ++k2) {
                const u32x4 av = *(const LAS u32x4*)(Vl + (16 * dt + r) * 144 + (32 * k2 + 8 * g) * 2);
#pragma unroll
                for (int a = 0; a < 3; ++a) o[a][dt] = __builtin_amdgcn_mfma_f32_16x16x32_bf16(__builtin_bit_cast(bf16x8, av), __builtin_bit_cast(bf16x8, bp[a][k2]), o[a][dt], 0, 0, 0);
            }
        if (ti + 1 < ntile) ATT_STAGE((ti + 1) & 1);
        __syncthreads();
    }
#undef ATT_KROW
#undef ATT_LOAD
#undef ATT_STAGE
#pragma unroll
    for (int a = 0; a < 3; ++a) {
        const float inv = 1.0f / lrun[a];
#pragma unroll
        for (int dt = 0; dt < 4; ++dt) {
            u32x2 w; w.x = pkbf(o[a][dt][0] * inv, o[a][dt][1] * inv); w.y = pkbf(o[a][dt][2] * inv, o[a][dt][3] * inv);
            *(u32x2*)(ACT + (size_t)(qrow0 + r) * D + 640 + (3 * hk + a) * 64 + 16 * dt + 4 * g) = w;
        }
    }
}

constexpr int X1_JOBS = 12 * (2 * (NSEG - 1) - 1);
__device__ __forceinline__ void scan_x1_phase(Frame& F, const Args& A, int layer) {
    const int b = blockIdx.x;
    if (b < X1_JOBS) {
        const int dh = b / (2 * (NSEG - 1) - 1), k = b % (2 * (NSEG - 1) - 1);
        if (k == 0) dn_scan_job<1>(F, dh, 0);
        else { const int sg = 1 + ((k - 1) >> 1); if ((k - 1) & 1) dn_scan_job<1>(F, dh, sg); else dn_scan_job<2>(F, dh, sg); }
        return;
    }
    const int nw = F.G - X1_JOBS;
    for (int u = b - X1_JOBS; u < 100; u += nw) { attn_unit(F, A, layer, u); __syncthreads(); }
}
__device__ __forceinline__ void scan_x2_phase(Frame& F) {
    if (blockIdx.x < 12) dn_combine(F, blockIdx.x);
}
__device__ __forceinline__ void scan_x3_phase(Frame& F, const Args& A, int layer) {
    if (blockIdx.x < 12 * NSEG) { dn_scan_job<0>(F, blockIdx.x / NSEG, blockIdx.x % NSEG); return; }
    const int nunits = layer == 0 ? 260 : 256, nw = F.G - 12 * NSEG;
    for (int u = 100 + blockIdx.x - 12 * NSEG; u < nunits; u += nw) { attn_unit(F, A, layer, u); __syncthreads(); }
}

constexpr int DO_BUF = 58880;
__device__ __forceinline__ void dn_out_phase(Frame& F, const Args& A, int layer) {
    const bf16_t* PX = (const bf16_t*)(F.ws + WS_PX);
    bf16_t* ACT = (bf16_t*)(F.ws + WS_ACT);
    const bf16_t* QD = (const bf16_t*)(F.ws + WS_QD); const bf16_t* KD = (const bf16_t*)(F.ws + WS_QD + QKV_STRIDE);
    const float* Gg = (const float*)(F.ws + WS_G);
    const bf16_t* VT = (const bf16_t*)(F.ws + WS_DN + 3 * DN_STRIDE); const bf16_t* ST = (const bf16_t*)(F.ws + WS_DN + 4 * DN_STRIDE);
    const float* ng = A.in[I_NORMG] + layer * 64;
    const int tid = F.tid, lane = F.lane, wave = F.wave, r = lane & 15, g = lane >> 4;
    const int it = wave & 3, hf = wave >> 2;
    const int nunits = (layer == 0 ? 260 : 256) * 6;
    const int srow = tid >> 3, sc = tid & 7;
    const int soff = srow * 128 + ((sc ^ ((srow >> 1) & 7)) << 4);
    u32x4 pre[7]; float gpre = 0.f;
#define DO_ROW0(u_) (((u_) / 6) < 256 ? 64 * ((u_) / 6) : NL + 64 * (((u_) / 6) - 256))
#define DO_LOAD(u_) do { const int oc_ = (u_) / 6, h_ = (u_) % 6, row0_ = DO_ROW0(u_); \
        const int s0_ = oc_ < 256 ? 4 + oc_ : oc_ - 256, s1_ = oc_ < 256 ? 4 + 255 - oc_ : 3 - (oc_ - 256); \
        const size_t U0_ = (size_t)(h_ * DN_NS + s0_) * 4096, U1_ = (size_t)((6 + h_) * DN_NS + s1_) * 4096; \
        pre[0] = *(const u32x4*)(QD + (size_t)(row0_ + srow) * 384 + h_ * 64 + sc * 8); pre[1] = *(const u32x4*)(KD + (size_t)(row0_ + srow) * 384 + h_ * 64 + sc * 8); \
        pre[2] = *(const u32x4*)(ST + U0_ + srow * 64 + sc * 8); pre[3] = *(const u32x4*)(ST + U1_ + srow * 64 + sc * 8); \
        pre[4] = *(const u32x4*)(VT + U0_ + srow * 64 + sc * 8); pre[5] = *(const u32x4*)(VT + U1_ + srow * 64 + sc * 8); \
        pre[6] = *(const u32x4*)(PX + (size_t)(row0_ + srow) * INP + C_DZ + h_ * 64 + sc * 8); \
        if (wave < 2) gpre = Gg[(size_t)(row0_ + lane) * 12 + wave * 6 + h_]; } while (0)
#define DO_STAGE(b_) do { LAS unsigned char* bb_ = F.lds + (b_) * DO_BUF; \
        _Pragma("unroll") for (int q_ = 0; q_ < 7; ++q_) *(LAS u32x4*)(bb_ + q_ * 8192 + soff) = pre[q_]; \
        if (wave < 2) { float gv_ = gpre; \
            _Pragma("unroll") for (int o_ = 1; o_ < 64; o_ <<= 1) { const float t_ = wave ? __shfl_down(gv_, o_) : __shfl_up(gv_, o_); if (wave ? (lane + o_ < 64) : (lane >= o_)) gv_ += t_; } \
            ((LAS float*)(bb_ + 57344))[wave * 64 + lane] = gv_; } } while (0)
    int u = blockIdx.x, cur = 0;
    if (u < nunits) { DO_LOAD(u); DO_STAGE(0); }
    __syncthreads();
    f32x4 ngv[2];
#pragma unroll
    for (int dtl = 0; dtl < 2; ++dtl) ngv[dtl] = *(const f32x4*)(ng + 16 * (2 * hf + dtl) + 4 * g);
#pragma unroll 1
    for (; u < nunits; u += F.G) {
        const int un = u + F.G;
        if (un < nunits) DO_LOAD(un);
        const int h = u % 6, row0 = DO_ROW0(u);
        LAS unsigned char* bb = F.lds + cur * DO_BUF;
        const LAS float* gc0 = (const LAS float*)(bb + 57344); const LAS float* gc1 = gc0 + 64;
        LAS float* ssx = (LAS float*)(bb + 57344 + 512);
        const int i = 16 * it + r;
        const float e0 = gc0[i], e1 = gc1[i];
        bf16x8 qf[2];
#pragma unroll
        for (int ks = 0; ks < 2; ++ks) qf[ks] = *(const LAS bf16x8*)(bb + sc_off(16 * it + r, 32 * ks + 8 * g));
        f32x4 pt[4];
#pragma unroll
        for (int jt = 0; jt < 4; ++jt) {
            f32x4 c = (f32x4){0.f, 0.f, 0.f, 0.f};
#pragma unroll
            for (int ks = 0; ks < 2; ++ks) c = __builtin_amdgcn_mfma_f32_16x16x32_bf16(*(const LAS bf16x8*)(bb + 8192 + sc_off(16 * jt + r, 32 * ks + 8 * g)), qf[ks], c, 0, 0, 0);
            pt[jt] = c;
        }
        f32x4 o[2];
#pragma unroll
        for (int dtl = 0; dtl < 2; ++dtl) o[dtl] = (f32x4){0.f, 0.f, 0.f, 0.f};
#pragma unroll
        for (int dir = 0; dir < 2; ++dir) {
            const LAS float* gcd = dir == 0 ? gc0 : gc1; const float ei = dir == 0 ? e0 : e1;
            const float xi = __expf(ei);
            u32x4 bp[2]; float pv[4][4];
#pragma unroll
            for (int jt = 0; jt < 4; ++jt)
#pragma unroll
                for (int e = 0; e < 4; ++e) {
                    const int j = 16 * jt + 4 * g + e;
                    const bool ok = dir == 0 ? (j <= i) : (j >= i);
                    pv[jt][e] = ok ? pt[jt][e] * __expf(ei - gcd[j]) : 0.f;
                }
#pragma unroll
            for (int k2 = 0; k2 < 2; ++k2) { bp[k2].x = pkbf(pv[2 * k2][0], pv[2 * k2][1]); bp[k2].y = pkbf(pv[2 * k2][2], pv[2 * k2][3]); bp[k2].z = pkbf(pv[2 * k2 + 1][0], pv[2 * k2 + 1][1]); bp[k2].w = pkbf(pv[2 * k2 + 1][2], pv[2 * k2 + 1][3]); }
            const LAS unsigned char* stt = bb + (2 + dir) * 8192; const LAS unsigned char* vtt = bb + (4 + dir) * 8192;
#pragma unroll
            for (int dtl = 0; dtl < 2; ++dtl) {
                const int dt = 2 * hf + dtl;
                f32x4 c = (f32x4){0.f, 0.f, 0.f, 0.f};
#pragma unroll
                for (int ks = 0; ks < 2; ++ks) c = __builtin_amdgcn_mfma_f32_16x16x32_bf16(*(const LAS bf16x8*)(stt + sc_off(16 * dt + r, 32 * ks + 8 * g)), qf[ks], c, 0, 0, 0);
                f32x4 acc = o[dtl] + c * xi;
#pragma unroll
                for (int k2 = 0; k2 < 2; ++k2) {
                    const u32x2 lo = *(const LAS u32x2*)(vtt + sc_off(16 * dt + r, 32 * k2 + 4 * g)), hi = *(const LAS u32x2*)(vtt + sc_off(16 * dt + r, 32 * k2 + 16 + 4 * g));
                    const u32x4 av = (u32x4){lo.x, lo.y, hi.x, hi.y};
                    acc = __builtin_amdgcn_mfma_f32_16x16x32_bf16(__builtin_bit_cast(bf16x8, av), __builtin_bit_cast(bf16x8, bp[k2]), acc, 0, 0, 0);
                }
                o[dtl] = acc;
            }
        }
        float ss = 0.f;
#pragma unroll
        for (int dtl = 0; dtl < 2; ++dtl) ss += (o[dtl][0] * o[dtl][0] + o[dtl][1] * o[dtl][1]) + (o[dtl][2] * o[dtl][2] + o[dtl][3] * o[dtl][3]);
        ss += __shfl_xor(ss, 16); ss += __shfl_xor(ss, 32);
        if (g == 0) ssx[wave * 16 + r] = ss;
        __syncthreads();
        const float rstd = 1.0f / sqrtf((ssx[wave * 16 + r] + ssx[(wave ^ 4) * 16 + r]) * (1.f / 64.f) + EPS);
#pragma unroll
        for (int dtl = 0; dtl < 2; ++dtl) {
            const int dt = 2 * hf + dtl;
            const u32x2 zz = *(const LAS u32x2*)(bb + 6 * 8192 + sc_off(i, 16 * dt + 4 * g));
            const float z0 = bf2f(zz.x & 0xffffu), z1 = bf2f(zz.x >> 16), z2 = bf2f(zz.y & 0xffffu), z3 = bf2f(zz.y >> 16);
            u32x2 w; w.x = pkbf(o[dtl][0] * rstd * ngv[dtl][0] * silu_f(z0), o[dtl][1] * rstd * ngv[dtl][1] * silu_f(z1));
            w.y = pkbf(o[dtl][2] * rstd * ngv[dtl][2] * silu_f(z2), o[dtl][3] * rstd * ngv[dtl][3] * silu_f(z3));
            *(LAS u32x2*)(bb + 8192 + sc_off(i, 16 * dt + 4 * g)) = w;
        }
        __syncthreads();
        *(u32x4*)(ACT + (size_t)(row0 + srow) * D + 256 + h * 64 + sc * 8) = *(const LAS u32x4*)(bb + 8192 + soff);
        if (un < nunits) DO_STAGE(cur ^ 1);
        __syncthreads();
        cur ^= 1;
    }
#undef DO_ROW0
#undef DO_LOAD
#undef DO_STAGE
}

constexpr size_t RT_EID = WS_ROUTE, RT_GATE = WS_ROUTE + 128 * 1024, RT_TSLOT = WS_ROUTE + 256 * 1024, RT_BCNT = WS_ROUTE + 384 * 1024, RT_TILEE = WS_ROUTE + 400 * 1024, RT_NT = WS_ROUTE + 404 * 1024;
constexpr size_t WS_XS = WS_BIG;
constexpr size_t WS_Y = 278 * MiB;
constexpr size_t WS_HM = 350 * MiB;
constexpr int MOE_CH = 72;
constexpr size_t WS_SLAB = 440 * MiB;
static_assert(WS_HM + (size_t)72 * 256 * DFE <= WS_SLAB && WS_SLAB + (size_t)8 * 28 * 65536 * 4 <= WS_END, "slab map");
static_assert(WS_XS + (size_t)36864 * 1024 <= WS_Y && WS_Y + (size_t)36864 * 2048 <= WS_HM, "moe map");

__device__ __forceinline__ void norm2_router_phase(Frame& F, const Args& A) {
    const float* mod = (const float*)(F.ws + WS_MOD) + (1 * 2 + 0) * 6144;
    const float* shift = mod + 3 * 1024; const float* scale = mod + 4 * 1024;
    unsigned char* act8 = F.ws + WS_ACT;
    int* EID = (int*)(F.ws + RT_EID); float* GATE = (float*)(F.ws + RT_GATE); int* BCNT = (int*)(F.ws + RT_BCNT);
    LAS int* se = (LAS int*)F.lds;
    LAS float* rw = (LAS float*)(F.lds + 1024);
    for (int i = F.tid; i < 2048; i += NTHREADS) ((LAS f32x4*)rw)[i] = ((const GAS f32x4*)A.in[I_ROUTER])[i];
    __syncthreads();
    const int lane = F.lane;
    f32x4 shl[4], scl[4];
#pragma unroll
    for (int j = 0; j < 4; ++j) { shl[j] = ((const GAS f32x4*)shift)[lane + 64 * j]; scl[j] = ((const GAS f32x4*)scale)[lane + 64 * j] + 1.0f; }
    for (int k = 0; k < 8; ++k) {
        const int tl = F.wave * 8 + k, t = blockIdx.x * 64 + tl;
        const GAS f32x4* xr = (const GAS f32x4*)(A.out + (size_t)t * D) + lane;
        f32x4 v[4]; float s = 0.f;
#pragma unroll
        for (int j = 0; j < 4; ++j) { v[j] = xr[64 * j]; s += (v[j].x * v[j].x + v[j].y * v[j].y) + (v[j].z * v[j].z + v[j].w * v[j].w); }
        const float rstd = 1.0f / sqrtf(wave_sum(s) * (1.f / D) + EPS);
        float lg[8];
#pragma unroll
        for (int e = 0; e < 8; ++e) lg[e] = 0.f;
        GAS unsigned* o8 = (GAS unsigned*)(act8 + (size_t)t * D) + lane;
#pragma unroll
        for (int j = 0; j < 4; ++j) {
            const f32x4 y = v[j] * rstd * scl[j] + shl[j];
            o8[64 * j] = pk_fp8x4(y.x, y.y, y.z, y.w);
            const int c0 = 4 * (lane + 64 * j);
#pragma unroll
            for (int q = 0; q < 4; ++q) {
                const f32x4 r0 = *(const LAS f32x4*)(rw + (c0 + q) * 8), r1 = *(const LAS f32x4*)(rw + (c0 + q) * 8 + 4);
                const float yy = y[q];
                lg[0] += yy * r0.x; lg[1] += yy * r0.y; lg[2] += yy * r0.z; lg[3] += yy * r0.w; lg[4] += yy * r1.x; lg[5] += yy * r1.y; lg[6] += yy * r1.z; lg[7] += yy * r1.w;
            }
        }
#pragma unroll
        for (int e = 0; e < 8; ++e) lg[e] = wave_sum(lg[e]);
        int e0 = 0; float l0 = lg[0];
#pragma unroll
        for (int e = 1; e < 8; ++e) if (lg[e] > l0) { l0 = lg[e]; e0 = e; }
        int e1 = -1; float l1 = -INFINITY;
#pragma unroll
        for (int e = 0; e < 8; ++e) if (e != e0 && lg[e] > l1) { l1 = lg[e]; e1 = e; }
        if (lane == 0) {
            const float g0 = 1.0f / (1.0f + expf(l1 - l0));
            EID[t * 2] = e0; EID[t * 2 + 1] = e1; GATE[t * 2] = g0; GATE[t * 2 + 1] = 1.0f - g0;
            se[tl * 2] = e0; se[tl * 2 + 1] = e1;
        }
    }
    __syncthreads();
    if (F.wave == 0) {
        const int a0 = se[lane * 2], a1 = se[lane * 2 + 1];
#pragma unroll
        for (int e = 0; e < 8; ++e) { const unsigned long long mk = __ballot(a0 == e || a1 == e); if (lane == e) BCNT[blockIdx.x * 8 + e] = __popcll(mk); }
    }
    __syncthreads();
}

__device__ __forceinline__ void moe_assign_phase(Frame& F) {
    const int* EID = (const int*)(F.ws + RT_EID); int* TSLOT = (int*)(F.ws + RT_TSLOT); const int* BCNT = (const int*)(F.ws + RT_BCNT);
    unsigned* TILEE = (unsigned*)(F.ws + RT_TILEE); unsigned* NTL = (unsigned*)(F.ws + RT_NT);
    const unsigned char* act8 = F.ws + WS_ACT; unsigned char* XS = F.ws + WS_XS;
    LAS int* sm = (LAS int*)F.lds;
    const int b = blockIdx.x, lane = F.lane;
    if (F.tid < 8) {
        int tot = 0, mine = 0;
        for (int bb = 0; bb < 256; ++bb) { const int c = __hip_atomic_load(BCNT + bb * 8 + F.tid, RLX_AGENT); if (bb < b) mine += c; tot += c; }
        sm[F.tid] = tot; sm[8 + F.tid] = mine;
    }
    __syncthreads();
    if (F.tid == 0) {
        int ps = 0, nt = 0;
        for (int e = 0; e < 8; ++e) { const int tl = (sm[e] + 255) >> 8; sm[16 + e] = ps; sm[24 + e] = tl; if (b == 0) for (int q = 0; q < tl; ++q) TILEE[nt + q] = (unsigned)e; ps += tl * 256; nt += tl; }
        if (b == 0) *NTL = (unsigned)nt;
    }
    __syncthreads();
    if (F.wave == 0) {
        const int t = b * 64 + lane;
        const int a0 = EID[t * 2], a1 = EID[t * 2 + 1];
        int s0 = 0, s1 = 0;
        const unsigned long long lower = (1ull << lane) - 1ull;
#pragma unroll
        for (int e = 0; e < 8; ++e) {
            const unsigned long long mk = __ballot(a0 == e || a1 == e);
            const int rank = __popcll(mk & lower), slot = sm[16 + e] + sm[8 + e] + rank;
            if (a0 == e) s0 = slot; if (a1 == e) s1 = slot;
        }
        TSLOT[t * 2] = s0; TSLOT[t * 2 + 1] = s1; sm[32 + lane * 2] = s0; sm[33 + lane * 2] = s1;
    }
    __syncthreads();
    for (int q = F.wave; q < 128; q += NWAVES) {
        const int t = b * 64 + (q >> 1), slot = sm[32 + q];
        const GAS u32x4* srcp = (const GAS u32x4*)(act8 + (size_t)t * D); GAS u32x4* dstp = (GAS u32x4*)(XS + (size_t)slot * D);
        dstp[lane] = srcp[lane];
    }
    { const int e = b & 7, cnt = sm[e], first = sm[16 + e] + cnt, npad = sm[24 + e] * 256 - cnt;
      for (int p = (b >> 3) * NWAVES + F.wave; p < npad; p += 32 * NWAVES) { GAS u32x4* dstp = (GAS u32x4*)(XS + (size_t)(first + p) * D); const u32x4 z = (u32x4){0u, 0u, 0u, 0u}; dstp[lane] = z; } }
}

__device__ __forceinline__ f32x4 moe_yrow(const bf16_t* Y, const float* SLAB, int slot, int tail0, int j, int lane) {
    const int tile = slot >> 8;
    if (tile < tail0) { const u32x2 a = ((const GAS u32x2*)(Y + (size_t)slot * D))[lane + 64 * j];
        return (f32x4){bf2f(a.x & 0xffffu), bf2f(a.x >> 16), bf2f(a.y & 0xffffu), bf2f(a.y >> 16)}; }
    const float* p = SLAB + (size_t)(((tile - tail0) * 4 + j) * 7) * 65536 + (size_t)(slot & 255) * 256 + 4 * lane;
    f32x4 s = *(const f32x4*)p;
#pragma unroll
    for (int ks = 1; ks < 7; ++ks) s = s + *(const f32x4*)(p + (size_t)ks * 65536);
    return s;
}
__device__ __forceinline__ void moe_final_phase(Frame& F, const Args& A) {
    const float* mod5 = (const float*)(F.ws + WS_MOD) + (1 * 2 + 0) * 6144 + 5 * 1024;
    const int* TSLOT = (const int*)(F.ws + RT_TSLOT); const float* GATE = (const float*)(F.ws + RT_GATE);
    const bf16_t* Y = (const bf16_t*)(F.ws + WS_Y); const float* SLAB = (const float*)(F.ws + WS_SLAB);
    const float* fng = A.in[I_FNG];
    const int lane = F.lane;
    const int ntl = (int)__builtin_amdgcn_readfirstlane(__hip_atomic_load((unsigned*)(F.ws + RT_NT), RLX_AGENT));
    const int tail0 = (ntl > 128 && ntl - 128 <= 8) ? 128 : (1 << 20);
    f32x4 m5v[4], fgv[4];
#pragma unroll
    for (int j = 0; j < 4; ++j) { m5v[j] = ((const GAS f32x4*)mod5)[lane + 64 * j]; fgv[j] = ((const GAS f32x4*)fng)[lane + 64 * j]; }
    for (int t = F.gw; t < NL; t += F.NGW) {
        const int s0 = TSLOT[t * 2], s1 = TSLOT[t * 2 + 1]; const float g0 = GATE[t * 2], g1 = GATE[t * 2 + 1];
        GAS f32x4* xr = (GAS f32x4*)(A.out + (size_t)t * D) + lane;
        f32x4 v[4]; float s = 0.f;
        if (((s0 >> 8) < tail0) && ((s1 >> 8) < tail0)) {
            const GAS u32x2* y0 = (const GAS u32x2*)(Y + (size_t)s0 * D) + lane; const GAS u32x2* y1 = (const GAS u32x2*)(Y + (size_t)s1 * D) + lane;
#pragma unroll
            for (int j = 0; j < 4; ++j) {
                const f32x4 x = xr[64 * j]; const u32x2 a = y0[64 * j], c = y1[64 * j];
                const f32x4 m5 = m5v[j];
                f32x4 f;
                f.x = g0 * bf2f(a.x & 0xffffu) + g1 * bf2f(c.x & 0xffffu); f.y = g0 * bf2f(a.x >> 16) + g1 * bf2f(c.x >> 16);
                f.z = g0 * bf2f(a.y & 0xffffu) + g1 * bf2f(c.y & 0xffffu); f.w = g0 * bf2f(a.y >> 16) + g1 * bf2f(c.y >> 16);
                v[j] = x + m5 * f;
                s += (v[j].x * v[j].x + v[j].y * v[j].y) + (v[j].z * v[j].z + v[j].w * v[j].w);
            }
        } else {
#pragma unroll
            for (int j = 0; j < 4; ++j) {
                const f32x4 x = xr[64 * j];
                const f32x4 m5 = m5v[j];
                const f32x4 f = moe_yrow(Y, SLAB, s0, tail0, j, lane) * g0 + moe_yrow(Y, SLAB, s1, tail0, j, lane) * g1;
                v[j] = x + m5 * f;
                s += (v[j].x * v[j].x + v[j].y * v[j].y) + (v[j].z * v[j].z + v[j].w * v[j].w);
            }
        }
        const float rstd = 1.0f / sqrtf(wave_sum_l(s, lane) * (1.f / D) + EPS);
#pragma unroll
        for (int j = 0; j < 4; ++j) xr[64 * j] = v[j] * rstd * fgv[j];
    }
}

#define GRID_BAR() do { { unsigned* bp_ = (unsigned*)(F.ws + WS_CTL) + 4096; asm volatile("" : "+s"(bp_)); bar.bar = bp_; } xcd_barrier(bar); TS_STAMP(); F.tid = opq((int)threadIdx.x); F.lane = F.tid & 63; } while (0)

template <int MODE>
__device__ __forceinline__ void ctx_pieces(Frame& F, const bf16_t* A, const bf16_t* Bt, int K, int ncg, void* O, int ldo, const float* base, const float* gate,
                                           int nrg = 16, const unsigned* tile_e = nullptr, int tile0 = 0, size_t estride = 0) {
    const int lane = F.lane, r = lane & 15, g = lane >> 4, wave = F.wave;
    LAS float* red = (LAS float*)F.lds;
    const int npieces = nrg * ncg, kw = K >> 3;
    for (int p = blockIdx.x; p < npieces; p += F.G) {
        const int rg = p % nrg, cg = p / nrg;
        f32x4 acc[4];
#pragma unroll
        for (int n = 0; n < 4; ++n) acc[n] = (f32x4){0.f, 0.f, 0.f, 0.f};
        const bf16_t* ap = A + (size_t)(16 * rg + r) * K + wave * kw + 8 * g;
        size_t eoff = 0;
        if (tile_e) eoff = (size_t)(__builtin_amdgcn_readfirstlane(__hip_atomic_load(tile_e + tile0 + (rg >> 4), __ATOMIC_RELAXED, __HIP_MEMORY_SCOPE_AGENT)) & 7u) * estride;
        const bf16_t* bp = Bt + eoff + (size_t)(64 * cg + r) * K + wave * kw + 8 * g;
        for (int k = 0; k < kw; k += 32) {
            const bf16x8 a = *(const bf16x8*)(ap + k);
#pragma unroll
            for (int n = 0; n < 4; ++n) { const bf16x8 b = *(const bf16x8*)(bp + (size_t)(16 * n) * K + k); acc[n] = __builtin_amdgcn_mfma_f32_16x16x32_bf16(a, b, acc[n], 0, 0, 0); }
        }
#pragma unroll
        for (int n = 0; n < 4; ++n)
#pragma unroll
            for (int e = 0; e < 4; ++e) red[wave * 1024 + (4 * g + e) * 64 + 16 * n + r] = acc[n][e];
        __syncthreads();
        for (int idx = F.tid; idx < 1024; idx += NTHREADS) {
            float s = 0.f;
#pragma unroll
            for (int w = 0; w < 8; ++w) s += red[w * 1024 + idx];
            const int row = 16 * rg + (idx >> 6), col = 64 * cg + (idx & 63);
            if (MODE == 0) ((bf16_t*)O)[(size_t)row * ldo + col] = (bf16_t)f2bf(s);
            else ((float*)O)[(size_t)row * 1024 + col] = base[(size_t)row * 1024 + col] + gate[col] * s;
        }
        __syncthreads();
    }
}

#ifndef STOP_AFTER
#define STOP_AFTER 0
#endif
__device__ __forceinline__ void dump_bf16(Frame& F, float* out, const bf16_t* buf, int ld, int ncols) {
    for (int m = F.gw; m < NL; m += F.NGW)
        for (int j = 0; j < 16; ++j) { const int c = F.lane + 64 * j; float s = 0.f; for (int k = 0; c + 1024 * k < ncols; ++k) s += bf2f(buf[(size_t)m * ld + c + 1024 * k]); out[(size_t)m * D + c] = s; }
}
#define STOP_DUMP(n, buf, ld, nc) do { if (layer == 0 && STOP_AFTER == (n)) { dump_bf16(F, args.out, (const bf16_t*)(buf), (ld), (nc)); F.ws = nullptr; return; } } while (0)
template <int layer>
__device__ __forceinline__ void layer_body(Frame& F, const Args& args, XcdBarrier& bar) {
    unsigned char* ws = F.ws;
    float* HC = (float*)(ws + WS_HC);
    const float* MOD = (const float*)(ws + WS_MOD);
        F.tid = opq((int)threadIdx.x); F.lane = F.tid & 63;
        const float* xl = layer == 0 ? args.in[I_X] : args.out;
        const float* xc = layer == 0 ? args.in[I_CTX] : HC;
        const float* modx = MOD + (layer * 2 + 0) * 6144; const float* modc = MOD + (layer * 2 + 1) * 6144;
        norm_phase(F, xl, xc, layer, 0, 1, NT);
        GRID_BAR();
        ctx_pieces<0>(F, (const bf16_t*)(ws + WS_ACT) + (size_t)NL * 1024, (const bf16_t*)(ws + WS_WIN) + (size_t)layer * INP * 1024, 1024, INP / 64, (bf16_t*)(ws + WS_PX) + (size_t)NL * INP, INP, nullptr, nullptr);
        { pg8::DenseSched S{NL / 256, INP / 256, F.G, (int)blockIdx.x, (const char*)(ws + WS_ACT), (const char*)(ws + WS_WIN) + (size_t)layer * INP * 1024 * 2, (size_t)256 * 1024 * 2};
          pg8::EpiStoreBf16 E{(bf16_t*)(ws + WS_PX), INP};
          pg8::gemm_phase(F.lds, 1024, S, E); }
        GRID_BAR();
        STOP_DUMP(2, ws + WS_PX, INP, INC);
        prep_phase(F, args, layer);
        GRID_BAR();
        STOP_DUMP(3, ws + WS_QD, 384, 384);
        STOP_DUMP(33, ws + WS_QD + QKV_STRIDE, 384, 384);
        dn_chunk_phase(F);
        GRID_BAR();
        STOP_DUMP(4, ws + WS_DN, 1024, 1024);
        STOP_DUMP(44, ws + WS_DN + DN_STRIDE, 1024, 1024);
        STOP_DUMP(45, ws + WS_DN + 2 * DN_STRIDE, 1024, 1024);
        scan_x1_phase(F, args, layer);
        GRID_BAR();
        scan_x3_phase(F, args, layer);
        GRID_BAR();
        STOP_DUMP(5, ws + WS_DN + 3 * DN_STRIDE, 1024, 1024);
        STOP_DUMP(55, ws + WS_DN + 4 * DN_STRIDE, 1024, 1024);
        STOP_DUMP(56, ws + WS_ACT, 1024, 1024);
        dn_out_phase(F, args, layer);
        GRID_BAR();
        STOP_DUMP(6, ws + WS_ACT, 1024, 1024);
        if (layer == 0) ctx_pieces<1>(F, (const bf16_t*)(ws + WS_ACT) + (size_t)NL * 1024, (const bf16_t*)(ws + WS_WOUT), 1024, 16, HC, 1024, xc, modc + 2 * 1024);
        { pg8::DenseSched S{NL / 256, 4, F.G, (int)blockIdx.x, (const char*)(ws + WS_ACT), (const char*)(ws + WS_WOUT) + (size_t)layer * 1024 * 1024 * 2, (size_t)256 * 1024 * 2};
          pg8::EpiResid E{xl, args.out, modx + 2 * 1024, xc, HC, modc + 2 * 1024, NL / 256};
          pg8::gemm_phase(F.lds, 1024, S, E); }
        GRID_BAR();
        if (layer == 0 && STOP_AFTER == 7) { F.ws = nullptr; return; }
        if (layer == 0) {
            norm_phase(F, args.out, HC, 0, 3, 4, NT);
            GRID_BAR();
            { pg8::DenseSched S{NT / 256, 2 * DFF / 256, F.G, (int)blockIdx.x, (const char*)(ws + WS_ACT), (const char*)(ws + WS_WGU), (size_t)256 * 1024 * 2};
              pg8::EpiSwiGLU E{(bf16_t*)(ws + WS_BIG), DFF};
              pg8::gemm_phase(F.lds, 1024, S, E); }
            GRID_BAR();
            ctx_pieces<1>(F, (const bf16_t*)(ws + WS_BIG) + (size_t)NL * DFF, (const bf16_t*)(ws + WS_WDN), DFF, 16, HC, 1024, HC, modc + 5 * 1024);
            { pg8::DenseSched S{NL / 256, 4, F.G, (int)blockIdx.x, (const char*)(ws + WS_BIG), (const char*)(ws + WS_WDN), (size_t)256 * DFF * 2};
              pg8::EpiResid E{args.out, args.out, modx + 5 * 1024, HC, HC, modc + 5 * 1024, NL / 256};
              pg8::gemm_phase(F.lds, DFF, S, E); }
            GRID_BAR();
            if (STOP_AFTER == 9) { F.ws = nullptr; return; }
        } else {
            norm2_router_phase(F, args);
            GRID_BAR();
            moe_assign_phase(F);
            GRID_BAR();
            const int ntl = (int)__builtin_amdgcn_readfirstlane(__hip_atomic_load((unsigned*)(ws + RT_NT), RLX_AGENT));
#pragma unroll 1
            for (int t0 = 0; t0 < ntl; t0 += 64) {
                const int left = ntl - t0; const int nM = left > MOE_CH ? 64 : left;
                const int ntail = (nM > 64 && nM - 64 <= 8) ? nM - 64 : 0, nG2 = nM - ntail;
                { pg8::MoeSched S{nM, 2 * DFE / 256, F.G, (int)blockIdx.x, (const char*)(ws + WS_XS) + (size_t)t0 * 256 * 1024, (const char*)(ws + WS_MGU), (size_t)256 * 1024, (size_t)2 * DFE * 1024, (const unsigned*)(ws + RT_TILEE), t0, 0};
                  pg8::EpiSwiGLU8 E{ws + WS_HM, DFE, 1.0f / MOE_WSCALE, MOE_HSCALE};
                  pg8::gemm_phase<true>(F.lds, 512, S, E); }
                GRID_BAR();
                { pg8::MoeSched S{nG2, 4, F.G, (int)blockIdx.x, (const char*)(ws + WS_HM), (const char*)(ws + WS_MDN), (size_t)256 * DFE, (size_t)1024 * DFE, (const unsigned*)(ws + RT_TILEE), t0, t0};
                  pg8::EpiStoreBf16 E{(bf16_t*)(ws + WS_Y), 1024, 1.0f / (MOE_WSCALE * MOE_HSCALE)};
                  pg8::gemm_phase<true>(F.lds, DFE / 2, S, E); }
                if (ntail > 0) {
                    pg8::MoeTailSched S{ntail, F.G, (int)((blockIdx.x + 128) % F.G), (const char*)(ws + WS_HM) + (size_t)nG2 * 256 * DFE, (const char*)(ws + WS_MDN), (size_t)256 * DFE, (size_t)1024 * DFE, (const unsigned*)(ws + RT_TILEE), t0 + nG2, (size_t)512};
                    pg8::EpiSlab E{(float*)(ws + WS_SLAB), 1.0f / (MOE_WSCALE * MOE_HSCALE)};
                    pg8::gemm_phase<true>(F.lds, DFE / 2, S, E, 4);
                }
                GRID_BAR();
                if (left <= MOE_CH) break;
            }
            moe_final_phase(F, args);
        }
    }

__global__ void __launch_bounds__(NTHREADS, 2) fwd_kernel(Args args) {
    extern __shared__ __attribute__((aligned(16))) unsigned char lds[];
    Frame F;
    F.lds = (LAS unsigned char*)lds;
    F.tid = threadIdx.x; F.lane = F.tid & 63; F.wave = __builtin_amdgcn_readfirstlane(F.tid >> 6);
    F.G = gridDim.x; { const int bx = blockIdx.x; F.vcu = (F.G % 8 == 0) ? (bx % 8) * (F.G / 8) + bx / 8 : bx; }
    F.gw = F.vcu * NWAVES + F.wave; F.NGW = F.G * NWAVES;
    F.ws = args.ws;
    volatile LAS unsigned* MISC = (volatile LAS unsigned*)(F.lds + MISC_OFF);
    for (int u = F.tid; u < (LDS_BYTES - MISC_OFF) / 4; u += NTHREADS) ((LAS unsigned*)(F.lds + MISC_OFF))[u] = 0u;
    __syncthreads();
    XcdBarrier bar = xcd_barrier_post((unsigned*)(F.ws + WS_CTL) + 4096, MISC + 8);
    TS_STAMP();

    unsigned char* ws = F.ws;
    float* HC = (float*)(ws + WS_HC);
    const float* MOD = (const float*)(ws + WS_MOD);
#ifdef DIAG_ZERO
    { GAS u32x4* p = (GAS u32x4*)(F.ws + WS_MOD); const size_t n16 = (WS_END - WS_MOD) / 16; const u32x4 z = (u32x4){0u, 0u, 0u, 0u};
      for (size_t i = (size_t)blockIdx.x * NTHREADS + F.tid; i < n16; i += (size_t)F.G * NTHREADS) p[i] = z; }
    GRID_BAR();
#endif
    p0_prologue(F, args);
    GRID_BAR();
    layer_body<0>(F, args, bar);
    if (F.ws == nullptr) return;
    layer_body<1>(F, args, bar);
#ifdef TS_A
    TS_STAMP();
    if (blockIdx.x == 0 && threadIdx.x == 0) {
        volatile LAS unsigned* M_ = (volatile LAS unsigned*)(F.lds + MISC_OFF);
        const unsigned long long ta = ((unsigned long long)M_[17 + 2 * (TS_A)] << 32) | M_[16 + 2 * (TS_A)], tb = ((unsigned long long)M_[17 + 2 * (TS_B)] << 32) | M_[16 + 2 * (TS_B)];
        const unsigned long long dl = (tb - ta) * (TS_MUL), t0 = __builtin_amdgcn_s_memrealtime();
        while (__builtin_amdgcn_s_memrealtime() - t0 < dl) __builtin_amdgcn_s_sleep(8);
    }
#endif
}

extern "C" void kernel_launch(void* const* d_in, const int* in_sizes, int n_in, void* d_out, int out_size, void* d_ws, size_t ws_size, hipStream_t stream) {
    static int grid = 0;
    if (grid == 0) {
        if (n_in != 22 || out_size != NL * D || ws_size < WS_END) { fprintf(stderr, "kernel_launch: unexpected shapes (n_in %d out %d ws %zu)\n", n_in, out_size, ws_size); grid = -1; return; }
        int dev = 0, cus = 0;
        if (hipGetDevice(&dev) != hipSuccess || hipDeviceGetAttribute(&cus, hipDeviceAttributeMultiprocessorCount, dev) != hipSuccess) { grid = -1; return; }
        if (hipFuncSetAttribute((const void*)fwd_kernel, hipFuncAttributeMaxDynamicSharedMemorySize, LDS_BYTES) != hipSuccess) { fprintf(stderr, "kernel_launch: hipFuncSetAttribute failed\n"); grid = -1; return; }
        int per_cu = 0;
        (void)hipOccupancyMaxActiveBlocksPerMultiprocessor(&per_cu, (const void*)fwd_kernel, NTHREADS, LDS_BYTES);
        (void)hipGetLastError();
        grid = cus;
    }
    if (grid < 0) return;
    (void)hipMemsetAsync((char*)d_ws + WS_CTL, 0, CTL_ZERO_BYTES, stream);
    Args a{};
    for (int i = 0; i < 22; ++i) a.in[i] = (const float*)d_in[i];
    a.out = (float*)d_out; a.ws = (unsigned char*)d_ws;
    hipLaunchKernelGGL(fwd_kernel, dim3(grid), dim3(NTHREADS), LDS_BYTES, stream, a);
}
```

```cpp
#define STOP_AFTER 0
#include <hip/hip_runtime.h>
#include <cstdint>
#include <cstdio>

#define GAS __attribute__((address_space(1)))
#define LAS __attribute__((address_space(3)))
typedef unsigned short bf16_t;
typedef short bf16x8 __attribute__((ext_vector_type(8)));
typedef short bf16x4 __attribute__((ext_vector_type(4)));
typedef float f32x4 __attribute__((ext_vector_type(4)));
typedef float f32x2 __attribute__((ext_vector_type(2)));
typedef unsigned u32x4 __attribute__((ext_vector_type(4)));
typedef unsigned u32x2 __attribute__((ext_vector_type(2)));
typedef GAS unsigned gu32;

constexpr int D = 1024, NL = 16384, NC = 256, NT = NL + NC;
constexpr int INC = 2968, INP = 3072;
constexpr int C_CB = 0, C_CC = 256, C_CH = 512, C_DQ = 768, C_DK = 1152, C_DV = 1536, C_DZ = 1920, C_DA = 2304, C_DB = 2316, C_AQ = 2328, C_AK = 2712, C_AV = 2840;
constexpr int DFF = 2816, NEXP = 8, DFE = 3584;
constexpr int NWAVES = 8, NTHREADS = 512;
constexpr float EPS = 1e-6f;

constexpr size_t MiB = 1u << 20;
constexpr size_t WS_CTL = 0, CTL_ZERO_BYTES = 1 * MiB;
constexpr size_t WS_MOD = 1 * MiB;
constexpr size_t WS_ROPE = 1 * MiB + 128 * 1024;
constexpr size_t WS_HC = 2 * MiB;
constexpr size_t WS_G = 3 * MiB;
constexpr size_t WS_BETA = 4 * MiB;
constexpr size_t WS_ROUTE = 5 * MiB;
constexpr size_t WS_WIN = 8 * MiB;
constexpr size_t WS_WOUT = 20 * MiB;
constexpr size_t WS_WGU = 24 * MiB;
constexpr size_t WS_WDN = 35 * MiB;
constexpr size_t WS_MGU = 41 * MiB;
constexpr size_t WS_MDN = 153 * MiB;
constexpr size_t WS_ACT = 209 * MiB;
constexpr size_t WS_BIG = 242 * MiB;
constexpr size_t WS_PX = WS_BIG;
constexpr size_t WS_QD = 340 * MiB;
constexpr size_t QKV_STRIDE = 12 * MiB + 512 * 1024;
constexpr size_t WS_DN = 378 * MiB;
constexpr size_t DN_STRIDE = 25 * MiB;
constexpr size_t WS_END = 512 * MiB;
static_assert(WS_QD + 3 * QKV_STRIDE <= WS_DN && WS_DN + 5 * DN_STRIDE <= WS_END, "ws map");
static_assert((size_t)NT * INP * 2 <= WS_QD - WS_PX && (size_t)NT * 384 * 2 <= QKV_STRIDE && (size_t)3120 * 8192 <= DN_STRIDE, "ws map 2");

constexpr int SCR_BYTES = 139264;
constexpr int MISC_OFF = SCR_BYTES;
constexpr int LDS_BYTES = 147456;

#define RLX_AGENT __ATOMIC_RELAXED, __HIP_MEMORY_SCOPE_AGENT
#define LDS_WAIT() asm volatile("s_waitcnt lgkmcnt(0)" ::: "memory")
#define VM_WAIT() asm volatile("s_waitcnt vmcnt(0)" ::: "memory")

__device__ __forceinline__ unsigned f2bf(float f) { unsigned u = __builtin_bit_cast(unsigned, f); return (u + 0x7fffu + ((u >> 16) & 1u)) >> 16; }
__device__ __forceinline__ unsigned pk2(float lo, float hi) { return f2bf(lo) | (f2bf(hi) << 16); }
__device__ __forceinline__ float bf2f(unsigned h) { return __builtin_bit_cast(float, h << 16); }
__device__ __forceinline__ unsigned pk_fp8x4(float a, float b, float c, float d) {
    a = __builtin_fminf(__builtin_fmaxf(a, -448.f), 448.f); b = __builtin_fminf(__builtin_fmaxf(b, -448.f), 448.f);
    c = __builtin_fminf(__builtin_fmaxf(c, -448.f), 448.f); d = __builtin_fminf(__builtin_fmaxf(d, -448.f), 448.f);
    int p = __builtin_amdgcn_cvt_pk_fp8_f32(a, b, 0, false); p = __builtin_amdgcn_cvt_pk_fp8_f32(c, d, p, true); return (unsigned)p;
}
__device__ __forceinline__ float silu_f(float x) { return x * __builtin_amdgcn_rcpf(1.f + __expf(-x)); }
__device__ __forceinline__ int opq(int v) { asm volatile("" : "+v"(v)); return v; }
template <int CTRL> __device__ __forceinline__ float dpp_all(float v) { return __builtin_bit_cast(float, __builtin_amdgcn_update_dpp(0, __builtin_bit_cast(int, v), CTRL, 0xF, 0xF, true)); }
template <int CTRL, int RM> __device__ __forceinline__ float dpp_rows(float v) { return __builtin_bit_cast(float, __builtin_amdgcn_update_dpp(0, __builtin_bit_cast(int, v), CTRL, RM, 0xF, false)); }
__device__ __forceinline__ float sum8(float v) { v += dpp_all<0xB1>(v); v += dpp_all<0x4E>(v); v += dpp_all<0x141>(v); return v; }
__device__ __forceinline__ float wave_sum(float v) {
    v = sum8(v); v += dpp_all<0x140>(v);
    v += dpp_rows<0x142, 0xA>(v);
    v += dpp_rows<0x143, 0xC>(v);
    return __builtin_bit_cast(float, __builtin_amdgcn_readlane(__builtin_bit_cast(int, v), 63));
}
__device__ __forceinline__ float wave_sum_l(float v, int) { return wave_sum(v); }

#define XB_TMO      128
#define XB_XCNT(j)  (256  + 64 * (j))
#define XB_XSUB(j)  (1280 + 64 * (j))
#define XB_XGEN(j)  (2304 + 64 * (j))
#define XB_TOP      3328
#define XB_TOPGEN   3392
#define XCD_BAR_WORDS 3456
#define XB_SPIN_CAP (1u << 22)
__device__ __forceinline__ unsigned xb_ld(unsigned* p)              { return __hip_atomic_load(p, __ATOMIC_RELAXED, __HIP_MEMORY_SCOPE_AGENT); }
__device__ __forceinline__ unsigned xb_add(unsigned* p, unsigned v) { return __hip_atomic_fetch_add(p, v, __ATOMIC_RELAXED, __HIP_MEMORY_SCOPE_AGENT); }
__device__ __forceinline__ unsigned xb_xcc_id() { return (unsigned)__builtin_amdgcn_s_getreg((3 << 11) | 20) & 0xFu; }
#define XB_SPIN(cond, bar) do { unsigned _sp = 0; while (cond) { __builtin_amdgcn_s_sleep(1); \
    if ((++_sp & 255u) == 0u) { if (xb_ld(&(bar)[XB_TMO])) break; if (_sp > XB_SPIN_CAP) { atomicAdd(&(bar)[XB_TMO], 1u); break; } } } } while (0)
struct XcdBarrier { unsigned* bar; unsigned x; volatile LAS unsigned* st; };
__device__ __forceinline__ XcdBarrier xcd_barrier_post(unsigned* bar, volatile LAS unsigned* st) {
    XcdBarrier b; b.bar = bar; b.x = xb_xcc_id(); b.st = st;
    if (threadIdx.x == 0) (void)xb_add(&bar[XB_XCNT(b.x)], 1u);
    return b;
}
__device__ __forceinline__ void xcd_barrier_complete(unsigned* bar, unsigned x, unsigned& nloc, unsigned& nx) {
    const unsigned G = gridDim.x * gridDim.y * gridDim.z;
    unsigned sum, cnt, mine, sp = 0u;
    for (;;) {
        sum = 0u; cnt = 0u; mine = 0u;
#pragma unroll
        for (unsigned j = 0; j < 16; ++j) { const unsigned c = xb_ld(&bar[XB_XCNT(j)]); sum += c; cnt += (c > 0u) ? 1u : 0u; mine = (j == x) ? c : mine; }
        if (sum == G) break;
        __builtin_amdgcn_s_sleep(1);
        if ((++sp & 255u) == 0u) { if (xb_ld(&bar[XB_TMO])) break; if (sp > XB_SPIN_CAP) { atomicAdd(&bar[XB_TMO], 1u); break; } }
    }
    nloc = mine > 0u ? mine : 1u; nx = cnt > 0u ? cnt : 1u;
}
__device__ __forceinline__ void xcd_barrier(const XcdBarrier& b) {
    asm volatile("s_waitcnt vmcnt(0)" ::: "memory");
    __syncthreads();
    if (threadIdx.x == 0) {
        unsigned* bar = b.bar;
        __builtin_amdgcn_s_waitcnt(0);
        unsigned nloc = b.st[0], nx = b.st[1];
        if (nloc == 0u) { xcd_barrier_complete(bar, b.x, nloc, nx); b.st[0] = nloc; b.st[1] = nx; }
        const unsigned old = xb_add(&bar[XB_XSUB(b.x)], 1u);
        const unsigned gen = old / nloc;
        if (old + 1u == (gen + 1u) * nloc) {
            __builtin_amdgcn_fence(__ATOMIC_RELEASE, "agent");
            asm volatile("s_waitcnt vmcnt(0)" ::: "memory");
            const unsigned og = xb_add(&bar[XB_TOP], 1u);
            const unsigned tg = og / nx;
            if (og + 1u == (tg + 1u) * nx) xb_add(&bar[XB_TOPGEN], 1u);
            else XB_SPIN(xb_ld(&bar[XB_TOPGEN]) == tg, bar);
            __builtin_amdgcn_fence(__ATOMIC_ACQUIRE, "agent");
            xb_add(&bar[XB_XGEN(b.x)], 1u);
            asm volatile("s_waitcnt vmcnt(0)" ::: "memory");
        } else {
            XB_SPIN(xb_ld(&bar[XB_XGEN(b.x)]) == gen, bar);
            __builtin_amdgcn_fence(__ATOMIC_ACQUIRE, "agent");
            asm volatile("s_waitcnt vmcnt(0)" ::: "memory");
        }
    }
    __syncthreads();
}

#ifdef TS_A
#define TS_STAMP() do { if (blockIdx.x == 0 && threadIdx.x == 0) { volatile LAS unsigned* M_ = (volatile LAS unsigned*)(F.lds + MISC_OFF); const unsigned k_ = M_[12]; const unsigned long long t_ = __builtin_amdgcn_s_memrealtime(); M_[16 + 2 * k_] = (unsigned)t_; M_[17 + 2 * k_] = (unsigned)(t_ >> 32); M_[12] = k_ + 1; } } while (0)
#else
#define TS_STAMP() do {} while (0)
#endif
struct Args { const float* in[22]; float* out; unsigned char* ws; };
enum { I_X = 0, I_C, I_CTX, I_CCTX, I_WMOD, I_BMOD, I_WIN, I_WOUT, I_CONVW, I_DNCONVW, I_ALOG, I_DTB, I_NORMG, I_SINK, I_FG, I_FU, I_FD, I_ROUTER, I_MG, I_MU, I_MD, I_FNG };
struct Frame {
    LAS unsigned char* lds;
    int tid, lane, wave, vcu, G, gw, NGW;
    unsigned char* ws;
};

__device__ __forceinline__ void transpose_item(const float* __restrict__ W, int K, int N, bf16_t* WT, int mode, LAS float* scr, int kb, int nb, int lane) {
    const int k0 = 64 * kb, n0 = 64 * nb;
    const int nn = n0 + lane; const bool ok = nn < N;
    const float* src = W + (size_t)k0 * N + (ok ? nn : 0);
#pragma unroll 8
    for (int i = 0; i < 64; ++i) { float v = src[(size_t)i * N]; scr[i * 65 + lane] = ok ? v : 0.f; }
    LDS_WAIT(); asm volatile("" ::: "memory");
    const int c = lane & 7;
#pragma unroll
    for (int j = 0; j < 8; ++j) {
        const int n = (lane >> 3) + 8 * j; const LAS float* s = scr + (8 * c) * 65 + n;
        u32x4 o; o.x = pk2(s[0 * 65], s[1 * 65]); o.y = pk2(s[2 * 65], s[3 * 65]); o.z = pk2(s[4 * 65], s[5 * 65]); o.w = pk2(s[6 * 65], s[7 * 65]);
        const int ng = n0 + n; int drow = ng;
        if (mode == 1) drow = (ng >> 2) * 8 + (ng & 3); else if (mode == 2) drow = (ng >> 2) * 8 + 4 + (ng & 3);
        *(GAS u32x4*)(WT + (size_t)drow * K + k0 + 8 * c) = o;
    }
    LDS_WAIT(); asm volatile("" ::: "memory");
}

__device__ __forceinline__ void transpose_item8(const float* __restrict__ W, int K, int N, unsigned char* WT, int mode, float wscale, LAS float* scr, int kb, int nb, int lane) {
    const int k0 = 64 * kb, n0 = 64 * nb;
    const float* src = W + (size_t)k0 * N + n0 + lane;
#pragma unroll 8
    for (int i = 0; i < 64; ++i) scr[i * 65 + lane] = src[(size_t)i * N];
    LDS_WAIT(); asm volatile("" ::: "memory");
    const int c = lane & 3;
#pragma unroll
    for (int j = 0; j < 4; ++j) {
        const int n = (lane >> 2) + 16 * j; const LAS float* s = scr + (16 * c) * 65 + n;
        u32x4 o;
        o.x = pk_fp8x4(s[0 * 65] * wscale, s[1 * 65] * wscale, s[2 * 65] * wscale, s[3 * 65] * wscale);
        o.y = pk_fp8x4(s[4 * 65] * wscale, s[5 * 65] * wscale, s[6 * 65] * wscale, s[7 * 65] * wscale);
        o.z = pk_fp8x4(s[8 * 65] * wscale, s[9 * 65] * wscale, s[10 * 65] * wscale, s[11 * 65] * wscale);
        o.w = pk_fp8x4(s[12 * 65] * wscale, s[13 * 65] * wscale, s[14 * 65] * wscale, s[15 * 65] * wscale);
        const int ng = n0 + n; int drow = ng;
        if (mode == 1) drow = (ng >> 2) * 8 + (ng & 3); else if (mode == 2) drow = (ng >> 2) * 8 + 4 + (ng & 3);
        *(GAS u32x4*)(WT + (size_t)drow * K + k0 + 16 * c) = o;
    }
    LDS_WAIT(); asm volatile("" ::: "memory");
}
constexpr float MOE_WSCALE = 64.0f, MOE_HSCALE = 8.0f;
__device__ __forceinline__ void p0_prologue(Frame& F, const Args& A) {
    if (blockIdx.x < 192) {
        LAS float* sc = (LAS float*)F.lds;
        for (int i = F.tid; i < 1024; i += NTHREADS) { sc[i] = silu_f(A.in[I_C][i]); sc[1024 + i] = silu_f(A.in[I_CCTX][i]); }
        __syncthreads();
        const int l = blockIdx.x / 96, cg = blockIdx.x % 96;
        const float* W = A.in[I_WMOD] + (size_t)l * 1024 * 6144 + cg * 64 + F.lane;
        float ax = 0.f, ac = 0.f;
        const int kb = F.wave * 128;
#pragma unroll 8
        for (int k = 0; k < 128; ++k) { const float wv = W[(size_t)(kb + k) * 6144]; ax += sc[kb + k] * wv; ac += sc[1024 + kb + k] * wv; }
        LAS float* red = sc + 2048;
        red[F.wave * 64 + F.lane] = ax; red[512 + F.wave * 64 + F.lane] = ac;
        __syncthreads();
        if (F.wave == 0) {
            float sx = 0.f, sc2 = 0.f;
#pragma unroll
            for (int w = 0; w < 8; ++w) { sx += red[w * 64 + F.lane]; sc2 += red[512 + w * 64 + F.lane]; }
            const float b = A.in[I_BMOD][l * 6144 + cg * 64 + F.lane];
            float* mod = (float*)(F.ws + WS_MOD);
            mod[(l * 2 + 0) * 6144 + cg * 64 + F.lane] = sx + b;
            mod[(l * 2 + 1) * 6144 + cg * 64 + F.lane] = sc2 + b;
        }
        __syncthreads();
    } else if (blockIdx.x == 192) {
        float* rope = (float*)(F.ws + WS_ROPE);
        for (int i = F.tid; i < 256 * 16; i += NTHREADS) {
            const int pos = i >> 4, f = i & 15;
            const float inv = powf(10000.0f, -(float)(2 * f) / 32.0f);
            const float ang = (float)pos * inv;
            rope[2 * i] = cosf(ang); rope[2 * i + 1] = sinf(ang);
        }
    }
    LAS float* scr = (LAS float*)(F.lds + F.wave * 16640);
    constexpr int N_WIN = 2 * 16 * 48, N_WOUT = 2 * 16 * 16, N_FG = 16 * 44, N_FD = 44 * 16, N_MG = 8 * 16 * 56, N_MD = 8 * 56 * 16;
    constexpr int NITEMS = N_WIN + N_WOUT + 2 * N_FG + N_FD + 2 * N_MG + N_MD;
    bf16_t* ws16 = (bf16_t*)F.ws;
    for (int it = F.gw; it < NITEMS; it += F.NGW) {
        int r = it;
        if (r < N_WIN) { const int l = r / (16 * 48), q = r % (16 * 48); transpose_item(A.in[I_WIN] + (size_t)l * 1024 * INC, 1024, INC, (bf16_t*)(F.ws + WS_WIN) + (size_t)l * INP * 1024, 0, scr, q / 48, q % 48, F.lane); continue; } r -= N_WIN;
        if (r < N_WOUT) { const int l = r / 256, q = r % 256; transpose_item(A.in[I_WOUT] + (size_t)l * 1024 * 1024, 1024, 1024, (bf16_t*)(F.ws + WS_WOUT) + (size_t)l * 1024 * 1024, 0, scr, q / 16, q % 16, F.lane); continue; } r -= N_WOUT;
        if (r < N_FG) { transpose_item(A.in[I_FG], 1024, DFF, (bf16_t*)(F.ws + WS_WGU), 1, scr, r / 44, r % 44, F.lane); continue; } r -= N_FG;
        if (r < N_FG) { transpose_item(A.in[I_FU], 1024, DFF, (bf16_t*)(F.ws + WS_WGU), 2, scr, r / 44, r % 44, F.lane); continue; } r -= N_FG;
        if (r < N_FD) { transpose_item(A.in[I_FD], DFF, 1024, (bf16_t*)(F.ws + WS_WDN), 0, scr, r / 16, r % 16, F.lane); continue; } r -= N_FD;
        if (r < N_MG) { const int e = r / (16 * 56), q = r % (16 * 56); transpose_item8(A.in[I_MG] + (size_t)e * 1024 * DFE, 1024, DFE, F.ws + WS_MGU + (size_t)e * 2 * DFE * 1024, 1, MOE_WSCALE, scr, q / 56, q % 56, F.lane); continue; } r -= N_MG;
        if (r < N_MG) { const int e = r / (16 * 56), q = r % (16 * 56); transpose_item8(A.in[I_MU] + (size_t)e * 1024 * DFE, 1024, DFE, F.ws + WS_MGU + (size_t)e * 2 * DFE * 1024, 2, MOE_WSCALE, scr, q / 56, q % 56, F.lane); continue; } r -= N_MG;
        { const int e = r / (56 * 16), q = r % (56 * 16); transpose_item8(A.in[I_MD] + (size_t)e * DFE * 1024, DFE, 1024, F.ws + WS_MDN + (size_t)e * 1024 * DFE, 0, MOE_WSCALE, scr, q / 16, q % 16, F.lane); }
    }
    (void)ws16;
}

__device__ __forceinline__ void norm_mod_row(const float* xrow, const f32x4 (&sh)[4], const f32x4 (&sc1)[4], bf16_t* orow, int lane) {
    const GAS f32x4* xr = (const GAS f32x4*)xrow + lane;
    f32x4 v[4]; float s = 0.f;
#pragma unroll
    for (int j = 0; j < 4; ++j) { v[j] = xr[64 * j]; s += (v[j].x * v[j].x + v[j].y * v[j].y) + (v[j].z * v[j].z + v[j].w * v[j].w); }
    const float rstd = 1.0f / sqrtf(wave_sum(s) * (1.f / D) + EPS);
    GAS u32x2* o8 = (GAS u32x2*)orow + lane;
#pragma unroll
    for (int j = 0; j < 4; ++j) {
        const f32x4 y = v[j] * rstd * sc1[j] + sh[j];
        u32x2 w; w.x = pk2(y.x, y.y); w.y = pk2(y.z, y.w); o8[64 * j] = w;
    }
}
__device__ __forceinline__ void norm_phase(Frame& F, const float* xl, const float* xc, int layer, int s_shift, int s_scale, int nrows) {
    const float* mod = (const float*)(F.ws + WS_MOD);
    const float* mx = mod + (layer * 2 + 0) * 6144; const float* mc = mod + (layer * 2 + 1) * 6144;
    bf16_t* act = (bf16_t*)(F.ws + WS_ACT);
    f32x4 shl[4], scl[4];
#pragma unroll
    for (int j = 0; j < 4; ++j) { shl[j] = ((const GAS f32x4*)(mx + s_shift * 1024))[F.lane + 64 * j]; scl[j] = ((const GAS f32x4*)(mx + s_scale * 1024))[F.lane + 64 * j] + 1.0f; }
    for (int m = F.gw; m < nrows; m += F.NGW) {
        if (m < NL) norm_mod_row(xl + (size_t)m * D, shl, scl, act + (size_t)m * D, F.lane);
        else { f32x4 shc[4], scc[4];
#pragma unroll
            for (int j = 0; j < 4; ++j) { shc[j] = ((const GAS f32x4*)(mc + s_shift * 1024))[F.lane + 64 * j]; scc[j] = ((const GAS f32x4*)(mc + s_scale * 1024))[F.lane + 64 * j] + 1.0f; }
            norm_mod_row(xc + (size_t)(m - NL) * D, shc, scc, act + (size_t)m * D, F.lane); }
    }
}

namespace pg8 {
typedef int v8i __attribute__((ext_vector_type(8)));
constexpr int BM = 256, BK = 64, HALF = 128, HTB = HALF * BK * 2, STAGE_BYTES = 8 * HTB, NXCD = 8, WGM = 8;
__host__ __device__ __forceinline__ int lds_byte(int r, int c) { const int st = (r >> 4) * 2 + (c >> 5), rr = r & 15, cc = c & 31, ob = rr * 64 + cc * 2; return st * 1024 + (ob ^ (((ob >> 9) & 1) << 5)); }
__host__ __device__ __forceinline__ void stage_rc(int b, int& R, int& C) { const int st = b / 1024, sb = b % 1024, swz = sb ^ (((sb >> 9) & 1) << 5); R = (st >> 1) * 16 + swz / 64; C = (st & 1) * 32 + (swz % 64) / 2; }
__host__ __device__ __forceinline__ int perm32(int rho) { const int n = rho >> 4, i = rho & 15; return 8 * (i >> 2) + 4 * n + (i & 3); }
struct Unit { int pm, pn; const char* a; const char* b; };
typedef __bf16 bf16x2_t __attribute__((ext_vector_type(2)));
__device__ __forceinline__ unsigned cvt_pk_bf16(float lo, float hi) { f32x2 v = {lo, hi}; bf16x2_t b = __builtin_convertvector(v, bf16x2_t); return __builtin_bit_cast(unsigned, b); }

__device__ __forceinline__ bool tile_order(int i, int G, int c, int nM, int nN, int& pm, int& pn) {
    const int nwg = nM * nN; const long L = (long)i * G + c; if (L >= nwg) return false;
    int wgid = (int)L; { const int q = nwg / NXCD, r = nwg % NXCD, xcd = wgid % NXCD, off = wgid / NXCD; wgid = (xcd < r ? xcd * (q + 1) : r * (q + 1) + (xcd - r) * q) + off; }
    const int nig = WGM * nN, gid = wgid / nig, fm = gid * WGM, gsz = (nM - fm) < WGM ? (nM - fm) : WGM;
    pm = fm + ((wgid % nig) % gsz); pn = (wgid % nig) / gsz; return true;
}
struct DenseSched {
    int nM, nN, G, c; const char* A; const char* B; size_t tstep;
    __device__ __forceinline__ bool next(int i, Unit& u) const {
        int pm, pn; if (!tile_order(i, G, c, nM, nN, pm, pn)) return false;
        u.pm = pm; u.pn = pn; u.a = A + (size_t)pm * tstep; u.b = B + (size_t)pn * tstep; return true;
    }
};
struct MoeSched {
    int nM, nN, G, c; const char* A; const char* B; size_t tstep, estride; const unsigned* tile_e; int t0, pm_off;
    __device__ __forceinline__ bool next(int i, Unit& u) const {
        int pm, pn; if (!tile_order(i, G, c, nM, nN, pm, pn)) return false;
        const unsigned e = __builtin_amdgcn_readfirstlane(__hip_atomic_load(tile_e + t0 + pm, __ATOMIC_RELAXED, __HIP_MEMORY_SCOPE_AGENT)) & 7u;
        u.pm = pm + pm_off; u.pn = pn; u.a = A + (size_t)pm * tstep; u.b = B + (size_t)e * estride + (size_t)pn * tstep; return true;
    }
};

using ::pk_fp8x4;
struct EpiSwiGLU8 {
    static constexpr bool PERM = true;
    unsigned char* H; int ldh; float ascale, hs;
    __device__ __forceinline__ void operator()(const f32x4 (&acc)[2][2][4][2], const Unit& u, int wr, int wc, int fr, int fq) const {
        const int row0 = u.pm * BM + wr * 64 + fr, col0 = u.pn * 128 + wc * 16 + 4 * fq;
#pragma unroll
        for (int ai = 0; ai < 2; ++ai)
#pragma unroll
            for (int m = 0; m < 4; ++m) { unsigned char* rowp = H + (size_t)(row0 + ai * HALF + m * 16) * ldh + col0;
#pragma unroll
                for (int bj = 0; bj < 2; ++bj) { const f32x4 g = acc[ai][bj][m][0] * ascale, up = acc[ai][bj][m][1] * (ascale * hs);
                    float h[4];
#pragma unroll
                    for (int e = 0; e < 4; ++e) h[e] = g[e] * __builtin_amdgcn_rcpf(1.f + __expf(-g[e])) * up[e];
                    *(unsigned*)(rowp + bj * 64) = pk_fp8x4(h[0], h[1], h[2], h[3]); }
                asm volatile("" ::: "memory"); }
    }
};
struct EpiStoreBf16 {
    static constexpr bool PERM = true;
    bf16_t* O; int ldc; float scale = 1.0f;
    __device__ __forceinline__ void operator()(const f32x4 (&acc)[2][2][4][2], const Unit& u, int wr, int wc, int fr, int fq) const {
        const int row0 = u.pm * BM + wr * 64 + fr, col0 = u.pn * BM + wc * 32 + 8 * fq;
#pragma unroll
        for (int ai = 0; ai < 2; ++ai)
#pragma unroll
            for (int m = 0; m < 4; ++m) { bf16_t* rowp = O + (size_t)(row0 + ai * HALF + m * 16) * ldc + col0;
#pragma unroll
                for (int bj = 0; bj < 2; ++bj) { const f32x4 v0 = acc[ai][bj][m][0] * scale, v1 = acc[ai][bj][m][1] * scale;
                    u32x4 w; w.x = cvt_pk_bf16(v0[0], v0[1]); w.y = cvt_pk_bf16(v0[2], v0[3]); w.z = cvt_pk_bf16(v1[0], v1[1]); w.w = cvt_pk_bf16(v1[2], v1[3]);
                    *(u32x4*)(rowp + bj * HALF) = w; } }
    }
};
struct EpiSwiGLU {
    static constexpr bool PERM = true;
    bf16_t* H; int ldh;
    __device__ __forceinline__ void operator()(const f32x4 (&acc)[2][2][4][2], const Unit& u, int wr, int wc, int fr, int fq) const {
        const int row0 = u.pm * BM + wr * 64 + fr, col0 = u.pn * 128 + wc * 16 + 4 * fq;
#pragma unroll
        for (int ai = 0; ai < 2; ++ai)
#pragma unroll
            for (int m = 0; m < 4; ++m) { bf16_t* rowp = H + (size_t)(row0 + ai * HALF + m * 16) * ldh + col0;
#pragma unroll
                for (int bj = 0; bj < 2; ++bj) { const f32x4 g = acc[ai][bj][m][0], up = acc[ai][bj][m][1];
                    float h[4];
#pragma unroll
                    for (int e = 0; e < 4; ++e) h[e] = g[e] * __builtin_amdgcn_rcpf(1.f + __expf(-g[e])) * up[e];
                    u32x2 w; w.x = cvt_pk_bf16(h[0], h[1]); w.y = cvt_pk_bf16(h[2], h[3]);
                    *(u32x2*)(rowp + bj * 64) = w; }
                asm volatile("" ::: "memory"); }
    }
};
struct EpiResid {
    static constexpr bool PERM = false;
    const float* base_l; float* out_l; const float* gate_l; const float* base_c; float* out_c; const float* gate_c; int ctx_tile;
    __device__ __forceinline__ void operator()(const f32x4 (&acc)[2][2][4][2], const Unit& u, int wr, int wc, int fr, int fq) const {
        const bool isc = u.pm >= ctx_tile;
        const float* base = isc ? base_c : base_l; float* out = isc ? out_c : out_l; const float* gate = isc ? gate_c : gate_l;
        const int row0 = (isc ? (u.pm - ctx_tile) : u.pm) * BM + wr * 64 + fr, col0 = u.pn * BM + wc * 32 + 4 * fq;
        f32x4 gv[2][2];
#pragma unroll
        for (int bj = 0; bj < 2; ++bj)
#pragma unroll
            for (int n = 0; n < 2; ++n) gv[bj][n] = *(const f32x4*)(gate + col0 + bj * HALF + n * 16);
#pragma unroll
        for (int ai = 0; ai < 2; ++ai)
#pragma unroll
            for (int m = 0; m < 4; ++m) { const size_t off = (size_t)(row0 + ai * HALF + m * 16) * D + col0;
#pragma unroll
                for (int bj = 0; bj < 2; ++bj)
#pragma unroll
                    for (int n = 0; n < 2; ++n) { const f32x4 bs = *(const f32x4*)(base + off + bj * HALF + n * 16);
                        *(f32x4*)(out + off + bj * HALF + n * 16) = bs + gv[bj][n] * acc[ai][bj][m][n]; } }
    }
};

struct MoeTailSched {
    int ntail, G, c; const char* A; const char* B; size_t tstep, estride; const unsigned* tile_e; int tile0; size_t ksb;
    __device__ __forceinline__ bool next(int i, Unit& u) const {
        const long L = (long)i * G + c; if (L >= (long)ntail * 28) return false;
        const int ks = (int)(L % 7), q = (int)(L / 7), pn = q & 3, tt = q >> 2;
        const unsigned e = __builtin_amdgcn_readfirstlane(__hip_atomic_load(tile_e + tile0 + tt, __ATOMIC_RELAXED, __HIP_MEMORY_SCOPE_AGENT)) & 7u;
        u.pm = q * 7 + ks; u.pn = 0; u.a = A + (size_t)tt * tstep + (size_t)ks * ksb; u.b = B + (size_t)e * estride + (size_t)pn * tstep + (size_t)ks * ksb; return true;
    }
};
struct EpiSlab {
    static constexpr bool PERM = false;
    float* slab; float scale = 1.0f;
    __device__ __forceinline__ void operator()(const f32x4 (&acc)[2][2][4][2], const Unit& u, int wr, int wc, int fr, int fq) const {
        float* base = slab + (size_t)u.pm * 65536 + (size_t)(wr * 64 + fr) * 256 + wc * 32 + 4 * fq;
#pragma unroll
        for (int ai = 0; ai < 2; ++ai)
#pragma unroll
            for (int m = 0; m < 4; ++m)
#pragma unroll
                for (int bj = 0; bj < 2; ++bj)
#pragma unroll
                    for (int n = 0; n < 2; ++n) *(f32x4*)(base + (size_t)(ai * HALF + m * 16) * 256 + bj * HALF + n * 16) = acc[ai][bj][m][n] * scale;
    }
};

template <bool FP8 = false, class Epi, class Sched>
__device__ __forceinline__ void gemm_phase(LAS unsigned char* lds, const int K, const Sched& S, const Epi& E, const int ntk = 0) {
    int tid_ = threadIdx.x; asm volatile("" : "+v"(tid_));
    const int tid = tid_, wid = __builtin_amdgcn_readfirstlane(tid >> 6), lane = tid & 63, wr = wid >> 2, wc = wid & 3, fr = lane & 15, fq = lane >> 4;
    const int nt = ntk ? ntk : K / BK;
    unsigned voffA[2], voffB[2];
#pragma unroll
    for (int i = 0; i < 2; ++i) { int R, C; stage_rc(tid * 16 + i * 8192, R, C); const int Rb = Epi::PERM ? ((R & ~31) + perm32(R & 31)) : R;
        voffA[i] = (unsigned)(R * K + C) * 2u; voffB[i] = (unsigned)(Rb * K + C) * 2u; }
    const size_t kstep = (size_t)(BK * 2);
    const size_t hstep = (size_t)HALF * K * 2;
    const unsigned ldsw = (unsigned)wid * 1024u;
    const int aoff = lds_byte(wr * 64 + fr, fq * 8), boff = lds_byte(wc * 32 + fr, fq * 8);
#define PG8_SA(b, h) (((b) * 2 + (h)) * HTB)
#define PG8_SB(b, h) ((4 + (b) * 2 + (h)) * HTB)
#define PG8_STAGE(bufoff, gbase, voff) do { _Pragma("unroll") for (int _i = 0; _i < 2; ++_i) \
        __builtin_amdgcn_global_load_lds((const unsigned*)((const char*)(gbase) + (voff)[_i]), (LAS unsigned*)(lds + (bufoff) + ldsw + _i * 8192), 16, 0, 0); } while (0)
#define PG8_LDA(dst, b, h) do { _Pragma("unroll") for (int m = 0; m < 4; ++m) _Pragma("unroll") for (int k = 0; k < 2; ++k) dst[m].k[k] = *(const LAS bf16x8*)(lds + PG8_SA(b, h) + aoff + m * 2048 + k * 1024); } while (0)
#define PG8_LDB(dst, b, h) do { _Pragma("unroll") for (int n = 0; n < 2; ++n) _Pragma("unroll") for (int k = 0; k < 2; ++k) dst[n].k[k] = *(const LAS bf16x8*)(lds + PG8_SB(b, h) + boff + n * 2048 + k * 1024); } while (0)
#define PG8_MMA(ai, bj, At, Bt) do { if constexpr (FP8) __builtin_amdgcn_sched_barrier(0); __builtin_amdgcn_s_setprio(1); _Pragma("unroll") for (int m = 0; m < 4; ++m) _Pragma("unroll") for (int n = 0; n < 2; ++n) { \
        if constexpr (FP8) acc[ai][bj][m][n] = __builtin_amdgcn_mfma_scale_f32_16x16x128_f8f6f4(__builtin_bit_cast(v8i, Bt[n]), __builtin_bit_cast(v8i, At[m]), acc[ai][bj][m][n], 0, 0, 0, 127, 0, 127); \
        else { _Pragma("unroll") for (int k = 0; k < 2; ++k) acc[ai][bj][m][n] = __builtin_amdgcn_mfma_f32_16x16x32_bf16(Bt[n].k[k], At[m].k[k], acc[ai][bj][m][n], 0, 0, 0); } } \
        if constexpr (FP8) { _Pragma("unroll") for (int m = 0; m < 4; ++m) _Pragma("unroll") for (int n = 0; n < 2; ++n) asm volatile("" : "+v"(acc[ai][bj][m][n])); } \
        __builtin_amdgcn_s_setprio(0); if constexpr (FP8) __builtin_amdgcn_sched_barrier(0); } while (0)
#define PG8_WAIT_V(n) asm volatile("s_waitcnt vmcnt(" #n ")" ::: "memory")
#define PG8_WAIT_L(n) asm volatile("s_waitcnt lgkmcnt(" #n ")" ::: "memory")
#define PG8_BAR __builtin_amdgcn_s_barrier()
#define PG8_SCHED __builtin_amdgcn_sched_barrier(0)
    Unit cur, nxt; int ui = 0;
    if (!S.next(0, cur)) return;
    f32x4 acc[2][2][4][2];
#pragma unroll
    for (int a = 0; a < 2; ++a)
#pragma unroll
        for (int b = 0; b < 2; ++b)
#pragma unroll
            for (int m = 0; m < 4; ++m)
#pragma unroll
                for (int n = 0; n < 2; ++n) acc[a][b][m][n] = (f32x4){0.f, 0.f, 0.f, 0.f};
    struct Frag { bf16x8 k[2]; };
    Frag At[4], B0[2], B1[2];
    const char* cA = cur.a; const char* cB = cur.b;
    PG8_STAGE(PG8_SB(0, 0), cB, voffB); PG8_STAGE(PG8_SB(0, 1), cB + hstep, voffB); PG8_STAGE(PG8_SA(0, 0), cA, voffA); PG8_STAGE(PG8_SA(0, 1), cA + hstep, voffA);
    if (wr == 1) PG8_BAR;
    PG8_WAIT_V(2); PG8_BAR;
    PG8_STAGE(PG8_SB(1, 0), cB + kstep, voffB); PG8_STAGE(PG8_SA(1, 0), cA + kstep, voffA); PG8_STAGE(PG8_SB(1, 1), cB + hstep + kstep, voffB);
    PG8_WAIT_V(6); PG8_BAR;
    for (;;) {
        const bool has_next = S.next(ui + 1, nxt);
        const char* nA = has_next ? nxt.a : cA; const char* nB = has_next ? nxt.b : cB;
        for (int t = 0; t < nt; t += 2) {
            const bool last = (t == nt - 2);
            const char* a1 = cA + (size_t)(t + 1) * kstep;
            const char* a2 = last ? nA : cA + (size_t)(t + 2) * kstep; const char* b2 = last ? nB : cB + (size_t)(t + 2) * kstep;
            const char* a3 = a2 + kstep; const char* b3 = b2 + kstep;
            PG8_LDB(B0, 0, 0); PG8_LDB(B1, 0, 1); PG8_SCHED; PG8_LDA(At, 0, 0); PG8_STAGE(PG8_SA(1, 1), a1 + hstep, voffA);
            PG8_WAIT_V(8); PG8_WAIT_L(0); PG8_BAR; PG8_MMA(0, 0, At, B0); PG8_MMA(0, 1, At, B1); PG8_BAR; PG8_SCHED;
            PG8_LDA(At, 0, 1); PG8_STAGE(PG8_SB(0, 0), b2, voffB); PG8_STAGE(PG8_SB(0, 1), b2 + hstep, voffB); PG8_STAGE(PG8_SA(0, 0), a2, voffA);
            PG8_WAIT_V(8); PG8_WAIT_L(0); PG8_BAR; PG8_MMA(1, 0, At, B0); PG8_MMA(1, 1, At, B1); PG8_BAR; PG8_SCHED;
            PG8_LDB(B0, 1, 0); PG8_LDB(B1, 1, 1); PG8_SCHED; PG8_LDA(At, 1, 0); PG8_STAGE(PG8_SA(0, 1), a2 + hstep, voffA);
            PG8_WAIT_V(8); PG8_WAIT_L(0); PG8_BAR; PG8_MMA(0, 0, At, B0); PG8_MMA(0, 1, At, B1); PG8_BAR; PG8_SCHED;
            PG8_LDA(At, 1, 1); PG8_STAGE(PG8_SB(1, 0), b3, voffB); PG8_STAGE(PG8_SB(1, 1), b3 + hstep, voffB); PG8_STAGE(PG8_SA(1, 0), a3, voffA);
            PG8_WAIT_V(8); PG8_WAIT_L(0); PG8_BAR; PG8_MMA(1, 0, At, B0); PG8_MMA(1, 1, At, B1); PG8_BAR; PG8_SCHED;
        }
        if (wr == 0) PG8_BAR;
        E(acc, cur, wr, wc, fr, fq);
        if (!has_next) break;
#pragma unroll
        for (int a = 0; a < 2; ++a)
#pragma unroll
            for (int b = 0; b < 2; ++b)
#pragma unroll
                for (int m = 0; m < 4; ++m)
#pragma unroll
                    for (int n = 0; n < 2; ++n) acc[a][b][m][n] = (f32x4){0.f, 0.f, 0.f, 0.f};
        cur = nxt; cA = nA; cB = nB; ++ui;
        if (wr == 1) PG8_BAR;
    }
    PG8_WAIT_V(0);
    PG8_BAR;
#undef PG8_SA
#undef PG8_SB
#undef PG8_STAGE
#undef PG8_LDA
#undef PG8_LDB
#undef PG8_MMA
#undef PG8_WAIT_V
#undef PG8_WAIT_L
#undef PG8_BAR
#undef PG8_SCHED
}
}

constexpr size_t WS_GL = 7 * MiB;
__device__ __forceinline__ float ldbf(const bf16_t* p) { return bf2f(*p); }
__device__ __forceinline__ void unpk8(const u32x4 v, float (&f)[8]) {
    f[0] = bf2f(v.x & 0xffffu); f[1] = bf2f(v.x >> 16); f[2] = bf2f(v.y & 0xffffu); f[3] = bf2f(v.y >> 16);
    f[4] = bf2f(v.z & 0xffffu); f[5] = bf2f(v.z >> 16); f[6] = bf2f(v.w & 0xffffu); f[7] = bf2f(v.w >> 16);
}
__device__ __forceinline__ u32x4 pk8(const float (&f)[8]) { u32x4 o; o.x = pk2(f[0], f[1]); o.y = pk2(f[2], f[3]); o.z = pk2(f[4], f[5]); o.w = pk2(f[6], f[7]); return o; }
struct PrepRow { u32x4 cc, hh, bb, dq0, dq1, dq2, ro; float ab; };
__device__ __forceinline__ PrepRow prep_load(const bf16_t* PX, int m, int lane) {
    PrepRow R; const bf16_t* r0 = PX + (size_t)m * INP;
    const int c0 = 8 * (lane & 31);
    R.cc = *(const u32x4*)(r0 + C_CC + c0); R.hh = *(const u32x4*)(r0 + C_CH + c0); R.bb = *(const u32x4*)(r0 + C_CB + c0);
    R.dq0 = *(const u32x4*)(r0 + C_DQ + 8 * lane); R.dq1 = *(const u32x4*)(r0 + C_DQ + 8 * (64 + lane)); R.dq2 = *(const u32x4*)(r0 + C_DQ + 8 * (128 + (lane & 15)));
    const int head = lane >> 3, v8 = lane & 7;
    R.ro = *(const u32x4*)(r0 + (head < 6 ? C_AQ + head * 64 : C_AK + (head - 6) * 64) + 8 * v8);
    const int q = (lane - 32) & 31; R.ab = bf2f(r0[C_DA + (q < 24 ? q : 23)]);
    return R;
}
__device__ __forceinline__ void prep_phase(Frame& F, const Args& A, int layer) {
    bf16_t* PX = (bf16_t*)(F.ws + WS_PX);
    bf16_t* ACT = (bf16_t*)(F.ws + WS_ACT);
    bf16_t* QD = (bf16_t*)(F.ws + WS_QD); bf16_t* KD = (bf16_t*)(F.ws + WS_QD + QKV_STRIDE); bf16_t* VD = (bf16_t*)(F.ws + WS_QD + 2 * QKV_STRIDE);
    float* Gg = (float*)(F.ws + WS_G); float* Bt = (float*)(F.ws + WS_BETA);
    const float* rope = (const float*)(F.ws + WS_ROPE);
    LAS float* sdw = (LAS float*)F.lds;
    LAS float* scw = sdw + 3 * 1152;
    for (int i = F.tid; i < 3 * 1152; i += NTHREADS) sdw[i] = A.in[I_DNCONVW][layer * 3 * 1152 + i];
    for (int i = F.tid; i < 3 * 256; i += NTHREADS) scw[i] = A.in[I_CONVW][layer * 3 * 256 + i];
    __syncthreads();
    const int lane = F.lane;
    constexpr int RPW = (NT + 2047) / 2048;
    const int mlo = F.gw * RPW, mhi = (mlo + RPW) < NT ? (mlo + RPW) : NT;
    const int qgb = lane - 32;
    const float dtb = (qgb >= 0 && qgb < 12) ? A.in[I_DTB][layer * 12 + qgb] : 0.f;
    const float nalog = (qgb >= 0 && qgb < 12) ? -__expf(A.in[I_ALOG][layer * 12 + qgb]) : 0.f;
    if (mlo < mhi) {
        PrepRow prv = prep_load(PX, mlo > 0 ? mlo - 1 : 0, lane), cur = prep_load(PX, mlo, lane), nxt = prep_load(PX, (mlo + 1) < NT ? mlo + 1 : mlo, lane);
#pragma unroll 1
        for (int m = mlo; m < mhi; ++m) {
            const PrepRow nn = prep_load(PX, (m + 2) < NT ? m + 2 : m, lane);
            const bool hasp = (m != 0 && m != NL), hasn = (m != NL - 1 && m != NT - 1);
            const float fp = hasp ? 1.f : 0.f, fn = hasn ? 1.f : 0.f;
            if (lane < 32) {
                const int c0 = 8 * lane;
                float b[8], c1[8], h1[8], cp[8], hp[8], cn[8], hn[8], o[8];
                unpk8(cur.bb, b); unpk8(cur.cc, c1); unpk8(cur.hh, h1); unpk8(prv.cc, cp); unpk8(prv.hh, hp); unpk8(nxt.cc, cn); unpk8(nxt.hh, hn);
#pragma unroll
                for (int e = 0; e < 8; ++e) o[e] = b[e] * (scw[c0 + e] * (cp[e] * hp[e]) * fp + scw[256 + c0 + e] * (c1[e] * h1[e]) + scw[512 + c0 + e] * (cn[e] * hn[e]) * fn);
                *(u32x4*)(ACT + (size_t)m * D + c0) = pk8(o);
            } else if (lane < 56) {
                if (qgb < 12) { const float sp = cur.ab + dtb; const float softp = (sp > 20.f) ? sp : __logf(1.0f + __expf(sp)); Gg[(size_t)m * 12 + qgb] = nalog * softp; }
                else Bt[(size_t)m * 12 + (qgb - 12)] = __builtin_amdgcn_rcpf(1.0f + __expf(-cur.ab));
            }
            __builtin_amdgcn_sched_barrier(0);
#pragma unroll
            for (int ps = 0; ps < 3; ++ps) {
                __builtin_amdgcn_sched_barrier(0);
                const int v = ps < 2 ? 64 * ps + lane : 128 + (lane & 15);
                const int c0 = 8 * v, p = c0 / 384;
                float x0[8], x1[8], x2[8], o[8];
                unpk8(ps == 0 ? prv.dq0 : ps == 1 ? prv.dq1 : prv.dq2, x0); unpk8(ps == 0 ? cur.dq0 : ps == 1 ? cur.dq1 : cur.dq2, x1); unpk8(ps == 0 ? nxt.dq0 : ps == 1 ? nxt.dq1 : nxt.dq2, x2);
                float ss = 0.f;
#pragma unroll
                for (int e = 0; e < 8; ++e) { o[e] = silu_f(sdw[c0 + e] * x0[e] * fp + sdw[1152 + c0 + e] * x1[e] + sdw[2304 + c0 + e] * x2[e] * fn); ss += o[e] * o[e]; }
                ss = sum8(ss);
                const float sc = p == 2 ? 1.0f : __builtin_amdgcn_rsqf(ss + 1e-6f) * (p == 0 ? 0.125f : 1.0f);
#pragma unroll
                for (int e = 0; e < 8; ++e) o[e] *= sc;
                if (ps < 2 || lane < 16) { bf16_t* dst = (p == 0 ? QD : (p == 1 ? KD : VD)) + (size_t)m * 384 + (c0 - p * 384); *(u32x4*)dst = pk8(o); }
            }
            __builtin_amdgcn_sched_barrier(0);
            if (m < NL) {
                const int head = lane >> 3, v8 = lane & 7, axis = v8 >> 2, vv = v8 & 3;
                bf16_t* px = PX + (size_t)m * INP + (head < 6 ? C_AQ + head * 64 : C_AK + (head - 6) * 64) + 8 * v8;
                const u32x4 own = cur.ro;
                u32x4 oth;
                oth.x = (unsigned)__builtin_amdgcn_update_dpp(0, (int)own.x, 0x4E, 0xF, 0xF, true); oth.y = (unsigned)__builtin_amdgcn_update_dpp(0, (int)own.y, 0x4E, 0xF, 0xF, true);
                oth.z = (unsigned)__builtin_amdgcn_update_dpp(0, (int)own.z, 0x4E, 0xF, 0xF, true); oth.w = (unsigned)__builtin_amdgcn_update_dpp(0, (int)own.w, 0x4E, 0xF, 0xF, true);
                float a[8], b[8], o[8]; unpk8(own, a); unpk8(oth, b);
                const int pos = axis == 0 ? (m >> 6) : (m & 63);
                const float* rt = rope + (pos * 16 + 8 * (vv & 1)) * 2;
                const float sgn = (vv < 2) ? -1.0f : 1.0f;
#pragma unroll
                for (int e = 0; e < 8; ++e) o[e] = a[e] * rt[2 * e] + sgn * b[e] * rt[2 * e + 1];
                *(u32x4*)px = pk8(o);
            }
            prv = cur; cur = nxt; nxt = nn;
        }
    }
    __syncthreads();
}

constexpr int DN_NS = 260, DN_NU = 12 * DN_NS;
__device__ __forceinline__ int dn_row0(int d, int s) {
    if (s < 4) return NL + 64 * (d == 0 ? s : 3 - s);
    return 64 * (d == 0 ? (s - 4) : 255 - (s - 4));
}
__device__ __forceinline__ void pair_bar(volatile LAS unsigned* cnt, unsigned& epoch, int lane) {
    epoch += 2u;
    asm volatile("s_waitcnt vmcnt(0) lgkmcnt(0)" ::: "memory");
    if (lane == 0) __hip_atomic_fetch_add((LAS unsigned*)cnt, 1u, __ATOMIC_RELAXED, __HIP_MEMORY_SCOPE_WORKGROUP);
    while (*cnt < epoch) __builtin_amdgcn_s_sleep(1);
    asm volatile("" ::: "memory");
}
__device__ __forceinline__ void dn_chunk_phase(Frame& F) {
    const bf16_t* KD = (const bf16_t*)(F.ws + WS_QD + QKV_STRIDE); const bf16_t* VD = (const bf16_t*)(F.ws + WS_QD + 2 * QKV_STRIDE);
    const float* Gg = (const float*)(F.ws + WS_G); const float* Bt = (const float*)(F.ws + WS_BETA);
    bf16_t* Wm = (bf16_t*)(F.ws + WS_DN); bf16_t* KDt = (bf16_t*)(F.ws + WS_DN + DN_STRIDE); bf16_t* Ut = (bf16_t*)(F.ws + WS_DN + 2 * DN_STRIDE);
    float* GL = (float*)(F.ws + WS_GL);
    const int gi = F.wave >> 1, wl = F.wave & 1;
    LAS unsigned char* R = F.lds + gi * 18432;
    LAS float* Am = (LAS float*)R;
    LAS float* gcs = Am + 64 * 68; LAS float* bts = gcs + 64;
    volatile LAS unsigned* pcnt = (volatile LAS unsigned*)(R + 17920);
    if (F.tid < 4) *(volatile LAS unsigned*)(F.lds + F.tid * 18432 + 17920) = 0u;
    __syncthreads();
    unsigned epoch = 0u;
#pragma unroll 1
    for (int base = blockIdx.x * 4; base + gi < DN_NU; base += F.G * 4) {
        const int lane = opq(F.lane), r = lane & 15, g = lane >> 4;
        const int U = base + gi; const bool act = U < DN_NU;
        const int dh = act ? U / DN_NS : 0, s = act ? U % DN_NS : 0, d = dh / 6, h = dh % 6;
        const int row0 = dn_row0(d, s);
        const size_t ub = (size_t)U * 4096;
        if (act) {
            if (wl == 0) {
                const int io = d ? 63 - lane : lane;
                float gv = Gg[(size_t)(row0 + io) * 12 + d * 6 + h];
#pragma unroll
                for (int o = 1; o < 64; o <<= 1) { const float t = __shfl_up(gv, o); if (lane >= o) gv += t; }
                gcs[lane] = gv; bts[lane] = Bt[(size_t)(row0 + io) * 12 + d * 6 + h];
                if (lane == 63) GL[U] = expf(gv);
            }
            const bf16_t* tsrc = (wl == 0 ? VD : KD) + (size_t)row0 * 384 + h * 64;
            u32x4 tv[8];
#pragma unroll
            for (int j = 0; j < 8; ++j) tv[j] = *(const u32x4*)(tsrc + (size_t)(8 * j + (lane >> 3)) * 384 + (lane & 7) * 8);
#pragma unroll
            for (int j = 0; j < 8; ++j) *(LAS u32x4*)(R + (1 - wl) * 8192 + (8 * j + (lane >> 3)) * 128 + (lane & 7) * 16) = tv[j];
        }
        pair_bar(pcnt, epoch, lane);
        float x[64];
        if (act) {
            const LAS unsigned char* tb = R + (1 - wl) * 8192 + lane * 2;
            const int rb = d ? 63 * 128 : 0, rs = d ? -128 : 128;
#pragma unroll
            for (int i = 0; i < 64; ++i) x[i] = bf2f(*(const LAS bf16_t*)(tb + rb + i * rs));
            if (wl == 1) {
                const float gcl = gcs[63];
#pragma unroll
                for (int q = 0; q < 8; ++q) { u32x4 o;
                    const int ia = 32 * (q >> 2) + 4 * (q & 3), ib = ia + 16;
                    o.x = pk2(x[ia + 0] * __expf(gcl - gcs[ia + 0]), x[ia + 1] * __expf(gcl - gcs[ia + 1]));
                    o.y = pk2(x[ia + 2] * __expf(gcl - gcs[ia + 2]), x[ia + 3] * __expf(gcl - gcs[ia + 3]));
                    o.z = pk2(x[ib + 0] * __expf(gcl - gcs[ib + 0]), x[ib + 1] * __expf(gcl - gcs[ib + 1]));
                    o.w = pk2(x[ib + 2] * __expf(gcl - gcs[ib + 2]), x[ib + 3] * __expf(gcl - gcs[ib + 3]));
                    *(LAS u32x4*)(R + lane * 128 + ((q ^ (lane & 7)) << 4)) = o; }
#pragma unroll
                for (int j = 0; j < 8; ++j) { const int row = 8 * j + (lane >> 3), c = lane & 7;
                    ((GAS u32x4*)(KDt + ub))[64 * j + lane] = *(const LAS u32x4*)(R + row * 128 + ((c ^ (row & 7)) << 4)); }
#pragma unroll
                for (int i = 0; i < 64; ++i) x[i] *= bts[i] * __expf(gcs[i]);
            } else {
#pragma unroll
                for (int i = 0; i < 64; ++i) x[i] *= bts[i];
            }
        }
        pair_bar(pcnt, epoch, lane);
        if (act) {
            bf16x8 kf[4][2];
#pragma unroll
            for (int jt = 0; jt < 4; ++jt)
#pragma unroll
                for (int ks = 0; ks < 2; ++ks) kf[jt][ks] = *(const bf16x8*)(KD + (size_t)(row0 + 16 * jt + r) * 384 + h * 64 + 32 * ks + 8 * g);
#pragma unroll
            for (int itl = 0; itl < 2; ++itl) {
                const int it = 2 * wl + itl;
#pragma unroll
                for (int jt = 0; jt < 4; ++jt) {
                    f32x4 c = (f32x4){0.f, 0.f, 0.f, 0.f};
                    const bf16x8 a0 = (it == 0 ? kf[0][0] : it == 1 ? kf[1][0] : it == 2 ? kf[2][0] : kf[3][0]);
                    const bf16x8 a1 = (it == 0 ? kf[0][1] : it == 1 ? kf[1][1] : it == 2 ? kf[2][1] : kf[3][1]);
                    c = __builtin_amdgcn_mfma_f32_16x16x32_bf16(a0, kf[jt][0], c, 0, 0, 0);
                    c = __builtin_amdgcn_mfma_f32_16x16x32_bf16(a1, kf[jt][1], c, 0, 0, 0);
                    const int jo = 16 * jt + r, jp = d ? 63 - jo : jo;
#pragma unroll
                    for (int e = 0; e < 4; ++e) {
                        const int io = 16 * it + 4 * g + e, ip = d ? 63 - io : io;
                        Am[ip * 68 + jp] = (jp < ip) ? bts[ip] * c[e] * __expf(gcs[ip] - gcs[jp]) : 0.f;
                    }
                }
            }
        }
        pair_bar(pcnt, epoch, lane);
        if (act) {
#pragma unroll
            for (int b = 0; b < 4; ++b) {
                float acc[16];
#pragma unroll
                for (int ii = 0; ii < 16; ++ii) acc[ii] = 0.f;
#pragma unroll
                for (int j4 = 0; j4 < 4 * b; ++j4) {
#pragma unroll
                    for (int ii = 0; ii < 16; ++ii) {
                        const f32x4 a = *(const LAS f32x4*)(Am + (16 * b + ii) * 68 + 4 * j4);
                        acc[ii] += a.x * x[4 * j4]; acc[ii] += a.y * x[4 * j4 + 1]; acc[ii] += a.z * x[4 * j4 + 2]; acc[ii] += a.w * x[4 * j4 + 3];
                    }
                    if ((j4 & 1) == 1) asm volatile("" ::: "memory");
                }
#pragma unroll
                for (int ii = 0; ii < 16; ++ii) {
                    const int i = 16 * b + ii;
                    float s0 = acc[ii], s1 = 0.f;
#pragma unroll
                    for (int j4 = 0; j4 < (ii + 3) / 4; ++j4) {
                        const f32x4 a = *(const LAS f32x4*)(Am + i * 68 + 16 * b + 4 * j4);
                        s0 += a.x * x[16 * b + 4 * j4]; s1 += a.y * x[16 * b + 4 * j4 + 1]; s0 += a.z * x[16 * b + 4 * j4 + 2]; s1 += a.w * x[16 * b + 4 * j4 + 3];
                    }
                    x[i] -= s0 + s1;
                    if ((ii & 3) == 3) asm volatile("" : "+v"(x[i]) :: "memory");
                }
            }
        }
        pair_bar(pcnt, epoch, lane);
        if (act) {
            if (wl == 0) {
#pragma unroll
                for (int q = 0; q < 8; ++q) { u32x4 o; o.x = pk2(x[8 * q], x[8 * q + 1]); o.y = pk2(x[8 * q + 2], x[8 * q + 3]); o.z = pk2(x[8 * q + 4], x[8 * q + 5]); o.w = pk2(x[8 * q + 6], x[8 * q + 7]);
                    *(LAS u32x4*)(R + lane * 128 + ((q ^ (lane & 7)) << 4)) = o; }
#pragma unroll
                for (int j = 0; j < 8; ++j) { const int row = 8 * j + (lane >> 3), c = lane & 7;
                    ((GAS u32x4*)(Ut + ub))[64 * j + lane] = *(const LAS u32x4*)(R + row * 128 + ((c ^ (row & 7)) << 4)); }
            } else {
                const int kk2 = lane & 31, pc = (lane & 32) + 8 * ((kk2 & 15) >> 2) + 4 * (kk2 >> 4) + (kk2 & 3);
#pragma unroll
                for (int i = 0; i < 64; ++i) *(LAS bf16_t*)(R + 8192 + i * 128 + ((((pc >> 3) ^ (i & 7)) << 4) | ((pc & 7) << 1))) = (bf16_t)f2bf(-x[i]);
#pragma unroll
                for (int j = 0; j < 8; ++j) { const int row = 8 * j + (lane >> 3), c = lane & 7;
                    ((GAS u32x4*)(Wm + ub))[64 * j + lane] = *(const LAS u32x4*)(R + 8192 + row * 128 + ((c ^ (row & 7)) << 4)); }
            }
        }
        pair_bar(pcnt, epoch, lane);
    }
}

constexpr int SC_D = 7, SC_STAGE = 16384, SC_P = 4;
__device__ __forceinline__ unsigned pkbf(float lo, float hi) { return pg8::cvt_pk_bf16(lo, hi); }
__device__ __forceinline__ int sc_off(int row, int col) {
    const int c = col >> 3; return row * 128 + ((c ^ ((row >> 1) & 7)) << 4) + ((col & 4) << 1);
}
constexpr int NSEG = 8;
constexpr size_t WS_SEG = 503 * MiB;
constexpr size_t WS_SST = 507 * MiB;
static_assert(WS_DN + 5 * DN_STRIDE <= WS_SEG && WS_SEG + (size_t)12 * NSEG * 2 * 16384 <= WS_SST && WS_SST + (size_t)12 * NSEG * 16384 <= WS_END, "seg map");
__host__ __device__ constexpr int seg_begin(int s) { return s == 0 ? 0 : 36 + 32 * (s - 1); }
__host__ __device__ constexpr int seg_len(int s) { return s == 0 ? 36 : 32; }
static_assert(seg_begin(NSEG - 1) + seg_len(NSEG - 1) == DN_NS, "segments cover the chain");
template <int MODE>
__device__ __forceinline__ void dn_scan_job(Frame& F, const int dh, const int sg) {
    const int d = dh / 6, lane = F.lane, wave = F.wave, r = lane & 15, g = lane >> 4;
    const int tb = seg_begin(sg), ns = seg_len(sg);
    const unsigned char* srcW = F.ws + WS_DN + ((size_t)dh * DN_NS + tb) * 8192;
    const unsigned char* srcK = srcW + DN_STRIDE; const unsigned char* srcU = srcW + 2 * DN_STRIDE;
    bf16_t* VT = (bf16_t*)(F.ws + WS_DN + 3 * DN_STRIDE) + ((size_t)dh * DN_NS + tb) * 4096;
    bf16_t* ST = (bf16_t*)(F.ws + WS_DN + 4 * DN_STRIDE) + ((size_t)dh * DN_NS + tb) * 4096;
    LAS float* gls = (LAS float*)(F.lds + MISC_OFF + 1024);
    LAS unsigned char* ost = F.lds + SC_D * SC_STAGE + (wave & 3) * 6144;
    { const float* GL = (const float*)(F.ws + WS_GL) + dh * DN_NS + tb; for (int i = F.tid; i < ns; i += NTHREADS) gls[i] = GL[i]; }
    __syncthreads();
#define SC_WAITV(n) asm volatile("s_waitcnt vmcnt(" #n ")" ::: "memory")
#define SC_BAR() do { asm volatile("" ::: "memory"); __builtin_amdgcn_s_barrier(); asm volatile("" ::: "memory"); } while (0)
    if (wave >= 4) {
        const int lw = wave - 4;
        const int lrow = lane >> 3, lc = lane & 7;
#define SC_ISSUE(st) do { const int slot_ = ((st) % SC_D) * SC_STAGE; \
            _Pragma("unroll") for (int e = 0; e < 4; ++e) { \
                const int q = lw * 4 + e, mi = q >> 3, n = q & 7, row = 8 * n + lrow; \
                const unsigned char* mb = (mi == 0 ? srcW : srcK) + (size_t)(st) * 8192; \
                const unsigned char* gp = mb + row * 128 + ((lc ^ ((row >> 1) & 7)) << 4); \
                __builtin_amdgcn_global_load_lds((const unsigned*)gp, (LAS unsigned*)(F.lds + slot_ + mi * 8192 + n * 1024), 16, 0, 0); } } while (0)
        SC_ISSUE(0); SC_ISSUE(1); SC_ISSUE(2); SC_ISSUE(3); SC_ISSUE(4); SC_ISSUE(5);
        SC_WAITV(20); SC_BAR();
        for (int t = 0; t < ns; ++t) {
            if (t + SC_D - 1 < ns) { SC_ISSUE(t + SC_D - 1); SC_WAITV(20); }
            else { SC_WAITV(0); }
            SC_BAR();
        }
    } else {
        f32x4 S[4];
        if (MODE == 0) {
            if (sg == 0) {
#pragma unroll
                for (int t = 0; t < 4; ++t) S[t] = (f32x4){0.f, 0.f, 0.f, 0.f};
            } else {
                const float* seg0 = (const float*)(F.ws + WS_SEG) + (size_t)dh * NSEG * 2 * 4096;
                { const float* q0 = seg0 + 4096 + 16 * wave + r;
#pragma unroll
                  for (int t = 0; t < 4; ++t)
#pragma unroll
                      for (int e2 = 0; e2 < 4; ++e2) S[t][e2] = q0[(16 * t + 4 * g + e2) * 64]; }
#pragma unroll 1
                for (int s = 1; s < sg; ++s) {
                    const float* Pm = seg0 + (size_t)s * 2 * 4096; const float* Qm = Pm + 4096 + 16 * wave + r;
                    u32x4 bsf[2];
#pragma unroll
                    for (int ks = 0; ks < 2; ++ks) { bsf[ks].x = pkbf(S[2 * ks][0], S[2 * ks][1]); bsf[ks].y = pkbf(S[2 * ks][2], S[2 * ks][3]); bsf[ks].z = pkbf(S[2 * ks + 1][0], S[2 * ks + 1][1]); bsf[ks].w = pkbf(S[2 * ks + 1][2], S[2 * ks + 1][3]); }
                    f32x4 Sn[4];
#pragma unroll
                    for (int t = 0; t < 4; ++t) {
                        f32x4 c;
#pragma unroll
                        for (int e2 = 0; e2 < 4; ++e2) c[e2] = Qm[(16 * t + 4 * g + e2) * 64];
#pragma unroll
                        for (int ks = 0; ks < 2; ++ks) {
                            const f32x4 lo = *(const f32x4*)(Pm + (16 * t + r) * 64 + 32 * ks + 4 * g), hi = *(const f32x4*)(Pm + (16 * t + r) * 64 + 32 * ks + 16 + 4 * g);
                            u32x4 a; a.x = pkbf(lo[0], lo[1]); a.y = pkbf(lo[2], lo[3]); a.z = pkbf(hi[0], hi[1]); a.w = pkbf(hi[2], hi[3]);
                            c = __builtin_amdgcn_mfma_f32_16x16x32_bf16(__builtin_bit_cast(bf16x8, a), __builtin_bit_cast(bf16x8, bsf[ks]), c, 0, 0, 0);
                        }
                        Sn[t] = c;
                    }
#pragma unroll
                    for (int t = 0; t < 4; ++t) S[t] = Sn[t];
                }
            }
        } else {
#pragma unroll
            for (int t = 0; t < 4; ++t)
#pragma unroll
                for (int e2 = 0; e2 < 4; ++e2) S[t][e2] = (MODE == 2 && (16 * t + 4 * g + e2) == 16 * wave + r) ? 1.f : 0.f;
        }
        const int dvrow = 16 * wave + r;
        const GAS u32x4* usrc = (const GAS u32x4*)(srcU + wave * 2048) + lane;
        u32x4 uq[SC_P][2];
        if (MODE != 2) {
#pragma unroll
            for (int p = 0; p < SC_P; ++p) { uq[p][0] = usrc[(size_t)p * 512]; uq[p][1] = usrc[(size_t)p * 512 + 64]; }
        }
        SC_BAR();
#define OST_W(base, t_, lo_, hi_) *(LAS u32x2*)(ost + (base) + r * 128 + (((2 * (t_) + (g >> 1)) ^ (r & 7)) << 4) + ((g & 1) << 3)) = (u32x2){lo_, hi_}
        for (int t4 = 0; t4 < ns; t4 += SC_P) {
#pragma unroll
          for (int tp = 0; tp < SC_P; ++tp) {
            const int t = t4 + tp;
            const LAS unsigned char* sb = F.lds + (t % SC_D) * SC_STAGE;
            const float gl = gls[t];
            if (MODE != 2) {
#pragma unroll
                for (int j = 0; j < 2; ++j) { const int row = 8 * j + (lane >> 3), c = lane & 7; *(LAS u32x4*)(ost + 4096 + row * 128 + ((c ^ (row & 7)) << 4)) = uq[tp][j]; }
                if (t + SC_P < ns) { uq[tp][0] = usrc[(size_t)(t + SC_P) * 512]; uq[tp][1] = usrc[(size_t)(t + SC_P) * 512 + 64]; }
            }
            u32x4 bs[2];
#pragma unroll
            for (int ks = 0; ks < 2; ++ks) { bs[ks].x = pkbf(S[2 * ks][0], S[2 * ks][1]); bs[ks].y = pkbf(S[2 * ks][2], S[2 * ks][3]); bs[ks].z = pkbf(S[2 * ks + 1][0], S[2 * ks + 1][1]); bs[ks].w = pkbf(S[2 * ks + 1][2], S[2 * ks + 1][3]); }
            if (MODE == 0) { OST_W(0, 0, bs[0].x, bs[0].y); OST_W(0, 1, bs[0].z, bs[0].w); OST_W(0, 2, bs[1].x, bs[1].y); OST_W(0, 3, bs[1].z, bs[1].w); }
            f32x4 vn[4];
#pragma unroll
            for (int it = 0; it < 4; ++it) {
                f32x4 c = (f32x4){0.f, 0.f, 0.f, 0.f};
                if (MODE != 2) { const u32x2 uu = *(const LAS u32x2*)(ost + 4096 + r * 128 + (((2 * it + (g >> 1)) ^ (r & 7)) << 4) + ((g & 1) << 3));
                    c = (f32x4){bf2f(uu.x & 0xffffu), bf2f(uu.x >> 16), bf2f(uu.y & 0xffffu), bf2f(uu.y >> 16)}; }
#pragma unroll
                for (int ks = 0; ks < 2; ++ks) {
                    const u32x4 a = *(const LAS u32x4*)(sb + sc_off(16 * it + r, 32 * ks + 8 * g));
                    c = __builtin_amdgcn_mfma_f32_16x16x32_bf16(__builtin_bit_cast(bf16x8, a), __builtin_bit_cast(bf16x8, bs[ks]), c, 0, 0, 0);
                }
                vn[it] = c;
            }
            u32x4 bv[2];
#pragma unroll
            for (int ks = 0; ks < 2; ++ks) { bv[ks].x = pkbf(vn[2 * ks][0], vn[2 * ks][1]); bv[ks].y = pkbf(vn[2 * ks][2], vn[2 * ks][3]); bv[ks].z = pkbf(vn[2 * ks + 1][0], vn[2 * ks + 1][1]); bv[ks].w = pkbf(vn[2 * ks + 1][2], vn[2 * ks + 1][3]); }
            if (MODE == 0) {
                if (d == 0) {
                    OST_W(2048, 0, bv[0].x, bv[0].y); OST_W(2048, 1, bv[0].z, bv[0].w); OST_W(2048, 2, bv[1].x, bv[1].y); OST_W(2048, 3, bv[1].z, bv[1].w);
                } else {
#define SC_ROT(a) (((a) >> 16) | ((a) << 16))
#define OST_WR(t_, lo_, hi_) *(LAS u32x2*)(ost + 2048 + r * 128 + (((2 * (3 - (t_)) + ((3 - g) >> 1)) ^ (r & 7)) << 4) + (((3 - g) & 1) << 3)) = (u32x2){SC_ROT(hi_), SC_ROT(lo_)}
                    OST_WR(0, bv[0].x, bv[0].y); OST_WR(1, bv[0].z, bv[0].w); OST_WR(2, bv[1].x, bv[1].y); OST_WR(3, bv[1].z, bv[1].w);
#undef OST_WR
#undef SC_ROT
                }
                GAS u32x4* gst = (GAS u32x4*)(ST + (size_t)t * 4096 + wave * 1024); GAS u32x4* gvt = (GAS u32x4*)(VT + (size_t)t * 4096 + wave * 1024);
#pragma unroll
                for (int j = 0; j < 2; ++j) {
                    const int row = 8 * j + (lane >> 3), c = lane & 7; const int off = row * 128 + ((c ^ (row & 7)) << 4);
                    gst[64 * j + lane] = *(const LAS u32x4*)(ost + off); gvt[64 * j + lane] = *(const LAS u32x4*)(ost + 2048 + off);
                }
            }
#pragma unroll
            for (int tt = 0; tt < 4; ++tt) {
                f32x4 c = S[tt] * gl;
#pragma unroll
                for (int ks = 0; ks < 2; ++ks) {
                    const u32x4 a = *(const LAS u32x4*)(sb + 8192 + sc_off(16 * tt + r, 32 * ks + 8 * g));
                    c = __builtin_amdgcn_mfma_f32_16x16x32_bf16(__builtin_bit_cast(bf16x8, a), __builtin_bit_cast(bf16x8, bv[ks]), c, 0, 0, 0);
                }
                S[tt] = c;
            }
            asm volatile("s_waitcnt lgkmcnt(0)" ::: "memory");
            SC_BAR();
          }
        }
        if (MODE != 0) {
            float* o = (float*)(F.ws + WS_SEG) + ((size_t)(dh * NSEG + sg) * 2 + (MODE == 2 ? 0 : 1)) * 4096 + 16 * wave + r;
#pragma unroll
            for (int t = 0; t < 4; ++t)
#pragma unroll
                for (int e2 = 0; e2 < 4; ++e2) o[(16 * t + 4 * g + e2) * 64] = S[t][e2];
        }
    }
#undef SC_WAITV
#undef OST_W
#undef SC_BAR
#undef SC_ISSUE
    asm volatile("s_waitcnt vmcnt(0) lgkmcnt(0)" ::: "memory");
    __syncthreads();
}
__device__ __forceinline__ void dn_combine(Frame& F, const int dh) {
    const float* SEG = (const float*)(F.ws + WS_SEG) + (size_t)dh * NSEG * 2 * 4096;
    float* SST = (float*)(F.ws + WS_SST) + (size_t)dh * NSEG * 4096;
    LAS float* Sl = (LAS float*)F.lds; LAS float* Pl = Sl + 4096;
    for (int i = F.tid; i < 4096; i += NTHREADS) { const float v = SEG[4096 + i]; Sl[i] = v; SST[4096 + i] = v; }
    __syncthreads();
    const int col = F.tid & 63, dk0 = F.tid >> 6;
    float pre[8], qre[8];
#pragma unroll
    for (int k = 0; k < 8; ++k) { pre[k] = SEG[(size_t)1 * 2 * 4096 + F.tid + NTHREADS * k]; qre[k] = SEG[(size_t)1 * 2 * 4096 + 4096 + (dk0 + 8 * k) * 64 + col]; }
#pragma unroll 1
    for (int sg = 1; sg <= NSEG - 2; ++sg) {
        float out[8];
#pragma unroll
        for (int k = 0; k < 8; ++k) { Pl[F.tid + NTHREADS * k] = pre[k]; out[k] = qre[k]; }
        if (sg + 1 <= NSEG - 2) {
#pragma unroll
            for (int k = 0; k < 8; ++k) { pre[k] = SEG[(size_t)(sg + 1) * 2 * 4096 + F.tid + NTHREADS * k]; qre[k] = SEG[(size_t)(sg + 1) * 2 * 4096 + 4096 + (dk0 + 8 * k) * 64 + col]; }
        }
        __syncthreads();
#pragma unroll 2
        for (int k4 = 0; k4 < 16; ++k4) {
            const float s0 = Sl[(4 * k4 + 0) * 64 + col], s1 = Sl[(4 * k4 + 1) * 64 + col], s2 = Sl[(4 * k4 + 2) * 64 + col], s3 = Sl[(4 * k4 + 3) * 64 + col];
#pragma unroll
            for (int k = 0; k < 8; ++k) { const f32x4 pv = *(const LAS f32x4*)(Pl + (dk0 + 8 * k) * 64 + 4 * k4); out[k] += (pv.x * s0 + pv.y * s1) + (pv.z * s2 + pv.w * s3); }
        }
        __syncthreads();
#pragma unroll
        for (int k = 0; k < 8; ++k) { Sl[(dk0 + 8 * k) * 64 + col] = out[k]; SST[(size_t)(sg + 1) * 4096 + (dk0 + 8 * k) * 64 + col] = out[k]; }
        __syncthreads();
    }
}

__device__ __forceinline__ void attn_unit(Frame& F, const Args& A, int layer, int unit) {
    const bf16_t* PX = (const bf16_t*)(F.ws + WS_PX);
    bf16_t* ACT = (bf16_t*)(F.ws + WS_ACT);
    const int lane = F.lane, wave = F.wave, r = lane & 15, g = lane >> 4, tid = F.tid;
    const bool isctx = unit >= 256;
    const int qb = isctx ? (unit - 256) >> 1 : unit >> 1, hk = unit & 1;
    const int qrow0 = (isctx ? NL : 0) + 128 * qb + 16 * wave;
    const int qpos = 128 * qb + 16 * wave + r;
    const float SCL = 0.125f * 1.4426950408889634f;
    bf16x8 qf[3][2];
#pragma unroll
    for (int a = 0; a < 3; ++a)
#pragma unroll
        for (int ks = 0; ks < 2; ++ks) qf[a][ks] = *(const bf16x8*)(PX + (size_t)(qrow0 + r) * INP + C_AQ + (3 * hk + a) * 64 + 32 * ks + 8 * g);
    float mrun[3], lrun[3]; f32x4 o[3][4];
#pragma unroll
    for (int a = 0; a < 3; ++a) { mrun[a] = A.in[I_SINK][layer * 6 + 3 * hk + a] * 1.4426950408889634f; lrun[a] = 1.f;
#pragma unroll
        for (int dt = 0; dt < 4; ++dt) o[a][dt] = (f32x4){0.f, 0.f, 0.f, 0.f}; }
    const int jlo = (!isctx && qb == 0) ? 2 : 0, jhi = isctx ? 0 : ((qb == 127) ? 4 : 6);
    const int ntile = 4 + (jhi - jlo);
    const int skey = tid >> 3, sch = tid & 7;
    const int spk = (skey & 32) + 8 * (((skey & 31) & 15) >> 2) + 4 * ((skey & 31) >> 4) + (skey & 3);
#define ATT_KROW(s_) ((s_) < 4 ? NL + 64 * (s_) : 128 * (qb - 1) + 64 * (jlo + (s_) - 4))
#define ATT_LOAD(s_) do { const size_t ro_ = (size_t)(ATT_KROW(s_) + skey) * INP; pkv = *(const u32x4*)(PX + ro_ + C_AK + hk * 64 + sch * 8); pvv = *(const u32x4*)(PX + ro_ + C_AV + hk * 64 + sch * 8); } while (0)
#define ATT_STAGE(buf_) do { LAS unsigned char* kb_ = F.lds + (buf_) * 18432; *(LAS u32x4*)(kb_ + skey * 144 + sch * 16) = pkv; LAS bf16_t* vt = (LAS bf16_t*)(kb_ + 9216); \
        vt[(sch * 8 + 0) * 72 + spk] = (bf16_t)(pvv.x & 0xffffu); vt[(sch * 8 + 1) * 72 + spk] = (bf16_t)(pvv.x >> 16); vt[(sch * 8 + 2) * 72 + spk] = (bf16_t)(pvv.y & 0xffffu); vt[(sch * 8 + 3) * 72 + spk] = (bf16_t)(pvv.y >> 16); \
        vt[(sch * 8 + 4) * 72 + spk] = (bf16_t)(pvv.z & 0xffffu); vt[(sch * 8 + 5) * 72 + spk] = (bf16_t)(pvv.z >> 16); vt[(sch * 8 + 6) * 72 + spk] = (bf16_t)(pvv.w & 0xffffu); vt[(sch * 8 + 7) * 72 + spk] = (bf16_t)(pvv.w >> 16); } while (0)
    u32x4 pkv, pvv;
    ATT_LOAD(0); ATT_STAGE(0);
    __syncthreads();
    for (int ti = 0; ti < ntile; ++ti) {
        const int krow0 = ATT_KROW(ti);
        const int q0w = 128 * qb + 16 * wave;
        const bool local = ti >= 4 && ((krow0 + 63 - q0w > 128) || (q0w + 15 - krow0 > 128));
        if (ti + 1 < ntile) ATT_LOAD(ti + 1);
        LAS unsigned char* Kl = F.lds + (ti & 1) * 18432;
        LAS unsigned char* Vl = Kl + 9216;
        f32x4 st[3][4];
#pragma unroll
        for (int kt = 0; kt < 4; ++kt) {
            const bf16x8 k0 = *(const LAS bf16x8*)(Kl + (16 * kt + r) * 144 + (8 * g) * 2);
            const bf16x8 k1 = *(const LAS bf16x8*)(Kl + (16 * kt + r) * 144 + (32 + 8 * g) * 2);
#pragma unroll
            for (int a = 0; a < 3; ++a) {
                f32x4 c = (f32x4){0.f, 0.f, 0.f, 0.f};
                c = __builtin_amdgcn_mfma_f32_16x16x32_bf16(k0, qf[a][0], c, 0, 0, 0);
                c = __builtin_amdgcn_mfma_f32_16x16x32_bf16(k1, qf[a][1], c, 0, 0, 0);
                st[a][kt] = c;
            }
        }
        u32x4 bp[3][2];
#pragma unroll
        for (int a = 0; a < 3; ++a) {
            float tmax = -INFINITY;
#pragma unroll
            for (int kt = 0; kt < 4; ++kt)
#pragma unroll
                for (int e = 0; e < 4; ++e) {
                    float sv = st[a][kt][e] * SCL;
                    if (local) { const int kp = krow0 + 16 * kt + 4 * g + e; const int df = qpos - kp; if (df > 128 || df < -128) sv = -INFINITY; }
                    st[a][kt][e] = sv; tmax = fmaxf(tmax, sv);
                }
            tmax = fmaxf(tmax, __shfl_xor(tmax, 16)); tmax = fmaxf(tmax, __shfl_xor(tmax, 32));
            const float mnew = fmaxf(mrun[a], tmax);
            const float alpha = __builtin_amdgcn_exp2f(mrun[a] - mnew);
            float ls = 0.f;
#pragma unroll
            for (int kt = 0; kt < 4; ++kt)
#pragma unroll
                for (int e = 0; e < 4; ++e) { const float p = __builtin_amdgcn_exp2f(st[a][kt][e] - mnew); st[a][kt][e] = p; ls += p; }
            ls += __shfl_xor(ls, 16); ls += __shfl_xor(ls, 32);
            lrun[a] = lrun[a] * alpha + ls; mrun[a] = mnew;
#pragma unroll
            for (int dt = 0; dt < 4; ++dt) o[a][dt] = o[a][dt] * alpha;
#pragma unroll
            for (int k2 = 0; k2 < 2; ++k2) { bp[a][k2].x = pkbf(st[a][2 * k2][0], st[a][2 * k2][1]); bp[a][k2].y = pkbf(st[a][2 * k2][2], st[a][2 * k2][3]);
                bp[a][k2].z = pkbf(st[a][2 * k2 + 1][0], st[a][2 * k2 + 1][1]); bp[a][k2].w = pkbf(st[a][2 * k2 + 1][2], st[a][2 * k2 + 1][3]); }
        }
#pragma unroll
        for (int dt = 0; dt < 4; ++dt)
#pragma unroll
            for (int k2 = 0; k2 < 2; ++k2) {
                const u32x4 av = *(const LAS u32x4*)(Vl + (16 * dt + r) * 144 + (32 * k2 + 8 * g) * 2);
#pragma unroll
                for (int a = 0; a < 3; ++a) o[a][dt] = __builtin_amdgcn_mfma_f32_16x16x32_bf16(__builtin_bit_cast(bf16x8, av), __builtin_bit_cast(bf16x8, bp[a][k2]), o[a][dt], 0, 0, 0);
            }
        if (ti + 1 < ntile) ATT_STAGE((ti + 1) & 1);
        __syncthreads();
    }
#undef ATT_KROW
#undef ATT_LOAD
#undef ATT_STAGE
#pragma unroll
    for (int a = 0; a < 3; ++a) {
        const float inv = 1.0f / lrun[a];
#pragma unroll
        for (int dt = 0; dt < 4; ++dt) {
            u32x2 w; w.x = pkbf(o[a][dt][0] * inv, o[a][dt][1] * inv); w.y = pkbf(o[a][dt][2] * inv, o[a][dt][3] * inv);
            *(u32x2*)(ACT + (size_t)(qrow0 + r) * D + 640 + (3 * hk + a) * 64 + 16 * dt + 4 * g) = w;
        }
    }
}

constexpr int X1_JOBS = 12 * (2 * (NSEG - 1) - 1);
__device__ __forceinline__ void scan_x1_phase(Frame& F, const Args& A, int layer) {
    const int b = blockIdx.x;
    if (b < X1_JOBS) {
        const int dh = b / (2 * (NSEG - 1) - 1), k = b % (2 * (NSEG - 1) - 1);
        if (k == 0) dn_scan_job<1>(F, dh, 0);
        else { const int sg = 1 + ((k - 1) >> 1); if ((k - 1) & 1) dn_scan_job<1>(F, dh, sg); else dn_scan_job<2>(F, dh, sg); }
        return;
    }
    const int nw = F.G - X1_JOBS;
    for (int u = b - X1_JOBS; u < 100; u += nw) { attn_unit(F, A, layer, u); __syncthreads(); }
}
__device__ __forceinline__ void scan_x2_phase(Frame& F) {
    if (blockIdx.x < 12) dn_combine(F, blockIdx.x);
}
__device__ __forceinline__ void scan_x3_phase(Frame& F, const Args& A, int layer) {
    if (blockIdx.x < 12 * NSEG) { dn_scan_job<0>(F, blockIdx.x / NSEG, blockIdx.x % NSEG); return; }
    const int nunits = layer == 0 ? 260 : 256, nw = F.G - 12 * NSEG;
    for (int u = 100 + blockIdx.x - 12 * NSEG; u < nunits; u += nw) { attn_unit(F, A, layer, u); __syncthreads(); }
}

constexpr int DO_BUF = 58880;
__device__ __forceinline__ void dn_out_phase(Frame& F, const Args& A, int layer) {
    const bf16_t* PX = (const bf16_t*)(F.ws + WS_PX);
    bf16_t* ACT = (bf16_t*)(F.ws + WS_ACT);
    const bf16_t* QD = (const bf16_t*)(F.ws + WS_QD); const bf16_t* KD = (const bf16_t*)(F.ws + WS_QD + QKV_STRIDE);
    const float* Gg = (const float*)(F.ws + WS_G);
    const bf16_t* VT = (const bf16_t*)(F.ws + WS_DN + 3 * DN_STRIDE); const bf16_t* ST = (const bf16_t*)(F.ws + WS_DN + 4 * DN_STRIDE);
    const float* ng = A.in[I_NORMG] + layer * 64;
    const int tid = F.tid, lane = F.lane, wave = F.wave, r = lane & 15, g = lane >> 4;
    const int it = wave & 3, hf = wave >> 2;
    const int nunits = (layer == 0 ? 260 : 256) * 6;
    const int srow = tid >> 3, sc = tid & 7;
    const int soff = srow * 128 + ((sc ^ ((srow >> 1) & 7)) << 4);
    u32x4 pre[7]; float gpre = 0.f;
#define DO_ROW0(u_) (((u_) / 6) < 256 ? 64 * ((u_) / 6) : NL + 64 * (((u_) / 6) - 256))
#define DO_LOAD(u_) do { const int oc_ = (u_) / 6, h_ = (u_) % 6, row0_ = DO_ROW0(u_); \
        const int s0_ = oc_ < 256 ? 4 + oc_ : oc_ - 256, s1_ = oc_ < 256 ? 4 + 255 - oc_ : 3 - (oc_ - 256); \
        const size_t U0_ = (size_t)(h_ * DN_NS + s0_) * 4096, U1_ = (size_t)((6 + h_) * DN_NS + s1_) * 4096; \
        pre[0] = *(const u32x4*)(QD + (size_t)(row0_ + srow) * 384 + h_ * 64 + sc * 8); pre[1] = *(const u32x4*)(KD + (size_t)(row0_ + srow) * 384 + h_ * 64 + sc * 8); \
        pre[2] = *(const u32x4*)(ST + U0_ + srow * 64 + sc * 8); pre[3] = *(const u32x4*)(ST + U1_ + srow * 64 + sc * 8); \
        pre[4] = *(const u32x4*)(VT + U0_ + srow * 64 + sc * 8); pre[5] = *(const u32x4*)(VT + U1_ + srow * 64 + sc * 8); \
        pre[6] = *(const u32x4*)(PX + (size_t)(row0_ + srow) * INP + C_DZ + h_ * 64 + sc * 8); \
        if (wave < 2) gpre = Gg[(size_t)(row0_ + lane) * 12 + wave * 6 + h_]; } while (0)
#define DO_STAGE(b_) do { LAS unsigned char* bb_ = F.lds + (b_) * DO_BUF; \
        _Pragma("unroll") for (int q_ = 0; q_ < 7; ++q_) *(LAS u32x4*)(bb_ + q_ * 8192 + soff) = pre[q_]; \
        if (wave < 2) { float gv_ = gpre; \
            _Pragma("unroll") for (int o_ = 1; o_ < 64; o_ <<= 1) { const float t_ = wave ? __shfl_down(gv_, o_) : __shfl_up(gv_, o_); if (wave ? (lane + o_ < 64) : (lane >= o_)) gv_ += t_; } \
            ((LAS float*)(bb_ + 57344))[wave * 64 + lane] = gv_; } } while (0)
    int u = blockIdx.x, cur = 0;
    if (u < nunits) { DO_LOAD(u); DO_STAGE(0); }
    __syncthreads();
    f32x4 ngv[2];
#pragma unroll
    for (int dtl = 0; dtl < 2; ++dtl) ngv[dtl] = *(const f32x4*)(ng + 16 * (2 * hf + dtl) + 4 * g);
#pragma unroll 1
    for (; u < nunits; u += F.G) {
        const int un = u + F.G;
        if (un < nunits) DO_LOAD(un);
        const int h = u % 6, row0 = DO_ROW0(u);
        LAS unsigned char* bb = F.lds + cur * DO_BUF;
        const LAS float* gc0 = (const LAS float*)(bb + 57344); const LAS float* gc1 = gc0 + 64;
        LAS float* ssx = (LAS float*)(bb + 57344 + 512);
        const int i = 16 * it + r;
        const float e0 = gc0[i], e1 = gc1[i];
        bf16x8 qf[2];
#pragma unroll
        for (int ks = 0; ks < 2; ++ks) qf[ks] = *(const LAS bf16x8*)(bb + sc_off(16 * it + r, 32 * ks + 8 * g));
        f32x4 pt[4];
#pragma unroll
        for (int jt = 0; jt < 4; ++jt) {
            f32x4 c = (f32x4){0.f, 0.f, 0.f, 0.f};
#pragma unroll
            for (int ks = 0; ks < 2; ++ks) c = __builtin_amdgcn_mfma_f32_16x16x32_bf16(*(const LAS bf16x8*)(bb + 8192 + sc_off(16 * jt + r, 32 * ks + 8 * g)), qf[ks], c, 0, 0, 0);
            pt[jt] = c;
        }
        f32x4 o[2];
#pragma unroll
        for (int dtl = 0; dtl < 2; ++dtl) o[dtl] = (f32x4){0.f, 0.f, 0.f, 0.f};
#pragma unroll
        for (int dir = 0; dir < 2; ++dir) {
            const LAS float* gcd = dir == 0 ? gc0 : gc1; const float ei = dir == 0 ? e0 : e1;
            const float xi = __expf(ei);
            u32x4 bp[2]; float pv[4][4];
#pragma unroll
            for (int jt = 0; jt < 4; ++jt)
#pragma unroll
                for (int e = 0; e < 4; ++e) {
                    const int j = 16 * jt + 4 * g + e;
                    const bool ok = dir == 0 ? (j <= i) : (j >= i);
                    pv[jt][e] = ok ? pt[jt][e] * __expf(ei - gcd[j]) : 0.f;
                }
#pragma unroll
            for (int k2 = 0; k2 < 2; ++k2) { bp[k2].x = pkbf(pv[2 * k2][0], pv[2 * k2][1]); bp[k2].y = pkbf(pv[2 * k2][2], pv[2 * k2][3]); bp[k2].z = pkbf(pv[2 * k2 + 1][0], pv[2 * k2 + 1][1]); bp[k2].w = pkbf(pv[2 * k2 + 1][2], pv[2 * k2 + 1][3]); }
            const LAS unsigned char* stt = bb + (2 + dir) * 8192; const LAS unsigned char* vtt = bb + (4 + dir) * 8192;
#pragma unroll
            for (int dtl = 0; dtl < 2; ++dtl) {
                const int dt = 2 * hf + dtl;
                f32x4 c = (f32x4){0.f, 0.f, 0.f, 0.f};
#pragma unroll
                for (int ks = 0; ks < 2; ++ks) c = __builtin_amdgcn_mfma_f32_16x16x32_bf16(*(const LAS bf16x8*)(stt + sc_off(16 * dt + r, 32 * ks + 8 * g)), qf[ks], c, 0, 0, 0);
                f32x4 acc = o[dtl] + c * xi;
#pragma unroll
                for (int k2 = 0; k2 < 2; ++k2) {
                    const u32x2 lo = *(const LAS u32x2*)(vtt + sc_off(16 * dt + r, 32 * k2 + 4 * g)), hi = *(const LAS u32x2*)(vtt + sc_off(16 * dt + r, 32 * k2 + 16 + 4 * g));
                    const u32x4 av = (u32x4){lo.x, lo.y, hi.x, hi.y};
                    acc = __builtin_amdgcn_mfma_f32_16x16x32_bf16(__builtin_bit_cast(bf16x8, av), __builtin_bit_cast(bf16x8, bp[k2]), acc, 0, 0, 0);
                }
                o[dtl] = acc;
            }
        }
        float ss = 0.f;
#pragma unroll
        for (int dtl = 0; dtl < 2; ++dtl) ss += (o[dtl][0] * o[dtl][0] + o[dtl][1] * o[dtl][1]) + (o[dtl][2] * o[dtl][2] + o[dtl][3] * o[dtl][3]);
        ss += __shfl_xor(ss, 16); ss += __shfl_xor(ss, 32);
        if (g == 0) ssx[wave * 16 + r] = ss;
        __syncthreads();
        const float rstd = 1.0f / sqrtf((ssx[wave * 16 + r] + ssx[(wave ^ 4) * 16 + r]) * (1.f / 64.f) + EPS);
#pragma unroll
        for (int dtl = 0; dtl < 2; ++dtl) {
            const int dt = 2 * hf + dtl;
            const u32x2 zz = *(const LAS u32x2*)(bb + 6 * 8192 + sc_off(i, 16 * dt + 4 * g));
            const float z0 = bf2f(zz.x & 0xffffu), z1 = bf2f(zz.x >> 16), z2 = bf2f(zz.y & 0xffffu), z3 = bf2f(zz.y >> 16);
            u32x2 w; w.x = pkbf(o[dtl][0] * rstd * ngv[dtl][0] * silu_f(z0), o[dtl][1] * rstd * ngv[dtl][1] * silu_f(z1));
            w.y = pkbf(o[dtl][2] * rstd * ngv[dtl][2] * silu_f(z2), o[dtl][3] * rstd * ngv[dtl][3] * silu_f(z3));
            *(LAS u32x2*)(bb + 8192 + sc_off(i, 16 * dt + 4 * g)) = w;
        }
        __syncthreads();
        *(u32x4*)(ACT + (size_t)(row0 + srow) * D + 256 + h * 64 + sc * 8) = *(const LAS u32x4*)(bb + 8192 + soff);
        if (un < nunits) DO_STAGE(cur ^ 1);
        __syncthreads();
        cur ^= 1;
    }
#undef DO_ROW0
#undef DO_LOAD
#undef DO_STAGE
}

constexpr size_t RT_EID = WS_ROUTE, RT_GATE = WS_ROUTE + 128 * 1024, RT_TSLOT = WS_ROUTE + 256 * 1024, RT_BCNT = WS_ROUTE + 384 * 1024, RT_TILEE = WS_ROUTE + 400 * 1024, RT_NT = WS_ROUTE + 404 * 1024;
constexpr size_t WS_XS = WS_BIG;
constexpr size_t WS_Y = 278 * MiB;
constexpr size_t WS_HM = 350 * MiB;
constexpr int MOE_CH = 72;
constexpr size_t WS_SLAB = 440 * MiB;
static_assert(WS_HM + (size_t)72 * 256 * DFE <= WS_SLAB && WS_SLAB + (size_t)8 * 28 * 65536 * 4 <= WS_END, "slab map");
static_assert(WS_XS + (size_t)36864 * 1024 <= WS_Y && WS_Y + (size_t)36864 * 2048 <= WS_HM, "moe map");

__device__ __forceinline__ void norm2_router_phase(Frame& F, const Args& A) {
    const float* mod = (const float*)(F.ws + WS_MOD) + (1 * 2 + 0) * 6144;
    const float* shift = mod + 3 * 1024; const float* scale = mod + 4 * 1024;
    unsigned char* act8 = F.ws + WS_ACT;
    int* EID = (int*)(F.ws + RT_EID); float* GATE = (float*)(F.ws + RT_GATE); int* BCNT = (int*)(F.ws + RT_BCNT);
    LAS int* se = (LAS int*)F.lds;
    LAS float* rw = (LAS float*)(F.lds + 1024);
    for (int i = F.tid; i < 2048; i += NTHREADS) ((LAS f32x4*)rw)[i] = ((const GAS f32x4*)A.in[I_ROUTER])[i];
    __syncthreads();
    const int lane = F.lane;
    f32x4 shl[4], scl[4];
#pragma unroll
    for (int j = 0; j < 4; ++j) { shl[j] = ((const GAS f32x4*)shift)[lane + 64 * j]; scl[j] = ((const GAS f32x4*)scale)[lane + 64 * j] + 1.0f; }
    for (int k = 0; k < 8; ++k) {
        const int tl = F.wave * 8 + k, t = blockIdx.x * 64 + tl;
        const GAS f32x4* xr = (const GAS f32x4*)(A.out + (size_t)t * D) + lane;
        f32x4 v[4]; float s = 0.f;
#pragma unroll
        for (int j = 0; j < 4; ++j) { v[j] = xr[64 * j]; s += (v[j].x * v[j].x + v[j].y * v[j].y) + (v[j].z * v[j].z + v[j].w * v[j].w); }
        const float rstd = 1.0f / sqrtf(wave_sum(s) * (1.f / D) + EPS);
        float lg[8];
#pragma unroll
        for (int e = 0; e < 8; ++e) lg[e] = 0.f;
        GAS unsigned* o8 = (GAS unsigned*)(act8 + (size_t)t * D) + lane;
#pragma unroll
        for (int j = 0; j < 4; ++j) {
            const f32x4 y = v[j] * rstd * scl[j] + shl[j];
            o8[64 * j] = pk_fp8x4(y.x, y.y, y.z, y.w);
            const int c0 = 4 * (lane + 64 * j);
#pragma unroll
            for (int q = 0; q < 4; ++q) {
                const f32x4 r0 = *(const LAS f32x4*)(rw + (c0 + q) * 8), r1 = *(const LAS f32x4*)(rw + (c0 + q) * 8 + 4);
                const float yy = y[q];
                lg[0] += yy * r0.x; lg[1] += yy * r0.y; lg[2] += yy * r0.z; lg[3] += yy * r0.w; lg[4] += yy * r1.x; lg[5] += yy * r1.y; lg[6] += yy * r1.z; lg[7] += yy * r1.w;
            }
        }
#pragma unroll
        for (int e = 0; e < 8; ++e) lg[e] = wave_sum(lg[e]);
        int e0 = 0; float l0 = lg[0];
#pragma unroll
        for (int e = 1; e < 8; ++e) if (lg[e] > l0) { l0 = lg[e]; e0 = e; }
        int e1 = -1; float l1 = -INFINITY;
#pragma unroll
        for (int e = 0; e < 8; ++e) if (e != e0 && lg[e] > l1) { l1 = lg[e]; e1 = e; }
        if (lane == 0) {
            const float g0 = 1.0f / (1.0f + expf(l1 - l0));
            EID[t * 2] = e0; EID[t * 2 + 1] = e1; GATE[t * 2] = g0; GATE[t * 2 + 1] = 1.0f - g0;
            se[tl * 2] = e0; se[tl * 2 + 1] = e1;
        }
    }
    __syncthreads();
    if (F.wave == 0) {
        const int a0 = se[lane * 2], a1 = se[lane * 2 + 1];
#pragma unroll
        for (int e = 0; e < 8; ++e) { const unsigned long long mk = __ballot(a0 == e || a1 == e); if (lane == e) BCNT[blockIdx.x * 8 + e] = __popcll(mk); }
    }
    __syncthreads();
}

__device__ __forceinline__ void moe_assign_phase(Frame& F) {
    const int* EID = (const int*)(F.ws + RT_EID); int* TSLOT = (int*)(F.ws + RT_TSLOT); const int* BCNT = (const int*)(F.ws + RT_BCNT);
    unsigned* TILEE = (unsigned*)(F.ws + RT_TILEE); unsigned* NTL = (unsigned*)(F.ws + RT_NT);
    const unsigned char* act8 = F.ws + WS_ACT; unsigned char* XS = F.ws + WS_XS;
    LAS int* sm = (LAS int*)F.lds;
    const int b = blockIdx.x, lane = F.lane;
    if (F.tid < 8) {
        int tot = 0, mine = 0;
        for (int bb = 0; bb < 256; ++bb) { const int c = __hip_atomic_load(BCNT + bb * 8 + F.tid, RLX_AGENT); if (bb < b) mine += c; tot += c; }
        sm[F.tid] = tot; sm[8 + F.tid] = mine;
    }
    __syncthreads();
    if (F.tid == 0) {
        int ps = 0, nt = 0;
        for (int e = 0; e < 8; ++e) { const int tl = (sm[e] + 255) >> 8; sm[16 + e] = ps; sm[24 + e] = tl; if (b == 0) for (int q = 0; q < tl; ++q) TILEE[nt + q] = (unsigned)e; ps += tl * 256; nt += tl; }
        if (b == 0) *NTL = (unsigned)nt;
    }
    __syncthreads();
    if (F.wave == 0) {
        const int t = b * 64 + lane;
        const int a0 = EID[t * 2], a1 = EID[t * 2 + 1];
        int s0 = 0, s1 = 0;
        const unsigned long long lower = (1ull << lane) - 1ull;
#pragma unroll
        for (int e = 0; e < 8; ++e) {
            const unsigned long long mk = __ballot(a0 == e || a1 == e);
            const int rank = __popcll(mk & lower), slot = sm[16 + e] + sm[8 + e] + rank;
            if (a0 == e) s0 = slot; if (a1 == e) s1 = slot;
        }
        TSLOT[t * 2] = s0; TSLOT[t * 2 + 1] = s1; sm[32 + lane * 2] = s0; sm[33 + lane * 2] = s1;
    }
    __syncthreads();
    for (int q = F.wave; q < 128; q += NWAVES) {
        const int t = b * 64 + (q >> 1), slot = sm[32 + q];
        const GAS u32x4* srcp = (const GAS u32x4*)(act8 + (size_t)t * D); GAS u32x4* dstp = (GAS u32x4*)(XS + (size_t)slot * D);
        dstp[lane] = srcp[lane];
    }
    { const int e = b & 7, cnt = sm[e], first = sm[16 + e] + cnt, npad = sm[24 + e] * 256 - cnt;
      for (int p = (b >> 3) * NWAVES + F.wave; p < npad; p += 32 * NWAVES) { GAS u32x4* dstp = (GAS u32x4*)(XS + (size_t)(first + p) * D); const u32x4 z = (u32x4){0u, 0u, 0u, 0u}; dstp[lane] = z; } }
}

__device__ __forceinline__ f32x4 moe_yrow(const bf16_t* Y, const float* SLAB, int slot, int tail0, int j, int lane) {
    const int tile = slot >> 8;
    if (tile < tail0) { const u32x2 a = ((const GAS u32x2*)(Y + (size_t)slot * D))[lane + 64 * j];
        return (f32x4){bf2f(a.x & 0xffffu), bf2f(a.x >> 16), bf2f(a.y & 0xffffu), bf2f(a.y >> 16)}; }
    const float* p = SLAB + (size_t)(((tile - tail0) * 4 + j) * 7) * 65536 + (size_t)(slot & 255) * 256 + 4 * lane;
    f32x4 s = *(const f32x4*)p;
#pragma unroll
    for (int ks = 1; ks < 7; ++ks) s = s + *(const f32x4*)(p + (size_t)ks * 65536);
    return s;
}
__device__ __forceinline__ void moe_final_phase(Frame& F, const Args& A) {
    const float* mod5 = (const float*)(F.ws + WS_MOD) + (1 * 2 + 0) * 6144 + 5 * 1024;
    const int* TSLOT = (const int*)(F.ws + RT_TSLOT); const float* GATE = (const float*)(F.ws + RT_GATE);
    const bf16_t* Y = (const bf16_t*)(F.ws + WS_Y); const float* SLAB = (const float*)(F.ws + WS_SLAB);
    const float* fng = A.in[I_FNG];
    const int lane = F.lane;
    const int ntl = (int)__builtin_amdgcn_readfirstlane(__hip_atomic_load((unsigned*)(F.ws + RT_NT), RLX_AGENT));
    const int tail0 = (ntl > 128 && ntl - 128 <= 8) ? 128 : (1 << 20);
    f32x4 m5v[4], fgv[4];
#pragma unroll
    for (int j = 0; j < 4; ++j) { m5v[j] = ((const GAS f32x4*)mod5)[lane + 64 * j]; fgv[j] = ((const GAS f32x4*)fng)[lane + 64 * j]; }
    for (int t = F.gw; t < NL; t += F.NGW) {
        const int s0 = TSLOT[t * 2], s1 = TSLOT[t * 2 + 1]; const float g0 = GATE[t * 2], g1 = GATE[t * 2 + 1];
        GAS f32x4* xr = (GAS f32x4*)(A.out + (size_t)t * D) + lane;
        f32x4 v[4]; float s = 0.f;
        if (((s0 >> 8) < tail0) && ((s1 >> 8) < tail0)) {
            const GAS u32x2* y0 = (const GAS u32x2*)(Y + (size_t)s0 * D) + lane; const GAS u32x2* y1 = (const GAS u32x2*)(Y + (size_t)s1 * D) + lane;
#pragma unroll
            for (int j = 0; j < 4; ++j) {
                const f32x4 x = xr[64 * j]; const u32x2 a = y0[64 * j], c = y1[64 * j];
                const f32x4 m5 = m5v[j];
                f32x4 f;
                f.x = g0 * bf2f(a.x & 0xffffu) + g1 * bf2f(c.x & 0xffffu); f.y = g0 * bf2f(a.x >> 16) + g1 * bf2f(c.x >> 16);
                f.z = g0 * bf2f(a.y & 0xffffu) + g1 * bf2f(c.y & 0xffffu); f.w = g0 * bf2f(a.y >> 16) + g1 * bf2f(c.y >> 16);
                v[j] = x + m5 * f;
                s += (v[j].x * v[j].x + v[j].y * v[j].y) + (v[j].z * v[j].z + v[j].w * v[j].w);
            }
        } else {
#pragma unroll
            for (int j = 0; j < 4; ++j) {
                const f32x4 x = xr[64 * j];
                const f32x4 m5 = m5v[j];
                const f32x4 f = moe_yrow(Y, SLAB, s0, tail0, j, lane) * g0 + moe_yrow(Y, SLAB, s1, tail0, j, lane) * g1;
                v[j] = x + m5 * f;
                s += (v[j].x * v[j].x + v[j].y * v[j].y) + (v[j].z * v[j].z + v[j].w * v[j].w);
            }
        }
        const float rstd = 1.0f / sqrtf(wave_sum_l(s, lane) * (1.f / D) + EPS);
#pragma unroll
        for (int j = 0; j < 4; ++j) xr[64 * j] = v[j] * rstd * fgv[j];
    }
}

#define GRID_BAR() do { { unsigned* bp_ = (unsigned*)(F.ws + WS_CTL) + 4096; asm volatile("" : "+s"(bp_)); bar.bar = bp_; } xcd_barrier(bar); TS_STAMP(); F.tid = opq((int)threadIdx.x); F.lane = F.tid & 63; } while (0)

template <int MODE>
__device__ __forceinline__ void ctx_pieces(Frame& F, const bf16_t* A, const bf16_t* Bt, int K, int ncg, void* O, int ldo, const float* base, const float* gate,
                                           int nrg = 16, const unsigned* tile_e = nullptr, int tile0 = 0, size_t estride = 0) {
    const int lane = F.lane, r = lane & 15, g = lane >> 4, wave = F.wave;
    LAS float* red = (LAS float*)F.lds;
    const int npieces = nrg * ncg, kw = K >> 3;
    for (int p = blockIdx.x; p < npieces; p += F.G) {
        const int rg = p % nrg, cg = p / nrg;
        f32x4 acc[4];
#pragma unroll
        for (int n = 0; n < 4; ++n) acc[n] = (f32x4){0.f, 0.f, 0.f, 0.f};
        const bf16_t* ap = A + (size_t)(16 * rg + r) * K + wave * kw + 8 * g;
        size_t eoff = 0;
        if (tile_e) eoff = (size_t)(__builtin_amdgcn_readfirstlane(__hip_atomic_load(tile_e + tile0 + (rg >> 4), __ATOMIC_RELAXED, __HIP_MEMORY_SCOPE_AGENT)) & 7u) * estride;
        const bf16_t* bp = Bt + eoff + (size_t)(64 * cg + r) * K + wave * kw + 8 * g;
        bf16x8 a0 = *(const bf16x8*)ap, b0[4];
#pragma unroll
        for (int n = 0; n < 4; ++n) b0[n] = *(const bf16x8*)(bp + (size_t)(16 * n) * K);
        for (int k = 32; k < kw; k += 32) {
            const bf16x8 a1 = *(const bf16x8*)(ap + k); bf16x8 b1[4];
#pragma unroll
            for (int n = 0; n < 4; ++n) b1[n] = *(const bf16x8*)(bp + (size_t)(16 * n) * K + k);
#pragma unroll
            for (int n = 0; n < 4; ++n) acc[n] = __builtin_amdgcn_mfma_f32_16x16x32_bf16(a0, b0[n], acc[n], 0, 0, 0);
            a0 = a1;
#pragma unroll
            for (int n = 0; n < 4; ++n) b0[n] = b1[n];
        }
#pragma unroll
        for (int n = 0; n < 4; ++n) acc[n] = __builtin_amdgcn_mfma_f32_16x16x32_bf16(a0, b0[n], acc[n], 0, 0, 0);
#pragma unroll
        for (int n = 0; n < 4; ++n)
#pragma unroll
            for (int e = 0; e < 4; ++e) red[wave * 1024 + (4 * g + e) * 64 + 16 * n + r] = acc[n][e];
        __syncthreads();
        for (int idx = F.tid; idx < 1024; idx += NTHREADS) {
            float s = 0.f;
#pragma unroll
            for (int w = 0; w < 8; ++w) s += red[w * 1024 + idx];
            const int row = 16 * rg + (idx >> 6), col = 64 * cg + (idx & 63);
            if (MODE == 0) ((bf16_t*)O)[(size_t)row * ldo + col] = (bf16_t)f2bf(s);
            else ((float*)O)[(size_t)row * 1024 + col] = base[(size_t)row * 1024 + col] + gate[col] * s;
        }
        __syncthreads();
    }
}

#ifndef STOP_AFTER
#define STOP_AFTER 0
#endif
__device__ __forceinline__ void dump_bf16(Frame& F, float* out, const bf16_t* buf, int ld, int ncols) {
    for (int m = F.gw; m < NL; m += F.NGW)
        for (int j = 0; j < 16; ++j) { const int c = F.lane + 64 * j; float s = 0.f; for (int k = 0; c + 1024 * k < ncols; ++k) s += bf2f(buf[(size_t)m * ld + c + 1024 * k]); out[(size_t)m * D + c] = s; }
}
#define STOP_DUMP(n, buf, ld, nc) do { if (layer == 0 && STOP_AFTER == (n)) { dump_bf16(F, args.out, (const bf16_t*)(buf), (ld), (nc)); F.ws = nullptr; return; } } while (0)
template <int layer>
__device__ __forceinline__ void layer_body(Frame& F, const Args& args, XcdBarrier& bar) {
    unsigned char* ws = F.ws;
    float* HC = (float*)(ws + WS_HC);
    const float* MOD = (const float*)(ws + WS_MOD);
        F.tid = opq((int)threadIdx.x); F.lane = F.tid & 63;
        const float* xl = layer == 0 ? args.in[I_X] : args.out;
        const float* xc = layer == 0 ? args.in[I_CTX] : HC;
        const float* modx = MOD + (layer * 2 + 0) * 6144; const float* modc = MOD + (layer * 2 + 1) * 6144;
        norm_phase(F, xl, xc, layer, 0, 1, NT);
        GRID_BAR();
        ctx_pieces<0>(F, (const bf16_t*)(ws + WS_ACT) + (size_t)NL * 1024, (const bf16_t*)(ws + WS_WIN) + (size_t)layer * INP * 1024, 1024, INP / 64, (bf16_t*)(ws + WS_PX) + (size_t)NL * INP, INP, nullptr, nullptr);
        { pg8::DenseSched S{NL / 256, INP / 256, F.G, (int)blockIdx.x, (const char*)(ws + WS_ACT), (const char*)(ws + WS_WIN) + (size_t)layer * INP * 1024 * 2, (size_t)256 * 1024 * 2};
          pg8::EpiStoreBf16 E{(bf16_t*)(ws + WS_PX), INP};
          pg8::gemm_phase(F.lds, 1024, S, E); }
        GRID_BAR();
        STOP_DUMP(2, ws + WS_PX, INP, INC);
        prep_phase(F, args, layer);
        GRID_BAR();
        STOP_DUMP(3, ws + WS_QD, 384, 384);
        STOP_DUMP(33, ws + WS_QD + QKV_STRIDE, 384, 384);
        dn_chunk_phase(F);
        GRID_BAR();
        STOP_DUMP(4, ws + WS_DN, 1024, 1024);
        STOP_DUMP(44, ws + WS_DN + DN_STRIDE, 1024, 1024);
        STOP_DUMP(45, ws + WS_DN + 2 * DN_STRIDE, 1024, 1024);
        scan_x1_phase(F, args, layer);
        GRID_BAR();
        scan_x3_phase(F, args, layer);
        GRID_BAR();
        STOP_DUMP(5, ws + WS_DN + 3 * DN_STRIDE, 1024, 1024);
        STOP_DUMP(55, ws + WS_DN + 4 * DN_STRIDE, 1024, 1024);
        STOP_DUMP(56, ws + WS_ACT, 1024, 1024);
        dn_out_phase(F, args, layer);
        GRID_BAR();
        STOP_DUMP(6, ws + WS_ACT, 1024, 1024);
        if (layer == 0) ctx_pieces<1>(F, (const bf16_t*)(ws + WS_ACT) + (size_t)NL * 1024, (const bf16_t*)(ws + WS_WOUT), 1024, 16, HC, 1024, xc, modc + 2 * 1024);
        { pg8::DenseSched S{NL / 256, 4, F.G, (int)blockIdx.x, (const char*)(ws + WS_ACT), (const char*)(ws + WS_WOUT) + (size_t)layer * 1024 * 1024 * 2, (size_t)256 * 1024 * 2};
          pg8::EpiResid E{xl, args.out, modx + 2 * 1024, xc, HC, modc + 2 * 1024, NL / 256};
          pg8::gemm_phase(F.lds, 1024, S, E); }
        GRID_BAR();
        if (layer == 0 && STOP_AFTER == 7) { F.ws = nullptr; return; }
        if (layer == 0) {
            norm_phase(F, args.out, HC, 0, 3, 4, NT);
            GRID_BAR();
            { pg8::DenseSched S{NT / 256, 2 * DFF / 256, F.G, (int)blockIdx.x, (const char*)(ws + WS_ACT), (const char*)(ws + WS_WGU), (size_t)256 * 1024 * 2};
              pg8::EpiSwiGLU E{(bf16_t*)(ws + WS_BIG), DFF};
              pg8::gemm_phase(F.lds, 1024, S, E); }
            GRID_BAR();
            ctx_pieces<1>(F, (const bf16_t*)(ws + WS_BIG) + (size_t)NL * DFF, (const bf16_t*)(ws + WS_WDN), DFF, 16, HC, 1024, HC, modc + 5 * 1024);
            { pg8::DenseSched S{NL / 256, 4, F.G, (int)blockIdx.x, (const char*)(ws + WS_BIG), (const char*)(ws + WS_WDN), (size_t)256 * DFF * 2};
              pg8::EpiResid E{args.out, args.out, modx + 5 * 1024, HC, HC, modc + 5 * 1024, NL / 256};
              pg8::gemm_phase(F.lds, DFF, S, E); }
            GRID_BAR();
            if (STOP_AFTER == 9) { F.ws = nullptr; return; }
        } else {
            norm2_router_phase(F, args);
            GRID_BAR();
            moe_assign_phase(F);
            GRID_BAR();
            const int ntl = (int)__builtin_amdgcn_readfirstlane(__hip_atomic_load((unsigned*)(ws + RT_NT), RLX_AGENT));
#pragma unroll 1
            for (int t0 = 0; t0 < ntl; t0 += 64) {
                const int left = ntl - t0; const int nM = left > MOE_CH ? 64 : left;
                const int ntail = (nM > 64 && nM - 64 <= 8) ? nM - 64 : 0, nG2 = nM - ntail;
                { pg8::MoeSched S{nM, 2 * DFE / 256, F.G, (int)blockIdx.x, (const char*)(ws + WS_XS) + (size_t)t0 * 256 * 1024, (const char*)(ws + WS_MGU), (size_t)256 * 1024, (size_t)2 * DFE * 1024, (const unsigned*)(ws + RT_TILEE), t0, 0};
                  pg8::EpiSwiGLU8 E{ws + WS_HM, DFE, 1.0f / MOE_WSCALE, MOE_HSCALE};
                  pg8::gemm_phase<true>(F.lds, 512, S, E); }
                GRID_BAR();
                { pg8::MoeSched S{nG2, 4, F.G, (int)blockIdx.x, (const char*)(ws + WS_HM), (const char*)(ws + WS_MDN), (size_t)256 * DFE, (size_t)1024 * DFE, (const unsigned*)(ws + RT_TILEE), t0, t0};
                  pg8::EpiStoreBf16 E{(bf16_t*)(ws + WS_Y), 1024, 1.0f / (MOE_WSCALE * MOE_HSCALE)};
                  pg8::gemm_phase<true>(F.lds, DFE / 2, S, E); }
                if (ntail > 0) {
                    pg8::MoeTailSched S{ntail, F.G, (int)((blockIdx.x + 128) % F.G), (const char*)(ws + WS_HM) + (size_t)nG2 * 256 * DFE, (const char*)(ws + WS_MDN), (size_t)256 * DFE, (size_t)1024 * DFE, (const unsigned*)(ws + RT_TILEE), t0 + nG2, (size_t)512};
                    pg8::EpiSlab E{(float*)(ws + WS_SLAB), 1.0f / (MOE_WSCALE * MOE_HSCALE)};
                    pg8::gemm_phase<true>(F.lds, DFE / 2, S, E, 4);
                }
                GRID_BAR();
                if (left <= MOE_CH) break;
            }
            moe_final_phase(F, args);
        }
    }

__global__ void __launch_bounds__(NTHREADS, 2) fwd_kernel(Args args) {
    extern __shared__ __attribute__((aligned(16))) unsigned char lds[];
    Frame F;
    F.lds = (LAS unsigned char*)lds;
    F.tid = threadIdx.x; F.lane = F.tid & 63; F.wave = __builtin_amdgcn_readfirstlane(F.tid >> 6);
    F.G = gridDim.x; { const int bx = blockIdx.x; F.vcu = (F.G % 8 == 0) ? (bx % 8) * (F.G / 8) + bx / 8 : bx; }
    F.gw = F.vcu * NWAVES + F.wave; F.NGW = F.G * NWAVES;
    F.ws = args.ws;
    volatile LAS unsigned* MISC = (volatile LAS unsigned*)(F.lds + MISC_OFF);
    for (int u = F.tid; u < (LDS_BYTES - MISC_OFF) / 4; u += NTHREADS) ((LAS unsigned*)(F.lds + MISC_OFF))[u] = 0u;
    __syncthreads();
    XcdBarrier bar = xcd_barrier_post((unsigned*)(F.ws + WS_CTL) + 4096, MISC + 8);
    TS_STAMP();

    unsigned char* ws = F.ws;
    float* HC = (float*)(ws + WS_HC);
    const float* MOD = (const float*)(ws + WS_MOD);
#ifdef DIAG_ZERO
    { GAS u32x4* p = (GAS u32x4*)(F.ws + WS_MOD); const size_t n16 = (WS_END - WS_MOD) / 16; const u32x4 z = (u32x4){0u, 0u, 0u, 0u};
      for (size_t i = (size_t)blockIdx.x * NTHREADS + F.tid; i < n16; i += (size_t)F.G * NTHREADS) p[i] = z; }
    GRID_BAR();
#endif
    p0_prologue(F, args);
    GRID_BAR();
    layer_body<0>(F, args, bar);
    if (F.ws == nullptr) return;
    layer_body<1>(F, args, bar);
#ifdef TS_A
    TS_STAMP();
    if (blockIdx.x == 0 && threadIdx.x == 0) {
        volatile LAS unsigned* M_ = (volatile LAS unsigned*)(F.lds + MISC_OFF);
        const unsigned long long ta = ((unsigned long long)M_[17 + 2 * (TS_A)] << 32) | M_[16 + 2 * (TS_A)], tb = ((unsigned long long)M_[17 + 2 * (TS_B)] << 32) | M_[16 + 2 * (TS_B)];
        const unsigned long long dl = (tb - ta) * (TS_MUL), t0 = __builtin_amdgcn_s_memrealtime();
        while (__builtin_amdgcn_s_memrealtime() - t0 < dl) __builtin_amdgcn_s_sleep(8);
    }
#endif
}

extern "C" void kernel_launch(void* const* d_in, const int* in_sizes, int n_in, void* d_out, int out_size, void* d_ws, size_t ws_size, hipStream_t stream) {
    static int grid = 0;
    if (grid == 0) {
        if (n_in != 22 || out_size != NL * D || ws_size < WS_END) { fprintf(stderr, "kernel_launch: unexpected shapes (n_in %d out %d ws %zu)\n", n_in, out_size, ws_size); grid = -1; return; }
        int dev = 0, cus = 0;
        if (hipGetDevice(&dev) != hipSuccess || hipDeviceGetAttribute(&cus, hipDeviceAttributeMultiprocessorCount, dev) != hipSuccess) { grid = -1; return; }
        if (hipFuncSetAttribute((const void*)fwd_kernel, hipFuncAttributeMaxDynamicSharedMemorySize, LDS_BYTES) != hipSuccess) { fprintf(stderr, "kernel_launch: hipFuncSetAttribute failed\n"); grid = -1; return; }
        int per_cu = 0;
        (void)hipOccupancyMaxActiveBlocksPerMultiprocessor(&per_cu, (const void*)fwd_kernel, NTHREADS, LDS_BYTES);
        (void)hipGetLastError();
        grid = cus;
    }
    if (grid < 0) return;
    (void)hipMemsetAsync((char*)d_ws + WS_CTL, 0, CTL_ZERO_BYTES, stream);
    Args a{};
    for (int i = 0; i < 22; ++i) a.in[i] = (const float*)d_in[i];
    a.out = (float*)d_out; a.ws = (unsigned char*)d_ws;
    hipLaunchKernelGGL(fwd_kernel, dim3(grid), dim3(NTHREADS), LDS_BYTES, stream, a);
}
```

```cpp
#define STOP_AFTER 0
#include <hip/hip_runtime.h>
#include <cstdint>
#include <cstdio>

#define GAS __attribute__((address_space(1)))
#define LAS __attribute__((address_space(3)))
typedef unsigned short bf16_t;
typedef short bf16x8 __attribute__((ext_vector_type(8)));
typedef short bf16x4 __attribute__((ext_vector_type(4)));
typedef float f32x4 __attribute__((ext_vector_type(4)));
typedef float f32x2 __attribute__((ext_vector_type(2)));
typedef unsigned u32x4 __attribute__((ext_vector_type(4)));
typedef unsigned u32x2 __attribute__((ext_vector_type(2)));
typedef GAS unsigned gu32;

constexpr int D = 1024, NL = 16384, NC = 256, NT = NL + NC;
constexpr int INC = 2968, INP = 3072;
constexpr int C_CB = 0, C_CC = 256, C_CH = 512, C_DQ = 768, C_DK = 1152, C_DV = 1536, C_DZ = 1920, C_DA = 2304, C_DB = 2316, C_AQ = 2328, C_AK = 2712, C_AV = 2840;
constexpr int DFF = 2816, NEXP = 8, DFE = 3584;
constexpr int NWAVES = 8, NTHREADS = 512;
constexpr float EPS = 1e-6f;

constexpr size_t MiB = 1u << 20;
constexpr size_t WS_CTL = 0, CTL_ZERO_BYTES = 1 * MiB;
constexpr size_t WS_MOD = 1 * MiB;
constexpr size_t WS_ROPE = 1 * MiB + 128 * 1024;
constexpr size_t WS_HC = 2 * MiB;
constexpr size_t WS_G = 3 * MiB;
constexpr size_t WS_BETA = 4 * MiB;
constexpr size_t WS_ROUTE = 5 * MiB;
constexpr size_t WS_WIN = 8 * MiB;
constexpr size_t WS_WOUT = 20 * MiB;
constexpr size_t WS_WGU = 24 * MiB;
constexpr size_t WS_WDN = 35 * MiB;
constexpr size_t WS_MGU = 41 * MiB;
constexpr size_t WS_MDN = 153 * MiB;
constexpr size_t WS_ACT = 209 * MiB;
constexpr size_t WS_BIG = 242 * MiB;
constexpr size_t WS_PX = WS_BIG;
constexpr size_t WS_QD = 340 * MiB;
constexpr size_t QKV_STRIDE = 12 * MiB + 512 * 1024;
constexpr size_t WS_DN = 378 * MiB;
constexpr size_t DN_STRIDE = 25 * MiB;
constexpr size_t WS_END = 512 * MiB;
static_assert(WS_QD + 3 * QKV_STRIDE <= WS_DN && WS_DN + 5 * DN_STRIDE <= WS_END, "ws map");
static_assert((size_t)NT * INP * 2 <= WS_QD - WS_PX && (size_t)NT * 384 * 2 <= QKV_STRIDE && (size_t)3120 * 8192 <= DN_STRIDE, "ws map 2");

constexpr int SCR_BYTES = 139264;
constexpr int MISC_OFF = SCR_BYTES;
constexpr int LDS_BYTES = 147456;

#define RLX_AGENT __ATOMIC_RELAXED, __HIP_MEMORY_SCOPE_AGENT
#define LDS_WAIT() asm volatile("s_waitcnt lgkmcnt(0)" ::: "memory")
#define VM_WAIT() asm volatile("s_waitcnt vmcnt(0)" ::: "memory")

__device__ __forceinline__ unsigned f2bf(float f) { unsigned u = __builtin_bit_cast(unsigned, f); return (u + 0x7fffu + ((u >> 16) & 1u)) >> 16; }
__device__ __forceinline__ unsigned pk2(float lo, float hi) { return f2bf(lo) | (f2bf(hi) << 16); }
__device__ __forceinline__ float bf2f(unsigned h) { return __builtin_bit_cast(float, h << 16); }
__device__ __forceinline__ unsigned pk_fp8x4(float a, float b, float c, float d) {
    a = __builtin_fminf(__builtin_fmaxf(a, -448.f), 448.f); b = __builtin_fminf(__builtin_fmaxf(b, -448.f), 448.f);
    c = __builtin_fminf(__builtin_fmaxf(c, -448.f), 448.f); d = __builtin_fminf(__builtin_fmaxf(d, -448.f), 448.f);
    int p = __builtin_amdgcn_cvt_pk_fp8_f32(a, b, 0, false); p = __builtin_amdgcn_cvt_pk_fp8_f32(c, d, p, true); return (unsigned)p;
}
__device__ __forceinline__ float silu_f(float x) { return x * __builtin_amdgcn_rcpf(1.f + __expf(-x)); }
__device__ __forceinline__ int opq(int v) { asm volatile("" : "+v"(v)); return v; }
template <int CTRL> __device__ __forceinline__ float dpp_all(float v) { return __builtin_bit_cast(float, __builtin_amdgcn_update_dpp(0, __builtin_bit_cast(int, v), CTRL, 0xF, 0xF, true)); }
template <int CTRL, int RM> __device__ __forceinline__ float dpp_rows(float v) { return __builtin_bit_cast(float, __builtin_amdgcn_update_dpp(0, __builtin_bit_cast(int, v), CTRL, RM, 0xF, false)); }
__device__ __forceinline__ float sum8(float v) { v += dpp_all<0xB1>(v); v += dpp_all<0x4E>(v); v += dpp_all<0x141>(v); return v; }
__device__ __forceinline__ float wave_sum(float v) {
    v = sum8(v); v += dpp_all<0x140>(v);
    v += dpp_rows<0x142, 0xA>(v);
    v += dpp_rows<0x143, 0xC>(v);
    return __builtin_bit_cast(float, __builtin_amdgcn_readlane(__builtin_bit_cast(int, v), 63));
}
__device__ __forceinline__ float wave_sum_l(float v, int) { return wave_sum(v); }

#define XB_TMO      128
#define XB_XCNT(j)  (256  + 64 * (j))
#define XB_XSUB(j)  (1280 + 64 * (j))
#define XB_XGEN(j)  (2304 + 64 * (j))
#define XB_TOP      3328
#define XB_TOPGEN   3392
#define XCD_BAR_WORDS 3456
#define XB_SPIN_CAP (1u << 22)
__device__ __forceinline__ unsigned xb_ld(unsigned* p)              { return __hip_atomic_load(p, __ATOMIC_RELAXED, __HIP_MEMORY_SCOPE_AGENT); }
__device__ __forceinline__ unsigned xb_add(unsigned* p, unsigned v) { return __hip_atomic_fetch_add(p, v, __ATOMIC_RELAXED, __HIP_MEMORY_SCOPE_AGENT); }
__device__ __forceinline__ unsigned xb_xcc_id() { return (unsigned)__builtin_amdgcn_s_getreg((3 << 11) | 20) & 0xFu; }
#define XB_SPIN(cond, bar) do { unsigned _sp = 0; while (cond) { __builtin_amdgcn_s_sleep(1); \
    if ((++_sp & 255u) == 0u) { if (xb_ld(&(bar)[XB_TMO])) break; if (_sp > XB_SPIN_CAP) { atomicAdd(&(bar)[XB_TMO], 1u); break; } } } } while (0)
struct XcdBarrier { unsigned* bar; unsigned x; volatile LAS unsigned* st; };
__device__ __forceinline__ XcdBarrier xcd_barrier_post(unsigned* bar, volatile LAS unsigned* st) {
    XcdBarrier b; b.bar = bar; b.x = xb_xcc_id(); b.st = st;
    if (threadIdx.x == 0) (void)xb_add(&bar[XB_XCNT(b.x)], 1u);
    return b;
}
__device__ __forceinline__ void xcd_barrier_complete(unsigned* bar, unsigned x, unsigned& nloc, unsigned& nx) {
    const unsigned G = gridDim.x * gridDim.y * gridDim.z;
    unsigned sum, cnt, mine, sp = 0u;
    for (;;) {
        sum = 0u; cnt = 0u; mine = 0u;
#pragma unroll
        for (unsigned j = 0; j < 16; ++j) { const unsigned c = xb_ld(&bar[XB_XCNT(j)]); sum += c; cnt += (c > 0u) ? 1u : 0u; mine = (j == x) ? c : mine; }
        if (sum == G) break;
        __builtin_amdgcn_s_sleep(1);
        if ((++sp & 255u) == 0u) { if (xb_ld(&bar[XB_TMO])) break; if (sp > XB_SPIN_CAP) { atomicAdd(&bar[XB_TMO], 1u); break; } }
    }
    nloc = mine > 0u ? mine : 1u; nx = cnt > 0u ? cnt : 1u;
}
__device__ __forceinline__ void xcd_barrier(const XcdBarrier& b) {
    asm volatile("s_waitcnt vmcnt(0)" ::: "memory");
    __syncthreads();
    if (threadIdx.x == 0) {
        unsigned* bar = b.bar;
        __builtin_amdgcn_s_waitcnt(0);
        unsigned nloc = b.st[0], nx = b.st[1];
        if (nloc == 0u) { xcd_barrier_complete(bar, b.x, nloc, nx); b.st[0] = nloc; b.st[1] = nx; }
        const unsigned old = xb_add(&bar[XB_XSUB(b.x)], 1u);
        const unsigned gen = old / nloc;
        if (old + 1u == (gen + 1u) * nloc) {
            __builtin_amdgcn_fence(__ATOMIC_RELEASE, "agent");
            asm volatile("s_waitcnt vmcnt(0)" ::: "memory");
            const unsigned og = xb_add(&bar[XB_TOP], 1u);
            const unsigned tg = og / nx;
            if (og + 1u == (tg + 1u) * nx) xb_add(&bar[XB_TOPGEN], 1u);
            else XB_SPIN(xb_ld(&bar[XB_TOPGEN]) == tg, bar);
            __builtin_amdgcn_fence(__ATOMIC_ACQUIRE, "agent");
            xb_add(&bar[XB_XGEN(b.x)], 1u);
            asm volatile("s_waitcnt vmcnt(0)" ::: "memory");
        } else {
            XB_SPIN(xb_ld(&bar[XB_XGEN(b.x)]) == gen, bar);
            __builtin_amdgcn_fence(__ATOMIC_ACQUIRE, "agent");
            asm volatile("s_waitcnt vmcnt(0)" ::: "memory");
        }
    }
    __syncthreads();
}

#ifdef TS_A
#define TS_STAMP() do { if (blockIdx.x == 0 && threadIdx.x == 0) { volatile LAS unsigned* M_ = (volatile LAS unsigned*)(F.lds + MISC_OFF); const unsigned k_ = M_[12]; const unsigned long long t_ = __builtin_amdgcn_s_memrealtime(); M_[16 + 2 * k_] = (unsigned)t_; M_[17 + 2 * k_] = (unsigned)(t_ >> 32); M_[12] = k_ + 1; } } while (0)
#else
#define TS_STAMP() do {} while (0)
#endif
struct Args { const float* in[22]; float* out; unsigned char* ws; };
enum { I_X = 0, I_C, I_CTX, I_CCTX, I_WMOD, I_BMOD, I_WIN, I_WOUT, I_CONVW, I_DNCONVW, I_ALOG, I_DTB, I_NORMG, I_SINK, I_FG, I_FU, I_FD, I_ROUTER, I_MG, I_MU, I_MD, I_FNG };
struct Frame {
    LAS unsigned char* lds;
    int tid, lane, wave, vcu, G, gw, NGW;
    unsigned char* ws;
};

struct P0Item { const float* src; unsigned char* dst; int N, K, n0, k0, mode, f8; };
__device__ __forceinline__ int p0_drow(int ng, int mode) { return mode == 0 ? ng : (ng >> 2) * 8 + (mode == 2 ? 4 : 0) + (ng & 3); }
constexpr float MOE_WSCALE = 64.0f, MOE_HSCALE = 8.0f;
__device__ __forceinline__ void p0_prologue(Frame& F, const Args& A) {
    if (blockIdx.x < 192) {
        LAS float* sc = (LAS float*)F.lds;
        for (int i = F.tid; i < 1024; i += NTHREADS) { sc[i] = silu_f(A.in[I_C][i]); sc[1024 + i] = silu_f(A.in[I_CCTX][i]); }
        __syncthreads();
        const int l = blockIdx.x / 96, cg = blockIdx.x % 96;
        const float* W = A.in[I_WMOD] + (size_t)l * 1024 * 6144 + cg * 64 + F.lane;
        float ax = 0.f, ac = 0.f;
        const int kb = F.wave * 128;
#pragma unroll 32
        for (int k = 0; k < 128; ++k) { const float wv = W[(size_t)(kb + k) * 6144]; ax += sc[kb + k] * wv; ac += sc[1024 + kb + k] * wv; }
        LAS float* red = sc + 2048;
        red[F.wave * 64 + F.lane] = ax; red[512 + F.wave * 64 + F.lane] = ac;
        __syncthreads();
        if (F.wave == 0) {
            float sx = 0.f, sc2 = 0.f;
#pragma unroll
            for (int w = 0; w < 8; ++w) { sx += red[w * 64 + F.lane]; sc2 += red[512 + w * 64 + F.lane]; }
            const float b = A.in[I_BMOD][l * 6144 + cg * 64 + F.lane];
            float* mod = (float*)(F.ws + WS_MOD);
            mod[(l * 2 + 0) * 6144 + cg * 64 + F.lane] = sx + b;
            mod[(l * 2 + 1) * 6144 + cg * 64 + F.lane] = sc2 + b;
        }
        __syncthreads();
    } else if (blockIdx.x == 192) {
        float* rope = (float*)(F.ws + WS_ROPE);
        for (int i = F.tid; i < 256 * 16; i += NTHREADS) {
            const int pos = i >> 4, f = i & 15;
            const float inv = powf(10000.0f, -(float)(2 * f) / 32.0f);
            const float ang = (float)pos * inv;
            rope[2 * i] = cosf(ang); rope[2 * i + 1] = sinf(ang);
        }
    }
    LAS float* tile = (LAS float*)F.lds;
    constexpr int N_WIN = 2 * 8 * 12, N_WOUT = 2 * 8 * 4, N_FG = 8 * 11, N_FD = 22 * 4, N_MG = 8 * 8 * 14, N_MD = 8 * 28 * 4;
    constexpr int NITEMS = N_WIN + N_WOUT + 2 * N_FG + N_FD + 2 * N_MG + N_MD;
    auto decode = [&](int r) -> P0Item {
        P0Item t; t.f8 = 0; t.mode = 0;
        if (r < N_WIN) { const int l = r / 96, q = r % 96; t.src = A.in[I_WIN] + (size_t)l * 1024 * INC; t.N = INC; t.K = 1024; t.dst = F.ws + WS_WIN + (size_t)l * INP * 1024 * 2; t.k0 = 128 * (q / 12); t.n0 = 256 * (q % 12); return t; } r -= N_WIN;
        if (r < N_WOUT) { const int l = r / 32, q = r % 32; t.src = A.in[I_WOUT] + (size_t)l * 1024 * 1024; t.N = 1024; t.K = 1024; t.dst = F.ws + WS_WOUT + (size_t)l * 1024 * 1024 * 2; t.k0 = 128 * (q / 4); t.n0 = 256 * (q % 4); return t; } r -= N_WOUT;
        if (r < 2 * N_FG) { const int u = r >= N_FG; if (u) r -= N_FG; t.src = A.in[u ? I_FU : I_FG]; t.N = DFF; t.K = 1024; t.dst = F.ws + WS_WGU; t.mode = 1 + u; t.k0 = 128 * (r / 11); t.n0 = 256 * (r % 11); return t; } r -= 2 * N_FG;
        if (r < N_FD) { t.src = A.in[I_FD]; t.N = 1024; t.K = DFF; t.dst = F.ws + WS_WDN; t.k0 = 128 * (r / 4); t.n0 = 256 * (r % 4); return t; } r -= N_FD;
        t.f8 = 1;
        if (r < 2 * N_MG) { const int u = r >= N_MG; if (u) r -= N_MG; const int e = r / 112, q = r % 112; t.src = A.in[u ? I_MU : I_MG] + (size_t)e * 1024 * DFE; t.N = DFE; t.K = 1024; t.dst = F.ws + WS_MGU + (size_t)e * 2 * DFE * 1024; t.mode = 1 + u; t.k0 = 128 * (q / 14); t.n0 = 256 * (q % 14); return t; } r -= 2 * N_MG;
        { const int e = r / 112, q = r % 112; t.src = A.in[I_MD] + (size_t)e * DFE * 1024; t.N = 1024; t.K = DFE; t.dst = F.ws + WS_MDN + (size_t)e * 1024 * DFE; t.k0 = 128 * (q / 4); t.n0 = 256 * (q % 4); return t; }
    };
    volatile LAS unsigned* MQ = (volatile LAS unsigned*)(F.lds + MISC_OFF) + 14;
    unsigned* qctr = (unsigned*)(F.ws + WS_CTL) + 65536;
    unsigned tk = 0;
    if (F.tid == 0) { tk = __hip_atomic_fetch_add(qctr, 1u, __ATOMIC_RELAXED, __HIP_MEMORY_SCOPE_AGENT); *MQ = tk; }
    __syncthreads();
    int it = (int)*MQ;
    const int c = F.lane & 7, nn = F.lane >> 3;
    while (it < NITEMS) {
        if (F.tid == 0) tk = __hip_atomic_fetch_add(qctr, 1u, __ATOMIC_RELAXED, __HIP_MEMORY_SCOPE_AGENT);
        const P0Item t = decode(it);
        {
            const int gcol = t.n0 + 4 * (F.lane ^ F.wave);
            const float* sp = t.src + (size_t)(t.k0 + 16 * F.wave) * t.N + (gcol < t.N ? gcol : 0);
            LAS float* dp = tile + (16 * F.wave) * 256;
#pragma unroll
            for (int i = 0; i < 16; ++i)
                __builtin_amdgcn_global_load_lds((const unsigned*)(sp + (size_t)i * t.N), (LAS unsigned*)(dp + i * 256), 16, 0, 0);
        }
        VM_WAIT();
        __syncthreads();
#pragma unroll
        for (int q4 = 0; q4 < 4; ++q4) {
            const int nl = 32 * F.wave + 8 * q4 + nn, ng = t.n0 + nl;
            const LAS float* sp = tile + (16 * c) * 256 + 4 * ((nl >> 2) ^ c) + (nl & 3);
            float v[16];
#pragma unroll
            for (int j = 0; j < 16; ++j) v[j] = sp[j * 256];
            if (t.f8) {
                u32x4 o;
                o.x = pk_fp8x4(v[0] * MOE_WSCALE, v[1] * MOE_WSCALE, v[2] * MOE_WSCALE, v[3] * MOE_WSCALE);
                o.y = pk_fp8x4(v[4] * MOE_WSCALE, v[5] * MOE_WSCALE, v[6] * MOE_WSCALE, v[7] * MOE_WSCALE);
                o.z = pk_fp8x4(v[8] * MOE_WSCALE, v[9] * MOE_WSCALE, v[10] * MOE_WSCALE, v[11] * MOE_WSCALE);
                o.w = pk_fp8x4(v[12] * MOE_WSCALE, v[13] * MOE_WSCALE, v[14] * MOE_WSCALE, v[15] * MOE_WSCALE);
                *(GAS u32x4*)(t.dst + (size_t)p0_drow(ng, t.mode) * t.K + t.k0 + 16 * c) = o;
            } else {
                u32x4 o0, o1;
                o0.x = pk2(v[0], v[1]); o0.y = pk2(v[2], v[3]); o0.z = pk2(v[4], v[5]); o0.w = pk2(v[6], v[7]);
                o1.x = pk2(v[8], v[9]); o1.y = pk2(v[10], v[11]); o1.z = pk2(v[12], v[13]); o1.w = pk2(v[14], v[15]);
                if (ng >= t.N) { o0 = u32x4{0u, 0u, 0u, 0u}; o1 = o0; }
                GAS u32x4* op = (GAS u32x4*)(t.dst + ((size_t)p0_drow(ng, t.mode) * t.K + t.k0 + 16 * c) * 2);
                op[0] = o0; op[1] = o1;
            }
        }
        LDS_WAIT();
        if (F.tid == 0) *MQ = tk;
        __syncthreads();
        it = (int)*MQ;
    }
}

__device__ __forceinline__ void norm_mod_row(const float* xrow, const f32x4 (&sh)[4], const f32x4 (&sc1)[4], bf16_t* orow, int lane) {
    const GAS f32x4* xr = (const GAS f32x4*)xrow + lane;
    f32x4 v[4]; float s = 0.f;
#pragma unroll
    for (int j = 0; j < 4; ++j) { v[j] = xr[64 * j]; s += (v[j].x * v[j].x + v[j].y * v[j].y) + (v[j].z * v[j].z + v[j].w * v[j].w); }
    const float rstd = 1.0f / sqrtf(wave_sum(s) * (1.f / D) + EPS);
    GAS u32x2* o8 = (GAS u32x2*)orow + lane;
#pragma unroll
    for (int j = 0; j < 4; ++j) {
        const f32x4 y = v[j] * rstd * sc1[j] + sh[j];
        u32x2 w; w.x = pk2(y.x, y.y); w.y = pk2(y.z, y.w); o8[64 * j] = w;
    }
}
__device__ __forceinline__ void norm_phase(Frame& F, const float* xl, const float* xc, int layer, int s_shift, int s_scale, int nrows) {
    const float* mod = (const float*)(F.ws + WS_MOD);
    const float* mx = mod + (layer * 2 + 0) * 6144; const float* mc = mod + (layer * 2 + 1) * 6144;
    bf16_t* act = (bf16_t*)(F.ws + WS_ACT);
    f32x4 shl[4], scl[4];
#pragma unroll
    for (int j = 0; j < 4; ++j) { shl[j] = ((const GAS f32x4*)(mx + s_shift * 1024))[F.lane + 64 * j]; scl[j] = ((const GAS f32x4*)(mx + s_scale * 1024))[F.lane + 64 * j] + 1.0f; }
    for (int m = F.gw; m < nrows; m += F.NGW) {
        if (m < NL) norm_mod_row(xl + (size_t)m * D, shl, scl, act + (size_t)m * D, F.lane);
        else { f32x4 shc[4], scc[4];
#pragma unroll
            for (int j = 0; j < 4; ++j) { shc[j] = ((const GAS f32x4*)(mc + s_shift * 1024))[F.lane + 64 * j]; scc[j] = ((const GAS f32x4*)(mc + s_scale * 1024))[F.lane + 64 * j] + 1.0f; }
            norm_mod_row(xc + (size_t)(m - NL) * D, shc, scc, act + (size_t)m * D, F.lane); }
    }
}

namespace pg8 {
typedef int v8i __attribute__((ext_vector_type(8)));
constexpr int BM = 256, BK = 64, HALF = 128, HTB = HALF * BK * 2, STAGE_BYTES = 8 * HTB, NXCD = 8, WGM = 8;
__host__ __device__ __forceinline__ int lds_byte(int r, int c) { const int st = (r >> 4) * 2 + (c >> 5), rr = r & 15, cc = c & 31, ob = rr * 64 + cc * 2; return st * 1024 + (ob ^ (((ob >> 9) & 1) << 5)); }
__host__ __device__ __forceinline__ void stage_rc(int b, int& R, int& C) { const int st = b / 1024, sb = b % 1024, swz = sb ^ (((sb >> 9) & 1) << 5); R = (st >> 1) * 16 + swz / 64; C = (st & 1) * 32 + (swz % 64) / 2; }
__host__ __device__ __forceinline__ int perm32(int rho) { const int n = rho >> 4, i = rho & 15; return 8 * (i >> 2) + 4 * n + (i & 3); }
struct Unit { int pm, pn; const char* a; const char* b; };
typedef __bf16 bf16x2_t __attribute__((ext_vector_type(2)));
__device__ __forceinline__ unsigned cvt_pk_bf16(float lo, float hi) { f32x2 v = {lo, hi}; bf16x2_t b = __builtin_convertvector(v, bf16x2_t); return __builtin_bit_cast(unsigned, b); }

__device__ __forceinline__ bool tile_order(int i, int G, int c, int nM, int nN, int& pm, int& pn) {
    const int nwg = nM * nN; const long L = (long)i * G + c; if (L >= nwg) return false;
    int wgid = (int)L; { const int q = nwg / NXCD, r = nwg % NXCD, xcd = wgid % NXCD, off = wgid / NXCD; wgid = (xcd < r ? xcd * (q + 1) : r * (q + 1) + (xcd - r) * q) + off; }
    const int nig = WGM * nN, gid = wgid / nig, fm = gid * WGM, gsz = (nM - fm) < WGM ? (nM - fm) : WGM;
    pm = fm + ((wgid % nig) % gsz); pn = (wgid % nig) / gsz; return true;
}
struct DenseSched {
    int nM, nN, G, c; const char* A; const char* B; size_t tstep;
    __device__ __forceinline__ bool next(int i, Unit& u) const {
        int pm, pn; if (!tile_order(i, G, c, nM, nN, pm, pn)) return false;
        u.pm = pm; u.pn = pn; u.a = A + (size_t)pm * tstep; u.b = B + (size_t)pn * tstep; return true;
    }
};
struct MoeSched {
    int nM, nN, G, c; const char* A; const char* B; size_t tstep, estride; const unsigned* tile_e; int t0, pm_off;
    __device__ __forceinline__ bool next(int i, Unit& u) const {
        int pm, pn; if (!tile_order(i, G, c, nM, nN, pm, pn)) return false;
        const unsigned e = __builtin_amdgcn_readfirstlane(__hip_atomic_load(tile_e + t0 + pm, __ATOMIC_RELAXED, __HIP_MEMORY_SCOPE_AGENT)) & 7u;
        u.pm = pm + pm_off; u.pn = pn; u.a = A + (size_t)pm * tstep; u.b = B + (size_t)e * estride + (size_t)pn * tstep; return true;
    }
};

using ::pk_fp8x4;
struct EpiSwiGLU8 {
    static constexpr bool PERM = true;
    unsigned char* H; int ldh; float ascale, hs;
    __device__ __forceinline__ void operator()(const f32x4 (&acc)[2][2][4][2], const Unit& u, int wr, int wc, int fr, int fq) const {
        const int row0 = u.pm * BM + wr * 64 + fr, col0 = u.pn * 128 + wc * 16 + 4 * fq;
#pragma unroll
        for (int ai = 0; ai < 2; ++ai)
#pragma unroll
            for (int m = 0; m < 4; ++m) { unsigned char* rowp = H + (size_t)(row0 + ai * HALF + m * 16) * ldh + col0;
#pragma unroll
                for (int bj = 0; bj < 2; ++bj) { const f32x4 g = acc[ai][bj][m][0] * ascale, up = acc[ai][bj][m][1] * (ascale * hs);
                    float h[4];
#pragma unroll
                    for (int e = 0; e < 4; ++e) h[e] = g[e] * __builtin_amdgcn_rcpf(1.f + __expf(-g[e])) * up[e];
                    *(unsigned*)(rowp + bj * 64) = pk_fp8x4(h[0], h[1], h[2], h[3]); }
                asm volatile("" ::: "memory"); }
    }
};
struct EpiStoreBf16 {
    static constexpr bool PERM = true;
    bf16_t* O; int ldc; float scale = 1.0f;
    __device__ __forceinline__ void operator()(const f32x4 (&acc)[2][2][4][2], const Unit& u, int wr, int wc, int fr, int fq) const {
        const int row0 = u.pm * BM + wr * 64 + fr, col0 = u.pn * BM + wc * 32 + 8 * fq;
#pragma unroll
        for (int ai = 0; ai < 2; ++ai)
#pragma unroll
            for (int m = 0; m < 4; ++m) { bf16_t* rowp = O + (size_t)(row0 + ai * HALF + m * 16) * ldc + col0;
#pragma unroll
                for (int bj = 0; bj < 2; ++bj) { const f32x4 v0 = acc[ai][bj][m][0] * scale, v1 = acc[ai][bj][m][1] * scale;
                    u32x4 w; w.x = cvt_pk_bf16(v0[0], v0[1]); w.y = cvt_pk_bf16(v0[2], v0[3]); w.z = cvt_pk_bf16(v1[0], v1[1]); w.w = cvt_pk_bf16(v1[2], v1[3]);
                    *(u32x4*)(rowp + bj * HALF) = w; } }
    }
};
struct EpiSwiGLU {
    static constexpr bool PERM = true;
    bf16_t* H; int ldh;
    __device__ __forceinline__ void operator()(const f32x4 (&acc)[2][2][4][2], const Unit& u, int wr, int wc, int fr, int fq) const {
        const int row0 = u.pm * BM + wr * 64 + fr, col0 = u.pn * 128 + wc * 16 + 4 * fq;
#pragma unroll
        for (int ai = 0; ai < 2; ++ai)
#pragma unroll
            for (int m = 0; m < 4; ++m) { bf16_t* rowp = H + (size_t)(row0 + ai * HALF + m * 16) * ldh + col0;
#pragma unroll
                for (int bj = 0; bj < 2; ++bj) { const f32x4 g = acc[ai][bj][m][0], up = acc[ai][bj][m][1];
                    float h[4];
#pragma unroll
                    for (int e = 0; e < 4; ++e) h[e] = g[e] * __builtin_amdgcn_rcpf(1.f + __expf(-g[e])) * up[e];
                    u32x2 w; w.x = cvt_pk_bf16(h[0], h[1]); w.y = cvt_pk_bf16(h[2], h[3]);
                    *(u32x2*)(rowp + bj * 64) = w; }
                asm volatile("" ::: "memory"); }
    }
};
struct EpiResid {
    static constexpr bool PERM = false;
    const float* base_l; float* out_l; const float* gate_l; const float* base_c; float* out_c; const float* gate_c; int ctx_tile;
    __device__ __forceinline__ void operator()(const f32x4 (&acc)[2][2][4][2], const Unit& u, int wr, int wc, int fr, int fq) const {
        const bool isc = u.pm >= ctx_tile;
        const float* base = isc ? base_c : base_l; float* out = isc ? out_c : out_l; const float* gate = isc ? gate_c : gate_l;
        const int row0 = (isc ? (u.pm - ctx_tile) : u.pm) * BM + wr * 64 + fr, col0 = u.pn * BM + wc * 32 + 4 * fq;
        f32x4 gv[2][2];
#pragma unroll
        for (int bj = 0; bj < 2; ++bj)
#pragma unroll
            for (int n = 0; n < 2; ++n) gv[bj][n] = *(const f32x4*)(gate + col0 + bj * HALF + n * 16);
#pragma unroll
        for (int ai = 0; ai < 2; ++ai)
#pragma unroll
            for (int m = 0; m < 4; ++m) { const size_t off = (size_t)(row0 + ai * HALF + m * 16) * D + col0;
#pragma unroll
                for (int bj = 0; bj < 2; ++bj)
#pragma unroll
                    for (int n = 0; n < 2; ++n) { const f32x4 bs = *(const f32x4*)(base + off + bj * HALF + n * 16);
                        *(f32x4*)(out + off + bj * HALF + n * 16) = bs + gv[bj][n] * acc[ai][bj][m][n]; } }
    }
};

struct MoeTailSched {
    int ntail, G, c; const char* A; const char* B; size_t tstep, estride; const unsigned* tile_e; int tile0; size_t ksb;
    __device__ __forceinline__ bool next(int i, Unit& u) const {
        const long L = (long)i * G + c; if (L >= (long)ntail * 28) return false;
        const int ks = (int)(L % 7), q = (int)(L / 7), pn = q & 3, tt = q >> 2;
        const unsigned e = __builtin_amdgcn_readfirstlane(__hip_atomic_load(tile_e + tile0 + tt, __ATOMIC_RELAXED, __HIP_MEMORY_SCOPE_AGENT)) & 7u;
        u.pm = q * 7 + ks; u.pn = 0; u.a = A + (size_t)tt * tstep + (size_t)ks * ksb; u.b = B + (size_t)e * estride + (size_t)pn * tstep + (size_t)ks * ksb; return true;
    }
};
struct EpiSlab {
    static constexpr bool PERM = false;
    float* slab; float scale = 1.0f;
    __device__ __forceinline__ void operator()(const f32x4 (&acc)[2][2][4][2], const Unit& u, int wr, int wc, int fr, int fq) const {
        float* base = slab + (size_t)u.pm * 65536 + (size_t)(wr * 64 + fr) * 256 + wc * 32 + 4 * fq;
#pragma unroll
        for (int ai = 0; ai < 2; ++ai)
#pragma unroll
            for (int m = 0; m < 4; ++m)
#pragma unroll
                for (int bj = 0; bj < 2; ++bj)
#pragma unroll
                    for (int n = 0; n < 2; ++n) *(f32x4*)(base + (size_t)(ai * HALF + m * 16) * 256 + bj * HALF + n * 16) = acc[ai][bj][m][n] * scale;
    }
};

template <bool FP8 = false, class Epi, class Sched>
__device__ __forceinline__ void gemm_phase(LAS unsigned char* lds, const int K, const Sched& S, const Epi& E, const int ntk = 0) {
    int tid_ = threadIdx.x; asm volatile("" : "+v"(tid_));
    const int tid = tid_, wid = __builtin_amdgcn_readfirstlane(tid >> 6), lane = tid & 63, wr = wid >> 2, wc = wid & 3, fr = lane & 15, fq = lane >> 4;
    const int nt = ntk ? ntk : K / BK;
    unsigned voffA[2], voffB[2];
#pragma unroll
    for (int i = 0; i < 2; ++i) { int R, C; stage_rc(tid * 16 + i * 8192, R, C); const int Rb = Epi::PERM ? ((R & ~31) + perm32(R & 31)) : R;
        voffA[i] = (unsigned)(R * K + C) * 2u; voffB[i] = (unsigned)(Rb * K + C) * 2u; }
    const size_t kstep = (size_t)(BK * 2);
    const size_t hstep = (size_t)HALF * K * 2;
    const unsigned ldsw = (unsigned)wid * 1024u;
    const int aoff = lds_byte(wr * 64 + fr, fq * 8), boff = lds_byte(wc * 32 + fr, fq * 8);
#define PG8_SA(b, h) (((b) * 2 + (h)) * HTB)
#define PG8_SB(b, h) ((4 + (b) * 2 + (h)) * HTB)
#define PG8_STAGE(bufoff, gbase, voff) do { _Pragma("unroll") for (int _i = 0; _i < 2; ++_i) \
        __builtin_amdgcn_global_load_lds((const unsigned*)((const char*)(gbase) + (voff)[_i]), (LAS unsigned*)(lds + (bufoff) + ldsw + _i * 8192), 16, 0, 0); } while (0)
#define PG8_LDA(dst, b, h) do { _Pragma("unroll") for (int m = 0; m < 4; ++m) _Pragma("unroll") for (int k = 0; k < 2; ++k) dst[m].k[k] = *(const LAS bf16x8*)(lds + PG8_SA(b, h) + aoff + m * 2048 + k * 1024); } while (0)
#define PG8_LDB(dst, b, h) do { _Pragma("unroll") for (int n = 0; n < 2; ++n) _Pragma("unroll") for (int k = 0; k < 2; ++k) dst[n].k[k] = *(const LAS bf16x8*)(lds + PG8_SB(b, h) + boff + n * 2048 + k * 1024); } while (0)
#define PG8_MMA(ai, bj, At, Bt) do { if constexpr (FP8) __builtin_amdgcn_sched_barrier(0); __builtin_amdgcn_s_setprio(1); _Pragma("unroll") for (int m = 0; m < 4; ++m) _Pragma("unroll") for (int n = 0; n < 2; ++n) { \
        if constexpr (FP8) acc[ai][bj][m][n] = __builtin_amdgcn_mfma_scale_f32_16x16x128_f8f6f4(__builtin_bit_cast(v8i, Bt[n]), __builtin_bit_cast(v8i, At[m]), acc[ai][bj][m][n], 0, 0, 0, 127, 0, 127); \
        else { _Pragma("unroll") for (int k = 0; k < 2; ++k) acc[ai][bj][m][n] = __builtin_amdgcn_mfma_f32_16x16x32_bf16(Bt[n].k[k], At[m].k[k], acc[ai][bj][m][n], 0, 0, 0); } } \
        if constexpr (FP8) { _Pragma("unroll") for (int m = 0; m < 4; ++m) _Pragma("unroll") for (int n = 0; n < 2; ++n) asm volatile("" : "+v"(acc[ai][bj][m][n])); } \
        __builtin_amdgcn_s_setprio(0); if constexpr (FP8) __builtin_amdgcn_sched_barrier(0); } while (0)
#define PG8_WAIT_V(n) asm volatile("s_waitcnt vmcnt(" #n ")" ::: "memory")
#define PG8_WAIT_L(n) asm volatile("s_waitcnt lgkmcnt(" #n ")" ::: "memory")
#define PG8_BAR __builtin_amdgcn_s_barrier()
#define PG8_SCHED __builtin_amdgcn_sched_barrier(0)
    Unit cur, nxt; int ui = 0;
    if (!S.next(0, cur)) return;
    f32x4 acc[2][2][4][2];
#pragma unroll
    for (int a = 0; a < 2; ++a)
#pragma unroll
        for (int b = 0; b < 2; ++b)
#pragma unroll
            for (int m = 0; m < 4; ++m)
#pragma unroll
                for (int n = 0; n < 2; ++n) acc[a][b][m][n] = (f32x4){0.f, 0.f, 0.f, 0.f};
    struct Frag { bf16x8 k[2]; };
    Frag At[4], B0[2], B1[2];
    const char* cA = cur.a; const char* cB = cur.b;
    PG8_STAGE(PG8_SB(0, 0), cB, voffB); PG8_STAGE(PG8_SB(0, 1), cB + hstep, voffB); PG8_STAGE(PG8_SA(0, 0), cA, voffA); PG8_STAGE(PG8_SA(0, 1), cA + hstep, voffA);
    if (wr == 1) PG8_BAR;
    PG8_WAIT_V(2); PG8_BAR;
    PG8_STAGE(PG8_SB(1, 0), cB + kstep, voffB); PG8_STAGE(PG8_SA(1, 0), cA + kstep, voffA); PG8_STAGE(PG8_SB(1, 1), cB + hstep + kstep, voffB);
    PG8_WAIT_V(6); PG8_BAR;
    for (;;) {
        const bool has_next = S.next(ui + 1, nxt);
        const char* nA = has_next ? nxt.a : cA; const char* nB = has_next ? nxt.b : cB;
        for (int t = 0; t < nt; t += 2) {
            const bool last = (t == nt - 2);
            const char* a1 = cA + (size_t)(t + 1) * kstep;
            const char* a2 = last ? nA : cA + (size_t)(t + 2) * kstep; const char* b2 = last ? nB : cB + (size_t)(t + 2) * kstep;
            const char* a3 = a2 + kstep; const char* b3 = b2 + kstep;
            PG8_LDB(B0, 0, 0); PG8_LDB(B1, 0, 1); PG8_SCHED; PG8_LDA(At, 0, 0); PG8_STAGE(PG8_SA(1, 1), a1 + hstep, voffA);
            PG8_WAIT_V(8); PG8_WAIT_L(0); PG8_BAR; PG8_MMA(0, 0, At, B0); PG8_MMA(0, 1, At, B1); PG8_BAR; PG8_SCHED;
            PG8_LDA(At, 0, 1); PG8_STAGE(PG8_SB(0, 0), b2, voffB); PG8_STAGE(PG8_SB(0, 1), b2 + hstep, voffB); PG8_STAGE(PG8_SA(0, 0), a2, voffA);
            PG8_WAIT_V(8); PG8_WAIT_L(0); PG8_BAR; PG8_MMA(1, 0, At, B0); PG8_MMA(1, 1, At, B1); PG8_BAR; PG8_SCHED;
            PG8_LDB(B0, 1, 0); PG8_LDB(B1, 1, 1); PG8_SCHED; PG8_LDA(At, 1, 0); PG8_STAGE(PG8_SA(0, 1), a2 + hstep, voffA);
            PG8_WAIT_V(8); PG8_WAIT_L(0); PG8_BAR; PG8_MMA(0, 0, At, B0); PG8_MMA(0, 1, At, B1); PG8_BAR; PG8_SCHED;
            PG8_LDA(At, 1, 1); PG8_STAGE(PG8_SB(1, 0), b3, voffB); PG8_STAGE(PG8_SB(1, 1), b3 + hstep, voffB); PG8_STAGE(PG8_SA(1, 0), a3, voffA);
            PG8_WAIT_V(8); PG8_WAIT_L(0); PG8_BAR; PG8_MMA(1, 0, At, B0); PG8_MMA(1, 1, At, B1); PG8_BAR; PG8_SCHED;
        }
        if (wr == 0) PG8_BAR;
        E(acc, cur, wr, wc, fr, fq);
        if (!has_next) break;
#pragma unroll
        for (int a = 0; a < 2; ++a)
#pragma unroll
            for (int b = 0; b < 2; ++b)
#pragma unroll
                for (int m = 0; m < 4; ++m)
#pragma unroll
                    for (int n = 0; n < 2; ++n) acc[a][b][m][n] = (f32x4){0.f, 0.f, 0.f, 0.f};
        cur = nxt; cA = nA; cB = nB; ++ui;
        if (wr == 1) PG8_BAR;
    }
    PG8_WAIT_V(0);
    PG8_BAR;
#undef PG8_SA
#undef PG8_SB
#undef PG8_STAGE
#undef PG8_LDA
#undef PG8_LDB
#undef PG8_MMA
#undef PG8_WAIT_V
#undef PG8_WAIT_L
#undef PG8_BAR
#undef PG8_SCHED
}
}

constexpr size_t WS_GL = 7 * MiB;
__device__ __forceinline__ float ldbf(const bf16_t* p) { return bf2f(*p); }
__device__ __forceinline__ void unpk8(const u32x4 v, float (&f)[8]) {
    f[0] = bf2f(v.x & 0xffffu); f[1] = bf2f(v.x >> 16); f[2] = bf2f(v.y & 0xffffu); f[3] = bf2f(v.y >> 16);
    f[4] = bf2f(v.z & 0xffffu); f[5] = bf2f(v.z >> 16); f[6] = bf2f(v.w & 0xffffu); f[7] = bf2f(v.w >> 16);
}
__device__ __forceinline__ u32x4 pk8(const float (&f)[8]) { u32x4 o; o.x = pk2(f[0], f[1]); o.y = pk2(f[2], f[3]); o.z = pk2(f[4], f[5]); o.w = pk2(f[6], f[7]); return o; }
struct PrepRow { u32x4 cc, hh, bb, dq0, dq1, dq2, ro; float ab; };
__device__ __forceinline__ PrepRow prep_load(const bf16_t* PX, int m, int lane) {
    PrepRow R; const bf16_t* r0 = PX + (size_t)m * INP;
    const int c0 = 8 * (lane & 31);
    R.cc = *(const u32x4*)(r0 + C_CC + c0); R.hh = *(const u32x4*)(r0 + C_CH + c0); R.bb = *(const u32x4*)(r0 + C_CB + c0);
    R.dq0 = *(const u32x4*)(r0 + C_DQ + 8 * lane); R.dq1 = *(const u32x4*)(r0 + C_DQ + 8 * (64 + lane)); R.dq2 = *(const u32x4*)(r0 + C_DQ + 8 * (128 + (lane & 15)));
    const int head = lane >> 3, v8 = lane & 7;
    R.ro = *(const u32x4*)(r0 + (head < 6 ? C_AQ + head * 64 : C_AK + (head - 6) * 64) + 8 * v8);
    const int q = (lane - 32) & 31; R.ab = bf2f(r0[C_DA + (q < 24 ? q : 23)]);
    return R;
}
__device__ __forceinline__ void prep_phase(Frame& F, const Args& A, int layer) {
    bf16_t* PX = (bf16_t*)(F.ws + WS_PX);
    bf16_t* ACT = (bf16_t*)(F.ws + WS_ACT);
    bf16_t* QD = (bf16_t*)(F.ws + WS_QD); bf16_t* KD = (bf16_t*)(F.ws + WS_QD + QKV_STRIDE); bf16_t* VD = (bf16_t*)(F.ws + WS_QD + 2 * QKV_STRIDE);
    float* Gg = (float*)(F.ws + WS_G); float* Bt = (float*)(F.ws + WS_BETA);
    const float* rope = (const float*)(F.ws + WS_ROPE);
    LAS float* sdw = (LAS float*)F.lds;
    LAS float* scw = sdw + 3 * 1152;
    for (int i = F.tid; i < 3 * 1152; i += NTHREADS) sdw[i] = A.in[I_DNCONVW][layer * 3 * 1152 + i];
    for (int i = F.tid; i < 3 * 256; i += NTHREADS) scw[i] = A.in[I_CONVW][layer * 3 * 256 + i];
    __syncthreads();
    const int lane = F.lane;
    constexpr int RPW = (NT + 2047) / 2048;
    const int mlo = F.gw * RPW, mhi = (mlo + RPW) < NT ? (mlo + RPW) : NT;
    const int qgb = lane - 32;
    const float dtb = (qgb >= 0 && qgb < 12) ? A.in[I_DTB][layer * 12 + qgb] : 0.f;
    const float nalog = (qgb >= 0 && qgb < 12) ? -__expf(A.in[I_ALOG][layer * 12 + qgb]) : 0.f;
    if (mlo < mhi) {
        PrepRow prv = prep_load(PX, mlo > 0 ? mlo - 1 : 0, lane), cur = prep_load(PX, mlo, lane), nxt = prep_load(PX, (mlo + 1) < NT ? mlo + 1 : mlo, lane);
#pragma unroll 1
        for (int m = mlo; m < mhi; ++m) {
            const PrepRow nn = prep_load(PX, (m + 2) < NT ? m + 2 : m, lane);
            const bool hasp = (m != 0 && m != NL), hasn = (m != NL - 1 && m != NT - 1);
            const float fp = hasp ? 1.f : 0.f, fn = hasn ? 1.f : 0.f;
            if (lane < 32) {
                const int c0 = 8 * lane;
                float b[8], c1[8], h1[8], cp[8], hp[8], cn[8], hn[8], o[8];
                unpk8(cur.bb, b); unpk8(cur.cc, c1); unpk8(cur.hh, h1); unpk8(prv.cc, cp); unpk8(prv.hh, hp); unpk8(nxt.cc, cn); unpk8(nxt.hh, hn);
#pragma unroll
                for (int e = 0; e < 8; ++e) o[e] = b[e] * (scw[c0 + e] * (cp[e] * hp[e]) * fp + scw[256 + c0 + e] * (c1[e] * h1[e]) + scw[512 + c0 + e] * (cn[e] * hn[e]) * fn);
                *(u32x4*)(ACT + (size_t)m * D + c0) = pk8(o);
            } else if (lane < 56) {
                if (qgb < 12) { const float sp = cur.ab + dtb; const float softp = (sp > 20.f) ? sp : __logf(1.0f + __expf(sp)); Gg[(size_t)m * 12 + qgb] = nalog * softp; }
                else Bt[(size_t)m * 12 + (qgb - 12)] = __builtin_amdgcn_rcpf(1.0f + __expf(-cur.ab));
            }
            __builtin_amdgcn_sched_barrier(0);
#pragma unroll
            for (int ps = 0; ps < 3; ++ps) {
                __builtin_amdgcn_sched_barrier(0);
                const int v = ps < 2 ? 64 * ps + lane : 128 + (lane & 15);
                const int c0 = 8 * v, p = c0 / 384;
                float x0[8], x1[8], x2[8], o[8];
                unpk8(ps == 0 ? prv.dq0 : ps == 1 ? prv.dq1 : prv.dq2, x0); unpk8(ps == 0 ? cur.dq0 : ps == 1 ? cur.dq1 : cur.dq2, x1); unpk8(ps == 0 ? nxt.dq0 : ps == 1 ? nxt.dq1 : nxt.dq2, x2);
                float ss = 0.f;
#pragma unroll
                for (int e = 0; e < 8; ++e) { o[e] = silu_f(sdw[c0 + e] * x0[e] * fp + sdw[1152 + c0 + e] * x1[e] + sdw[2304 + c0 + e] * x2[e] * fn); ss += o[e] * o[e]; }
                ss = sum8(ss);
                const float sc = p == 2 ? 1.0f : __builtin_amdgcn_rsqf(ss + 1e-6f) * (p == 0 ? 0.125f : 1.0f);
#pragma unroll
                for (int e = 0; e < 8; ++e) o[e] *= sc;
                if (ps < 2 || lane < 16) { bf16_t* dst = (p == 0 ? QD : (p == 1 ? KD : VD)) + (size_t)m * 384 + (c0 - p * 384); *(u32x4*)dst = pk8(o); }
            }
            __builtin_amdgcn_sched_barrier(0);
            if (m < NL) {
                const int head = lane >> 3, v8 = lane & 7, axis = v8 >> 2, vv = v8 & 3;
                bf16_t* px = PX + (size_t)m * INP + (head < 6 ? C_AQ + head * 64 : C_AK + (head - 6) * 64) + 8 * v8;
                const u32x4 own = cur.ro;
                u32x4 oth;
                oth.x = (unsigned)__builtin_amdgcn_update_dpp(0, (int)own.x, 0x4E, 0xF, 0xF, true); oth.y = (unsigned)__builtin_amdgcn_update_dpp(0, (int)own.y, 0x4E, 0xF, 0xF, true);
                oth.z = (unsigned)__builtin_amdgcn_update_dpp(0, (int)own.z, 0x4E, 0xF, 0xF, true); oth.w = (unsigned)__builtin_amdgcn_update_dpp(0, (int)own.w, 0x4E, 0xF, 0xF, true);
                float a[8], b[8], o[8]; unpk8(own, a); unpk8(oth, b);
                const int pos = axis == 0 ? (m >> 6) : (m & 63);
                const float* rt = rope + (pos * 16 + 8 * (vv & 1)) * 2;
                const float sgn = (vv < 2) ? -1.0f : 1.0f;
#pragma unroll
                for (int e = 0; e < 8; ++e) o[e] = a[e] * rt[2 * e] + sgn * b[e] * rt[2 * e + 1];
                *(u32x4*)px = pk8(o);
            }
            prv = cur; cur = nxt; nxt = nn;
        }
    }
    __syncthreads();
}

constexpr int DN_NS = 260, DN_NU = 12 * DN_NS;
__device__ __forceinline__ int dn_row0(int d, int s) {
    if (s < 4) return NL + 64 * (d == 0 ? s : 3 - s);
    return 64 * (d == 0 ? (s - 4) : 255 - (s - 4));
}
__device__ __forceinline__ void pair_bar(volatile LAS unsigned* cnt, unsigned& epoch, int lane) {
    epoch += 2u;
    asm volatile("s_waitcnt vmcnt(0) lgkmcnt(0)" ::: "memory");
    if (lane == 0) __hip_atomic_fetch_add((LAS unsigned*)cnt, 1u, __ATOMIC_RELAXED, __HIP_MEMORY_SCOPE_WORKGROUP);
    while (*cnt < epoch) __builtin_amdgcn_s_sleep(1);
    asm volatile("" ::: "memory");
}
__device__ __forceinline__ void dn_chunk_phase(Frame& F) {
    const bf16_t* KD = (const bf16_t*)(F.ws + WS_QD + QKV_STRIDE); const bf16_t* VD = (const bf16_t*)(F.ws + WS_QD + 2 * QKV_STRIDE);
    const float* Gg = (const float*)(F.ws + WS_G); const float* Bt = (const float*)(F.ws + WS_BETA);
    bf16_t* Wm = (bf16_t*)(F.ws + WS_DN); bf16_t* KDt = (bf16_t*)(F.ws + WS_DN + DN_STRIDE); bf16_t* Ut = (bf16_t*)(F.ws + WS_DN + 2 * DN_STRIDE);
    float* GL = (float*)(F.ws + WS_GL);
    const int gi = F.wave >> 1, wl = F.wave & 1;
    LAS unsigned char* R = F.lds + gi * 18432;
    LAS float* Am = (LAS float*)R;
    LAS float* gcs = Am + 64 * 68; LAS float* bts = gcs + 64;
    volatile LAS unsigned* pcnt = (volatile LAS unsigned*)(R + 17920);
    if (F.tid < 4) *(volatile LAS unsigned*)(F.lds + F.tid * 18432 + 17920) = 0u;
    __syncthreads();
    unsigned epoch = 0u;
#pragma unroll 1
    for (int base = blockIdx.x * 4; base + gi < DN_NU; base += F.G * 4) {
        const int lane = opq(F.lane), r = lane & 15, g = lane >> 4;
        const int U = base + gi; const bool act = U < DN_NU;
        const int dh = act ? U / DN_NS : 0, s = act ? U % DN_NS : 0, d = dh / 6, h = dh % 6;
        const int row0 = dn_row0(d, s);
        const size_t ub = (size_t)U * 4096;
        if (act) {
            if (wl == 0) {
                const int io = d ? 63 - lane : lane;
                float gv = Gg[(size_t)(row0 + io) * 12 + d * 6 + h];
#pragma unroll
                for (int o = 1; o < 64; o <<= 1) { const float t = __shfl_up(gv, o); if (lane >= o) gv += t; }
                gcs[lane] = gv; bts[lane] = Bt[(size_t)(row0 + io) * 12 + d * 6 + h];
                if (lane == 63) GL[U] = expf(gv);
            }
            const bf16_t* tsrc = (wl == 0 ? VD : KD) + (size_t)row0 * 384 + h * 64;
            u32x4 tv[8];
#pragma unroll
            for (int j = 0; j < 8; ++j) tv[j] = *(const u32x4*)(tsrc + (size_t)(8 * j + (lane >> 3)) * 384 + (lane & 7) * 8);
#pragma unroll
            for (int j = 0; j < 8; ++j) *(LAS u32x4*)(R + (1 - wl) * 8192 + (8 * j + (lane >> 3)) * 128 + (lane & 7) * 16) = tv[j];
        }
        pair_bar(pcnt, epoch, lane);
        float x[64];
        if (act) {
            const LAS unsigned char* tb = R + (1 - wl) * 8192 + lane * 2;
            const int rb = d ? 63 * 128 : 0, rs = d ? -128 : 128;
#pragma unroll
            for (int i = 0; i < 64; ++i) x[i] = bf2f(*(const LAS bf16_t*)(tb + rb + i * rs));
            if (wl == 1) {
                const float gcl = gcs[63];
#pragma unroll
                for (int q = 0; q < 8; ++q) { u32x4 o;
                    const int ia = 32 * (q >> 2) + 4 * (q & 3), ib = ia + 16;
                    o.x = pk2(x[ia + 0] * __expf(gcl - gcs[ia + 0]), x[ia + 1] * __expf(gcl - gcs[ia + 1]));
                    o.y = pk2(x[ia + 2] * __expf(gcl - gcs[ia + 2]), x[ia + 3] * __expf(gcl - gcs[ia + 3]));
                    o.z = pk2(x[ib + 0] * __expf(gcl - gcs[ib + 0]), x[ib + 1] * __expf(gcl - gcs[ib + 1]));
                    o.w = pk2(x[ib + 2] * __expf(gcl - gcs[ib + 2]), x[ib + 3] * __expf(gcl - gcs[ib + 3]));
                    *(LAS u32x4*)(R + lane * 128 + ((q ^ (lane & 7)) << 4)) = o; }
#pragma unroll
                for (int j = 0; j < 8; ++j) { const int row = 8 * j + (lane >> 3), c = lane & 7;
                    ((GAS u32x4*)(KDt + ub))[64 * j + lane] = *(const LAS u32x4*)(R + row * 128 + ((c ^ (row & 7)) << 4)); }
#pragma unroll
                for (int i = 0; i < 64; ++i) x[i] *= bts[i] * __expf(gcs[i]);
            } else {
#pragma unroll
                for (int i = 0; i < 64; ++i) x[i] *= bts[i];
            }
        }
        pair_bar(pcnt, epoch, lane);
        if (act) {
            bf16x8 kf[4][2];
#pragma unroll
            for (int jt = 0; jt < 4; ++jt)
#pragma unroll
                for (int ks = 0; ks < 2; ++ks) kf[jt][ks] = *(const bf16x8*)(KD + (size_t)(row0 + 16 * jt + r) * 384 + h * 64 + 32 * ks + 8 * g);
#pragma unroll
            for (int itl = 0; itl < 2; ++itl) {
                const int it = 2 * wl + itl;
#pragma unroll
                for (int jt = 0; jt < 4; ++jt) {
                    f32x4 c = (f32x4){0.f, 0.f, 0.f, 0.f};
                    const bf16x8 a0 = (it == 0 ? kf[0][0] : it == 1 ? kf[1][0] : it == 2 ? kf[2][0] : kf[3][0]);
                    const bf16x8 a1 = (it == 0 ? kf[0][1] : it == 1 ? kf[1][1] : it == 2 ? kf[2][1] : kf[3][1]);
                    c = __builtin_amdgcn_mfma_f32_16x16x32_bf16(a0, kf[jt][0], c, 0, 0, 0);
                    c = __builtin_amdgcn_mfma_f32_16x16x32_bf16(a1, kf[jt][1], c, 0, 0, 0);
                    const int jo = 16 * jt + r, jp = d ? 63 - jo : jo;
#pragma unroll
                    for (int e = 0; e < 4; ++e) {
                        const int io = 16 * it + 4 * g + e, ip = d ? 63 - io : io;
                        Am[ip * 68 + jp] = (jp < ip) ? bts[ip] * c[e] * __expf(gcs[ip] - gcs[jp]) : 0.f;
                    }
                }
            }
        }
        pair_bar(pcnt, epoch, lane);
        if (act) {
#pragma unroll
            for (int b = 0; b < 4; ++b) {
                float acc[16];
#pragma unroll
                for (int ii = 0; ii < 16; ++ii) acc[ii] = 0.f;
#pragma unroll
                for (int j4 = 0; j4 < 4 * b; ++j4) {
#pragma unroll
                    for (int ii = 0; ii < 16; ++ii) {
                        const f32x4 a = *(const LAS f32x4*)(Am + (16 * b + ii) * 68 + 4 * j4);
                        acc[ii] += a.x * x[4 * j4]; acc[ii] += a.y * x[4 * j4 + 1]; acc[ii] += a.z * x[4 * j4 + 2]; acc[ii] += a.w * x[4 * j4 + 3];
                    }
                    if ((j4 & 1) == 1) asm volatile("" ::: "memory");
                }
#pragma unroll
                for (int ii = 0; ii < 16; ++ii) {
                    const int i = 16 * b + ii;
                    float s0 = acc[ii], s1 = 0.f;
#pragma unroll
                    for (int j4 = 0; j4 < (ii + 3) / 4; ++j4) {
                        const f32x4 a = *(const LAS f32x4*)(Am + i * 68 + 16 * b + 4 * j4);
                        s0 += a.x * x[16 * b + 4 * j4]; s1 += a.y * x[16 * b + 4 * j4 + 1]; s0 += a.z * x[16 * b + 4 * j4 + 2]; s1 += a.w * x[16 * b + 4 * j4 + 3];
                    }
                    x[i] -= s0 + s1;
                    if ((ii & 3) == 3) asm volatile("" : "+v"(x[i]) :: "memory");
                }
            }
        }
        pair_bar(pcnt, epoch, lane);
        if (act) {
            if (wl == 0) {
#pragma unroll
                for (int q = 0; q < 8; ++q) { u32x4 o; o.x = pk2(x[8 * q], x[8 * q + 1]); o.y = pk2(x[8 * q + 2], x[8 * q + 3]); o.z = pk2(x[8 * q + 4], x[8 * q + 5]); o.w = pk2(x[8 * q + 6], x[8 * q + 7]);
                    *(LAS u32x4*)(R + lane * 128 + ((q ^ (lane & 7)) << 4)) = o; }
#pragma unroll
                for (int j = 0; j < 8; ++j) { const int row = 8 * j + (lane >> 3), c = lane & 7;
                    ((GAS u32x4*)(Ut + ub))[64 * j + lane] = *(const LAS u32x4*)(R + row * 128 + ((c ^ (row & 7)) << 4)); }
            } else {
                const int kk2 = lane & 31, pc = (lane & 32) + 8 * ((kk2 & 15) >> 2) + 4 * (kk2 >> 4) + (kk2 & 3);
#pragma unroll
                for (int i = 0; i < 64; ++i) *(LAS bf16_t*)(R + 8192 + i * 128 + ((((pc >> 3) ^ (i & 7)) << 4) | ((pc & 7) << 1))) = (bf16_t)f2bf(-x[i]);
#pragma unroll
                for (int j = 0; j < 8; ++j) { const int row = 8 * j + (lane >> 3), c = lane & 7;
                    ((GAS u32x4*)(Wm + ub))[64 * j + lane] = *(const LAS u32x4*)(R + 8192 + row * 128 + ((c ^ (row & 7)) << 4)); }
            }
        }
        pair_bar(pcnt, epoch, lane);
    }
}

constexpr int SC_D = 7, SC_STAGE = 16384, SC_P = 4;
__device__ __forceinline__ unsigned pkbf(float lo, float hi) { return pg8::cvt_pk_bf16(lo, hi); }
__device__ __forceinline__ int sc_off(int row, int col) {
    const int c = col >> 3; return row * 128 + ((c ^ ((row >> 1) & 7)) << 4) + ((col & 4) << 1);
}
constexpr int NSEG = 8;
constexpr size_t WS_SEG = 503 * MiB;
constexpr size_t WS_SST = 507 * MiB;
static_assert(WS_DN + 5 * DN_STRIDE <= WS_SEG && WS_SEG + (size_t)12 * NSEG * 2 * 16384 <= WS_SST && WS_SST + (size_t)12 * NSEG * 16384 <= WS_END, "seg map");
__host__ __device__ constexpr int seg_begin(int s) { return s == 0 ? 0 : 36 + 32 * (s - 1); }
__host__ __device__ constexpr int seg_len(int s) { return s == 0 ? 36 : 32; }
static_assert(seg_begin(NSEG - 1) + seg_len(NSEG - 1) == DN_NS, "segments cover the chain");
template <int MODE>
__device__ __forceinline__ void dn_scan_job(Frame& F, const int dh, const int sg) {
    const int d = dh / 6, lane = F.lane, wave = F.wave, r = lane & 15, g = lane >> 4;
    const int tb = seg_begin(sg), ns = seg_len(sg);
    const unsigned char* srcW = F.ws + WS_DN + ((size_t)dh * DN_NS + tb) * 8192;
    const unsigned char* srcK = srcW + DN_STRIDE; const unsigned char* srcU = srcW + 2 * DN_STRIDE;
    bf16_t* VT = (bf16_t*)(F.ws + WS_DN + 3 * DN_STRIDE) + ((size_t)dh * DN_NS + tb) * 4096;
    bf16_t* ST = (bf16_t*)(F.ws + WS_DN + 4 * DN_STRIDE) + ((size_t)dh * DN_NS + tb) * 4096;
    LAS float* gls = (LAS float*)(F.lds + MISC_OFF + 1024);
    LAS unsigned char* ost = F.lds + SC_D * SC_STAGE + (wave & 3) * 6144;
    { const float* GL = (const float*)(F.ws + WS_GL) + dh * DN_NS + tb; for (int i = F.tid; i < ns; i += NTHREADS) gls[i] = GL[i]; }
    __syncthreads();
#define SC_WAITV(n) asm volatile("s_waitcnt vmcnt(" #n ")" ::: "memory")
#define SC_BAR() do { asm volatile("" ::: "memory"); __builtin_amdgcn_s_barrier(); asm volatile("" ::: "memory"); } while (0)
    if (wave >= 4) {
        const int lw = wave - 4;
        const int lrow = lane >> 3, lc = lane & 7;
#define SC_ISSUE(st) do { const int slot_ = ((st) % SC_D) * SC_STAGE; \
            _Pragma("unroll") for (int e = 0; e < 4; ++e) { \
                const int q = lw * 4 + e, mi = q >> 3, n = q & 7, row = 8 * n + lrow; \
                const unsigned char* mb = (mi == 0 ? srcW : srcK) + (size_t)(st) * 8192; \
                const unsigned char* gp = mb + row * 128 + ((lc ^ ((row >> 1) & 7)) << 4); \
                __builtin_amdgcn_global_load_lds((const unsigned*)gp, (LAS unsigned*)(F.lds + slot_ + mi * 8192 + n * 1024), 16, 0, 0); } } while (0)
        SC_ISSUE(0); SC_ISSUE(1); SC_ISSUE(2); SC_ISSUE(3); SC_ISSUE(4); SC_ISSUE(5);
        SC_WAITV(20); SC_BAR();
        for (int t = 0; t < ns; ++t) {
            if (t + SC_D - 1 < ns) { SC_ISSUE(t + SC_D - 1); SC_WAITV(20); }
            else { SC_WAITV(0); }
            SC_BAR();
        }
    } else {
        f32x4 S[4];
        if (MODE == 0) {
            if (sg == 0) {
#pragma unroll
                for (int t = 0; t < 4; ++t) S[t] = (f32x4){0.f, 0.f, 0.f, 0.f};
            } else {
                const float* seg0 = (const float*)(F.ws + WS_SEG) + (size_t)dh * NSEG * 2 * 4096;
                { const float* q0 = seg0 + 4096 + 16 * wave + r;
#pragma unroll
                  for (int t = 0; t < 4; ++t)
#pragma unroll
                      for (int e2 = 0; e2 < 4; ++e2) S[t][e2] = q0[(16 * t + 4 * g + e2) * 64]; }
#pragma unroll 1
                for (int s = 1; s < sg; ++s) {
                    const float* Pm = seg0 + (size_t)s * 2 * 4096; const float* Qm = Pm + 4096 + 16 * wave + r;
                    u32x4 bsf[2];
#pragma unroll
                    for (int ks = 0; ks < 2; ++ks) { bsf[ks].x = pkbf(S[2 * ks][0], S[2 * ks][1]); bsf[ks].y = pkbf(S[2 * ks][2], S[2 * ks][3]); bsf[ks].z = pkbf(S[2 * ks + 1][0], S[2 * ks + 1][1]); bsf[ks].w = pkbf(S[2 * ks + 1][2], S[2 * ks + 1][3]); }
                    f32x4 Sn[4];
#pragma unroll
                    for (int t = 0; t < 4; ++t) {
                        f32x4 c;
#pragma unroll
                        for (int e2 = 0; e2 < 4; ++e2) c[e2] = Qm[(16 * t + 4 * g + e2) * 64];
#pragma unroll
                        for (int ks = 0; ks < 2; ++ks) {
                            const f32x4 lo = *(const f32x4*)(Pm + (16 * t + r) * 64 + 32 * ks + 4 * g), hi = *(const f32x4*)(Pm + (16 * t + r) * 64 + 32 * ks + 16 + 4 * g);
                            u32x4 a; a.x = pkbf(lo[0], lo[1]); a.y = pkbf(lo[2], lo[3]); a.z = pkbf(hi[0], hi[1]); a.w = pkbf(hi[2], hi[3]);
                            c = __builtin_amdgcn_mfma_f32_16x16x32_bf16(__builtin_bit_cast(bf16x8, a), __builtin_bit_cast(bf16x8, bsf[ks]), c, 0, 0, 0);
                        }
                        Sn[t] = c;
                    }
#pragma unroll
                    for (int t = 0; t < 4; ++t) S[t] = Sn[t];
                }
            }
        } else {
#pragma unroll
            for (int t = 0; t < 4; ++t)
#pragma unroll
                for (int e2 = 0; e2 < 4; ++e2) S[t][e2] = (MODE == 2 && (16 * t + 4 * g + e2) == 16 * wave + r) ? 1.f : 0.f;
        }
        const int dvrow = 16 * wave + r;
        const GAS u32x4* usrc = (const GAS u32x4*)(srcU + wave * 2048) + lane;
        u32x4 uq[SC_P][2];
        if (MODE != 2) {
#pragma unroll
            for (int p = 0; p < SC_P; ++p) { uq[p][0] = usrc[(size_t)p * 512]; uq[p][1] = usrc[(size_t)p * 512 + 64]; }
        }
        SC_BAR();
#define OST_W(base, t_, lo_, hi_) *(LAS u32x2*)(ost + (base) + r * 128 + (((2 * (t_) + (g >> 1)) ^ (r & 7)) << 4) + ((g & 1) << 3)) = (u32x2){lo_, hi_}
        for (int t4 = 0; t4 < ns; t4 += SC_P) {
#pragma unroll
          for (int tp = 0; tp < SC_P; ++tp) {
            const int t = t4 + tp;
            const LAS unsigned char* sb = F.lds + (t % SC_D) * SC_STAGE;
            const float gl = gls[t];
            if (MODE != 2) {
#pragma unroll
                for (int j = 0; j < 2; ++j) { const int row = 8 * j + (lane >> 3), c = lane & 7; *(LAS u32x4*)(ost + 4096 + row * 128 + ((c ^ (row & 7)) << 4)) = uq[tp][j]; }
                if (t + SC_P < ns) { uq[tp][0] = usrc[(size_t)(t + SC_P) * 512]; uq[tp][1] = usrc[(size_t)(t + SC_P) * 512 + 64]; }
            }
            u32x4 bs[2];
#pragma unroll
            for (int ks = 0; ks < 2; ++ks) { bs[ks].x = pkbf(S[2 * ks][0], S[2 * ks][1]); bs[ks].y = pkbf(S[2 * ks][2], S[2 * ks][3]); bs[ks].z = pkbf(S[2 * ks + 1][0], S[2 * ks + 1][1]); bs[ks].w = pkbf(S[2 * ks + 1][2], S[2 * ks + 1][3]); }
            if (MODE == 0) { OST_W(0, 0, bs[0].x, bs[0].y); OST_W(0, 1, bs[0].z, bs[0].w); OST_W(0, 2, bs[1].x, bs[1].y); OST_W(0, 3, bs[1].z, bs[1].w); }
            f32x4 vn[4];
#pragma unroll
            for (int it = 0; it < 4; ++it) {
                f32x4 c = (f32x4){0.f, 0.f, 0.f, 0.f};
                if (MODE != 2) { const u32x2 uu = *(const LAS u32x2*)(ost + 4096 + r * 128 + (((2 * it + (g >> 1)) ^ (r & 7)) << 4) + ((g & 1) << 3));
                    c = (f32x4){bf2f(uu.x & 0xffffu), bf2f(uu.x >> 16), bf2f(uu.y & 0xffffu), bf2f(uu.y >> 16)}; }
#pragma unroll
                for (int ks = 0; ks < 2; ++ks) {
                    const u32x4 a = *(const LAS u32x4*)(sb + sc_off(16 * it + r, 32 * ks + 8 * g));
                    c = __builtin_amdgcn_mfma_f32_16x16x32_bf16(__builtin_bit_cast(bf16x8, a), __builtin_bit_cast(bf16x8, bs[ks]), c, 0, 0, 0);
                }
                vn[it] = c;
            }
            u32x4 bv[2];
#pragma unroll
            for (int ks = 0; ks < 2; ++ks) { bv[ks].x = pkbf(vn[2 * ks][0], vn[2 * ks][1]); bv[ks].y = pkbf(vn[2 * ks][2], vn[2 * ks][3]); bv[ks].z = pkbf(vn[2 * ks + 1][0], vn[2 * ks + 1][1]); bv[ks].w = pkbf(vn[2 * ks + 1][2], vn[2 * ks + 1][3]); }
            if (MODE == 0) {
                if (d == 0) {
                    OST_W(2048, 0, bv[0].x, bv[0].y); OST_W(2048, 1, bv[0].z, bv[0].w); OST_W(2048, 2, bv[1].x, bv[1].y); OST_W(2048, 3, bv[1].z, bv[1].w);
                } else {
#define SC_ROT(a) (((a) >> 16) | ((a) << 16))
#define OST_WR(t_, lo_, hi_) *(LAS u32x2*)(ost + 2048 + r * 128 + (((2 * (3 - (t_)) + ((3 - g) >> 1)) ^ (r & 7)) << 4) + (((3 - g) & 1) << 3)) = (u32x2){SC_ROT(hi_), SC_ROT(lo_)}
                    OST_WR(0, bv[0].x, bv[0].y); OST_WR(1, bv[0].z, bv[0].w); OST_WR(2, bv[1].x, bv[1].y); OST_WR(3, bv[1].z, bv[1].w);
#undef OST_WR
#undef SC_ROT
                }
                GAS u32x4* gst = (GAS u32x4*)(ST + (size_t)t * 4096 + wave * 1024); GAS u32x4* gvt = (GAS u32x4*)(VT + (size_t)t * 4096 + wave * 1024);
#pragma unroll
                for (int j = 0; j < 2; ++j) {
                    const int row = 8 * j + (lane >> 3), c = lane & 7; const int off = row * 128 + ((c ^ (row & 7)) << 4);
                    gst[64 * j + lane] = *(const LAS u32x4*)(ost + off); gvt[64 * j + lane] = *(const LAS u32x4*)(ost + 2048 + off);
                }
            }
#pragma unroll
            for (int tt = 0; tt < 4; ++tt) {
                f32x4 c = S[tt] * gl;
#pragma unroll
                for (int ks = 0; ks < 2; ++ks) {
                    const u32x4 a = *(const LAS u32x4*)(sb + 8192 + sc_off(16 * tt + r, 32 * ks + 8 * g));
                    c = __builtin_amdgcn_mfma_f32_16x16x32_bf16(__builtin_bit_cast(bf16x8, a), __builtin_bit_cast(bf16x8, bv[ks]), c, 0, 0, 0);
                }
                S[tt] = c;
            }
            asm volatile("s_waitcnt lgkmcnt(0)" ::: "memory");
            SC_BAR();
          }
        }
        if (MODE != 0) {
            float* o = (float*)(F.ws + WS_SEG) + ((size_t)(dh * NSEG + sg) * 2 + (MODE == 2 ? 0 : 1)) * 4096 + 16 * wave + r;
#pragma unroll
            for (int t = 0; t < 4; ++t)
#pragma unroll
                for (int e2 = 0; e2 < 4; ++e2) o[(16 * t + 4 * g + e2) * 64] = S[t][e2];
        }
    }
#undef SC_WAITV
#undef OST_W
#undef SC_BAR
#undef SC_ISSUE
    asm volatile("s_waitcnt vmcnt(0) lgkmcnt(0)" ::: "memory");
    __syncthreads();
}
__device__ __forceinline__ void dn_combine(Frame& F, const int dh) {
    const float* SEG = (const float*)(F.ws + WS_SEG) + (size_t)dh * NSEG * 2 * 4096;
    float* SST = (float*)(F.ws + WS_SST) + (size_t)dh * NSEG * 4096;
    LAS float* Sl = (LAS float*)F.lds; LAS float* Pl = Sl + 4096;
    for (int i = F.tid; i < 4096; i += NTHREADS) { const float v = SEG[4096 + i]; Sl[i] = v; SST[4096 + i] = v; }
    __syncthreads();
    const int col = F.tid & 63, dk0 = F.tid >> 6;
    float pre[8], qre[8];
#pragma unroll
    for (int k = 0; k < 8; ++k) { pre[k] = SEG[(size_t)1 * 2 * 4096 + F.tid + NTHREADS * k]; qre[k] = SEG[(size_t)1 * 2 * 4096 + 4096 + (dk0 + 8 * k) * 64 + col]; }
#pragma unroll 1
    for (int sg = 1; sg <= NSEG - 2; ++sg) {
        float out[8];
#pragma unroll
        for (int k = 0; k < 8; ++k) { Pl[F.tid + NTHREADS * k] = pre[k]; out[k] = qre[k]; }
        if (sg + 1 <= NSEG - 2) {
#pragma unroll
            for (int k = 0; k < 8; ++k) { pre[k] = SEG[(size_t)(sg + 1) * 2 * 4096 + F.tid + NTHREADS * k]; qre[k] = SEG[(size_t)(sg + 1) * 2 * 4096 + 4096 + (dk0 + 8 * k) * 64 + col]; }
        }
        __syncthreads();
#pragma unroll 2
        for (int k4 = 0; k4 < 16; ++k4) {
            const float s0 = Sl[(4 * k4 + 0) * 64 + col], s1 = Sl[(4 * k4 + 1) * 64 + col], s2 = Sl[(4 * k4 + 2) * 64 + col], s3 = Sl[(4 * k4 + 3) * 64 + col];
#pragma unroll
            for (int k = 0; k < 8; ++k) { const f32x4 pv = *(const LAS f32x4*)(Pl + (dk0 + 8 * k) * 64 + 4 * k4); out[k] += (pv.x * s0 + pv.y * s1) + (pv.z * s2 + pv.w * s3); }
        }
        __syncthreads();
#pragma unroll
        for (int k = 0; k < 8; ++k) { Sl[(dk0 + 8 * k) * 64 + col] = out[k]; SST[(size_t)(sg + 1) * 4096 + (dk0 + 8 * k) * 64 + col] = out[k]; }
        __syncthreads();
    }
}

__device__ __forceinline__ void attn_unit(Frame& F, const Args& A, int layer, int unit) {
    const bf16_t* PX = (const bf16_t*)(F.ws + WS_PX);
    bf16_t* ACT = (bf16_t*)(F.ws + WS_ACT);
    const int lane = F.lane, wave = F.wave, r = lane & 15, g = lane >> 4, tid = F.tid;
    const bool isctx = unit >= 256;
    const int qb = isctx ? (unit - 256) >> 1 : unit >> 1, hk = unit & 1;
    const int qrow0 = (isctx ? NL : 0) + 128 * qb + 16 * wave;
    const int qpos = 128 * qb + 16 * wave + r;
    const float SCL = 0.125f * 1.4426950408889634f;
    bf16x8 qf[3][2];
#pragma unroll
    for (int a = 0; a < 3; ++a)
#pragma unroll
        for (int ks = 0; ks < 2; ++ks) qf[a][ks] = *(const bf16x8*)(PX + (size_t)(qrow0 + r) * INP + C_AQ + (3 * hk + a) * 64 + 32 * ks + 8 * g);
    float mrun[3], lrun[3]; f32x4 o[3][4];
#pragma unroll
    for (int a = 0; a < 3; ++a) { mrun[a] = A.in[I_SINK][layer * 6 + 3 * hk + a] * 1.4426950408889634f; lrun[a] = 1.f;
#pragma unroll
        for (int dt = 0; dt < 4; ++dt) o[a][dt] = (f32x4){0.f, 0.f, 0.f, 0.f}; }
    const int jlo = (!isctx && qb == 0) ? 2 : 0, jhi = isctx ? 0 : ((qb == 127) ? 4 : 6);
    const int ntile = 4 + (jhi - jlo);
    const int skey = tid >> 3, sch = tid & 7;
    const int spk = (skey & 32) + 8 * (((skey & 31) & 15) >> 2) + 4 * ((skey & 31) >> 4) + (skey & 3);
#define ATT_KROW(s_) ((s_) < 4 ? NL + 64 * (s_) : 128 * (qb - 1) + 64 * (jlo + (s_) - 4))
#define ATT_LOAD(s_) do { const size_t ro_ = (size_t)(ATT_KROW(s_) + skey) * INP; pkv = *(const u32x4*)(PX + ro_ + C_AK + hk * 64 + sch * 8); pvv = *(const u32x4*)(PX + ro_ + C_AV + hk * 64 + sch * 8); } while (0)
#define ATT_STAGE(buf_) do { LAS unsigned char* kb_ = F.lds + (buf_) * 18432; *(LAS u32x4*)(kb_ + skey * 144 + sch * 16) = pkv; LAS bf16_t* vt = (LAS bf16_t*)(kb_ + 9216); \
        vt[(sch * 8 + 0) * 72 + spk] = (bf16_t)(pvv.x & 0xffffu); vt[(sch * 8 + 1) * 72 + spk] = (bf16_t)(pvv.x >> 16); vt[(sch * 8 + 2) * 72 + spk] = (bf16_t)(pvv.y & 0xffffu); vt[(sch * 8 + 3) * 72 + spk] = (bf16_t)(pvv.y >> 16); \
        vt[(sch * 8 + 4) * 72 + spk] = (bf16_t)(pvv.z & 0xffffu); vt[(sch * 8 + 5) * 72 + spk] = (bf16_t)(pvv.z >> 16); vt[(sch * 8 + 6) * 72 + spk] = (bf16_t)(pvv.w & 0xffffu); vt[(sch * 8 + 7) * 72 + spk] = (bf16_t)(pvv.w >> 16); } while (0)
    u32x4 pkv, pvv;
    ATT_LOAD(0); ATT_STAGE(0);
    __syncthreads();
    for (int ti = 0; ti < ntile; ++ti) {
        const int krow0 = ATT_KROW(ti);
        const int q0w = 128 * qb + 16 * wave;
        const bool local = ti >= 4 && ((krow0 + 63 - q0w > 128) || (q0w + 15 - krow0 > 128));
        if (ti + 1 < ntile) ATT_LOAD(ti + 1);
        LAS unsigned char* Kl = F.lds + (ti & 1) * 18432;
        LAS unsigned char* Vl = Kl + 9216;
        f32x4 st[3][4];
#pragma unroll
        for (int kt = 0; kt < 4; ++kt) {
            const bf16x8 k0 = *(const LAS bf16x8*)(Kl + (16 * kt + r) * 144 + (8 * g) * 2);
            const bf16x8 k1 = *(const LAS bf16x8*)(Kl + (16 * kt + r) * 144 + (32 + 8 * g) * 2);
#pragma unroll
            for (int a = 0; a < 3; ++a) {
                f32x4 c = (f32x4){0.f, 0.f, 0.f, 0.f};
                c = __builtin_amdgcn_mfma_f32_16x16x32_bf16(k0, qf[a][0], c, 0, 0, 0);
                c = __builtin_amdgcn_mfma_f32_16x16x32_bf16(k1, qf[a][1], c, 0, 0, 0);
                st[a][kt] = c;
            }
        }
        u32x4 bp[3][2];
#pragma unroll
        for (int a = 0; a < 3; ++a) {
            float tmax = -INFINITY;
#pragma unroll
            for (int kt = 0; kt < 4; ++kt)
#pragma unroll
                for (int e = 0; e < 4; ++e) {
                    float sv = st[a][kt][e] * SCL;
                    if (local) { const int kp = krow0 + 16 * kt + 4 * g + e; const int df = qpos - kp; if (df > 128 || df < -128) sv = -INFINITY; }
                    st[a][kt][e] = sv; tmax = fmaxf(tmax, sv);
                }
            tmax = fmaxf(tmax, __shfl_xor(tmax, 16)); tmax = fmaxf(tmax, __shfl_xor(tmax, 32));
            const float mnew = fmaxf(mrun[a], tmax);
            const float alpha = __builtin_amdgcn_exp2f(mrun[a] - mnew);
            float ls = 0.f;
#pragma unroll
            for (int kt = 0; kt < 4; ++kt)
#pragma unroll
                for (int e = 0; e < 4; ++e) { const float p = __builtin_amdgcn_exp2f(st[a][kt][e] - mnew); st[a][kt][e] = p; ls += p; }
            ls += __shfl_xor(ls, 16); ls += __shfl_xor(ls, 32);
            lrun[a] = lrun[a] * alpha + ls; mrun[a] = mnew;
#pragma unroll
            for (int dt = 0; dt < 4; ++dt) o[a][dt] = o[a][dt] * alpha;
#pragma unroll
            for (int k2 = 0; k2 < 2; ++k2) { bp[a][k2].x = pkbf(st[a][2 * k2][0], st[a][2 * k2][1]); bp[a][k2].y = pkbf(st[a][2 * k2][2], st[a][2 * k2][3]);
                bp[a][k2].z = pkbf(st[a][2 * k2 + 1][0], st[a][2 * k2 + 1][1]); bp[a][k2].w = pkbf(st[a][2 * k2 + 1][2], st[a][2 * k2 + 1][3]); }
        }
#pragma unroll
        for (int dt = 0; dt < 4; ++dt)
#pragma unroll
            for (int k2 = 0; k2 < 2; ++k2) {
                const u32x4 av = *(const LAS u32x4*)(Vl + (16 * dt + r) * 144 + (32 * k2 + 8 * g) * 2);
#pragma unroll
                for (int a = 0; a < 3; ++a) o[a][dt] = __builtin_amdgcn_mfma_f32_16x16x32_bf16(__builtin_bit_cast(bf16x8, av), __builtin_bit_cast(bf16x8, bp[a][k2]), o[a][dt], 0, 0, 0);
            }
        if (ti + 1 < ntile) ATT_STAGE((ti + 1) & 1);
        __syncthreads();
    }
#undef ATT_KROW
#undef ATT_LOAD
#undef ATT_STAGE
#pragma unroll
    for (int a = 0; a < 3; ++a) {
        const float inv = 1.0f / lrun[a];
#pragma unroll
        for (int dt = 0; dt < 4; ++dt) {
            u32x2 w; w.x = pkbf(o[a][dt][0] * inv, o[a][dt][1] * inv); w.y = pkbf(o[a][dt][2] * inv, o[a][dt][3] * inv);
            *(u32x2*)(ACT + (size_t)(qrow0 + r) * D + 640 + (3 * hk + a) * 64 + 16 * dt + 4 * g) = w;
        }
    }
}

constexpr int X1_JOBS = 12 * (2 * (NSEG - 1) - 1);
__device__ __forceinline__ void scan_x1_phase(Frame& F, const Args& A, int layer) {
    const int b = blockIdx.x;
    if (b < X1_JOBS) {
        const int dh = b / (2 * (NSEG - 1) - 1), k = b % (2 * (NSEG - 1) - 1);
        if (k == 0) dn_scan_job<1>(F, dh, 0);
        else { const int sg = 1 + ((k - 1) >> 1); if ((k - 1) & 1) dn_scan_job<1>(F, dh, sg); else dn_scan_job<2>(F, dh, sg); }
        return;
    }
    const int nw = F.G - X1_JOBS;
    for (int u = b - X1_JOBS; u < 100; u += nw) { attn_unit(F, A, layer, u); __syncthreads(); }
}
__device__ __forceinline__ void scan_x2_phase(Frame& F) {
    if (blockIdx.x < 12) dn_combine(F, blockIdx.x);
}
__device__ __forceinline__ void scan_x3_phase(Frame& F, const Args& A, int layer) {
    if (blockIdx.x < 12 * NSEG) { dn_scan_job<0>(F, blockIdx.x / NSEG, blockIdx.x % NSEG); return; }
    const int nunits = layer == 0 ? 260 : 256, nw = F.G - 12 * NSEG;
    for (int u = 100 + blockIdx.x - 12 * NSEG; u < nunits; u += nw) { attn_unit(F, A, layer, u); __syncthreads(); }
}

constexpr int DO_BUF = 58880;
__device__ __forceinline__ void dn_out_phase(Frame& F, const Args& A, int layer) {
    const bf16_t* PX = (const bf16_t*)(F.ws + WS_PX);
    bf16_t* ACT = (bf16_t*)(F.ws + WS_ACT);
    const bf16_t* QD = (const bf16_t*)(F.ws + WS_QD); const bf16_t* KD = (const bf16_t*)(F.ws + WS_QD + QKV_STRIDE);
    const float* Gg = (const float*)(F.ws + WS_G);
    const bf16_t* VT = (const bf16_t*)(F.ws + WS_DN + 3 * DN_STRIDE); const bf16_t* ST = (const bf16_t*)(F.ws + WS_DN + 4 * DN_STRIDE);
    const float* ng = A.in[I_NORMG] + layer * 64;
    const int tid = F.tid, lane = F.lane, wave = F.wave, r = lane & 15, g = lane >> 4;
    const int it = wave & 3, hf = wave >> 2;
    const int nunits = (layer == 0 ? 260 : 256) * 6;
    const int srow = tid >> 3, sc = tid & 7;
    const int soff = srow * 128 + ((sc ^ ((srow >> 1) & 7)) << 4);
    u32x4 pre[7]; float gpre = 0.f;
#define DO_ROW0(u_) (((u_) / 6) < 256 ? 64 * ((u_) / 6) : NL + 64 * (((u_) / 6) - 256))
#define DO_LOAD(u_) do { const int oc_ = (u_) / 6, h_ = (u_) % 6, row0_ = DO_ROW0(u_); \
        const int s0_ = oc_ < 256 ? 4 + oc_ : oc_ - 256, s1_ = oc_ < 256 ? 4 + 255 - oc_ : 3 - (oc_ - 256); \
        const size_t U0_ = (size_t)(h_ * DN_NS + s0_) * 4096, U1_ = (size_t)((6 + h_) * DN_NS + s1_) * 4096; \
        pre[0] = *(const u32x4*)(QD + (size_t)(row0_ + srow) * 384 + h_ * 64 + sc * 8); pre[1] = *(const u32x4*)(KD + (size_t)(row0_ + srow) * 384 + h_ * 64 + sc * 8); \
        pre[2] = *(const u32x4*)(ST + U0_ + srow * 64 + sc * 8); pre[3] = *(const u32x4*)(ST + U1_ + srow * 64 + sc * 8); \
        pre[4] = *(const u32x4*)(VT + U0_ + srow * 64 + sc * 8); pre[5] = *(const u32x4*)(VT + U1_ + srow * 64 + sc * 8); \
        pre[6] = *(const u32x4*)(PX + (size_t)(row0_ + srow) * INP + C_DZ + h_ * 64 + sc * 8); \
        if (wave < 2) gpre = Gg[(size_t)(row0_ + lane) * 12 + wave * 6 + h_]; } while (0)
#define DO_STAGE(b_) do { LAS unsigned char* bb_ = F.lds + (b_) * DO_BUF; \
        _Pragma("unroll") for (int q_ = 0; q_ < 7; ++q_) *(LAS u32x4*)(bb_ + q_ * 8192 + soff) = pre[q_]; \
        if (wave < 2) { float gv_ = gpre; \
            _Pragma("unroll") for (int o_ = 1; o_ < 64; o_ <<= 1) { const float t_ = wave ? __shfl_down(gv_, o_) : __shfl_up(gv_, o_); if (wave ? (lane + o_ < 64) : (lane >= o_)) gv_ += t_; } \
            ((LAS float*)(bb_ + 57344))[wave * 64 + lane] = gv_; } } while (0)
    int u = blockIdx.x, cur = 0;
    if (u < nunits) { DO_LOAD(u); DO_STAGE(0); }
    __syncthreads();
    f32x4 ngv[2];
#pragma unroll
    for (int dtl = 0; dtl < 2; ++dtl) ngv[dtl] = *(const f32x4*)(ng + 16 * (2 * hf + dtl) + 4 * g);
#pragma unroll 1
    for (; u < nunits; u += F.G) {
        const int un = u + F.G;
        if (un < nunits) DO_LOAD(un);
        const int h = u % 6, row0 = DO_ROW0(u);
        LAS unsigned char* bb = F.lds + cur * DO_BUF;
        const LAS float* gc0 = (const LAS float*)(bb + 57344); const LAS float* gc1 = gc0 + 64;
        LAS float* ssx = (LAS float*)(bb + 57344 + 512);
        const int i = 16 * it + r;
        const float e0 = gc0[i], e1 = gc1[i];
        bf16x8 qf[2];
#pragma unroll
        for (int ks = 0; ks < 2; ++ks) qf[ks] = *(const LAS bf16x8*)(bb + sc_off(16 * it + r, 32 * ks + 8 * g));
        f32x4 pt[4];
#pragma unroll
        for (int jt = 0; jt < 4; ++jt) {
            f32x4 c = (f32x4){0.f, 0.f, 0.f, 0.f};
#pragma unroll
            for (int ks = 0; ks < 2; ++ks) c = __builtin_amdgcn_mfma_f32_16x16x32_bf16(*(const LAS bf16x8*)(bb + 8192 + sc_off(16 * jt + r, 32 * ks + 8 * g)), qf[ks], c, 0, 0, 0);
            pt[jt] = c;
        }
        f32x4 o[2];
#pragma unroll
        for (int dtl = 0; dtl < 2; ++dtl) o[dtl] = (f32x4){0.f, 0.f, 0.f, 0.f};
#pragma unroll
        for (int dir = 0; dir < 2; ++dir) {
            const LAS float* gcd = dir == 0 ? gc0 : gc1; const float ei = dir == 0 ? e0 : e1;
            const float xi = __expf(ei);
            u32x4 bp[2]; float pv[4][4];
#pragma unroll
            for (int jt = 0; jt < 4; ++jt)
#pragma unroll
                for (int e = 0; e < 4; ++e) {
                    const int j = 16 * jt + 4 * g + e;
                    const bool ok = dir == 0 ? (j <= i) : (j >= i);
                    pv[jt][e] = ok ? pt[jt][e] * __expf(ei - gcd[j]) : 0.f;
                }
#pragma unroll
            for (int k2 = 0; k2 < 2; ++k2) { bp[k2].x = pkbf(pv[2 * k2][0], pv[2 * k2][1]); bp[k2].y = pkbf(pv[2 * k2][2], pv[2 * k2][3]); bp[k2].z = pkbf(pv[2 * k2 + 1][0], pv[2 * k2 + 1][1]); bp[k2].w = pkbf(pv[2 * k2 + 1][2], pv[2 * k2 + 1][3]); }
            const LAS unsigned char* stt = bb + (2 + dir) * 8192; const LAS unsigned char* vtt = bb + (4 + dir) * 8192;
#pragma unroll
            for (int dtl = 0; dtl < 2; ++dtl) {
                const int dt = 2 * hf + dtl;
                f32x4 c = (f32x4){0.f, 0.f, 0.f, 0.f};
#pragma unroll
                for (int ks = 0; ks < 2; ++ks) c = __builtin_amdgcn_mfma_f32_16x16x32_bf16(*(const LAS bf16x8*)(stt + sc_off(16 * dt + r, 32 * ks + 8 * g)), qf[ks], c, 0, 0, 0);
                f32x4 acc = o[dtl] + c * xi;
#pragma unroll
                for (int k2 = 0; k2 < 2; ++k2) {
                    const u32x2 lo = *(const LAS u32x2*)(vtt + sc_off(16 * dt + r, 32 * k2 + 4 * g)), hi = *(const LAS u32x2*)(vtt + sc_off(16 * dt + r, 32 * k2 + 16 + 4 * g));
                    const u32x4 av = (u32x4){lo.x, lo.y, hi.x, hi.y};
                    acc = __builtin_amdgcn_mfma_f32_16x16x32_bf16(__builtin_bit_cast(bf16x8, av), __builtin_bit_cast(bf16x8, bp[k2]), acc, 0, 0, 0);
                }
                o[dtl] = acc;
            }
        }
        float ss = 0.f;
#pragma unroll
        for (int dtl = 0; dtl < 2; ++dtl) ss += (o[dtl][0] * o[dtl][0] + o[dtl][1] * o[dtl][1]) + (o[dtl][2] * o[dtl][2] + o[dtl][3] * o[dtl][3]);
        ss += __shfl_xor(ss, 16); ss += __shfl_xor(ss, 32);
        if (g == 0) ssx[wave * 16 + r] = ss;
        __syncthreads();
        const float rstd = 1.0f / sqrtf((ssx[wave * 16 + r] + ssx[(wave ^ 4) * 16 + r]) * (1.f / 64.f) + EPS);
#pragma unroll
        for (int dtl = 0; dtl < 2; ++dtl) {
            const int dt = 2 * hf + dtl;
            const u32x2 zz = *(const LAS u32x2*)(bb + 6 * 8192 + sc_off(i, 16 * dt + 4 * g));
            const float z0 = bf2f(zz.x & 0xffffu), z1 = bf2f(zz.x >> 16), z2 = bf2f(zz.y & 0xffffu), z3 = bf2f(zz.y >> 16);
            u32x2 w; w.x = pkbf(o[dtl][0] * rstd * ngv[dtl][0] * silu_f(z0), o[dtl][1] * rstd * ngv[dtl][1] * silu_f(z1));
            w.y = pkbf(o[dtl][2] * rstd * ngv[dtl][2] * silu_f(z2), o[dtl][3] * rstd * ngv[dtl][3] * silu_f(z3));
            *(LAS u32x2*)(bb + 8192 + sc_off(i, 16 * dt + 4 * g)) = w;
        }
        __syncthreads();
        *(u32x4*)(ACT + (size_t)(row0 + srow) * D + 256 + h * 64 + sc * 8) = *(const LAS u32x4*)(bb + 8192 + soff);
        if (un < nunits) DO_STAGE(cur ^ 1);
        __syncthreads();
        cur ^= 1;
    }
#undef DO_ROW0
#undef DO_LOAD
#undef DO_STAGE
}

constexpr size_t RT_EID = WS_ROUTE, RT_GATE = WS_ROUTE + 128 * 1024, RT_TSLOT = WS_ROUTE + 256 * 1024, RT_BCNT = WS_ROUTE + 384 * 1024, RT_TILEE = WS_ROUTE + 400 * 1024, RT_NT = WS_ROUTE + 404 * 1024;
constexpr size_t WS_XS = WS_BIG;
constexpr size_t WS_Y = 278 * MiB;
constexpr size_t WS_HM = 350 * MiB;
constexpr int MOE_CH = 72;
constexpr size_t WS_SLAB = 440 * MiB;
static_assert(WS_HM + (size_t)72 * 256 * DFE <= WS_SLAB && WS_SLAB + (size_t)8 * 28 * 65536 * 4 <= WS_END, "slab map");
static_assert(WS_XS + (size_t)36864 * 1024 <= WS_Y && WS_Y + (size_t)36864 * 2048 <= WS_HM, "moe map");

__device__ __forceinline__ void norm2_router_phase(Frame& F, const Args& A) {
    const float* mod = (const float*)(F.ws + WS_MOD) + (1 * 2 + 0) * 6144;
    const float* shift = mod + 3 * 1024; const float* scale = mod + 4 * 1024;
    unsigned char* act8 = F.ws + WS_ACT;
    int* EID = (int*)(F.ws + RT_EID); float* GATE = (float*)(F.ws + RT_GATE); int* BCNT = (int*)(F.ws + RT_BCNT);
    LAS int* se = (LAS int*)F.lds;
    LAS float* rw = (LAS float*)(F.lds + 1024);
    for (int i = F.tid; i < 2048; i += NTHREADS) ((LAS f32x4*)rw)[i] = ((const GAS f32x4*)A.in[I_ROUTER])[i];
    __syncthreads();
    const int lane = F.lane;
    f32x4 shl[4], scl[4];
#pragma unroll
    for (int j = 0; j < 4; ++j) { shl[j] = ((const GAS f32x4*)shift)[lane + 64 * j]; scl[j] = ((const GAS f32x4*)scale)[lane + 64 * j] + 1.0f; }
    for (int k = 0; k < 8; ++k) {
        const int tl = F.wave * 8 + k, t = blockIdx.x * 64 + tl;
        const GAS f32x4* xr = (const GAS f32x4*)(A.out + (size_t)t * D) + lane;
        f32x4 v[4]; float s = 0.f;
#pragma unroll
        for (int j = 0; j < 4; ++j) { v[j] = xr[64 * j]; s += (v[j].x * v[j].x + v[j].y * v[j].y) + (v[j].z * v[j].z + v[j].w * v[j].w); }
        const float rstd = 1.0f / sqrtf(wave_sum(s) * (1.f / D) + EPS);
        float lg[8];
#pragma unroll
        for (int e = 0; e < 8; ++e) lg[e] = 0.f;
        GAS unsigned* o8 = (GAS unsigned*)(act8 + (size_t)t * D) + lane;
#pragma unroll
        for (int j = 0; j < 4; ++j) {
            const f32x4 y = v[j] * rstd * scl[j] + shl[j];
            o8[64 * j] = pk_fp8x4(y.x, y.y, y.z, y.w);
            const int c0 = 4 * (lane + 64 * j);
#pragma unroll
            for (int q = 0; q < 4; ++q) {
                const f32x4 r0 = *(const LAS f32x4*)(rw + (c0 + q) * 8), r1 = *(const LAS f32x4*)(rw + (c0 + q) * 8 + 4);
                const float yy = y[q];
                lg[0] += yy * r0.x; lg[1] += yy * r0.y; lg[2] += yy * r0.z; lg[3] += yy * r0.w; lg[4] += yy * r1.x; lg[5] += yy * r1.y; lg[6] += yy * r1.z; lg[7] += yy * r1.w;
            }
        }
#pragma unroll
        for (int e = 0; e < 8; ++e) lg[e] = wave_sum(lg[e]);
        int e0 = 0; float l0 = lg[0];
#pragma unroll
        for (int e = 1; e < 8; ++e) if (lg[e] > l0) { l0 = lg[e]; e0 = e; }
        int e1 = -1; float l1 = -INFINITY;
#pragma unroll
        for (int e = 0; e < 8; ++e) if (e != e0 && lg[e] > l1) { l1 = lg[e]; e1 = e; }
        if (lane == 0) {
            const float g0 = 1.0f / (1.0f + expf(l1 - l0));
            EID[t * 2] = e0; EID[t * 2 + 1] = e1; GATE[t * 2] = g0; GATE[t * 2 + 1] = 1.0f - g0;
            se[tl * 2] = e0; se[tl * 2 + 1] = e1;
        }
    }
    __syncthreads();
    if (F.wave == 0) {
        const int a0 = se[lane * 2], a1 = se[lane * 2 + 1];
#pragma unroll
        for (int e = 0; e < 8; ++e) { const unsigned long long mk = __ballot(a0 == e || a1 == e); if (lane == e) BCNT[blockIdx.x * 8 + e] = __popcll(mk); }
    }
    __syncthreads();
}

__device__ __forceinline__ void moe_assign_phase(Frame& F) {
    const int* EID = (const int*)(F.ws + RT_EID); int* TSLOT = (int*)(F.ws + RT_TSLOT); const int* BCNT = (const int*)(F.ws + RT_BCNT);
    unsigned* TILEE = (unsigned*)(F.ws + RT_TILEE); unsigned* NTL = (unsigned*)(F.ws + RT_NT);
    const unsigned char* act8 = F.ws + WS_ACT; unsigned char* XS = F.ws + WS_XS;
    LAS int* sm = (LAS int*)F.lds;
    const int b = blockIdx.x, lane = F.lane;
    if (F.tid < 8) {
        int tot = 0, mine = 0;
        for (int bb = 0; bb < 256; ++bb) { const int c = __hip_atomic_load(BCNT + bb * 8 + F.tid, RLX_AGENT); if (bb < b) mine += c; tot += c; }
        sm[F.tid] = tot; sm[8 + F.tid] = mine;
    }
    __syncthreads();
    if (F.tid == 0) {
        int ps = 0, nt = 0;
        for (int e = 0; e < 8; ++e) { const int tl = (sm[e] + 255) >> 8; sm[16 + e] = ps; sm[24 + e] = tl; if (b == 0) for (int q = 0; q < tl; ++q) TILEE[nt + q] = (unsigned)e; ps += tl * 256; nt += tl; }
        if (b == 0) *NTL = (unsigned)nt;
    }
    __syncthreads();
    if (F.wave == 0) {
        const int t = b * 64 + lane;
        const int a0 = EID[t * 2], a1 = EID[t * 2 + 1];
        int s0 = 0, s1 = 0;
        const unsigned long long lower = (1ull << lane) - 1ull;
#pragma unroll
        for (int e = 0; e < 8; ++e) {
            const unsigned long long mk = __ballot(a0 == e || a1 == e);
            const int rank = __popcll(mk & lower), slot = sm[16 + e] + sm[8 + e] + rank;
            if (a0 == e) s0 = slot; if (a1 == e) s1 = slot;
        }
        TSLOT[t * 2] = s0; TSLOT[t * 2 + 1] = s1; sm[32 + lane * 2] = s0; sm[33 + lane * 2] = s1;
    }
    __syncthreads();
    for (int q = F.wave; q < 128; q += NWAVES) {
        const int t = b * 64 + (q >> 1), slot = sm[32 + q];
        const GAS u32x4* srcp = (const GAS u32x4*)(act8 + (size_t)t * D); GAS u32x4* dstp = (GAS u32x4*)(XS + (size_t)slot * D);
        dstp[lane] = srcp[lane];
    }
    { const int e = b & 7, cnt = sm[e], first = sm[16 + e] + cnt, npad = sm[24 + e] * 256 - cnt;
      for (int p = (b >> 3) * NWAVES + F.wave; p < npad; p += 32 * NWAVES) { GAS u32x4* dstp = (GAS u32x4*)(XS + (size_t)(first + p) * D); const u32x4 z = (u32x4){0u, 0u, 0u, 0u}; dstp[lane] = z; } }
}

__device__ __forceinline__ f32x4 moe_yrow(const bf16_t* Y, const float* SLAB, int slot, int tail0, int j, int lane) {
    const int tile = slot >> 8;
    if (tile < tail0) { const u32x2 a = ((const GAS u32x2*)(Y + (size_t)slot * D))[lane + 64 * j];
        return (f32x4){bf2f(a.x & 0xffffu), bf2f(a.x >> 16), bf2f(a.y & 0xffffu), bf2f(a.y >> 16)}; }
    const float* p = SLAB + (size_t)(((tile - tail0) * 4 + j) * 7) * 65536 + (size_t)(slot & 255) * 256 + 4 * lane;
    f32x4 s = *(const f32x4*)p;
#pragma unroll
    for (int ks = 1; ks < 7; ++ks) s = s + *(const f32x4*)(p + (size_t)ks * 65536);
    return s;
}
__device__ __forceinline__ void moe_final_phase(Frame& F, const Args& A) {
    const float* mod5 = (const float*)(F.ws + WS_MOD) + (1 * 2 + 0) * 6144 + 5 * 1024;
    const int* TSLOT = (const int*)(F.ws + RT_TSLOT); const float* GATE = (const float*)(F.ws + RT_GATE);
    const bf16_t* Y = (const bf16_t*)(F.ws + WS_Y); const float* SLAB = (const float*)(F.ws + WS_SLAB);
    const float* fng = A.in[I_FNG];
    const int lane = F.lane;
    const int ntl = (int)__builtin_amdgcn_readfirstlane(__hip_atomic_load((unsigned*)(F.ws + RT_NT), RLX_AGENT));
    const int tail0 = (ntl > 128 && ntl - 128 <= 8) ? 128 : (1 << 20);
    f32x4 m5v[4], fgv[4];
#pragma unroll
    for (int j = 0; j < 4; ++j) { m5v[j] = ((const GAS f32x4*)mod5)[lane + 64 * j]; fgv[j] = ((const GAS f32x4*)fng)[lane + 64 * j]; }
    for (int t = F.gw; t < NL; t += F.NGW) {
        const int s0 = TSLOT[t * 2], s1 = TSLOT[t * 2 + 1]; const float g0 = GATE[t * 2], g1 = GATE[t * 2 + 1];
        GAS f32x4* xr = (GAS f32x4*)(A.out + (size_t)t * D) + lane;
        f32x4 v[4]; float s = 0.f;
        if (((s0 >> 8) < tail0) && ((s1 >> 8) < tail0)) {
            const GAS u32x2* y0 = (const GAS u32x2*)(Y + (size_t)s0 * D) + lane; const GAS u32x2* y1 = (const GAS u32x2*)(Y + (size_t)s1 * D) + lane;
#pragma unroll
            for (int j = 0; j < 4; ++j) {
                const f32x4 x = xr[64 * j]; const u32x2 a = y0[64 * j], c = y1[64 * j];
                const f32x4 m5 = m5v[j];
                f32x4 f;
                f.x = g0 * bf2f(a.x & 0xffffu) + g1 * bf2f(c.x & 0xffffu); f.y = g0 * bf2f(a.x >> 16) + g1 * bf2f(c.x >> 16);
                f.z = g0 * bf2f(a.y & 0xffffu) + g1 * bf2f(c.y & 0xffffu); f.w = g0 * bf2f(a.y >> 16) + g1 * bf2f(c.y >> 16);
                v[j] = x + m5 * f;
                s += (v[j].x * v[j].x + v[j].y * v[j].y) + (v[j].z * v[j].z + v[j].w * v[j].w);
            }
        } else {
#pragma unroll
            for (int j = 0; j < 4; ++j) {
                const f32x4 x = xr[64 * j];
                const f32x4 m5 = m5v[j];
                const f32x4 f = moe_yrow(Y, SLAB, s0, tail0, j, lane) * g0 + moe_yrow(Y, SLAB, s1, tail0, j, lane) * g1;
                v[j] = x + m5 * f;
                s += (v[j].x * v[j].x + v[j].y * v[j].y) + (v[j].z * v[j].z + v[j].w * v[j].w);
            }
        }
        const float rstd = 1.0f / sqrtf(wave_sum_l(s, lane) * (1.f / D) + EPS);
#pragma unroll
        for (int j = 0; j < 4; ++j) xr[64 * j] = v[j] * rstd * fgv[j];
    }
}

#define GRID_BAR() do { { unsigned* bp_ = (unsigned*)(F.ws + WS_CTL) + 4096; asm volatile("" : "+s"(bp_)); bar.bar = bp_; } xcd_barrier(bar); TS_STAMP(); F.tid = opq((int)threadIdx.x); F.lane = F.tid & 63; } while (0)

template <int MODE>
__device__ __forceinline__ void ctx_pieces(Frame& F, const bf16_t* A, const bf16_t* Bt, int K, int ncg, void* O, int ldo, const float* base, const float* gate,
                                           int nrg = 16, const unsigned* tile_e = nullptr, int tile0 = 0, size_t estride = 0) {
    const int lane = F.lane, r = lane & 15, g = lane >> 4, wave = F.wave;
    LAS float* red = (LAS float*)F.lds;
    const int npieces = nrg * ncg, kw = K >> 3;
    for (int p = blockIdx.x; p < npieces; p += F.G) {
        const int rg = p % nrg, cg = p / nrg;
        f32x4 acc[4];
#pragma unroll
        for (int n = 0; n < 4; ++n) acc[n] = (f32x4){0.f, 0.f, 0.f, 0.f};
        const bf16_t* ap = A + (size_t)(16 * rg + r) * K + wave * kw + 8 * g;
        size_t eoff = 0;
        if (tile_e) eoff = (size_t)(__builtin_amdgcn_readfirstlane(__hip_atomic_load(tile_e + tile0 + (rg >> 4), __ATOMIC_RELAXED, __HIP_MEMORY_SCOPE_AGENT)) & 7u) * estride;
        const bf16_t* bp = Bt + eoff + (size_t)(64 * cg + r) * K + wave * kw + 8 * g;
        bf16x8 a0 = *(const bf16x8*)ap, b0[4];
#pragma unroll
        for (int n = 0; n < 4; ++n) b0[n] = *(const bf16x8*)(bp + (size_t)(16 * n) * K);
        for (int k = 32; k < kw; k += 32) {
            const bf16x8 a1 = *(const bf16x8*)(ap + k); bf16x8 b1[4];
#pragma unroll
            for (int n = 0; n < 4; ++n) b1[n] = *(const bf16x8*)(bp + (size_t)(16 * n) * K + k);
#pragma unroll
            for (int n = 0; n < 4; ++n) acc[n] = __builtin_amdgcn_mfma_f32_16x16x32_bf16(a0, b0[n], acc[n], 0, 0, 0);
            a0 = a1;
#pragma unroll
            for (int n = 0; n < 4; ++n) b0[n] = b1[n];
        }
#pragma unroll
        for (int n = 0; n < 4; ++n) acc[n] = __builtin_amdgcn_mfma_f32_16x16x32_bf16(a0, b0[n], acc[n], 0, 0, 0);
#pragma unroll
        for (int n = 0; n < 4; ++n)
#pragma unroll
            for (int e = 0; e < 4; ++e) red[wave * 1024 + (4 * g + e) * 64 + 16 * n + r] = acc[n][e];
        __syncthreads();
        for (int idx = F.tid; idx < 1024; idx += NTHREADS) {
            float s = 0.f;
#pragma unroll
            for (int w = 0; w < 8; ++w) s += red[w * 1024 + idx];
            const int row = 16 * rg + (idx >> 6), col = 64 * cg + (idx & 63);
            if (MODE == 0) ((bf16_t*)O)[(size_t)row * ldo + col] = (bf16_t)f2bf(s);
            else ((float*)O)[(size_t)row * 1024 + col] = base[(size_t)row * 1024 + col] + gate[col] * s;
        }
        __syncthreads();
    }
}

#ifndef STOP_AFTER
#define STOP_AFTER 0
#endif
__device__ __forceinline__ void dump_bf16(Frame& F, float* out, const bf16_t* buf, int ld, int ncols) {
    for (int m = F.gw; m < NL; m += F.NGW)
        for (int j = 0; j < 16; ++j) { const int c = F.lane + 64 * j; float s = 0.f; for (int k = 0; c + 1024 * k < ncols; ++k) s += bf2f(buf[(size_t)m * ld + c + 1024 * k]); out[(size_t)m * D + c] = s; }
}
#define STOP_DUMP(n, buf, ld, nc) do { if (layer == 0 && STOP_AFTER == (n)) { dump_bf16(F, args.out, (const bf16_t*)(buf), (ld), (nc)); F.ws = nullptr; return; } } while (0)
template <int layer>
__device__ __forceinline__ void layer_body(Frame& F, const Args& args, XcdBarrier& bar) {
    unsigned char* ws = F.ws;
    float* HC = (float*)(ws + WS_HC);
    const float* MOD = (const float*)(ws + WS_MOD);
        F.tid = opq((int)threadIdx.x); F.lane = F.tid & 63;
        const float* xl = layer == 0 ? args.in[I_X] : args.out;
        const float* xc = layer == 0 ? args.in[I_CTX] : HC;
        const float* modx = MOD + (layer * 2 + 0) * 6144; const float* modc = MOD + (layer * 2 + 1) * 6144;
        norm_phase(F, xl, xc, layer, 0, 1, NT);
        GRID_BAR();
        ctx_pieces<0>(F, (const bf16_t*)(ws + WS_ACT) + (size_t)NL * 1024, (const bf16_t*)(ws + WS_WIN) + (size_t)layer * INP * 1024, 1024, INP / 64, (bf16_t*)(ws + WS_PX) + (size_t)NL * INP, INP, nullptr, nullptr);
        { pg8::DenseSched S{NL / 256, INP / 256, F.G, (int)blockIdx.x, (const char*)(ws + WS_ACT), (const char*)(ws + WS_WIN) + (size_t)layer * INP * 1024 * 2, (size_t)256 * 1024 * 2};
          pg8::EpiStoreBf16 E{(bf16_t*)(ws + WS_PX), INP};
          pg8::gemm_phase(F.lds, 1024, S, E); }
        GRID_BAR();
        STOP_DUMP(2, ws + WS_PX, INP, INC);
        prep_phase(F, args, layer);
        GRID_BAR();
        STOP_DUMP(3, ws + WS_QD, 384, 384);
        STOP_DUMP(33, ws + WS_QD + QKV_STRIDE, 384, 384);
        dn_chunk_phase(F);
        GRID_BAR();
        STOP_DUMP(4, ws + WS_DN, 1024, 1024);
        STOP_DUMP(44, ws + WS_DN + DN_STRIDE, 1024, 1024);
        STOP_DUMP(45, ws + WS_DN + 2 * DN_STRIDE, 1024, 1024);
        scan_x1_phase(F, args, layer);
        GRID_BAR();
        scan_x3_phase(F, args, layer);
        GRID_BAR();
        STOP_DUMP(5, ws + WS_DN + 3 * DN_STRIDE, 1024, 1024);
        STOP_DUMP(55, ws + WS_DN + 4 * DN_STRIDE, 1024, 1024);
        STOP_DUMP(56, ws + WS_ACT, 1024, 1024);
        dn_out_phase(F, args, layer);
        GRID_BAR();
        STOP_DUMP(6, ws + WS_ACT, 1024, 1024);
        if (layer == 0) ctx_pieces<1>(F, (const bf16_t*)(ws + WS_ACT) + (size_t)NL * 1024, (const bf16_t*)(ws + WS_WOUT), 1024, 16, HC, 1024, xc, modc + 2 * 1024);
        { pg8::DenseSched S{NL / 256, 4, F.G, (int)blockIdx.x, (const char*)(ws + WS_ACT), (const char*)(ws + WS_WOUT) + (size_t)layer * 1024 * 1024 * 2, (size_t)256 * 1024 * 2};
          pg8::EpiResid E{xl, args.out, modx + 2 * 1024, xc, HC, modc + 2 * 1024, NL / 256};
          pg8::gemm_phase(F.lds, 1024, S, E); }
        GRID_BAR();
        if (layer == 0 && STOP_AFTER == 7) { F.ws = nullptr; return; }
        if (layer == 0) {
            norm_phase(F, args.out, HC, 0, 3, 4, NT);
            GRID_BAR();
            { pg8::DenseSched S{NT / 256, 2 * DFF / 256, F.G, (int)blockIdx.x, (const char*)(ws + WS_ACT), (const char*)(ws + WS_WGU), (size_t)256 * 1024 * 2};
              pg8::EpiSwiGLU E{(bf16_t*)(ws + WS_BIG), DFF};
              pg8::gemm_phase(F.lds, 1024, S, E); }
            GRID_BAR();
            ctx_pieces<1>(F, (const bf16_t*)(ws + WS_BIG) + (size_t)NL * DFF, (const bf16_t*)(ws + WS_WDN), DFF, 16, HC, 1024, HC, modc + 5 * 1024);
            { pg8::DenseSched S{NL / 256, 4, F.G, (int)blockIdx.x, (const char*)(ws + WS_BIG), (const char*)(ws + WS_WDN), (size_t)256 * DFF * 2};
              pg8::EpiResid E{args.out, args.out, modx + 5 * 1024, HC, HC, modc + 5 * 1024, NL / 256};
              pg8::gemm_phase(F.lds, DFF, S, E); }
            GRID_BAR();
            if (STOP_AFTER == 9) { F.ws = nullptr; return; }
        } else {
            norm2_router_phase(F, args);
            GRID_BAR();
            moe_assign_phase(F);
            GRID_BAR();
            const int ntl = (int)__builtin_amdgcn_readfirstlane(__hip_atomic_load((unsigned*)(ws + RT_NT), RLX_AGENT));
#pragma unroll 1
            for (int t0 = 0; t0 < ntl; t0 += 64) {
                const int left = ntl - t0; const int nM = left > MOE_CH ? 64 : left;
                const int ntail = (nM > 64 && nM - 64 <= 8) ? nM - 64 : 0, nG2 = nM - ntail;
                { pg8::MoeSched S{nM, 2 * DFE / 256, F.G, (int)blockIdx.x, (const char*)(ws + WS_XS) + (size_t)t0 * 256 * 1024, (const char*)(ws + WS_MGU), (size_t)256 * 1024, (size_t)2 * DFE * 1024, (const unsigned*)(ws + RT_TILEE), t0, 0};
                  pg8::EpiSwiGLU8 E{ws + WS_HM, DFE, 1.0f / MOE_WSCALE, MOE_HSCALE};
                  pg8::gemm_phase<true>(F.lds, 512, S, E); }
                GRID_BAR();
                { pg8::MoeSched S{nG2, 4, F.G, (int)blockIdx.x, (const char*)(ws + WS_HM), (const char*)(ws + WS_MDN), (size_t)256 * DFE, (size_t)1024 * DFE, (const unsigned*)(ws + RT_TILEE), t0, t0};
                  pg8::EpiStoreBf16 E{(bf16_t*)(ws + WS_Y), 1024, 1.0f / (MOE_WSCALE * MOE_HSCALE)};
                  pg8::gemm_phase<true>(F.lds, DFE / 2, S, E); }
                if (ntail > 0) {
                    pg8::MoeTailSched S{ntail, F.G, (int)((blockIdx.x + 128) % F.G), (const char*)(ws + WS_HM) + (size_t)nG2 * 256 * DFE, (const char*)(ws + WS_MDN), (size_t)256 * DFE, (size_t)1024 * DFE, (const unsigned*)(ws + RT_TILEE), t0 + nG2, (size_t)512};
                    pg8::EpiSlab E{(float*)(ws + WS_SLAB), 1.0f / (MOE_WSCALE * MOE_HSCALE)};
                    pg8::gemm_phase<true>(F.lds, DFE / 2, S, E, 4);
                }
                GRID_BAR();
                if (left <= MOE_CH) break;
            }
            moe_final_phase(F, args);
        }
    }

__global__ void __launch_bounds__(NTHREADS, 2) fwd_kernel(Args args) {
    extern __shared__ __attribute__((aligned(16))) unsigned char lds[];
    Frame F;
    F.lds = (LAS unsigned char*)lds;
    F.tid = threadIdx.x; F.lane = F.tid & 63; F.wave = __builtin_amdgcn_readfirstlane(F.tid >> 6);
    F.G = gridDim.x; { const int bx = blockIdx.x; F.vcu = (F.G % 8 == 0) ? (bx % 8) * (F.G / 8) + bx / 8 : bx; }
    F.gw = F.vcu * NWAVES + F.wave; F.NGW = F.G * NWAVES;
    F.ws = args.ws;
    volatile LAS unsigned* MISC = (volatile LAS unsigned*)(F.lds + MISC_OFF);
    for (int u = F.tid; u < (LDS_BYTES - MISC_OFF) / 4; u += NTHREADS) ((LAS unsigned*)(F.lds + MISC_OFF))[u] = 0u;
    __syncthreads();
    XcdBarrier bar = xcd_barrier_post((unsigned*)(F.ws + WS_CTL) + 4096, MISC + 8);
    TS_STAMP();

    unsigned char* ws = F.ws;
    float* HC = (float*)(ws + WS_HC);
    const float* MOD = (const float*)(ws + WS_MOD);
#ifdef DIAG_ZERO
    { GAS u32x4* p = (GAS u32x4*)(F.ws + WS_MOD); const size_t n16 = (WS_END - WS_MOD) / 16; const u32x4 z = (u32x4){0u, 0u, 0u, 0u};
      for (size_t i = (size_t)blockIdx.x * NTHREADS + F.tid; i < n16; i += (size_t)F.G * NTHREADS) p[i] = z; }
    GRID_BAR();
#endif
    p0_prologue(F, args);
    GRID_BAR();
    layer_body<0>(F, args, bar);
    if (F.ws == nullptr) return;
    layer_body<1>(F, args, bar);
#ifdef TS_A
    TS_STAMP();
    if (blockIdx.x == 0 && threadIdx.x == 0) {
        volatile LAS unsigned* M_ = (volatile LAS unsigned*)(F.lds + MISC_OFF);
        const unsigned long long ta = ((unsigned long long)M_[17 + 2 * (TS_A)] << 32) | M_[16 + 2 * (TS_A)], tb = ((unsigned long long)M_[17 + 2 * (TS_B)] << 32) | M_[16 + 2 * (TS_B)];
        const unsigned long long dl = (tb - ta) * (TS_MUL), t0 = __builtin_amdgcn_s_memrealtime();
        while (__builtin_amdgcn_s_memrealtime() - t0 < dl) __builtin_amdgcn_s_sleep(8);
    }
#endif
}

extern "C" void kernel_launch(void* const* d_in, const int* in_sizes, int n_in, void* d_out, int out_size, void* d_ws, size_t ws_size, hipStream_t stream) {
    static int grid = 0;
    if (grid == 0) {
        if (n_in != 22 || out_size != NL * D || ws_size < WS_END) { fprintf(stderr, "kernel_launch: unexpected shapes (n_in %d out %d ws %zu)\n", n_in, out_size, ws_size); grid = -1; return; }
        int dev = 0, cus = 0;
        if (hipGetDevice(&dev) != hipSuccess || hipDeviceGetAttribute(&cus, hipDeviceAttributeMultiprocessorCount, dev) != hipSuccess) { grid = -1; return; }
        if (hipFuncSetAttribute((const void*)fwd_kernel, hipFuncAttributeMaxDynamicSharedMemorySize, LDS_BYTES) != hipSuccess) { fprintf(stderr, "kernel_launch: hipFuncSetAttribute failed\n"); grid = -1; return; }
        int per_cu = 0;
        (void)hipOccupancyMaxActiveBlocksPerMultiprocessor(&per_cu, (const void*)fwd_kernel, NTHREADS, LDS_BYTES);
        (void)hipGetLastError();
        grid = cus;
    }
    if (grid < 0) return;
    (void)hipMemsetAsync((char*)d_ws + WS_CTL, 0, CTL_ZERO_BYTES, stream);
    Args a{};
    for (int i = 0; i < 22; ++i) a.in[i] = (const float*)d_in[i];
    a.out = (float*)d_out; a.ws = (unsigned char*)d_ws;
    hipLaunchKernelGGL(fwd_kernel, dim3(grid), dim3(NTHREADS), LDS_BYTES, stream, a);
}
```

```cpp
#define STOP_AFTER 0
#include <hip/hip_runtime.h>
#include <cstdint>
#include <cstdio>

#define GAS __attribute__((address_space(1)))
#define LAS __attribute__((address_space(3)))
typedef unsigned short bf16_t;
typedef short bf16x8 __attribute__((ext_vector_type(8)));
typedef short bf16x4 __attribute__((ext_vector_type(4)));
typedef float f32x4 __attribute__((ext_vector_type(4)));
typedef float f32x2 __attribute__((ext_vector_type(2)));
typedef unsigned u32x4 __attribute__((ext_vector_type(4)));
typedef unsigned u32x2 __attribute__((ext_vector_type(2)));
typedef GAS unsigned gu32;

constexpr int D = 1024, NL = 16384, NC = 256, NT = NL + NC;
constexpr int INC = 2968, INP = 3072;
constexpr int C_CB = 0, C_CC = 256, C_CH = 512, C_DQ = 768, C_DK = 1152, C_DV = 1536, C_DZ = 1920, C_DA = 2304, C_DB = 2316, C_AQ = 2328, C_AK = 2712, C_AV = 2840;
constexpr int DFF = 2816, NEXP = 8, DFE = 3584;
constexpr int NWAVES = 8, NTHREADS = 512;
constexpr float EPS = 1e-6f;

constexpr size_t MiB = 1u << 20;
constexpr size_t WS_CTL = 0, CTL_ZERO_BYTES = 1 * MiB;
constexpr size_t WS_MOD = 1 * MiB;
constexpr size_t WS_ROPE = 1 * MiB + 128 * 1024;
constexpr size_t WS_HC = 2 * MiB;
constexpr size_t WS_G = 3 * MiB;
constexpr size_t WS_BETA = 4 * MiB;
constexpr size_t WS_ROUTE = 5 * MiB;
constexpr size_t WS_WIN = 8 * MiB;
constexpr size_t WS_WOUT = 20 * MiB;
constexpr size_t WS_WGU = 24 * MiB;
constexpr size_t WS_WDN = 35 * MiB;
constexpr size_t WS_MGU = 41 * MiB;
constexpr size_t WS_MDN = 153 * MiB;
constexpr size_t WS_ACT = 209 * MiB;
constexpr size_t WS_BIG = 242 * MiB;
constexpr size_t WS_PX = WS_BIG;
constexpr size_t WS_QD = 340 * MiB;
constexpr size_t QKV_STRIDE = 12 * MiB + 512 * 1024;
constexpr size_t WS_DN = 378 * MiB;
constexpr size_t DN_STRIDE = 25 * MiB;
constexpr size_t WS_END = 512 * MiB;
static_assert(WS_QD + 3 * QKV_STRIDE <= WS_DN && WS_DN + 5 * DN_STRIDE <= WS_END, "ws map");
static_assert((size_t)NT * INP * 2 <= WS_QD - WS_PX && (size_t)NT * 384 * 2 <= QKV_STRIDE && (size_t)3120 * 8192 <= DN_STRIDE, "ws map 2");

constexpr int SCR_BYTES = 139264;
constexpr int MISC_OFF = SCR_BYTES;
constexpr int LDS_BYTES = 147456;

#define RLX_AGENT __ATOMIC_RELAXED, __HIP_MEMORY_SCOPE_AGENT
#define LDS_WAIT() asm volatile("s_waitcnt lgkmcnt(0)" ::: "memory")
#define VM_WAIT() asm volatile("s_waitcnt vmcnt(0)" ::: "memory")

__device__ __forceinline__ unsigned f2bf(float f) { unsigned u = __builtin_bit_cast(unsigned, f); return (u + 0x7fffu + ((u >> 16) & 1u)) >> 16; }
__device__ __forceinline__ unsigned pk2(float lo, float hi) { return f2bf(lo) | (f2bf(hi) << 16); }
__device__ __forceinline__ float bf2f(unsigned h) { return __builtin_bit_cast(float, h << 16); }
__device__ __forceinline__ unsigned pk_fp8x4(float a, float b, float c, float d) {
    a = __builtin_fminf(__builtin_fmaxf(a, -448.f), 448.f); b = __builtin_fminf(__builtin_fmaxf(b, -448.f), 448.f);
    c = __builtin_fminf(__builtin_fmaxf(c, -448.f), 448.f); d = __builtin_fminf(__builtin_fmaxf(d, -448.f), 448.f);
    int p = __builtin_amdgcn_cvt_pk_fp8_f32(a, b, 0, false); p = __builtin_amdgcn_cvt_pk_fp8_f32(c, d, p, true); return (unsigned)p;
}
__device__ __forceinline__ float silu_f(float x) { return x * __builtin_amdgcn_rcpf(1.f + __expf(-x)); }
__device__ __forceinline__ int opq(int v) { asm volatile("" : "+v"(v)); return v; }
template <int CTRL> __device__ __forceinline__ float dpp_all(float v) { return __builtin_bit_cast(float, __builtin_amdgcn_update_dpp(0, __builtin_bit_cast(int, v), CTRL, 0xF, 0xF, true)); }
template <int CTRL, int RM> __device__ __forceinline__ float dpp_rows(float v) { return __builtin_bit_cast(float, __builtin_amdgcn_update_dpp(0, __builtin_bit_cast(int, v), CTRL, RM, 0xF, false)); }
__device__ __forceinline__ float sum8(float v) { v += dpp_all<0xB1>(v); v += dpp_all<0x4E>(v); v += dpp_all<0x141>(v); return v; }
__device__ __forceinline__ float wave_sum(float v) {
    v = sum8(v); v += dpp_all<0x140>(v);
    v += dpp_rows<0x142, 0xA>(v);
    v += dpp_rows<0x143, 0xC>(v);
    return __builtin_bit_cast(float, __builtin_amdgcn_readlane(__builtin_bit_cast(int, v), 63));
}
__device__ __forceinline__ float wave_sum_l(float v, int) { return wave_sum(v); }

#define XB_TMO      128
#define XB_XCNT(j)  (256  + 64 * (j))
#define XB_XSUB(j)  (1280 + 64 * (j))
#define XB_XGEN(j)  (2304 + 64 * (j))
#define XB_TOP      3328
#define XB_TOPGEN   3392
#define XCD_BAR_WORDS 3456
#define XB_SPIN_CAP (1u << 22)
__device__ __forceinline__ unsigned xb_ld(unsigned* p)              { return __hip_atomic_load(p, __ATOMIC_RELAXED, __HIP_MEMORY_SCOPE_AGENT); }
__device__ __forceinline__ unsigned xb_add(unsigned* p, unsigned v) { return __hip_atomic_fetch_add(p, v, __ATOMIC_RELAXED, __HIP_MEMORY_SCOPE_AGENT); }
__device__ __forceinline__ unsigned xb_xcc_id() { return (unsigned)__builtin_amdgcn_s_getreg((3 << 11) | 20) & 0xFu; }
#define XB_SPIN(cond, bar) do { unsigned _sp = 0; while (cond) { __builtin_amdgcn_s_sleep(1); \
    if ((++_sp & 255u) == 0u) { if (xb_ld(&(bar)[XB_TMO])) break; if (_sp > XB_SPIN_CAP) { atomicAdd(&(bar)[XB_TMO], 1u); break; } } } } while (0)
struct XcdBarrier { unsigned* bar; unsigned x; volatile LAS unsigned* st; };
__device__ __forceinline__ XcdBarrier xcd_barrier_post(unsigned* bar, volatile LAS unsigned* st) {
    XcdBarrier b; b.bar = bar; b.x = xb_xcc_id(); b.st = st;
    if (threadIdx.x == 0) (void)xb_add(&bar[XB_XCNT(b.x)], 1u);
    return b;
}
__device__ __forceinline__ void xcd_barrier_complete(unsigned* bar, unsigned x, unsigned& nloc, unsigned& nx) {
    const unsigned G = gridDim.x * gridDim.y * gridDim.z;
    unsigned sum, cnt, mine, sp = 0u;
    for (;;) {
        sum = 0u; cnt = 0u; mine = 0u;
#pragma unroll
        for (unsigned j = 0; j < 16; ++j) { const unsigned c = xb_ld(&bar[XB_XCNT(j)]); sum += c; cnt += (c > 0u) ? 1u : 0u; mine = (j == x) ? c : mine; }
        if (sum == G) break;
        __builtin_amdgcn_s_sleep(1);
        if ((++sp & 255u) == 0u) { if (xb_ld(&bar[XB_TMO])) break; if (sp > XB_SPIN_CAP) { atomicAdd(&bar[XB_TMO], 1u); break; } }
    }
    nloc = mine > 0u ? mine : 1u; nx = cnt > 0u ? cnt : 1u;
}
__device__ __forceinline__ void xcd_barrier(const XcdBarrier& b) {
    asm volatile("s_waitcnt vmcnt(0)" ::: "memory");
    __syncthreads();
    if (threadIdx.x == 0) {
        unsigned* bar = b.bar;
        __builtin_amdgcn_s_waitcnt(0);
        unsigned nloc = b.st[0], nx = b.st[1];
        if (nloc == 0u) { xcd_barrier_complete(bar, b.x, nloc, nx); b.st[0] = nloc; b.st[1] = nx; }
        const unsigned old = xb_add(&bar[XB_XSUB(b.x)], 1u);
        const unsigned gen = old / nloc;
        if (old + 1u == (gen + 1u) * nloc) {
            __builtin_amdgcn_fence(__ATOMIC_RELEASE, "agent");
            asm volatile("s_waitcnt vmcnt(0)" ::: "memory");
            const unsigned og = xb_add(&bar[XB_TOP], 1u);
            const unsigned tg = og / nx;
            if (og + 1u == (tg + 1u) * nx) xb_add(&bar[XB_TOPGEN], 1u);
            else XB_SPIN(xb_ld(&bar[XB_TOPGEN]) == tg, bar);
            __builtin_amdgcn_fence(__ATOMIC_ACQUIRE, "agent");
            xb_add(&bar[XB_XGEN(b.x)], 1u);
            asm volatile("s_waitcnt vmcnt(0)" ::: "memory");
        } else {
            XB_SPIN(xb_ld(&bar[XB_XGEN(b.x)]) == gen, bar);
            __builtin_amdgcn_fence(__ATOMIC_ACQUIRE, "agent");
            asm volatile("s_waitcnt vmcnt(0)" ::: "memory");
        }
    }
    __syncthreads();
}

#ifdef TS_A
#define TS_STAMP() do { if (blockIdx.x == 0 && threadIdx.x == 0) { volatile LAS unsigned* M_ = (volatile LAS unsigned*)(F.lds + MISC_OFF); const unsigned k_ = M_[12]; const unsigned long long t_ = __builtin_amdgcn_s_memrealtime(); M_[16 + 2 * k_] = (unsigned)t_; M_[17 + 2 * k_] = (unsigned)(t_ >> 32); M_[12] = k_ + 1; } } while (0)
#else
#define TS_STAMP() do {} while (0)
#endif
struct Args { const float* in[22]; float* out; unsigned char* ws; };
enum { I_X = 0, I_C, I_CTX, I_CCTX, I_WMOD, I_BMOD, I_WIN, I_WOUT, I_CONVW, I_DNCONVW, I_ALOG, I_DTB, I_NORMG, I_SINK, I_FG, I_FU, I_FD, I_ROUTER, I_MG, I_MU, I_MD, I_FNG };
struct Frame {
    LAS unsigned char* lds;
    int tid, lane, wave, vcu, G, gw, NGW;
    unsigned char* ws;
};

struct P0Item { const float* src; unsigned char* dst; int N, K, n0, k0, mode, f8; };
__device__ __forceinline__ int p0_drow(int ng, int mode) { return mode == 0 ? ng : (ng >> 2) * 8 + (mode == 2 ? 4 : 0) + (ng & 3); }
constexpr float MOE_WSCALE = 64.0f, MOE_HSCALE = 8.0f;
__device__ __forceinline__ void p0_prologue(Frame& F, const Args& A) {
    if (blockIdx.x < 192) {
        LAS float* sc = (LAS float*)F.lds;
        for (int i = F.tid; i < 1024; i += NTHREADS) { sc[i] = silu_f(A.in[I_C][i]); sc[1024 + i] = silu_f(A.in[I_CCTX][i]); }
        __syncthreads();
        const int l = blockIdx.x / 96, cg = blockIdx.x % 96;
        const float* W = A.in[I_WMOD] + (size_t)l * 1024 * 6144 + cg * 64 + F.lane;
        float ax = 0.f, ac = 0.f;
        const int kb = F.wave * 128;
#pragma unroll 32
        for (int k = 0; k < 128; ++k) { const float wv = W[(size_t)(kb + k) * 6144]; ax += sc[kb + k] * wv; ac += sc[1024 + kb + k] * wv; }
        LAS float* red = sc + 2048;
        red[F.wave * 64 + F.lane] = ax; red[512 + F.wave * 64 + F.lane] = ac;
        __syncthreads();
        if (F.wave == 0) {
            float sx = 0.f, sc2 = 0.f;
#pragma unroll
            for (int w = 0; w < 8; ++w) { sx += red[w * 64 + F.lane]; sc2 += red[512 + w * 64 + F.lane]; }
            const float b = A.in[I_BMOD][l * 6144 + cg * 64 + F.lane];
            float* mod = (float*)(F.ws + WS_MOD);
            mod[(l * 2 + 0) * 6144 + cg * 64 + F.lane] = sx + b;
            mod[(l * 2 + 1) * 6144 + cg * 64 + F.lane] = sc2 + b;
        }
        __syncthreads();
    } else if (blockIdx.x == 192) {
        float* rope = (float*)(F.ws + WS_ROPE);
        for (int i = F.tid; i < 256 * 16; i += NTHREADS) {
            const int pos = i >> 4, f = i & 15;
            const float inv = powf(10000.0f, -(float)(2 * f) / 32.0f);
            const float ang = (float)pos * inv;
            rope[2 * i] = cosf(ang); rope[2 * i + 1] = sinf(ang);
        }
    }
    LAS float* tile = (LAS float*)F.lds;
    constexpr int N_WIN = 2 * 8 * 12, N_WOUT = 2 * 8 * 4, N_FG = 8 * 11, N_FD = 22 * 4, N_MG = 8 * 8 * 14, N_MD = 8 * 28 * 4;
    constexpr int NITEMS = N_WIN + N_WOUT + 2 * N_FG + N_FD + 2 * N_MG + N_MD;
    auto decode = [&](int r) -> P0Item {
        P0Item t; t.f8 = 0; t.mode = 0;
        if (r < N_WIN) { const int l = r / 96, q = r % 96; t.src = A.in[I_WIN] + (size_t)l * 1024 * INC; t.N = INC; t.K = 1024; t.dst = F.ws + WS_WIN + (size_t)l * INP * 1024 * 2; t.k0 = 128 * (q / 12); t.n0 = 256 * (q % 12); return t; } r -= N_WIN;
        if (r < N_WOUT) { const int l = r / 32, q = r % 32; t.src = A.in[I_WOUT] + (size_t)l * 1024 * 1024; t.N = 1024; t.K = 1024; t.dst = F.ws + WS_WOUT + (size_t)l * 1024 * 1024 * 2; t.k0 = 128 * (q / 4); t.n0 = 256 * (q % 4); return t; } r -= N_WOUT;
        if (r < 2 * N_FG) { const int u = r >= N_FG; if (u) r -= N_FG; t.src = A.in[u ? I_FU : I_FG]; t.N = DFF; t.K = 1024; t.dst = F.ws + WS_WGU; t.mode = 1 + u; t.k0 = 128 * (r / 11); t.n0 = 256 * (r % 11); return t; } r -= 2 * N_FG;
        if (r < N_FD) { t.src = A.in[I_FD]; t.N = 1024; t.K = DFF; t.dst = F.ws + WS_WDN; t.k0 = 128 * (r / 4); t.n0 = 256 * (r % 4); return t; } r -= N_FD;
        t.f8 = 1;
        if (r < 2 * N_MG) { const int u = r >= N_MG; if (u) r -= N_MG; const int e = r / 112, q = r % 112; t.src = A.in[u ? I_MU : I_MG] + (size_t)e * 1024 * DFE; t.N = DFE; t.K = 1024; t.dst = F.ws + WS_MGU + (size_t)e * 2 * DFE * 1024; t.mode = 1 + u; t.k0 = 128 * (q / 14); t.n0 = 256 * (q % 14); return t; } r -= 2 * N_MG;
        { const int e = r / 112, q = r % 112; t.src = A.in[I_MD] + (size_t)e * DFE * 1024; t.N = 1024; t.K = DFE; t.dst = F.ws + WS_MDN + (size_t)e * 1024 * DFE; t.k0 = 128 * (q / 4); t.n0 = 256 * (q % 4); return t; }
    };
    volatile LAS unsigned* MQ = (volatile LAS unsigned*)(F.lds + MISC_OFF) + 14;
    unsigned* qctr = (unsigned*)(F.ws + WS_CTL) + 65536;
    unsigned tk = 0;
    if (F.tid == 0) { tk = __hip_atomic_fetch_add(qctr, 1u, __ATOMIC_RELAXED, __HIP_MEMORY_SCOPE_AGENT); *MQ = tk; }
    __syncthreads();
    int it = (int)*MQ;
    const int c = F.lane & 7, nn = F.lane >> 3;
    while (it < NITEMS) {
        if (F.tid == 0) tk = __hip_atomic_fetch_add(qctr, 1u, __ATOMIC_RELAXED, __HIP_MEMORY_SCOPE_AGENT);
        const P0Item t = decode(it);
        {
            const int gcol = t.n0 + 4 * (F.lane ^ F.wave);
            const float* sp = t.src + (size_t)(t.k0 + 16 * F.wave) * t.N + (gcol < t.N ? gcol : 0);
            LAS float* dp = tile + (16 * F.wave) * 256;
#pragma unroll
            for (int i = 0; i < 16; ++i)
                __builtin_amdgcn_global_load_lds((const unsigned*)(sp + (size_t)i * t.N), (LAS unsigned*)(dp + i * 256), 16, 0, 0);
        }
        VM_WAIT();
        __syncthreads();
#pragma unroll
        for (int q4 = 0; q4 < 4; ++q4) {
            const int nl = 32 * F.wave + 8 * q4 + nn, ng = t.n0 + nl;
            const LAS float* sp = tile + (16 * c) * 256 + 4 * ((nl >> 2) ^ c) + (nl & 3);
            float v[16];
#pragma unroll
            for (int j = 0; j < 16; ++j) v[j] = sp[j * 256];
            if (t.f8) {
                u32x4 o;
                o.x = pk_fp8x4(v[0] * MOE_WSCALE, v[1] * MOE_WSCALE, v[2] * MOE_WSCALE, v[3] * MOE_WSCALE);
                o.y = pk_fp8x4(v[4] * MOE_WSCALE, v[5] * MOE_WSCALE, v[6] * MOE_WSCALE, v[7] * MOE_WSCALE);
                o.z = pk_fp8x4(v[8] * MOE_WSCALE, v[9] * MOE_WSCALE, v[10] * MOE_WSCALE, v[11] * MOE_WSCALE);
                o.w = pk_fp8x4(v[12] * MOE_WSCALE, v[13] * MOE_WSCALE, v[14] * MOE_WSCALE, v[15] * MOE_WSCALE);
                *(GAS u32x4*)(t.dst + (size_t)p0_drow(ng, t.mode) * t.K + t.k0 + 16 * c) = o;
            } else {
                u32x4 o0, o1;
                o0.x = pk2(v[0], v[1]); o0.y = pk2(v[2], v[3]); o0.z = pk2(v[4], v[5]); o0.w = pk2(v[6], v[7]);
                o1.x = pk2(v[8], v[9]); o1.y = pk2(v[10], v[11]); o1.z = pk2(v[12], v[13]); o1.w = pk2(v[14], v[15]);
                if (ng >= t.N) { o0 = u32x4{0u, 0u, 0u, 0u}; o1 = o0; }
                GAS u32x4* op = (GAS u32x4*)(t.dst + ((size_t)p0_drow(ng, t.mode) * t.K + t.k0 + 16 * c) * 2);
                op[0] = o0; op[1] = o1;
            }
        }
        LDS_WAIT();
        if (F.tid == 0) *MQ = tk;
        __syncthreads();
        it = (int)*MQ;
    }
}

__device__ __forceinline__ void norm_mod_row(const float* xrow, const f32x4 (&sh)[4], const f32x4 (&sc1)[4], bf16_t* orow, int lane) {
    const GAS f32x4* xr = (const GAS f32x4*)xrow + lane;
    f32x4 v[4]; float s = 0.f;
#pragma unroll
    for (int j = 0; j < 4; ++j) { v[j] = xr[64 * j]; s += (v[j].x * v[j].x + v[j].y * v[j].y) + (v[j].z * v[j].z + v[j].w * v[j].w); }
    const float rstd = 1.0f / sqrtf(wave_sum(s) * (1.f / D) + EPS);
    GAS u32x2* o8 = (GAS u32x2*)orow + lane;
#pragma unroll
    for (int j = 0; j < 4; ++j) {
        const f32x4 y = v[j] * rstd * sc1[j] + sh[j];
        u32x2 w; w.x = pk2(y.x, y.y); w.y = pk2(y.z, y.w); o8[64 * j] = w;
    }
}
__device__ __forceinline__ void norm_phase(Frame& F, const float* xl, const float* xc, int layer, int s_shift, int s_scale, int nrows) {
    const float* mod = (const float*)(F.ws + WS_MOD);
    const float* mx = mod + (layer * 2 + 0) * 6144; const float* mc = mod + (layer * 2 + 1) * 6144;
    bf16_t* act = (bf16_t*)(F.ws + WS_ACT);
    f32x4 shl[4], scl[4];
#pragma unroll
    for (int j = 0; j < 4; ++j) { shl[j] = ((const GAS f32x4*)(mx + s_shift * 1024))[F.lane + 64 * j]; scl[j] = ((const GAS f32x4*)(mx + s_scale * 1024))[F.lane + 64 * j] + 1.0f; }
    for (int m = F.gw; m < nrows; m += F.NGW) {
        if (m < NL) norm_mod_row(xl + (size_t)m * D, shl, scl, act + (size_t)m * D, F.lane);
        else { f32x4 shc[4], scc[4];
#pragma unroll
            for (int j = 0; j < 4; ++j) { shc[j] = ((const GAS f32x4*)(mc + s_shift * 1024))[F.lane + 64 * j]; scc[j] = ((const GAS f32x4*)(mc + s_scale * 1024))[F.lane + 64 * j] + 1.0f; }
            norm_mod_row(xc + (size_t)(m - NL) * D, shc, scc, act + (size_t)m * D, F.lane); }
    }
}

namespace pg8 {
typedef int v8i __attribute__((ext_vector_type(8)));
constexpr int BM = 256, BK = 64, HALF = 128, HTB = HALF * BK * 2, STAGE_BYTES = 8 * HTB, NXCD = 8, WGM = 8;
__host__ __device__ __forceinline__ int lds_byte(int r, int c) { const int st = (r >> 4) * 2 + (c >> 5), rr = r & 15, cc = c & 31, ob = rr * 64 + cc * 2; return st * 1024 + (ob ^ (((ob >> 9) & 1) << 5)); }
__host__ __device__ __forceinline__ void stage_rc(int b, int& R, int& C) { const int st = b / 1024, sb = b % 1024, swz = sb ^ (((sb >> 9) & 1) << 5); R = (st >> 1) * 16 + swz / 64; C = (st & 1) * 32 + (swz % 64) / 2; }
__host__ __device__ __forceinline__ int perm32(int rho) { const int n = rho >> 4, i = rho & 15; return 8 * (i >> 2) + 4 * n + (i & 3); }
struct Unit { int pm, pn; const char* a; const char* b; };
typedef __bf16 bf16x2_t __attribute__((ext_vector_type(2)));
__device__ __forceinline__ unsigned cvt_pk_bf16(float lo, float hi) { f32x2 v = {lo, hi}; bf16x2_t b = __builtin_convertvector(v, bf16x2_t); return __builtin_bit_cast(unsigned, b); }

__device__ __forceinline__ bool tile_order(int i, int G, int c, int nM, int nN, int& pm, int& pn) {
    const int nwg = nM * nN; const long L = (long)i * G + c; if (L >= nwg) return false;
    int wgid = (int)L; { const int q = nwg / NXCD, r = nwg % NXCD, xcd = wgid % NXCD, off = wgid / NXCD; wgid = (xcd < r ? xcd * (q + 1) : r * (q + 1) + (xcd - r) * q) + off; }
    const int nig = WGM * nN, gid = wgid / nig, fm = gid * WGM, gsz = (nM - fm) < WGM ? (nM - fm) : WGM;
    pm = fm + ((wgid % nig) % gsz); pn = (wgid % nig) / gsz; return true;
}
struct DenseSched {
    int nM, nN, G, c; const char* A; const char* B; size_t tstep;
    __device__ __forceinline__ bool next(int i, Unit& u) const {
        int pm, pn; if (!tile_order(i, G, c, nM, nN, pm, pn)) return false;
        u.pm = pm; u.pn = pn; u.a = A + (size_t)pm * tstep; u.b = B + (size_t)pn * tstep; return true;
    }
};
struct MoeSched {
    int nM, nN, G, c; const char* A; const char* B; size_t tstep, estride; const unsigned* tile_e; int t0, pm_off;
    __device__ __forceinline__ bool next(int i, Unit& u) const {
        int pm, pn; if (!tile_order(i, G, c, nM, nN, pm, pn)) return false;
        const unsigned e = __builtin_amdgcn_readfirstlane(__hip_atomic_load(tile_e + t0 + pm, __ATOMIC_RELAXED, __HIP_MEMORY_SCOPE_AGENT)) & 7u;
        u.pm = pm + pm_off; u.pn = pn; u.a = A + (size_t)pm * tstep; u.b = B + (size_t)e * estride + (size_t)pn * tstep; return true;
    }
};

using ::pk_fp8x4;
struct EpiSwiGLU8 {
    static constexpr bool PERM = true;
    unsigned char* H; int ldh; float ascale, hs;
    __device__ __forceinline__ void operator()(const f32x4 (&acc)[2][2][4][2], const Unit& u, int wr, int wc, int fr, int fq) const {
        const int row0 = u.pm * BM + wr * 64 + fr, col0 = u.pn * 128 + wc * 16 + 4 * fq;
#pragma unroll
        for (int ai = 0; ai < 2; ++ai)
#pragma unroll
            for (int m = 0; m < 4; ++m) { unsigned char* rowp = H + (size_t)(row0 + ai * HALF + m * 16) * ldh + col0;
#pragma unroll
                for (int bj = 0; bj < 2; ++bj) { const f32x4 g = acc[ai][bj][m][0] * ascale, up = acc[ai][bj][m][1] * (ascale * hs);
                    float h[4];
#pragma unroll
                    for (int e = 0; e < 4; ++e) h[e] = g[e] * __builtin_amdgcn_rcpf(1.f + __expf(-g[e])) * up[e];
                    *(unsigned*)(rowp + bj * 64) = pk_fp8x4(h[0], h[1], h[2], h[3]); }
                asm volatile("" ::: "memory"); }
    }
};
struct EpiStoreBf16 {
    static constexpr bool PERM = true;
    bf16_t* O; int ldc; float scale = 1.0f;
    __device__ __forceinline__ void operator()(const f32x4 (&acc)[2][2][4][2], const Unit& u, int wr, int wc, int fr, int fq) const {
        const int row0 = u.pm * BM + wr * 64 + fr, col0 = u.pn * BM + wc * 32 + 8 * fq;
#pragma unroll
        for (int ai = 0; ai < 2; ++ai)
#pragma unroll
            for (int m = 0; m < 4; ++m) { bf16_t* rowp = O + (size_t)(row0 + ai * HALF + m * 16) * ldc + col0;
#pragma unroll
                for (int bj = 0; bj < 2; ++bj) { const f32x4 v0 = acc[ai][bj][m][0] * scale, v1 = acc[ai][bj][m][1] * scale;
                    u32x4 w; w.x = cvt_pk_bf16(v0[0], v0[1]); w.y = cvt_pk_bf16(v0[2], v0[3]); w.z = cvt_pk_bf16(v1[0], v1[1]); w.w = cvt_pk_bf16(v1[2], v1[3]);
                    *(u32x4*)(rowp + bj * HALF) = w; } }
    }
};
struct EpiSwiGLU {
    static constexpr bool PERM = true;
    bf16_t* H; int ldh;
    __device__ __forceinline__ void operator()(const f32x4 (&acc)[2][2][4][2], const Unit& u, int wr, int wc, int fr, int fq) const {
        const int row0 = u.pm * BM + wr * 64 + fr, col0 = u.pn * 128 + wc * 16 + 4 * fq;
#pragma unroll
        for (int ai = 0; ai < 2; ++ai)
#pragma unroll
            for (int m = 0; m < 4; ++m) { bf16_t* rowp = H + (size_t)(row0 + ai * HALF + m * 16) * ldh + col0;
#pragma unroll
                for (int bj = 0; bj < 2; ++bj) { const f32x4 g = acc[ai][bj][m][0], up = acc[ai][bj][m][1];
                    float h[4];
#pragma unroll
                    for (int e = 0; e < 4; ++e) h[e] = g[e] * __builtin_amdgcn_rcpf(1.f + __expf(-g[e])) * up[e];
                    u32x2 w; w.x = cvt_pk_bf16(h[0], h[1]); w.y = cvt_pk_bf16(h[2], h[3]);
                    *(u32x2*)(rowp + bj * 64) = w; }
                asm volatile("" ::: "memory"); }
    }
};
struct EpiResid {
    static constexpr bool PERM = false;
    const float* base_l; float* out_l; const float* gate_l; const float* base_c; float* out_c; const float* gate_c; int ctx_tile;
    __device__ __forceinline__ void operator()(const f32x4 (&acc)[2][2][4][2], const Unit& u, int wr, int wc, int fr, int fq) const {
        const bool isc = u.pm >= ctx_tile;
        const float* base = isc ? base_c : base_l; float* out = isc ? out_c : out_l; const float* gate = isc ? gate_c : gate_l;
        const int row0 = (isc ? (u.pm - ctx_tile) : u.pm) * BM + wr * 64 + fr, col0 = u.pn * BM + wc * 32 + 4 * fq;
        f32x4 gv[2][2];
#pragma unroll
        for (int bj = 0; bj < 2; ++bj)
#pragma unroll
            for (int n = 0; n < 2; ++n) gv[bj][n] = *(const f32x4*)(gate + col0 + bj * HALF + n * 16);
#pragma unroll
        for (int ai = 0; ai < 2; ++ai)
#pragma unroll
            for (int m = 0; m < 4; ++m) { const size_t off = (size_t)(row0 + ai * HALF + m * 16) * D + col0;
#pragma unroll
                for (int bj = 0; bj < 2; ++bj)
#pragma unroll
                    for (int n = 0; n < 2; ++n) { const f32x4 bs = *(const f32x4*)(base + off + bj * HALF + n * 16);
                        *(f32x4*)(out + off + bj * HALF + n * 16) = bs + gv[bj][n] * acc[ai][bj][m][n]; } }
    }
};

struct MoeTailSched {
    int ntail, G, c; const char* A; const char* B; size_t tstep, estride; const unsigned* tile_e; int tile0; size_t ksb;
    __device__ __forceinline__ bool next(int i, Unit& u) const {
        const long L = (long)i * G + c; if (L >= (long)ntail * 28) return false;
        const int ks = (int)(L % 7), q = (int)(L / 7), pn = q & 3, tt = q >> 2;
        const unsigned e = __builtin_amdgcn_readfirstlane(__hip_atomic_load(tile_e + tile0 + tt, __ATOMIC_RELAXED, __HIP_MEMORY_SCOPE_AGENT)) & 7u;
        u.pm = q * 7 + ks; u.pn = 0; u.a = A + (size_t)tt * tstep + (size_t)ks * ksb; u.b = B + (size_t)e * estride + (size_t)pn * tstep + (size_t)ks * ksb; return true;
    }
};
struct EpiSlab {
    static constexpr bool PERM = false;
    float* slab; float scale = 1.0f;
    __device__ __forceinline__ void operator()(const f32x4 (&acc)[2][2][4][2], const Unit& u, int wr, int wc, int fr, int fq) const {
        float* base = slab + (size_t)u.pm * 65536 + (size_t)(wr * 64 + fr) * 256 + wc * 32 + 4 * fq;
#pragma unroll
        for (int ai = 0; ai < 2; ++ai)
#pragma unroll
            for (int m = 0; m < 4; ++m)
#pragma unroll
                for (int bj = 0; bj < 2; ++bj)
#pragma unroll
                    for (int n = 0; n < 2; ++n) *(f32x4*)(base + (size_t)(ai * HALF + m * 16) * 256 + bj * HALF + n * 16) = acc[ai][bj][m][n] * scale;
    }
};

template <bool FP8 = false, class Epi, class Sched>
__device__ __forceinline__ void gemm_phase(LAS unsigned char* lds, const int K, const Sched& S, const Epi& E, const int ntk = 0) {
    int tid_ = threadIdx.x; asm volatile("" : "+v"(tid_));
    const int tid = tid_, wid = __builtin_amdgcn_readfirstlane(tid >> 6), lane = tid & 63, wr = wid >> 2, wc = wid & 3, fr = lane & 15, fq = lane >> 4;
    const int nt = ntk ? ntk : K / BK;
    unsigned voffA[2], voffB[2];
#pragma unroll
    for (int i = 0; i < 2; ++i) { int R, C; stage_rc(tid * 16 + i * 8192, R, C); const int Rb = Epi::PERM ? ((R & ~31) + perm32(R & 31)) : R;
        voffA[i] = (unsigned)(R * K + C) * 2u; voffB[i] = (unsigned)(Rb * K + C) * 2u; }
    const size_t kstep = (size_t)(BK * 2);
    const size_t hstep = (size_t)HALF * K * 2;
    const unsigned ldsw = (unsigned)wid * 1024u;
    const int aoff = lds_byte(wr * 64 + fr, fq * 8), boff = lds_byte(wc * 32 + fr, fq * 8);
#define PG8_SA(b, h) (((b) * 2 + (h)) * HTB)
#define PG8_SB(b, h) ((4 + (b) * 2 + (h)) * HTB)
#define PG8_STAGE(bufoff, gbase, voff) do { _Pragma("unroll") for (int _i = 0; _i < 2; ++_i) \
        __builtin_amdgcn_global_load_lds((const unsigned*)((const char*)(gbase) + (voff)[_i]), (LAS unsigned*)(lds + (bufoff) + ldsw + _i * 8192), 16, 0, 0); } while (0)
#define PG8_LDA(dst, b, h) do { _Pragma("unroll") for (int m = 0; m < 4; ++m) _Pragma("unroll") for (int k = 0; k < 2; ++k) dst[m].k[k] = *(const LAS bf16x8*)(lds + PG8_SA(b, h) + aoff + m * 2048 + k * 1024); } while (0)
#define PG8_LDB(dst, b, h) do { _Pragma("unroll") for (int n = 0; n < 2; ++n) _Pragma("unroll") for (int k = 0; k < 2; ++k) dst[n].k[k] = *(const LAS bf16x8*)(lds + PG8_SB(b, h) + boff + n * 2048 + k * 1024); } while (0)
#define PG8_MMA(ai, bj, At, Bt) do { if constexpr (FP8) __builtin_amdgcn_sched_barrier(0); __builtin_amdgcn_s_setprio(1); _Pragma("unroll") for (int m = 0; m < 4; ++m) _Pragma("unroll") for (int n = 0; n < 2; ++n) { \
        if constexpr (FP8) acc[ai][bj][m][n] = __builtin_amdgcn_mfma_scale_f32_16x16x128_f8f6f4(__builtin_bit_cast(v8i, Bt[n]), __builtin_bit_cast(v8i, At[m]), acc[ai][bj][m][n], 0, 0, 0, 127, 0, 127); \
        else { _Pragma("unroll") for (int k = 0; k < 2; ++k) acc[ai][bj][m][n] = __builtin_amdgcn_mfma_f32_16x16x32_bf16(Bt[n].k[k], At[m].k[k], acc[ai][bj][m][n], 0, 0, 0); } } \
        if constexpr (FP8) { _Pragma("unroll") for (int m = 0; m < 4; ++m) _Pragma("unroll") for (int n = 0; n < 2; ++n) asm volatile("" : "+v"(acc[ai][bj][m][n])); } \
        __builtin_amdgcn_s_setprio(0); if constexpr (FP8) __builtin_amdgcn_sched_barrier(0); } while (0)
#define PG8_WAIT_V(n) asm volatile("s_waitcnt vmcnt(" #n ")" ::: "memory")
#define PG8_WAIT_L(n) asm volatile("s_waitcnt lgkmcnt(" #n ")" ::: "memory")
#define PG8_BAR __builtin_amdgcn_s_barrier()
#define PG8_SCHED __builtin_amdgcn_sched_barrier(0)
    Unit cur, nxt; int ui = 0;
    if (!S.next(0, cur)) return;
    f32x4 acc[2][2][4][2];
#pragma unroll
    for (int a = 0; a < 2; ++a)
#pragma unroll
        for (int b = 0; b < 2; ++b)
#pragma unroll
            for (int m = 0; m < 4; ++m)
#pragma unroll
                for (int n = 0; n < 2; ++n) acc[a][b][m][n] = (f32x4){0.f, 0.f, 0.f, 0.f};
    struct Frag { bf16x8 k[2]; };
    Frag At[4], B0[2], B1[2];
    const char* cA = cur.a; const char* cB = cur.b;
    PG8_STAGE(PG8_SB(0, 0), cB, voffB); PG8_STAGE(PG8_SB(0, 1), cB + hstep, voffB); PG8_STAGE(PG8_SA(0, 0), cA, voffA); PG8_STAGE(PG8_SA(0, 1), cA + hstep, voffA);
    if (wr == 1) PG8_BAR;
    PG8_WAIT_V(2); PG8_BAR;
    PG8_STAGE(PG8_SB(1, 0), cB + kstep, voffB); PG8_STAGE(PG8_SA(1, 0), cA + kstep, voffA); PG8_STAGE(PG8_SB(1, 1), cB + hstep + kstep, voffB);
    PG8_WAIT_V(6); PG8_BAR;
    for (;;) {
        const bool has_next = S.next(ui + 1, nxt);
        const char* nA = has_next ? nxt.a : cA; const char* nB = has_next ? nxt.b : cB;
        for (int t = 0; t < nt; t += 2) {
            const bool last = (t == nt - 2);
            const char* a1 = cA + (size_t)(t + 1) * kstep;
            const char* a2 = last ? nA : cA + (size_t)(t + 2) * kstep; const char* b2 = last ? nB : cB + (size_t)(t + 2) * kstep;
            const char* a3 = a2 + kstep; const char* b3 = b2 + kstep;
            PG8_LDB(B0, 0, 0); PG8_LDB(B1, 0, 1); PG8_SCHED; PG8_LDA(At, 0, 0); PG8_STAGE(PG8_SA(1, 1), a1 + hstep, voffA);
            PG8_WAIT_V(8); PG8_WAIT_L(0); PG8_BAR; PG8_MMA(0, 0, At, B0); PG8_MMA(0, 1, At, B1); PG8_BAR; PG8_SCHED;
            PG8_LDA(At, 0, 1); PG8_STAGE(PG8_SB(0, 0), b2, voffB); PG8_STAGE(PG8_SB(0, 1), b2 + hstep, voffB); PG8_STAGE(PG8_SA(0, 0), a2, voffA);
            PG8_WAIT_V(8); PG8_WAIT_L(0); PG8_BAR; PG8_MMA(1, 0, At, B0); PG8_MMA(1, 1, At, B1); PG8_BAR; PG8_SCHED;
            PG8_LDB(B0, 1, 0); PG8_LDB(B1, 1, 1); PG8_SCHED; PG8_LDA(At, 1, 0); PG8_STAGE(PG8_SA(0, 1), a2 + hstep, voffA);
            PG8_WAIT_V(8); PG8_WAIT_L(0); PG8_BAR; PG8_MMA(0, 0, At, B0); PG8_MMA(0, 1, At, B1); PG8_BAR; PG8_SCHED;
            PG8_LDA(At, 1, 1); PG8_STAGE(PG8_SB(1, 0), b3, voffB); PG8_STAGE(PG8_SB(1, 1), b3 + hstep, voffB); PG8_STAGE(PG8_SA(1, 0), a3, voffA);
            PG8_WAIT_V(8); PG8_WAIT_L(0); PG8_BAR; PG8_MMA(1, 0, At, B0); PG8_MMA(1, 1, At, B1); PG8_BAR; PG8_SCHED;
        }
        if (wr == 0) PG8_BAR;
        E(acc, cur, wr, wc, fr, fq);
        if (!has_next) break;
#pragma unroll
        for (int a = 0; a < 2; ++a)
#pragma unroll
            for (int b = 0; b < 2; ++b)
#pragma unroll
                for (int m = 0; m < 4; ++m)
#pragma unroll
                    for (int n = 0; n < 2; ++n) acc[a][b][m][n] = (f32x4){0.f, 0.f, 0.f, 0.f};
        cur = nxt; cA = nA; cB = nB; ++ui;
        if (wr == 1) PG8_BAR;
    }
    PG8_WAIT_V(0);
    PG8_BAR;
#undef PG8_SA
#undef PG8_SB
#undef PG8_STAGE
#undef PG8_LDA
#undef PG8_LDB
#undef PG8_MMA
#undef PG8_WAIT_V
#undef PG8_WAIT_L
#undef PG8_BAR
#undef PG8_SCHED
}
}

constexpr size_t WS_GL = 7 * MiB;
__device__ __forceinline__ float ldbf(const bf16_t* p) { return bf2f(*p); }
__device__ __forceinline__ void unpk8(const u32x4 v, float (&f)[8]) {
    f[0] = bf2f(v.x & 0xffffu); f[1] = bf2f(v.x >> 16); f[2] = bf2f(v.y & 0xffffu); f[3] = bf2f(v.y >> 16);
    f[4] = bf2f(v.z & 0xffffu); f[5] = bf2f(v.z >> 16); f[6] = bf2f(v.w & 0xffffu); f[7] = bf2f(v.w >> 16);
}
__device__ __forceinline__ u32x4 pk8(const float (&f)[8]) { u32x4 o; o.x = pk2(f[0], f[1]); o.y = pk2(f[2], f[3]); o.z = pk2(f[4], f[5]); o.w = pk2(f[6], f[7]); return o; }
struct PrepRow { u32x4 cc, hh, bb, dq0, dq1, dq2, ro; float ab; };
__device__ __forceinline__ PrepRow prep_load(const bf16_t* PX, int m, int lane) {
    PrepRow R; const bf16_t* r0 = PX + (size_t)m * INP;
    const int c0 = 8 * (lane & 31);
    R.cc = *(const u32x4*)(r0 + C_CC + c0); R.hh = *(const u32x4*)(r0 + C_CH + c0); R.bb = *(const u32x4*)(r0 + C_CB + c0);
    R.dq0 = *(const u32x4*)(r0 + C_DQ + 8 * lane); R.dq1 = *(const u32x4*)(r0 + C_DQ + 8 * (64 + lane)); R.dq2 = *(const u32x4*)(r0 + C_DQ + 8 * (128 + (lane & 15)));
    const int head = lane >> 3, v8 = lane & 7;
    R.ro = *(const u32x4*)(r0 + (head < 6 ? C_AQ + head * 64 : C_AK + (head - 6) * 64) + 8 * v8);
    const int q = (lane - 32) & 31; R.ab = bf2f(r0[C_DA + (q < 24 ? q : 23)]);
    return R;
}
__device__ __forceinline__ void prep_phase(Frame& F, const Args& A, int layer) {
    bf16_t* PX = (bf16_t*)(F.ws + WS_PX);
    bf16_t* ACT = (bf16_t*)(F.ws + WS_ACT);
    bf16_t* QD = (bf16_t*)(F.ws + WS_QD); bf16_t* KD = (bf16_t*)(F.ws + WS_QD + QKV_STRIDE); bf16_t* VD = (bf16_t*)(F.ws + WS_QD + 2 * QKV_STRIDE);
    float* Gg = (float*)(F.ws + WS_G); float* Bt = (float*)(F.ws + WS_BETA);
    const float* rope = (const float*)(F.ws + WS_ROPE);
    LAS float* sdw = (LAS float*)F.lds;
    LAS float* scw = sdw + 3 * 1152;
    for (int i = F.tid; i < 3 * 1152; i += NTHREADS) sdw[i] = A.in[I_DNCONVW][layer * 3 * 1152 + i];
    for (int i = F.tid; i < 3 * 256; i += NTHREADS) scw[i] = A.in[I_CONVW][layer * 3 * 256 + i];
    __syncthreads();
    const int lane = F.lane;
    constexpr int RPW = (NT + 2047) / 2048;
    const int mlo = F.gw * RPW, mhi = (mlo + RPW) < NT ? (mlo + RPW) : NT;
    const int qgb = lane - 32;
    const float dtb = (qgb >= 0 && qgb < 12) ? A.in[I_DTB][layer * 12 + qgb] : 0.f;
    const float nalog = (qgb >= 0 && qgb < 12) ? -__expf(A.in[I_ALOG][layer * 12 + qgb]) : 0.f;
    if (mlo < mhi) {
        PrepRow prv = prep_load(PX, mlo > 0 ? mlo - 1 : 0, lane), cur = prep_load(PX, mlo, lane), nxt = prep_load(PX, (mlo + 1) < NT ? mlo + 1 : mlo, lane);
#pragma unroll 1
        for (int m = mlo; m < mhi; ++m) {
            const PrepRow nn = prep_load(PX, (m + 2) < NT ? m + 2 : m, lane);
            const bool hasp = (m != 0 && m != NL), hasn = (m != NL - 1 && m != NT - 1);
            const float fp = hasp ? 1.f : 0.f, fn = hasn ? 1.f : 0.f;
            if (lane < 32) {
                const int c0 = 8 * lane;
                float b[8], c1[8], h1[8], cp[8], hp[8], cn[8], hn[8], o[8];
                unpk8(cur.bb, b); unpk8(cur.cc, c1); unpk8(cur.hh, h1); unpk8(prv.cc, cp); unpk8(prv.hh, hp); unpk8(nxt.cc, cn); unpk8(nxt.hh, hn);
#pragma unroll
                for (int e = 0; e < 8; ++e) o[e] = b[e] * (scw[c0 + e] * (cp[e] * hp[e]) * fp + scw[256 + c0 + e] * (c1[e] * h1[e]) + scw[512 + c0 + e] * (cn[e] * hn[e]) * fn);
                *(u32x4*)(ACT + (size_t)m * D + c0) = pk8(o);
            } else if (lane < 56) {
                if (qgb < 12) { const float sp = cur.ab + dtb; const float softp = (sp > 20.f) ? sp : __logf(1.0f + __expf(sp)); Gg[(size_t)m * 12 + qgb] = nalog * softp; }
                else Bt[(size_t)m * 12 + (qgb - 12)] = __builtin_amdgcn_rcpf(1.0f + __expf(-cur.ab));
            }
            __builtin_amdgcn_sched_barrier(0);
#pragma unroll
            for (int ps = 0; ps < 3; ++ps) {
                __builtin_amdgcn_sched_barrier(0);
                const int v = ps < 2 ? 64 * ps + lane : 128 + (lane & 15);
                const int c0 = 8 * v, p = c0 / 384;
                float x0[8], x1[8], x2[8], o[8];
                unpk8(ps == 0 ? prv.dq0 : ps == 1 ? prv.dq1 : prv.dq2, x0); unpk8(ps == 0 ? cur.dq0 : ps == 1 ? cur.dq1 : cur.dq2, x1); unpk8(ps == 0 ? nxt.dq0 : ps == 1 ? nxt.dq1 : nxt.dq2, x2);
                float ss = 0.f;
#pragma unroll
                for (int e = 0; e < 8; ++e) { o[e] = silu_f(sdw[c0 + e] * x0[e] * fp + sdw[1152 + c0 + e] * x1[e] + sdw[2304 + c0 + e] * x2[e] * fn); ss += o[e] * o[e]; }
                ss = sum8(ss);
                const float sc = p == 2 ? 1.0f : __builtin_amdgcn_rsqf(ss + 1e-6f) * (p == 0 ? 0.125f : 1.0f);
#pragma unroll
                for (int e = 0; e < 8; ++e) o[e] *= sc;
                if (ps < 2 || lane < 16) { bf16_t* dst = (p == 0 ? QD : (p == 1 ? KD : VD)) + (size_t)m * 384 + (c0 - p * 384); *(u32x4*)dst = pk8(o); }
            }
            __builtin_amdgcn_sched_barrier(0);
            if (m < NL) {
                const int head = lane >> 3, v8 = lane & 7, axis = v8 >> 2, vv = v8 & 3;
                bf16_t* px = PX + (size_t)m * INP + (head < 6 ? C_AQ + head * 64 : C_AK + (head - 6) * 64) + 8 * v8;
                const u32x4 own = cur.ro;
                u32x4 oth;
                oth.x = (unsigned)__builtin_amdgcn_update_dpp(0, (int)own.x, 0x4E, 0xF, 0xF, true); oth.y = (unsigned)__builtin_amdgcn_update_dpp(0, (int)own.y, 0x4E, 0xF, 0xF, true);
                oth.z = (unsigned)__builtin_amdgcn_update_dpp(0, (int)own.z, 0x4E, 0xF, 0xF, true); oth.w = (unsigned)__builtin_amdgcn_update_dpp(0, (int)own.w, 0x4E, 0xF, 0xF, true);
                float a[8], b[8], o[8]; unpk8(own, a); unpk8(oth, b);
                const int pos = axis == 0 ? (m >> 6) : (m & 63);
                const float* rt = rope + (pos * 16 + 8 * (vv & 1)) * 2;
                const float sgn = (vv < 2) ? -1.0f : 1.0f;
#pragma unroll
                for (int e = 0; e < 8; ++e) o[e] = a[e] * rt[2 * e] + sgn * b[e] * rt[2 * e + 1];
                *(u32x4*)px = pk8(o);
            }
            prv = cur; cur = nxt; nxt = nn;
        }
    }
    __syncthreads();
}

constexpr int DN_NS = 260, DN_NU = 12 * DN_NS;
__device__ __forceinline__ int dn_row0(int d, int s) {
    if (s < 4) return NL + 64 * (d == 0 ? s : 3 - s);
    return 64 * (d == 0 ? (s - 4) : 255 - (s - 4));
}
__device__ __forceinline__ void pair_bar(volatile LAS unsigned* cnt, unsigned& epoch, int lane) {
    epoch += 2u;
    asm volatile("s_waitcnt vmcnt(0) lgkmcnt(0)" ::: "memory");
    if (lane == 0) __hip_atomic_fetch_add((LAS unsigned*)cnt, 1u, __ATOMIC_RELAXED, __HIP_MEMORY_SCOPE_WORKGROUP);
    while (*cnt < epoch) __builtin_amdgcn_s_sleep(1);
    asm volatile("" ::: "memory");
}
__device__ __forceinline__ void dn_chunk_phase(Frame& F) {
    const bf16_t* KD = (const bf16_t*)(F.ws + WS_QD + QKV_STRIDE); const bf16_t* VD = (const bf16_t*)(F.ws + WS_QD + 2 * QKV_STRIDE);
    const float* Gg = (const float*)(F.ws + WS_G); const float* Bt = (const float*)(F.ws + WS_BETA);
    bf16_t* Wm = (bf16_t*)(F.ws + WS_DN); bf16_t* KDt = (bf16_t*)(F.ws + WS_DN + DN_STRIDE); bf16_t* Ut = (bf16_t*)(F.ws + WS_DN + 2 * DN_STRIDE);
    float* GL = (float*)(F.ws + WS_GL);
    const int gi = F.wave >> 1, wl = F.wave & 1;
    LAS unsigned char* R = F.lds + gi * 18432;
    LAS float* Am = (LAS float*)R;
    LAS float* gcs = Am + 64 * 68; LAS float* bts = gcs + 64;
    volatile LAS unsigned* pcnt = (volatile LAS unsigned*)(R + 17920);
    LAS float* INV = (LAS float*)(F.lds + 4 * 18432 + F.wave * 5120);
    if (F.tid < 4) *(volatile LAS unsigned*)(F.lds + F.tid * 18432 + 17920) = 0u;
    __syncthreads();
    unsigned epoch = 0u;
    const int nfull = DN_NU / (4 * F.G), ntail = DN_NU - nfull * 4 * F.G;
#pragma unroll 1
    for (int rd = 0; rd <= nfull; ++rd) {
        const int lane = opq(F.lane), r = lane & 15, g = lane >> 4;
        const int U = rd < nfull ? rd * 4 * F.G + blockIdx.x * 4 + gi : ((int)blockIdx.x + F.G * gi < ntail ? nfull * 4 * F.G + (int)blockIdx.x + F.G * gi : DN_NU);
        if (U >= DN_NU) break;
        const bool act = true;
        const int dh = act ? U / DN_NS : 0, s = act ? U % DN_NS : 0, d = dh / 6, h = dh % 6;
        const int row0 = dn_row0(d, s);
        const size_t ub = (size_t)U * 4096;
        if (act) {
            if (wl == 0) {
                const int io = d ? 63 - lane : lane;
                float gv = Gg[(size_t)(row0 + io) * 12 + d * 6 + h];
#pragma unroll
                for (int o = 1; o < 64; o <<= 1) { const float t = __shfl_up(gv, o); if (lane >= o) gv += t; }
                gcs[lane] = gv; bts[lane] = Bt[(size_t)(row0 + io) * 12 + d * 6 + h];
                if (lane == 63) GL[U] = expf(gv);
            }
            const bf16_t* tsrc = (wl == 0 ? VD : KD) + (size_t)row0 * 384 + h * 64;
            u32x4 tv[8];
#pragma unroll
            for (int j = 0; j < 8; ++j) tv[j] = *(const u32x4*)(tsrc + (size_t)(8 * j + (lane >> 3)) * 384 + (lane & 7) * 8);
#pragma unroll
            for (int j = 0; j < 8; ++j) *(LAS u32x4*)(R + (1 - wl) * 8192 + (8 * j + (lane >> 3)) * 128 + (lane & 7) * 16) = tv[j];
        }
        pair_bar(pcnt, epoch, lane);
        float y[4][4][4];
        if (act) {
            const LAS unsigned char* tb = R + (1 - wl) * 8192 + r * 2;
#pragma unroll
            for (int b = 0; b < 4; ++b)
#pragma unroll
                for (int e = 0; e < 4; ++e) { const int ip = 16 * b + 4 * g + e, trow = d ? 63 - ip : ip;
#pragma unroll
                    for (int n = 0; n < 4; ++n) y[b][n][e] = bf2f(*(const LAS bf16_t*)(tb + trow * 128 + n * 32)); }
            f32x4 gc4[4], bt4[4];
#pragma unroll
            for (int b = 0; b < 4; ++b) { gc4[b] = *(const LAS f32x4*)(gcs + 16 * b + 4 * g); bt4[b] = *(const LAS f32x4*)(bts + 16 * b + 4 * g); }
            if (wl == 1) {
                const float gcl = gcs[63];
                f32x4 ef[4];
#pragma unroll
                for (int b = 0; b < 4; ++b)
#pragma unroll
                    for (int e = 0; e < 4; ++e) ef[b][e] = __expf(gcl - gc4[b][e]);
#pragma unroll
                for (int n = 0; n < 4; ++n)
#pragma unroll
                    for (int bb = 0; bb < 2; ++bb) { u32x4 o;
                        o.x = pk2(y[2 * bb][n][0] * ef[2 * bb][0], y[2 * bb][n][1] * ef[2 * bb][1]); o.y = pk2(y[2 * bb][n][2] * ef[2 * bb][2], y[2 * bb][n][3] * ef[2 * bb][3]);
                        o.z = pk2(y[2 * bb + 1][n][0] * ef[2 * bb + 1][0], y[2 * bb + 1][n][1] * ef[2 * bb + 1][1]); o.w = pk2(y[2 * bb + 1][n][2] * ef[2 * bb + 1][2], y[2 * bb + 1][n][3] * ef[2 * bb + 1][3]);
                        const int dk = 16 * n + r, q = 4 * bb + g;
                        *(LAS u32x4*)(R + dk * 128 + ((q ^ (dk & 7)) << 4)) = o; }
#pragma unroll
                for (int j = 0; j < 8; ++j) { const int row = 8 * j + (lane >> 3), c = lane & 7;
                    ((GAS u32x4*)(KDt + ub))[64 * j + lane] = *(const LAS u32x4*)(R + row * 128 + ((c ^ (row & 7)) << 4)); }
#pragma unroll
                for (int b = 0; b < 4; ++b)
#pragma unroll
                    for (int e = 0; e < 4; ++e) { const float f = bt4[b][e] * __expf(gc4[b][e]);
#pragma unroll
                        for (int n = 0; n < 4; ++n) y[b][n][e] *= f; }
            } else {
#pragma unroll
                for (int b = 0; b < 4; ++b)
#pragma unroll
                    for (int e = 0; e < 4; ++e)
#pragma unroll
                        for (int n = 0; n < 4; ++n) y[b][n][e] *= bt4[b][e];
            }
        }
        pair_bar(pcnt, epoch, lane);
        if (act) {
            bf16x8 kf[4][2];
#pragma unroll
            for (int jt = 0; jt < 4; ++jt)
#pragma unroll
                for (int ks = 0; ks < 2; ++ks) kf[jt][ks] = *(const bf16x8*)(KD + (size_t)(row0 + 16 * jt + r) * 384 + h * 64 + 32 * ks + 8 * g);
#pragma unroll
            for (int itl = 0; itl < 2; ++itl) {
                const int it = 2 * wl + itl;
#pragma unroll
                for (int jt = 0; jt < 4; ++jt) {
                    f32x4 c = (f32x4){0.f, 0.f, 0.f, 0.f};
                    const bf16x8 a0 = (it == 0 ? kf[0][0] : it == 1 ? kf[1][0] : it == 2 ? kf[2][0] : kf[3][0]);
                    const bf16x8 a1 = (it == 0 ? kf[0][1] : it == 1 ? kf[1][1] : it == 2 ? kf[2][1] : kf[3][1]);
                    c = __builtin_amdgcn_mfma_f32_16x16x32_bf16(a0, kf[jt][0], c, 0, 0, 0);
                    c = __builtin_amdgcn_mfma_f32_16x16x32_bf16(a1, kf[jt][1], c, 0, 0, 0);
                    const int jo = 16 * jt + r, jp = d ? 63 - jo : jo;
#pragma unroll
                    for (int e = 0; e < 4; ++e) {
                        const int io = 16 * it + 4 * g + e, ip = d ? 63 - io : io;
                        Am[ip * 68 + jp] = (jp < ip) ? bts[ip] * c[e] * __expf(gcs[ip] - gcs[jp]) : 0.f;
                    }
                }
            }
        }
        pair_bar(pcnt, epoch, lane);
        if (act) {
            {
                float z[16];
#pragma unroll
                for (int i = 0; i < 16; ++i) z[i] = 0.f;
                const LAS float* ab = Am + (16 * g) * 68 + 16 * g;
#pragma unroll
                for (int i = 0; i < 16; ++i) {
                    float s0 = (i == r) ? 1.f : 0.f, s1 = 0.f;
#pragma unroll
                    for (int j4 = 0; j4 < (i + 3) / 4; ++j4) {
                        const f32x4 a = *(const LAS f32x4*)(ab + i * 68 + 4 * j4);
                        s0 -= a.x * z[4 * j4]; s1 -= a.y * z[4 * j4 + 1]; s0 -= a.z * z[4 * j4 + 2]; s1 -= a.w * z[4 * j4 + 3];
                    }
                    z[i] = s0 + s1;
                    if ((i & 3) == 3) asm volatile("" : "+v"(z[i]) :: "memory");
                }
#pragma unroll
                for (int i = 0; i < 16; ++i) INV[g * 320 + i * 20 + r] = z[i];
            }
            asm volatile("s_waitcnt lgkmcnt(0)" ::: "memory");
#pragma unroll
            for (int b = 0; b < 4; ++b) {
                f32x4 acc[4];
#pragma unroll
                for (int n = 0; n < 4; ++n) acc[n] = (f32x4){0.f, 0.f, 0.f, 0.f};
#pragma unroll
                for (int bp = 0; bp < b; ++bp) {
                    const f32x4 af = *(const LAS f32x4*)(Am + (16 * b + r) * 68 + 16 * bp + 4 * g);
#pragma unroll
                    for (int sk = 0; sk < 4; ++sk)
#pragma unroll
                        for (int n = 0; n < 4; ++n) acc[n] = __builtin_amdgcn_mfma_f32_16x16x4f32(af[sk], y[bp][n][sk], acc[n], 0, 0, 0);
                }
                const f32x4 vf = *(const LAS f32x4*)(INV + b * 320 + r * 20 + 4 * g);
                f32x4 xn[4];
#pragma unroll
                for (int n = 0; n < 4; ++n) xn[n] = (f32x4){0.f, 0.f, 0.f, 0.f};
#pragma unroll
                for (int sk = 0; sk < 4; ++sk)
#pragma unroll
                    for (int n = 0; n < 4; ++n) xn[n] = __builtin_amdgcn_mfma_f32_16x16x4f32(vf[sk], y[b][n][sk] - acc[n][sk], xn[n], 0, 0, 0);
#pragma unroll
                for (int n = 0; n < 4; ++n)
#pragma unroll
                    for (int e = 0; e < 4; ++e) y[b][n][e] = xn[n][e];
            }
        }
        pair_bar(pcnt, epoch, lane);
        if (act) {
            if (wl == 0) {
#pragma unroll
                for (int n = 0; n < 4; ++n)
#pragma unroll
                    for (int b = 0; b < 4; ++b) { const int col = 16 * n + r, q = 2 * b + (g >> 1);
                        u32x2 o; o.x = pk2(y[b][n][0], y[b][n][1]); o.y = pk2(y[b][n][2], y[b][n][3]);
                        *(LAS u32x2*)(R + col * 128 + ((q ^ (col & 7)) << 4) + 8 * (g & 1)) = o; }
#pragma unroll
                for (int j = 0; j < 8; ++j) { const int row = 8 * j + (lane >> 3), c = lane & 7;
                    ((GAS u32x4*)(Ut + ub))[64 * j + lane] = *(const LAS u32x4*)(R + row * 128 + ((c ^ (row & 7)) << 4)); }
            } else {
#pragma unroll
                for (int n = 0; n < 4; ++n) {
                    const int dk = 16 * n + r, kk2 = dk & 31, pc = (dk & 32) + 8 * ((kk2 & 15) >> 2) + 4 * (kk2 >> 4) + (kk2 & 3);
#pragma unroll
                    for (int b = 0; b < 4; ++b)
#pragma unroll
                        for (int e = 0; e < 4; ++e) { const int i = 16 * b + 4 * g + e;
                            *(LAS bf16_t*)(R + 8192 + i * 128 + ((((pc >> 3) ^ (i & 7)) << 4) | ((pc & 7) << 1))) = (bf16_t)f2bf(-y[b][n][e]); }
                }
#pragma unroll
                for (int j = 0; j < 8; ++j) { const int row = 8 * j + (lane >> 3), c = lane & 7;
                    ((GAS u32x4*)(Wm + ub))[64 * j + lane] = *(const LAS u32x4*)(R + 8192 + row * 128 + ((c ^ (row & 7)) << 4)); }
            }
        }
        pair_bar(pcnt, epoch, lane);
    }
}

constexpr int SC_D = 7, SC_STAGE = 16384, SC_P = 4;
__device__ __forceinline__ unsigned pkbf(float lo, float hi) { return pg8::cvt_pk_bf16(lo, hi); }
__device__ __forceinline__ int sc_off(int row, int col) {
    const int c = col >> 3; return row * 128 + ((c ^ ((row >> 1) & 7)) << 4) + ((col & 4) << 1);
}
constexpr int NSEG = 8;
constexpr size_t WS_SEG = 503 * MiB;
constexpr size_t WS_SST = 507 * MiB;
static_assert(WS_DN + 5 * DN_STRIDE <= WS_SEG && WS_SEG + (size_t)12 * NSEG * 2 * 16384 <= WS_SST && WS_SST + (size_t)12 * NSEG * 16384 <= WS_END, "seg map");
__host__ __device__ constexpr int seg_begin(int s) { return s == 0 ? 0 : 36 + 32 * (s - 1); }
__host__ __device__ constexpr int seg_len(int s) { return s == 0 ? 36 : 32; }
static_assert(seg_begin(NSEG - 1) + seg_len(NSEG - 1) == DN_NS, "segments cover the chain");
template <int MODE>
__device__ __forceinline__ void dn_scan_job(Frame& F, const int dh, const int sg) {
    const int d = dh / 6, lane = F.lane, wave = F.wave, r = lane & 15, g = lane >> 4;
    const int tb = seg_begin(sg), ns = seg_len(sg);
    const unsigned char* srcW = F.ws + WS_DN + ((size_t)dh * DN_NS + tb) * 8192;
    const unsigned char* srcK = srcW + DN_STRIDE; const unsigned char* srcU = srcW + 2 * DN_STRIDE;
    bf16_t* VT = (bf16_t*)(F.ws + WS_DN + 3 * DN_STRIDE) + ((size_t)dh * DN_NS + tb) * 4096;
    bf16_t* ST = (bf16_t*)(F.ws + WS_DN + 4 * DN_STRIDE) + ((size_t)dh * DN_NS + tb) * 4096;
    LAS float* gls = (LAS float*)(F.lds + MISC_OFF + 1024);
    LAS unsigned char* ost = F.lds + SC_D * SC_STAGE + (wave & 3) * 6144;
    { const float* GL = (const float*)(F.ws + WS_GL) + dh * DN_NS + tb; for (int i = F.tid; i < ns; i += NTHREADS) gls[i] = GL[i]; }
    __syncthreads();
#define SC_WAITV(n) asm volatile("s_waitcnt vmcnt(" #n ")" ::: "memory")
#define SC_BAR() do { asm volatile("" ::: "memory"); __builtin_amdgcn_s_barrier(); asm volatile("" ::: "memory"); } while (0)
    if (wave >= 4) {
        const int lw = wave - 4;
        const int lrow = lane >> 3, lc = lane & 7;
#define SC_ISSUE(st) do { const int slot_ = ((st) % SC_D) * SC_STAGE; \
            _Pragma("unroll") for (int e = 0; e < 4; ++e) { \
                const int q = lw * 4 + e, mi = q >> 3, n = q & 7, row = 8 * n + lrow; \
                const unsigned char* mb = (mi == 0 ? srcW : srcK) + (size_t)(st) * 8192; \
                const unsigned char* gp = mb + row * 128 + ((lc ^ ((row >> 1) & 7)) << 4); \
                __builtin_amdgcn_global_load_lds((const unsigned*)gp, (LAS unsigned*)(F.lds + slot_ + mi * 8192 + n * 1024), 16, 0, 0); } } while (0)
        SC_ISSUE(0); SC_ISSUE(1); SC_ISSUE(2); SC_ISSUE(3); SC_ISSUE(4); SC_ISSUE(5);
        SC_WAITV(20); SC_BAR();
        for (int t = 0; t < ns; ++t) {
            if (t + SC_D - 1 < ns) { SC_ISSUE(t + SC_D - 1); SC_WAITV(20); }
            else { SC_WAITV(0); }
            SC_BAR();
        }
    } else {
        f32x4 S[4];
        if (MODE == 0) {
            if (sg == 0) {
#pragma unroll
                for (int t = 0; t < 4; ++t) S[t] = (f32x4){0.f, 0.f, 0.f, 0.f};
            } else {
                const float* seg0 = (const float*)(F.ws + WS_SEG) + (size_t)dh * NSEG * 2 * 4096;
                { const float* q0 = seg0 + 4096 + 16 * wave + r;
#pragma unroll
                  for (int t = 0; t < 4; ++t)
#pragma unroll
                      for (int e2 = 0; e2 < 4; ++e2) S[t][e2] = q0[(16 * t + 4 * g + e2) * 64]; }
#pragma unroll 1
                for (int s = 1; s < sg; ++s) {
                    const float* Pm = seg0 + (size_t)s * 2 * 4096; const float* Qm = Pm + 4096 + 16 * wave + r;
                    u32x4 bsf[2];
#pragma unroll
                    for (int ks = 0; ks < 2; ++ks) { bsf[ks].x = pkbf(S[2 * ks][0], S[2 * ks][1]); bsf[ks].y = pkbf(S[2 * ks][2], S[2 * ks][3]); bsf[ks].z = pkbf(S[2 * ks + 1][0], S[2 * ks + 1][1]); bsf[ks].w = pkbf(S[2 * ks + 1][2], S[2 * ks + 1][3]); }
                    f32x4 Sn[4];
#pragma unroll
                    for (int t = 0; t < 4; ++t) {
                        f32x4 c;
#pragma unroll
                        for (int e2 = 0; e2 < 4; ++e2) c[e2] = Qm[(16 * t + 4 * g + e2) * 64];
#pragma unroll
                        for (int ks = 0; ks < 2; ++ks) {
                            const f32x4 lo = *(const f32x4*)(Pm + (16 * t + r) * 64 + 32 * ks + 4 * g), hi = *(const f32x4*)(Pm + (16 * t + r) * 64 + 32 * ks + 16 + 4 * g);
                            u32x4 a; a.x = pkbf(lo[0], lo[1]); a.y = pkbf(lo[2], lo[3]); a.z = pkbf(hi[0], hi[1]); a.w = pkbf(hi[2], hi[3]);
                            c = __builtin_amdgcn_mfma_f32_16x16x32_bf16(__builtin_bit_cast(bf16x8, a), __builtin_bit_cast(bf16x8, bsf[ks]), c, 0, 0, 0);
                        }
                        Sn[t] = c;
                    }
#pragma unroll
                    for (int t = 0; t < 4; ++t) S[t] = Sn[t];
                }
            }
        } else {
#pragma unroll
            for (int t = 0; t < 4; ++t)
#pragma unroll
                for (int e2 = 0; e2 < 4; ++e2) S[t][e2] = (MODE == 2 && (16 * t + 4 * g + e2) == 16 * wave + r) ? 1.f : 0.f;
        }
        const int dvrow = 16 * wave + r;
        const GAS u32x4* usrc = (const GAS u32x4*)(srcU + wave * 2048) + lane;
        u32x4 uq[SC_P][2];
        if (MODE != 2) {
#pragma unroll
            for (int p = 0; p < SC_P; ++p) { uq[p][0] = usrc[(size_t)p * 512]; uq[p][1] = usrc[(size_t)p * 512 + 64]; }
        }
        SC_BAR();
#define OST_W(base, t_, lo_, hi_) *(LAS u32x2*)(ost + (base) + r * 128 + (((2 * (t_) + (g >> 1)) ^ (r & 7)) << 4) + ((g & 1) << 3)) = (u32x2){lo_, hi_}
        for (int t4 = 0; t4 < ns; t4 += SC_P) {
#pragma unroll
          for (int tp = 0; tp < SC_P; ++tp) {
            const int t = t4 + tp;
            const LAS unsigned char* sb = F.lds + (t % SC_D) * SC_STAGE;
            const float gl = gls[t];
            if (MODE != 2) {
#pragma unroll
                for (int j = 0; j < 2; ++j) { const int row = 8 * j + (lane >> 3), c = lane & 7; *(LAS u32x4*)(ost + 4096 + row * 128 + ((c ^ (row & 7)) << 4)) = uq[tp][j]; }
                if (t + SC_P < ns) { uq[tp][0] = usrc[(size_t)(t + SC_P) * 512]; uq[tp][1] = usrc[(size_t)(t + SC_P) * 512 + 64]; }
            }
            u32x4 bs[2];
#pragma unroll
            for (int ks = 0; ks < 2; ++ks) { bs[ks].x = pkbf(S[2 * ks][0], S[2 * ks][1]); bs[ks].y = pkbf(S[2 * ks][2], S[2 * ks][3]); bs[ks].z = pkbf(S[2 * ks + 1][0], S[2 * ks + 1][1]); bs[ks].w = pkbf(S[2 * ks + 1][2], S[2 * ks + 1][3]); }
            if (MODE == 0) { OST_W(0, 0, bs[0].x, bs[0].y); OST_W(0, 1, bs[0].z, bs[0].w); OST_W(0, 2, bs[1].x, bs[1].y); OST_W(0, 3, bs[1].z, bs[1].w); }
            f32x4 vn[4];
#pragma unroll
            for (int it = 0; it < 4; ++it) {
                f32x4 c = (f32x4){0.f, 0.f, 0.f, 0.f};
                if (MODE != 2) { const u32x2 uu = *(const LAS u32x2*)(ost + 4096 + r * 128 + (((2 * it + (g >> 1)) ^ (r & 7)) << 4) + ((g & 1) << 3));
                    c = (f32x4){bf2f(uu.x & 0xffffu), bf2f(uu.x >> 16), bf2f(uu.y & 0xffffu), bf2f(uu.y >> 16)}; }
#pragma unroll
                for (int ks = 0; ks < 2; ++ks) {
                    const u32x4 a = *(const LAS u32x4*)(sb + sc_off(16 * it + r, 32 * ks + 8 * g));
                    c = __builtin_amdgcn_mfma_f32_16x16x32_bf16(__builtin_bit_cast(bf16x8, a), __builtin_bit_cast(bf16x8, bs[ks]), c, 0, 0, 0);
                }
                vn[it] = c;
            }
            u32x4 bv[2];
#pragma unroll
            for (int ks = 0; ks < 2; ++ks) { bv[ks].x = pkbf(vn[2 * ks][0], vn[2 * ks][1]); bv[ks].y = pkbf(vn[2 * ks][2], vn[2 * ks][3]); bv[ks].z = pkbf(vn[2 * ks + 1][0], vn[2 * ks + 1][1]); bv[ks].w = pkbf(vn[2 * ks + 1][2], vn[2 * ks + 1][3]); }
            if (MODE == 0) {
                if (d == 0) {
                    OST_W(2048, 0, bv[0].x, bv[0].y); OST_W(2048, 1, bv[0].z, bv[0].w); OST_W(2048, 2, bv[1].x, bv[1].y); OST_W(2048, 3, bv[1].z, bv[1].w);
                } else {
#define SC_ROT(a) (((a) >> 16) | ((a) << 16))
#define OST_WR(t_, lo_, hi_) *(LAS u32x2*)(ost + 2048 + r * 128 + (((2 * (3 - (t_)) + ((3 - g) >> 1)) ^ (r & 7)) << 4) + (((3 - g) & 1) << 3)) = (u32x2){SC_ROT(hi_), SC_ROT(lo_)}
                    OST_WR(0, bv[0].x, bv[0].y); OST_WR(1, bv[0].z, bv[0].w); OST_WR(2, bv[1].x, bv[1].y); OST_WR(3, bv[1].z, bv[1].w);
#undef OST_WR
#undef SC_ROT
                }
                GAS u32x4* gst = (GAS u32x4*)(ST + (size_t)t * 4096 + wave * 1024); GAS u32x4* gvt = (GAS u32x4*)(VT + (size_t)t * 4096 + wave * 1024);
#pragma unroll
                for (int j = 0; j < 2; ++j) {
                    const int row = 8 * j + (lane >> 3), c = lane & 7; const int off = row * 128 + ((c ^ (row & 7)) << 4);
                    gst[64 * j + lane] = *(const LAS u32x4*)(ost + off); gvt[64 * j + lane] = *(const LAS u32x4*)(ost + 2048 + off);
                }
            }
#pragma unroll
            for (int tt = 0; tt < 4; ++tt) {
                f32x4 c = S[tt] * gl;
#pragma unroll
                for (int ks = 0; ks < 2; ++ks) {
                    const u32x4 a = *(const LAS u32x4*)(sb + 8192 + sc_off(16 * tt + r, 32 * ks + 8 * g));
                    c = __builtin_amdgcn_mfma_f32_16x16x32_bf16(__builtin_bit_cast(bf16x8, a), __builtin_bit_cast(bf16x8, bv[ks]), c, 0, 0, 0);
                }
                S[tt] = c;
            }
            asm volatile("s_waitcnt lgkmcnt(0)" ::: "memory");
            SC_BAR();
          }
        }
        if (MODE != 0) {
            float* o = (float*)(F.ws + WS_SEG) + ((size_t)(dh * NSEG + sg) * 2 + (MODE == 2 ? 0 : 1)) * 4096 + 16 * wave + r;
#pragma unroll
            for (int t = 0; t < 4; ++t)
#pragma unroll
                for (int e2 = 0; e2 < 4; ++e2) o[(16 * t + 4 * g + e2) * 64] = S[t][e2];
        }
    }
#undef SC_WAITV
#undef OST_W
#undef SC_BAR
#undef SC_ISSUE
    asm volatile("s_waitcnt vmcnt(0) lgkmcnt(0)" ::: "memory");
    __syncthreads();
}
__device__ __forceinline__ void dn_combine(Frame& F, const int dh) {
    const float* SEG = (const float*)(F.ws + WS_SEG) + (size_t)dh * NSEG * 2 * 4096;
    float* SST = (float*)(F.ws + WS_SST) + (size_t)dh * NSEG * 4096;
    LAS float* Sl = (LAS float*)F.lds; LAS float* Pl = Sl + 4096;
    for (int i = F.tid; i < 4096; i += NTHREADS) { const float v = SEG[4096 + i]; Sl[i] = v; SST[4096 + i] = v; }
    __syncthreads();
    const int col = F.tid & 63, dk0 = F.tid >> 6;
    float pre[8], qre[8];
#pragma unroll
    for (int k = 0; k < 8; ++k) { pre[k] = SEG[(size_t)1 * 2 * 4096 + F.tid + NTHREADS * k]; qre[k] = SEG[(size_t)1 * 2 * 4096 + 4096 + (dk0 + 8 * k) * 64 + col]; }
#pragma unroll 1
    for (int sg = 1; sg <= NSEG - 2; ++sg) {
        float out[8];
#pragma unroll
        for (int k = 0; k < 8; ++k) { Pl[F.tid + NTHREADS * k] = pre[k]; out[k] = qre[k]; }
        if (sg + 1 <= NSEG - 2) {
#pragma unroll
            for (int k = 0; k < 8; ++k) { pre[k] = SEG[(size_t)(sg + 1) * 2 * 4096 + F.tid + NTHREADS * k]; qre[k] = SEG[(size_t)(sg + 1) * 2 * 4096 + 4096 + (dk0 + 8 * k) * 64 + col]; }
        }
        __syncthreads();
#pragma unroll 2
        for (int k4 = 0; k4 < 16; ++k4) {
            const float s0 = Sl[(4 * k4 + 0) * 64 + col], s1 = Sl[(4 * k4 + 1) * 64 + col], s2 = Sl[(4 * k4 + 2) * 64 + col], s3 = Sl[(4 * k4 + 3) * 64 + col];
#pragma unroll
            for (int k = 0; k < 8; ++k) { const f32x4 pv = *(const LAS f32x4*)(Pl + (dk0 + 8 * k) * 64 + 4 * k4); out[k] += (pv.x * s0 + pv.y * s1) + (pv.z * s2 + pv.w * s3); }
        }
        __syncthreads();
#pragma unroll
        for (int k = 0; k < 8; ++k) { Sl[(dk0 + 8 * k) * 64 + col] = out[k]; SST[(size_t)(sg + 1) * 4096 + (dk0 + 8 * k) * 64 + col] = out[k]; }
        __syncthreads();
    }
}

__device__ __forceinline__ void attn_unit(Frame& F, const Args& A, int layer, int unit) {
    const bf16_t* PX = (const bf16_t*)(F.ws + WS_PX);
    bf16_t* ACT = (bf16_t*)(F.ws + WS_ACT);
    const int lane = F.lane, wave = F.wave, r = lane & 15, g = lane >> 4, tid = F.tid;
    const bool isctx = unit >= 256;
    const int qb = isctx ? (unit - 256) >> 1 : unit >> 1, hk = unit & 1;
    const int qrow0 = (isctx ? NL : 0) + 128 * qb + 16 * wave;
    const int qpos = 128 * qb + 16 * wave + r;
    const float SCL = 0.125f * 1.4426950408889634f;
    bf16x8 qf[3][2];
#pragma unroll
    for (int a = 0; a < 3; ++a)
#pragma unroll
        for (int ks = 0; ks < 2; ++ks) qf[a][ks] = *(const bf16x8*)(PX + (size_t)(qrow0 + r) * INP + C_AQ + (3 * hk + a) * 64 + 32 * ks + 8 * g);
    float mrun[3], lrun[3]; f32x4 o[3][4];
#pragma unroll
    for (int a = 0; a < 3; ++a) { mrun[a] = A.in[I_SINK][layer * 6 + 3 * hk + a] * 1.4426950408889634f; lrun[a] = 1.f;
#pragma unroll
        for (int dt = 0; dt < 4; ++dt) o[a][dt] = (f32x4){0.f, 0.f, 0.f, 0.f}; }
    const int jlo = (!isctx && qb == 0) ? 2 : 0, jhi = isctx ? 0 : ((qb == 127) ? 4 : 6);
    const int ntile = 4 + (jhi - jlo);
    const int skey = tid >> 3, sch = tid & 7;
    const int spk = (skey & 32) + 8 * (((skey & 31) & 15) >> 2) + 4 * ((skey & 31) >> 4) + (skey & 3);
#define ATT_KROW(s_) ((s_) < 4 ? NL + 64 * (s_) : 128 * (qb - 1) + 64 * (jlo + (s_) - 4))
#define ATT_LOAD(s_) do { const size_t ro_ = (size_t)(ATT_KROW(s_) + skey) * INP; pkv = *(const u32x4*)(PX + ro_ + C_AK + hk * 64 + sch * 8); pvv = *(const u32x4*)(PX + ro_ + C_AV + hk * 64 + sch * 8); } while (0)
#define ATT_STAGE(buf_) do { LAS unsigned char* kb_ = F.lds + (buf_) * 18432; *(LAS u32x4*)(kb_ + skey * 144 + sch * 16) = pkv; LAS bf16_t* vt = (LAS bf16_t*)(kb_ + 9216); \
        vt[(sch * 8 + 0) * 72 + spk] = (bf16_t)(pvv.x & 0xffffu); vt[(sch * 8 + 1) * 72 + spk] = (bf16_t)(pvv.x >> 16); vt[(sch * 8 + 2) * 72 + spk] = (bf16_t)(pvv.y & 0xffffu); vt[(sch * 8 + 3) * 72 + spk] = (bf16_t)(pvv.y >> 16); \
        vt[(sch * 8 + 4) * 72 + spk] = (bf16_t)(pvv.z & 0xffffu); vt[(sch * 8 + 5) * 72 + spk] = (bf16_t)(pvv.z >> 16); vt[(sch * 8 + 6) * 72 + spk] = (bf16_t)(pvv.w & 0xffffu); vt[(sch * 8 + 7) * 72 + spk] = (bf16_t)(pvv.w >> 16); } while (0)
    u32x4 pkv, pvv;
    ATT_LOAD(0); ATT_STAGE(0);
    __syncthreads();
    for (int ti = 0; ti < ntile; ++ti) {
        const int krow0 = ATT_KROW(ti);
        const int q0w = 128 * qb + 16 * wave;
        const bool local = ti >= 4 && ((krow0 + 63 - q0w > 128) || (q0w + 15 - krow0 > 128));
        if (ti + 1 < ntile) ATT_LOAD(ti + 1);
        LAS unsigned char* Kl = F.lds + (ti & 1) * 18432;
        LAS unsigned char* Vl = Kl + 9216;
        f32x4 st[3][4];
#pragma unroll
        for (int kt = 0; kt < 4; ++kt) {
            const bf16x8 k0 = *(const LAS bf16x8*)(Kl + (16 * kt + r) * 144 + (8 * g) * 2);
            const bf16x8 k1 = *(const LAS bf16x8*)(Kl + (16 * kt + r) * 144 + (32 + 8 * g) * 2);
#pragma unroll
            for (int a = 0; a < 3; ++a) {
                f32x4 c = (f32x4){0.f, 0.f, 0.f, 0.f};
                c = __builtin_amdgcn_mfma_f32_16x16x32_bf16(k0, qf[a][0], c, 0, 0, 0);
                c = __builtin_amdgcn_mfma_f32_16x16x32_bf16(k1, qf[a][1], c, 0, 0, 0);
                st[a][kt] = c;
            }
        }
        u32x4 bp[3][2];
#pragma unroll
        for (int a = 0; a < 3; ++a) {
            float tmax = -INFINITY;
#pragma unroll
            for (int kt = 0; kt < 4; ++kt)
#pragma unroll
                for (int e = 0; e < 4; ++e) {
                    float sv = st[a][kt][e] * SCL;
                    if (local) { const int kp = krow0 + 16 * kt + 4 * g + e; const int df = qpos - kp; if (df > 128 || df < -128) sv = -INFINITY; }
                    st[a][kt][e] = sv; tmax = fmaxf(tmax, sv);
                }
            tmax = fmaxf(tmax, __shfl_xor(tmax, 16)); tmax = fmaxf(tmax, __shfl_xor(tmax, 32));
            const float mnew = fmaxf(mrun[a], tmax);
            const float alpha = __builtin_amdgcn_exp2f(mrun[a] - mnew);
            float ls = 0.f;
#pragma unroll
            for (int kt = 0; kt < 4; ++kt)
#pragma unroll
                for (int e = 0; e < 4; ++e) { const float p = __builtin_amdgcn_exp2f(st[a][kt][e] - mnew); st[a][kt][e] = p; ls += p; }
            ls += __shfl_xor(ls, 16); ls += __shfl_xor(ls, 32);
            lrun[a] = lrun[a] * alpha + ls; mrun[a] = mnew;
#pragma unroll
            for (int dt = 0; dt < 4; ++dt) o[a][dt] = o[a][dt] * alpha;
#pragma unroll
            for (int k2 = 0; k2 < 2; ++k2) { bp[a][k2].x = pkbf(st[a][2 * k2][0], st[a][2 * k2][1]); bp[a][k2].y = pkbf(st[a][2 * k2][2], st[a][2 * k2][3]);
                bp[a][k2].z = pkbf(st[a][2 * k2 + 1][0], st[a][2 * k2 + 1][1]); bp[a][k2].w = pkbf(st[a][2 * k2 + 1][2], st[a][2 * k2 + 1][3]); }
        }
#pragma unroll
        for (int dt = 0; dt < 4; ++dt)
#pragma unroll
            for (int k2 = 0; k2 < 2; ++k2) {
                const u32x4 av = *(const LAS u32x4*)(Vl + (16 * dt + r) * 144 + (32 * k2 + 8 * g) * 2);
#pragma unroll
                for (int a = 0; a < 3; ++a) o[a][dt] = __builtin_amdgcn_mfma_f32_16x16x32_bf16(__builtin_bit_cast(bf16x8, av), __builtin_bit_cast(bf16x8, bp[a][k2]), o[a][dt], 0, 0, 0);
            }
        if (ti + 1 < ntile) ATT_STAGE((ti + 1) & 1);
        __syncthreads();
    }
#undef ATT_KROW
#undef ATT_LOAD
#undef ATT_STAGE
#pragma unroll
    for (int a = 0; a < 3; ++a) {
        const float inv = 1.0f / lrun[a];
#pragma unroll
        for (int dt = 0; dt < 4; ++dt) {
            u32x2 w; w.x = pkbf(o[a][dt][0] * inv, o[a][dt][1] * inv); w.y = pkbf(o[a][dt][2] * inv, o[a][dt][3] * inv);
            *(u32x2*)(ACT + (size_t)(qrow0 + r) * D + 640 + (3 * hk + a) * 64 + 16 * dt + 4 * g) = w;
        }
    }
}

constexpr int X1_JOBS = 12 * (2 * (NSEG - 1) - 1);
__device__ __forceinline__ void scan_x1_phase(Frame& F, const Args& A, int layer) {
    const int b = blockIdx.x;
    if (b < X1_JOBS) {
        const int dh = b / (2 * (NSEG - 1) - 1), k = b % (2 * (NSEG - 1) - 1);
        if (k == 0) dn_scan_job<1>(F, dh, 0);
        else { const int sg = 1 + ((k - 1) >> 1); if ((k - 1) & 1) dn_scan_job<1>(F, dh, sg); else dn_scan_job<2>(F, dh, sg); }
        return;
    }
    const int nw = F.G - X1_JOBS;
    for (int u = b - X1_JOBS; u < 100; u += nw) { attn_unit(F, A, layer, u); __syncthreads(); }
}
__device__ __forceinline__ void scan_x2_phase(Frame& F) {
    if (blockIdx.x < 12) dn_combine(F, blockIdx.x);
}
__device__ __forceinline__ void scan_x3_phase(Frame& F, const Args& A, int layer) {
    if (blockIdx.x < 12 * NSEG) { dn_scan_job<0>(F, blockIdx.x / NSEG, blockIdx.x % NSEG); return; }
    const int nunits = layer == 0 ? 260 : 256, nw = F.G - 12 * NSEG;
    for (int u = 100 + blockIdx.x - 12 * NSEG; u < nunits; u += nw) { attn_unit(F, A, layer, u); __syncthreads(); }
}

constexpr int DO_BUF = 58880;
__device__ __forceinline__ void dn_out_phase(Frame& F, const Args& A, int layer) {
    const bf16_t* PX = (const bf16_t*)(F.ws + WS_PX);
    bf16_t* ACT = (bf16_t*)(F.ws + WS_ACT);
    const bf16_t* QD = (const bf16_t*)(F.ws + WS_QD); const bf16_t* KD = (const bf16_t*)(F.ws + WS_QD + QKV_STRIDE);
    const float* Gg = (const float*)(F.ws + WS_G);
    const bf16_t* VT = (const bf16_t*)(F.ws + WS_DN + 3 * DN_STRIDE); const bf16_t* ST = (const bf16_t*)(F.ws + WS_DN + 4 * DN_STRIDE);
    const float* ng = A.in[I_NORMG] + layer * 64;
    const int tid = F.tid, lane = F.lane, wave = F.wave, r = lane & 15, g = lane >> 4;
    const int it = wave & 3, hf = wave >> 2;
    const int nunits = (layer == 0 ? 260 : 256) * 6;
    const int srow = tid >> 3, sc = tid & 7;
    const int soff = srow * 128 + ((sc ^ ((srow >> 1) & 7)) << 4);
    u32x4 pre[7]; float gpre = 0.f;
#define DO_ROW0(u_) (((u_) / 6) < 256 ? 64 * ((u_) / 6) : NL + 64 * (((u_) / 6) - 256))
#define DO_LOAD(u_) do { const int oc_ = (u_) / 6, h_ = (u_) % 6, row0_ = DO_ROW0(u_); \
        const int s0_ = oc_ < 256 ? 4 + oc_ : oc_ - 256, s1_ = oc_ < 256 ? 4 + 255 - oc_ : 3 - (oc_ - 256); \
        const size_t U0_ = (size_t)(h_ * DN_NS + s0_) * 4096, U1_ = (size_t)((6 + h_) * DN_NS + s1_) * 4096; \
        pre[0] = *(const u32x4*)(QD + (size_t)(row0_ + srow) * 384 + h_ * 64 + sc * 8); pre[1] = *(const u32x4*)(KD + (size_t)(row0_ + srow) * 384 + h_ * 64 + sc * 8); \
        pre[2] = *(const u32x4*)(ST + U0_ + srow * 64 + sc * 8); pre[3] = *(const u32x4*)(ST + U1_ + srow * 64 + sc * 8); \
        pre[4] = *(const u32x4*)(VT + U0_ + srow * 64 + sc * 8); pre[5] = *(const u32x4*)(VT + U1_ + srow * 64 + sc * 8); \
        pre[6] = *(const u32x4*)(PX + (size_t)(row0_ + srow) * INP + C_DZ + h_ * 64 + sc * 8); \
        if (wave < 2) gpre = Gg[(size_t)(row0_ + lane) * 12 + wave * 6 + h_]; } while (0)
#define DO_STAGE(b_) do { LAS unsigned char* bb_ = F.lds + (b_) * DO_BUF; \
        _Pragma("unroll") for (int q_ = 0; q_ < 7; ++q_) *(LAS u32x4*)(bb_ + q_ * 8192 + soff) = pre[q_]; \
        if (wave < 2) { float gv_ = gpre; \
            _Pragma("unroll") for (int o_ = 1; o_ < 64; o_ <<= 1) { const float t_ = wave ? __shfl_down(gv_, o_) : __shfl_up(gv_, o_); if (wave ? (lane + o_ < 64) : (lane >= o_)) gv_ += t_; } \
            ((LAS float*)(bb_ + 57344))[wave * 64 + lane] = gv_; } } while (0)
    int u = blockIdx.x, cur = 0;
    if (u < nunits) { DO_LOAD(u); DO_STAGE(0); }
    __syncthreads();
    f32x4 ngv[2];
#pragma unroll
    for (int dtl = 0; dtl < 2; ++dtl) ngv[dtl] = *(const f32x4*)(ng + 16 * (2 * hf + dtl) + 4 * g);
#pragma unroll 1
    for (; u < nunits; u += F.G) {
        const int un = u + F.G;
        if (un < nunits) DO_LOAD(un);
        const int h = u % 6, row0 = DO_ROW0(u);
        LAS unsigned char* bb = F.lds + cur * DO_BUF;
        const LAS float* gc0 = (const LAS float*)(bb + 57344); const LAS float* gc1 = gc0 + 64;
        LAS float* ssx = (LAS float*)(bb + 57344 + 512);
        const int i = 16 * it + r;
        const float e0 = gc0[i], e1 = gc1[i];
        bf16x8 qf[2];
#pragma unroll
        for (int ks = 0; ks < 2; ++ks) qf[ks] = *(const LAS bf16x8*)(bb + sc_off(16 * it + r, 32 * ks + 8 * g));
        f32x4 pt[4];
#pragma unroll
        for (int jt = 0; jt < 4; ++jt) {
            f32x4 c = (f32x4){0.f, 0.f, 0.f, 0.f};
#pragma unroll
            for (int ks = 0; ks < 2; ++ks) c = __builtin_amdgcn_mfma_f32_16x16x32_bf16(*(const LAS bf16x8*)(bb + 8192 + sc_off(16 * jt + r, 32 * ks + 8 * g)), qf[ks], c, 0, 0, 0);
            pt[jt] = c;
        }
        f32x4 o[2];
#pragma unroll
        for (int dtl = 0; dtl < 2; ++dtl) o[dtl] = (f32x4){0.f, 0.f, 0.f, 0.f};
#pragma unroll
        for (int dir = 0; dir < 2; ++dir) {
            const LAS float* gcd = dir == 0 ? gc0 : gc1; const float ei = dir == 0 ? e0 : e1;
            const float xi = __expf(ei);
            u32x4 bp[2]; float pv[4][4];
#pragma unroll
            for (int jt = 0; jt < 4; ++jt)
#pragma unroll
                for (int e = 0; e < 4; ++e) {
                    const int j = 16 * jt + 4 * g + e;
                    const bool ok = dir == 0 ? (j <= i) : (j >= i);
                    pv[jt][e] = ok ? pt[jt][e] * __expf(ei - gcd[j]) : 0.f;
                }
#pragma unroll
            for (int k2 = 0; k2 < 2; ++k2) { bp[k2].x = pkbf(pv[2 * k2][0], pv[2 * k2][1]); bp[k2].y = pkbf(pv[2 * k2][2], pv[2 * k2][3]); bp[k2].z = pkbf(pv[2 * k2 + 1][0], pv[2 * k2 + 1][1]); bp[k2].w = pkbf(pv[2 * k2 + 1][2], pv[2 * k2 + 1][3]); }
            const LAS unsigned char* stt = bb + (2 + dir) * 8192; const LAS unsigned char* vtt = bb + (4 + dir) * 8192;
#pragma unroll
            for (int dtl = 0; dtl < 2; ++dtl) {
                const int dt = 2 * hf + dtl;
                f32x4 c = (f32x4){0.f, 0.f, 0.f, 0.f};
#pragma unroll
                for (int ks = 0; ks < 2; ++ks) c = __builtin_amdgcn_mfma_f32_16x16x32_bf16(*(const LAS bf16x8*)(stt + sc_off(16 * dt + r, 32 * ks + 8 * g)), qf[ks], c, 0, 0, 0);
                f32x4 acc = o[dtl] + c * xi;
#pragma unroll
                for (int k2 = 0; k2 < 2; ++k2) {
                    const u32x2 lo = *(const LAS u32x2*)(vtt + sc_off(16 * dt + r, 32 * k2 + 4 * g)), hi = *(const LAS u32x2*)(vtt + sc_off(16 * dt + r, 32 * k2 + 16 + 4 * g));
                    const u32x4 av = (u32x4){lo.x, lo.y, hi.x, hi.y};
                    acc = __builtin_amdgcn_mfma_f32_16x16x32_bf16(__builtin_bit_cast(bf16x8, av), __builtin_bit_cast(bf16x8, bp[k2]), acc, 0, 0, 0);
                }
                o[dtl] = acc;
            }
        }
        float ss = 0.f;
#pragma unroll
        for (int dtl = 0; dtl < 2; ++dtl) ss += (o[dtl][0] * o[dtl][0] + o[dtl][1] * o[dtl][1]) + (o[dtl][2] * o[dtl][2] + o[dtl][3] * o[dtl][3]);
        ss += __shfl_xor(ss, 16); ss += __shfl_xor(ss, 32);
        if (g == 0) ssx[wave * 16 + r] = ss;
        __syncthreads();
        const float rstd = 1.0f / sqrtf((ssx[wave * 16 + r] + ssx[(wave ^ 4) * 16 + r]) * (1.f / 64.f) + EPS);
#pragma unroll
        for (int dtl = 0; dtl < 2; ++dtl) {
            const int dt = 2 * hf + dtl;
            const u32x2 zz = *(const LAS u32x2*)(bb + 6 * 8192 + sc_off(i, 16 * dt + 4 * g));
            const float z0 = bf2f(zz.x & 0xffffu), z1 = bf2f(zz.x >> 16), z2 = bf2f(zz.y & 0xffffu), z3 = bf2f(zz.y >> 16);
            u32x2 w; w.x = pkbf(o[dtl][0] * rstd * ngv[dtl][0] * silu_f(z0), o[dtl][1] * rstd * ngv[dtl][1] * silu_f(z1));
            w.y = pkbf(o[dtl][2] * rstd * ngv[dtl][2] * silu_f(z2), o[dtl][3] * rstd * ngv[dtl][3] * silu_f(z3));
            *(LAS u32x2*)(bb + 8192 + sc_off(i, 16 * dt + 4 * g)) = w;
        }
        __syncthreads();
        *(u32x4*)(ACT + (size_t)(row0 + srow) * D + 256 + h * 64 + sc * 8) = *(const LAS u32x4*)(bb + 8192 + soff);
        if (un < nunits) DO_STAGE(cur ^ 1);
        __syncthreads();
        cur ^= 1;
    }
#undef DO_ROW0
#undef DO_LOAD
#undef DO_STAGE
}

constexpr size_t RT_EID = WS_ROUTE, RT_GATE = WS_ROUTE + 128 * 1024, RT_TSLOT = WS_ROUTE + 256 * 1024, RT_BCNT = WS_ROUTE + 384 * 1024, RT_TILEE = WS_ROUTE + 400 * 1024, RT_NT = WS_ROUTE + 404 * 1024;
constexpr size_t WS_XS = WS_BIG;
constexpr size_t WS_Y = 278 * MiB;
constexpr size_t WS_HM = 350 * MiB;
constexpr int MOE_CH = 72;
constexpr size_t WS_SLAB = 440 * MiB;
static_assert(WS_HM + (size_t)72 * 256 * DFE <= WS_SLAB && WS_SLAB + (size_t)8 * 28 * 65536 * 4 <= WS_END, "slab map");
static_assert(WS_XS + (size_t)36864 * 1024 <= WS_Y && WS_Y + (size_t)36864 * 2048 <= WS_HM, "moe map");

__device__ __forceinline__ void norm2_router_phase(Frame& F, const Args& A) {
    const float* mod = (const float*)(F.ws + WS_MOD) + (1 * 2 + 0) * 6144;
    const float* shift = mod + 3 * 1024; const float* scale = mod + 4 * 1024;
    unsigned char* act8 = F.ws + WS_ACT;
    int* EID = (int*)(F.ws + RT_EID); float* GATE = (float*)(F.ws + RT_GATE); int* BCNT = (int*)(F.ws + RT_BCNT);
    LAS int* se = (LAS int*)F.lds;
    LAS float* rw = (LAS float*)(F.lds + 1024);
    for (int i = F.tid; i < 2048; i += NTHREADS) ((LAS f32x4*)rw)[i] = ((const GAS f32x4*)A.in[I_ROUTER])[i];
    __syncthreads();
    const int lane = F.lane;
    f32x4 shl[4], scl[4];
#pragma unroll
    for (int j = 0; j < 4; ++j) { shl[j] = ((const GAS f32x4*)shift)[lane + 64 * j]; scl[j] = ((const GAS f32x4*)scale)[lane + 64 * j] + 1.0f; }
    for (int k = 0; k < 8; ++k) {
        const int tl = F.wave * 8 + k, t = blockIdx.x * 64 + tl;
        const GAS f32x4* xr = (const GAS f32x4*)(A.out + (size_t)t * D) + lane;
        f32x4 v[4]; float s = 0.f;
#pragma unroll
        for (int j = 0; j < 4; ++j) { v[j] = xr[64 * j]; s += (v[j].x * v[j].x + v[j].y * v[j].y) + (v[j].z * v[j].z + v[j].w * v[j].w); }
        const float rstd = 1.0f / sqrtf(wave_sum(s) * (1.f / D) + EPS);
        float lg[8];
#pragma unroll
        for (int e = 0; e < 8; ++e) lg[e] = 0.f;
        GAS unsigned* o8 = (GAS unsigned*)(act8 + (size_t)t * D) + lane;
#pragma unroll
        for (int j = 0; j < 4; ++j) {
            const f32x4 y = v[j] * rstd * scl[j] + shl[j];
            o8[64 * j] = pk_fp8x4(y.x, y.y, y.z, y.w);
            const int c0 = 4 * (lane + 64 * j);
#pragma unroll
            for (int q = 0; q < 4; ++q) {
                const f32x4 r0 = *(const LAS f32x4*)(rw + (c0 + q) * 8), r1 = *(const LAS f32x4*)(rw + (c0 + q) * 8 + 4);
                const float yy = y[q];
                lg[0] += yy * r0.x; lg[1] += yy * r0.y; lg[2] += yy * r0.z; lg[3] += yy * r0.w; lg[4] += yy * r1.x; lg[5] += yy * r1.y; lg[6] += yy * r1.z; lg[7] += yy * r1.w;
            }
        }
#pragma unroll
        for (int e = 0; e < 8; ++e) lg[e] = wave_sum(lg[e]);
        int e0 = 0; float l0 = lg[0];
#pragma unroll
        for (int e = 1; e < 8; ++e) if (lg[e] > l0) { l0 = lg[e]; e0 = e; }
        int e1 = -1; float l1 = -INFINITY;
#pragma unroll
        for (int e = 0; e < 8; ++e) if (e != e0 && lg[e] > l1) { l1 = lg[e]; e1 = e; }
        if (lane == 0) {
            const float g0 = 1.0f / (1.0f + expf(l1 - l0));
            EID[t * 2] = e0; EID[t * 2 + 1] = e1; GATE[t * 2] = g0; GATE[t * 2 + 1] = 1.0f - g0;
            se[tl * 2] = e0; se[tl * 2 + 1] = e1;
        }
    }
    __syncthreads();
    if (F.wave == 0) {
        const int a0 = se[lane * 2], a1 = se[lane * 2 + 1];
#pragma unroll
        for (int e = 0; e < 8; ++e) { const unsigned long long mk = __ballot(a0 == e || a1 == e); if (lane == e) BCNT[blockIdx.x * 8 + e] = __popcll(mk); }
    }
    __syncthreads();
}

__device__ __forceinline__ void moe_assign_phase(Frame& F) {
    const int* EID = (const int*)(F.ws + RT_EID); int* TSLOT = (int*)(F.ws + RT_TSLOT); const int* BCNT = (const int*)(F.ws + RT_BCNT);
    unsigned* TILEE = (unsigned*)(F.ws + RT_TILEE); unsigned* NTL = (unsigned*)(F.ws + RT_NT);
    const unsigned char* act8 = F.ws + WS_ACT; unsigned char* XS = F.ws + WS_XS;
    LAS int* sm = (LAS int*)F.lds;
    const int b = blockIdx.x, lane = F.lane;
    if (F.tid < 8) {
        int tot = 0, mine = 0;
        for (int bb = 0; bb < 256; ++bb) { const int c = __hip_atomic_load(BCNT + bb * 8 + F.tid, RLX_AGENT); if (bb < b) mine += c; tot += c; }
        sm[F.tid] = tot; sm[8 + F.tid] = mine;
    }
    __syncthreads();
    if (F.tid == 0) {
        int ps = 0, nt = 0;
        for (int e = 0; e < 8; ++e) { const int tl = (sm[e] + 255) >> 8; sm[16 + e] = ps; sm[24 + e] = tl; if (b == 0) for (int q = 0; q < tl; ++q) TILEE[nt + q] = (unsigned)e; ps += tl * 256; nt += tl; }
        if (b == 0) *NTL = (unsigned)nt;
    }
    __syncthreads();
    if (F.wave == 0) {
        const int t = b * 64 + lane;
        const int a0 = EID[t * 2], a1 = EID[t * 2 + 1];
        int s0 = 0, s1 = 0;
        const unsigned long long lower = (1ull << lane) - 1ull;
#pragma unroll
        for (int e = 0; e < 8; ++e) {
            const unsigned long long mk = __ballot(a0 == e || a1 == e);
            const int rank = __popcll(mk & lower), slot = sm[16 + e] + sm[8 + e] + rank;
            if (a0 == e) s0 = slot; if (a1 == e) s1 = slot;
        }
        TSLOT[t * 2] = s0; TSLOT[t * 2 + 1] = s1; sm[32 + lane * 2] = s0; sm[33 + lane * 2] = s1;
    }
    __syncthreads();
    for (int q = F.wave; q < 128; q += NWAVES) {
        const int t = b * 64 + (q >> 1), slot = sm[32 + q];
        const GAS u32x4* srcp = (const GAS u32x4*)(act8 + (size_t)t * D); GAS u32x4* dstp = (GAS u32x4*)(XS + (size_t)slot * D);
        dstp[lane] = srcp[lane];
    }
    { const int e = b & 7, cnt = sm[e], first = sm[16 + e] + cnt, npad = sm[24 + e] * 256 - cnt;
      for (int p = (b >> 3) * NWAVES + F.wave; p < npad; p += 32 * NWAVES) { GAS u32x4* dstp = (GAS u32x4*)(XS + (size_t)(first + p) * D); const u32x4 z = (u32x4){0u, 0u, 0u, 0u}; dstp[lane] = z; } }
}

__device__ __forceinline__ f32x4 moe_yrow(const bf16_t* Y, const float* SLAB, int slot, int tail0, int j, int lane) {
    const int tile = slot >> 8;
    if (tile < tail0) { const u32x2 a = ((const GAS u32x2*)(Y + (size_t)slot * D))[lane + 64 * j];
        return (f32x4){bf2f(a.x & 0xffffu), bf2f(a.x >> 16), bf2f(a.y & 0xffffu), bf2f(a.y >> 16)}; }
    const float* p = SLAB + (size_t)(((tile - tail0) * 4 + j) * 7) * 65536 + (size_t)(slot & 255) * 256 + 4 * lane;
    f32x4 s = *(const f32x4*)p;
#pragma unroll
    for (int ks = 1; ks < 7; ++ks) s = s + *(const f32x4*)(p + (size_t)ks * 65536);
    return s;
}
__device__ __forceinline__ void moe_final_phase(Frame& F, const Args& A) {
    const float* mod5 = (const float*)(F.ws + WS_MOD) + (1 * 2 + 0) * 6144 + 5 * 1024;
    const int* TSLOT = (const int*)(F.ws + RT_TSLOT); const float* GATE = (const float*)(F.ws + RT_GATE);
    const bf16_t* Y = (const bf16_t*)(F.ws + WS_Y); const float* SLAB = (const float*)(F.ws + WS_SLAB);
    const float* fng = A.in[I_FNG];
    const int lane = F.lane;
    const int ntl = (int)__builtin_amdgcn_readfirstlane(__hip_atomic_load((unsigned*)(F.ws + RT_NT), RLX_AGENT));
    const int tail0 = (ntl > 128 && ntl - 128 <= 8) ? 128 : (1 << 20);
    f32x4 m5v[4], fgv[4];
#pragma unroll
    for (int j = 0; j < 4; ++j) { m5v[j] = ((const GAS f32x4*)mod5)[lane + 64 * j]; fgv[j] = ((const GAS f32x4*)fng)[lane + 64 * j]; }
    for (int t = F.gw; t < NL; t += F.NGW) {
        const int s0 = TSLOT[t * 2], s1 = TSLOT[t * 2 + 1]; const float g0 = GATE[t * 2], g1 = GATE[t * 2 + 1];
        GAS f32x4* xr = (GAS f32x4*)(A.out + (size_t)t * D) + lane;
        f32x4 v[4]; float s = 0.f;
        if (((s0 >> 8) < tail0) && ((s1 >> 8) < tail0)) {
            const GAS u32x2* y0 = (const GAS u32x2*)(Y + (size_t)s0 * D) + lane; const GAS u32x2* y1 = (const GAS u32x2*)(Y + (size_t)s1 * D) + lane;
#pragma unroll
            for (int j = 0; j < 4; ++j) {
                const f32x4 x = xr[64 * j]; const u32x2 a = y0[64 * j], c = y1[64 * j];
                const f32x4 m5 = m5v[j];
                f32x4 f;
                f.x = g0 * bf2f(a.x & 0xffffu) + g1 * bf2f(c.x & 0xffffu); f.y = g0 * bf2f(a.x >> 16) + g1 * bf2f(c.x >> 16);
                f.z = g0 * bf2f(a.y & 0xffffu) + g1 * bf2f(c.y & 0xffffu); f.w = g0 * bf2f(a.y >> 16) + g1 * bf2f(c.y >> 16);
                v[j] = x + m5 * f;
                s += (v[j].x * v[j].x + v[j].y * v[j].y) + (v[j].z * v[j].z + v[j].w * v[j].w);
            }
        } else {
#pragma unroll
            for (int j = 0; j < 4; ++j) {
                const f32x4 x = xr[64 * j];
                const f32x4 m5 = m5v[j];
                const f32x4 f = moe_yrow(Y, SLAB, s0, tail0, j, lane) * g0 + moe_yrow(Y, SLAB, s1, tail0, j, lane) * g1;
                v[j] = x + m5 * f;
                s += (v[j].x * v[j].x + v[j].y * v[j].y) + (v[j].z * v[j].z + v[j].w * v[j].w);
            }
        }
        const float rstd = 1.0f / sqrtf(wave_sum_l(s, lane) * (1.f / D) + EPS);
#pragma unroll
        for (int j = 0; j < 4; ++j) xr[64 * j] = v[j] * rstd * fgv[j];
    }
}

#define GRID_BAR() do { { unsigned* bp_ = (unsigned*)(F.ws + WS_CTL) + 4096; asm volatile("" : "+s"(bp_)); bar.bar = bp_; } xcd_barrier(bar); TS_STAMP(); F.tid = opq((int)threadIdx.x); F.lane = F.tid & 63; } while (0)

template <int MODE>
__device__ __forceinline__ void ctx_pieces(Frame& F, const bf16_t* A, const bf16_t* Bt, int K, int ncg, void* O, int ldo, const float* base, const float* gate,
                                           int nrg = 16, const unsigned* tile_e = nullptr, int tile0 = 0, size_t estride = 0) {
    const int lane = F.lane, r = lane & 15, g = lane >> 4, wave = F.wave;
    LAS float* red = (LAS float*)F.lds;
    const int npieces = nrg * ncg, kw = K >> 3;
    for (int p = blockIdx.x; p < npieces; p += F.G) {
        const int rg = p % nrg, cg = p / nrg;
        f32x4 acc[4];
#pragma unroll
        for (int n = 0; n < 4; ++n) acc[n] = (f32x4){0.f, 0.f, 0.f, 0.f};
        const bf16_t* ap = A + (size_t)(16 * rg + r) * K + wave * kw + 8 * g;
        size_t eoff = 0;
        if (tile_e) eoff = (size_t)(__builtin_amdgcn_readfirstlane(__hip_atomic_load(tile_e + tile0 + (rg >> 4), __ATOMIC_RELAXED, __HIP_MEMORY_SCOPE_AGENT)) & 7u) * estride;
        const bf16_t* bp = Bt + eoff + (size_t)(64 * cg + r) * K + wave * kw + 8 * g;
        bf16x8 a0 = *(const bf16x8*)ap, b0[4];
#pragma unroll
        for (int n = 0; n < 4; ++n) b0[n] = *(const bf16x8*)(bp + (size_t)(16 * n) * K);
        for (int k = 32; k < kw; k += 32) {
            const bf16x8 a1 = *(const bf16x8*)(ap + k); bf16x8 b1[4];
#pragma unroll
            for (int n = 0; n < 4; ++n) b1[n] = *(const bf16x8*)(bp + (size_t)(16 * n) * K + k);
#pragma unroll
            for (int n = 0; n < 4; ++n) acc[n] = __builtin_amdgcn_mfma_f32_16x16x32_bf16(a0, b0[n], acc[n], 0, 0, 0);
            a0 = a1;
#pragma unroll
            for (int n = 0; n < 4; ++n) b0[n] = b1[n];
        }
#pragma unroll
        for (int n = 0; n < 4; ++n) acc[n] = __builtin_amdgcn_mfma_f32_16x16x32_bf16(a0, b0[n], acc[n], 0, 0, 0);
#pragma unroll
        for (int n = 0; n < 4; ++n)
#pragma unroll
            for (int e = 0; e < 4; ++e) red[wave * 1024 + (4 * g + e) * 64 + 16 * n + r] = acc[n][e];
        __syncthreads();
        for (int idx = F.tid; idx < 1024; idx += NTHREADS) {
            float s = 0.f;
#pragma unroll
            for (int w = 0; w < 8; ++w) s += red[w * 1024 + idx];
            const int row = 16 * rg + (idx >> 6), col = 64 * cg + (idx & 63);
            if (MODE == 0) ((bf16_t*)O)[(size_t)row * ldo + col] = (bf16_t)f2bf(s);
            else ((float*)O)[(size_t)row * 1024 + col] = base[(size_t)row * 1024 + col] + gate[col] * s;
        }
        __syncthreads();
    }
}

#ifndef STOP_AFTER
#define STOP_AFTER 0
#endif
__device__ __forceinline__ void dump_bf16(Frame& F, float* out, const bf16_t* buf, int ld, int ncols) {
    for (int m = F.gw; m < NL; m += F.NGW)
        for (int j = 0; j < 16; ++j) { const int c = F.lane + 64 * j; float s = 0.f; for (int k = 0; c + 1024 * k < ncols; ++k) s += bf2f(buf[(size_t)m * ld + c + 1024 * k]); out[(size_t)m * D + c] = s; }
}
#define STOP_DUMP(n, buf, ld, nc) do { if (layer == 0 && STOP_AFTER == (n)) { dump_bf16(F, args.out, (const bf16_t*)(buf), (ld), (nc)); F.ws = nullptr; return; } } while (0)
template <int layer>
__device__ __forceinline__ void layer_body(Frame& F, const Args& args, XcdBarrier& bar) {
    unsigned char* ws = F.ws;
    float* HC = (float*)(ws + WS_HC);
    const float* MOD = (const float*)(ws + WS_MOD);
        F.tid = opq((int)threadIdx.x); F.lane = F.tid & 63;
        const float* xl = layer == 0 ? args.in[I_X] : args.out;
        const float* xc = layer == 0 ? args.in[I_CTX] : HC;
        const float* modx = MOD + (layer * 2 + 0) * 6144; const float* modc = MOD + (layer * 2 + 1) * 6144;
        norm_phase(F, xl, xc, layer, 0, 1, NT);
        GRID_BAR();
        ctx_pieces<0>(F, (const bf16_t*)(ws + WS_ACT) + (size_t)NL * 1024, (const bf16_t*)(ws + WS_WIN) + (size_t)layer * INP * 1024, 1024, INP / 64, (bf16_t*)(ws + WS_PX) + (size_t)NL * INP, INP, nullptr, nullptr);
        { pg8::DenseSched S{NL / 256, INP / 256, F.G, (int)blockIdx.x, (const char*)(ws + WS_ACT), (const char*)(ws + WS_WIN) + (size_t)layer * INP * 1024 * 2, (size_t)256 * 1024 * 2};
          pg8::EpiStoreBf16 E{(bf16_t*)(ws + WS_PX), INP};
          pg8::gemm_phase(F.lds, 1024, S, E); }
        GRID_BAR();
        STOP_DUMP(2, ws + WS_PX, INP, INC);
        prep_phase(F, args, layer);
        GRID_BAR();
        STOP_DUMP(3, ws + WS_QD, 384, 384);
        STOP_DUMP(33, ws + WS_QD + QKV_STRIDE, 384, 384);
        dn_chunk_phase(F);
        GRID_BAR();
        STOP_DUMP(4, ws + WS_DN, 1024, 1024);
        STOP_DUMP(44, ws + WS_DN + DN_STRIDE, 1024, 1024);
        STOP_DUMP(45, ws + WS_DN + 2 * DN_STRIDE, 1024, 1024);
        scan_x1_phase(F, args, layer);
        GRID_BAR();
        scan_x3_phase(F, args, layer);
        GRID_BAR();
        STOP_DUMP(5, ws + WS_DN + 3 * DN_STRIDE, 1024, 1024);
        STOP_DUMP(55, ws + WS_DN + 4 * DN_STRIDE, 1024, 1024);
        STOP_DUMP(56, ws + WS_ACT, 1024, 1024);
        dn_out_phase(F, args, layer);
        GRID_BAR();
        STOP_DUMP(6, ws + WS_ACT, 1024, 1024);
        if (layer == 0) ctx_pieces<1>(F, (const bf16_t*)(ws + WS_ACT) + (size_t)NL * 1024, (const bf16_t*)(ws + WS_WOUT), 1024, 16, HC, 1024, xc, modc + 2 * 1024);
        { pg8::DenseSched S{NL / 256, 4, F.G, (int)blockIdx.x, (const char*)(ws + WS_ACT), (const char*)(ws + WS_WOUT) + (size_t)layer * 1024 * 1024 * 2, (size_t)256 * 1024 * 2};
          pg8::EpiResid E{xl, args.out, modx + 2 * 1024, xc, HC, modc + 2 * 1024, NL / 256};
          pg8::gemm_phase(F.lds, 1024, S, E); }
        GRID_BAR();
        if (layer == 0 && STOP_AFTER == 7) { F.ws = nullptr; return; }
        if (layer == 0) {
            norm_phase(F, args.out, HC, 0, 3, 4, NT);
            GRID_BAR();
            { pg8::DenseSched S{NT / 256, 2 * DFF / 256, F.G, (int)blockIdx.x, (const char*)(ws + WS_ACT), (const char*)(ws + WS_WGU), (size_t)256 * 1024 * 2};
              pg8::EpiSwiGLU E{(bf16_t*)(ws + WS_BIG), DFF};
              pg8::gemm_phase(F.lds, 1024, S, E); }
            GRID_BAR();
            ctx_pieces<1>(F, (const bf16_t*)(ws + WS_BIG) + (size_t)NL * DFF, (const bf16_t*)(ws + WS_WDN), DFF, 16, HC, 1024, HC, modc + 5 * 1024);
            { pg8::DenseSched S{NL / 256, 4, F.G, (int)blockIdx.x, (const char*)(ws + WS_BIG), (const char*)(ws + WS_WDN), (size_t)256 * DFF * 2};
              pg8::EpiResid E{args.out, args.out, modx + 5 * 1024, HC, HC, modc + 5 * 1024, NL / 256};
              pg8::gemm_phase(F.lds, DFF, S, E); }
            GRID_BAR();
            if (STOP_AFTER == 9) { F.ws = nullptr; return; }
        } else {
            norm2_router_phase(F, args);
            GRID_BAR();
            moe_assign_phase(F);
            GRID_BAR();
            const int ntl = (int)__builtin_amdgcn_readfirstlane(__hip_atomic_load((unsigned*)(ws + RT_NT), RLX_AGENT));
#pragma unroll 1
            for (int t0 = 0; t0 < ntl; t0 += 64) {
                const int left = ntl - t0; const int nM = left > MOE_CH ? 64 : left;
                const int ntail = (nM > 64 && nM - 64 <= 8) ? nM - 64 : 0, nG2 = nM - ntail;
                { pg8::MoeSched S{nM, 2 * DFE / 256, F.G, (int)blockIdx.x, (const char*)(ws + WS_XS) + (size_t)t0 * 256 * 1024, (const char*)(ws + WS_MGU), (size_t)256 * 1024, (size_t)2 * DFE * 1024, (const unsigned*)(ws + RT_TILEE), t0, 0};
                  pg8::EpiSwiGLU8 E{ws + WS_HM, DFE, 1.0f / MOE_WSCALE, MOE_HSCALE};
                  pg8::gemm_phase<true>(F.lds, 512, S, E); }
                GRID_BAR();
                { pg8::MoeSched S{nG2, 4, F.G, (int)blockIdx.x, (const char*)(ws + WS_HM), (const char*)(ws + WS_MDN), (size_t)256 * DFE, (size_t)1024 * DFE, (const unsigned*)(ws + RT_TILEE), t0, t0};
                  pg8::EpiStoreBf16 E{(bf16_t*)(ws + WS_Y), 1024, 1.0f / (MOE_WSCALE * MOE_HSCALE)};
                  pg8::gemm_phase<true>(F.lds, DFE / 2, S, E); }
                if (ntail > 0) {
                    pg8::MoeTailSched S{ntail, F.G, (int)((blockIdx.x + 128) % F.G), (const char*)(ws + WS_HM) + (size_t)nG2 * 256 * DFE, (const char*)(ws + WS_MDN), (size_t)256 * DFE, (size_t)1024 * DFE, (const unsigned*)(ws + RT_TILEE), t0 + nG2, (size_t)512};
                    pg8::EpiSlab E{(float*)(ws + WS_SLAB), 1.0f / (MOE_WSCALE * MOE_HSCALE)};
                    pg8::gemm_phase<true>(F.lds, DFE / 2, S, E, 4);
                }
                GRID_BAR();
                if (left <= MOE_CH) break;
            }
            moe_final_phase(F, args);
        }
    }

__global__ void __launch_bounds__(NTHREADS, 2) fwd_kernel(Args args) {
    extern __shared__ __attribute__((aligned(16))) unsigned char lds[];
    Frame F;
    F.lds = (LAS unsigned char*)lds;
    F.tid = threadIdx.x; F.lane = F.tid & 63; F.wave = __builtin_amdgcn_readfirstlane(F.tid >> 6);
    F.G = gridDim.x; { const int bx = blockIdx.x; F.vcu = (F.G % 8 == 0) ? (bx % 8) * (F.G / 8) + bx / 8 : bx; }
    F.gw = F.vcu * NWAVES + F.wave; F.NGW = F.G * NWAVES;
    F.ws = args.ws;
    volatile LAS unsigned* MISC = (volatile LAS unsigned*)(F.lds + MISC_OFF);
    for (int u = F.tid; u < (LDS_BYTES - MISC_OFF) / 4; u += NTHREADS) ((LAS unsigned*)(F.lds + MISC_OFF))[u] = 0u;
    __syncthreads();
    XcdBarrier bar = xcd_barrier_post((unsigned*)(F.ws + WS_CTL) + 4096, MISC + 8);
    TS_STAMP();

    unsigned char* ws = F.ws;
    float* HC = (float*)(ws + WS_HC);
    const float* MOD = (const float*)(ws + WS_MOD);
#ifdef DIAG_ZERO
    { GAS u32x4* p = (GAS u32x4*)(F.ws + WS_MOD); const size_t n16 = (WS_END - WS_MOD) / 16; const u32x4 z = (u32x4){0u, 0u, 0u, 0u};
      for (size_t i = (size_t)blockIdx.x * NTHREADS + F.tid; i < n16; i += (size_t)F.G * NTHREADS) p[i] = z; }
    GRID_BAR();
#endif
    p0_prologue(F, args);
    GRID_BAR();
    layer_body<0>(F, args, bar);
    if (F.ws == nullptr) return;
    layer_body<1>(F, args, bar);
#ifdef TS_A
    TS_STAMP();
    if (blockIdx.x == 0 && threadIdx.x == 0) {
        volatile LAS unsigned* M_ = (volatile LAS unsigned*)(F.lds + MISC_OFF);
        const unsigned long long ta = ((unsigned long long)M_[17 + 2 * (TS_A)] << 32) | M_[16 + 2 * (TS_A)], tb = ((unsigned long long)M_[17 + 2 * (TS_B)] << 32) | M_[16 + 2 * (TS_B)];
        const unsigned long long dl = (tb - ta) * (TS_MUL), t0 = __builtin_amdgcn_s_memrealtime();
        while (__builtin_amdgcn_s_memrealtime() - t0 < dl) __builtin_amdgcn_s_sleep(8);
    }
#endif
}

extern "C" void kernel_launch(void* const* d_in, const int* in_sizes, int n_in, void* d_out, int out_size, void* d_ws, size_t ws_size, hipStream_t stream) {
    static int grid = 0;
    if (grid == 0) {
        if (n_in != 22 || out_size != NL * D || ws_size < WS_END) { fprintf(stderr, "kernel_launch: unexpected shapes (n_in %d out %d ws %zu)\n", n_in, out_size, ws_size); grid = -1; return; }
        int dev = 0, cus = 0;
        if (hipGetDevice(&dev) != hipSuccess || hipDeviceGetAttribute(&cus, hipDeviceAttributeMultiprocessorCount, dev) != hipSuccess) { grid = -1; return; }
        if (hipFuncSetAttribute((const void*)fwd_kernel, hipFuncAttributeMaxDynamicSharedMemorySize, LDS_BYTES) != hipSuccess) { fprintf(stderr, "kernel_launch: hipFuncSetAttribute failed\n"); grid = -1; return; }
        int per_cu = 0;
        (void)hipOccupancyMaxActiveBlocksPerMultiprocessor(&per_cu, (const void*)fwd_kernel, NTHREADS, LDS_BYTES);
        (void)hipGetLastError();
        grid = cus;
    }
    if (grid < 0) return;
    (void)hipMemsetAsync((char*)d_ws + WS_CTL, 0, CTL_ZERO_BYTES, stream);
    Args a{};
    for (int i = 0; i < 22; ++i) a.in[i] = (const float*)d_in[i];
    a.out = (float*)d_out; a.ws = (unsigned char*)d_ws;
    hipLaunchKernelGGL(fwd_kernel, dim3(grid), dim3(NTHREADS), LDS_BYTES, stream, a);
}
```

```cpp
#define STOP_AFTER 0
#include <hip/hip_runtime.h>
#include <cstdint>
#include <cstdio>

#define GAS __attribute__((address_space(1)))
#define LAS __attribute__((address_space(3)))
typedef unsigned short bf16_t;
typedef short bf16x8 __attribute__((ext_vector_type(8)));
typedef short bf16x4 __attribute__((ext_vector_type(4)));
typedef float f32x4 __attribute__((ext_vector_type(4)));
typedef float f32x2 __attribute__((ext_vector_type(2)));
typedef unsigned u32x4 __attribute__((ext_vector_type(4)));
typedef unsigned u32x2 __attribute__((ext_vector_type(2)));
typedef GAS unsigned gu32;

constexpr int D = 1024, NL = 16384, NC = 256, NT = NL + NC;
constexpr int INC = 2968, INP = 3072;
constexpr int C_CB = 0, C_CC = 256, C_CH = 512, C_DQ = 768, C_DK = 1152, C_DV = 1536, C_DZ = 1920, C_DA = 2304, C_DB = 2316, C_AQ = 2328, C_AK = 2712, C_AV = 2840;
constexpr int DFF = 2816, NEXP = 8, DFE = 3584;
constexpr int NWAVES = 8, NTHREADS = 512;
constexpr float EPS = 1e-6f;

constexpr size_t MiB = 1u << 20;
constexpr size_t WS_CTL = 0, CTL_ZERO_BYTES = 1 * MiB;
constexpr size_t WS_MOD = 1 * MiB;
constexpr size_t WS_ROPE = 1 * MiB + 128 * 1024;
constexpr size_t WS_HC = 2 * MiB;
constexpr size_t WS_G = 3 * MiB;
constexpr size_t WS_BETA = 4 * MiB;
constexpr size_t WS_ROUTE = 5 * MiB;
constexpr size_t WS_WIN = 8 * MiB;
constexpr size_t WS_WOUT = 20 * MiB;
constexpr size_t WS_WGU = 24 * MiB;
constexpr size_t WS_WDN = 35 * MiB;
constexpr size_t WS_MGU = 41 * MiB;
constexpr size_t WS_MDN = 153 * MiB;
constexpr size_t WS_ACT = 209 * MiB;
constexpr size_t WS_BIG = 242 * MiB;
constexpr size_t WS_PX = WS_BIG;
constexpr size_t WS_QD = 340 * MiB;
constexpr size_t QKV_STRIDE = 12 * MiB + 512 * 1024;
constexpr size_t WS_DN = 378 * MiB;
constexpr size_t DN_STRIDE = 25 * MiB;
constexpr size_t WS_AP = WS_DN;
constexpr size_t WS_SSQ = WS_DN + 40 * MiB;
constexpr size_t WS_SW = WS_MOD + 256 * 1024;
constexpr int SW1X = 0, SW1C = 3072, SW2X = 6144, SW2C = 6144 + 5632;
constexpr size_t WS_END = 512 * MiB;
static_assert(WS_QD + 3 * QKV_STRIDE <= WS_DN && WS_DN + 5 * DN_STRIDE <= WS_END, "ws map");
static_assert((size_t)NT * INP * 2 <= WS_QD - WS_PX && (size_t)NT * 384 * 2 <= QKV_STRIDE && (size_t)3120 * 8192 <= DN_STRIDE, "ws map 2");

constexpr int SCR_BYTES = 139264;
constexpr int MISC_OFF = SCR_BYTES;
constexpr int LDS_BYTES = 147456;

#define RLX_AGENT __ATOMIC_RELAXED, __HIP_MEMORY_SCOPE_AGENT
#define LDS_WAIT() asm volatile("s_waitcnt lgkmcnt(0)" ::: "memory")
#define VM_WAIT() asm volatile("s_waitcnt vmcnt(0)" ::: "memory")

__device__ __forceinline__ unsigned f2bf(float f) { unsigned u = __builtin_bit_cast(unsigned, f); return (u + 0x7fffu + ((u >> 16) & 1u)) >> 16; }
__device__ __forceinline__ unsigned pk2(float lo, float hi) { return f2bf(lo) | (f2bf(hi) << 16); }
__device__ __forceinline__ float bf2f(unsigned h) { return __builtin_bit_cast(float, h << 16); }
__device__ __forceinline__ unsigned pk_fp8x4(float a, float b, float c, float d) {
    a = __builtin_fminf(__builtin_fmaxf(a, -448.f), 448.f); b = __builtin_fminf(__builtin_fmaxf(b, -448.f), 448.f);
    c = __builtin_fminf(__builtin_fmaxf(c, -448.f), 448.f); d = __builtin_fminf(__builtin_fmaxf(d, -448.f), 448.f);
    int p = __builtin_amdgcn_cvt_pk_fp8_f32(a, b, 0, false); p = __builtin_amdgcn_cvt_pk_fp8_f32(c, d, p, true); return (unsigned)p;
}
__device__ __forceinline__ float silu_f(float x) { return x * __builtin_amdgcn_rcpf(1.f + __expf(-x)); }
__device__ __forceinline__ int opq(int v) { asm volatile("" : "+v"(v)); return v; }
template <int CTRL> __device__ __forceinline__ float dpp_all(float v) { return __builtin_bit_cast(float, __builtin_amdgcn_update_dpp(0, __builtin_bit_cast(int, v), CTRL, 0xF, 0xF, true)); }
template <int CTRL, int RM> __device__ __forceinline__ float dpp_rows(float v) { return __builtin_bit_cast(float, __builtin_amdgcn_update_dpp(0, __builtin_bit_cast(int, v), CTRL, RM, 0xF, false)); }
__device__ __forceinline__ float sum8(float v) { v += dpp_all<0xB1>(v); v += dpp_all<0x4E>(v); v += dpp_all<0x141>(v); return v; }
__device__ __forceinline__ float wave_sum(float v) {
    v = sum8(v); v += dpp_all<0x140>(v);
    v += dpp_rows<0x142, 0xA>(v);
    v += dpp_rows<0x143, 0xC>(v);
    return __builtin_bit_cast(float, __builtin_amdgcn_readlane(__builtin_bit_cast(int, v), 63));
}
__device__ __forceinline__ float wave_sum_l(float v, int) { return wave_sum(v); }

#define XB_TMO      128
#define XB_XCNT(j)  (256  + 64 * (j))
#define XB_XSUB(j)  (1280 + 64 * (j))
#define XB_XGEN(j)  (2304 + 64 * (j))
#define XB_TOP      3328
#define XB_TOPGEN   3392
#define XCD_BAR_WORDS 3456
#define XB_SPIN_CAP (1u << 22)
__device__ __forceinline__ unsigned xb_ld(unsigned* p)              { return __hip_atomic_load(p, __ATOMIC_RELAXED, __HIP_MEMORY_SCOPE_AGENT); }
__device__ __forceinline__ unsigned xb_add(unsigned* p, unsigned v) { return __hip_atomic_fetch_add(p, v, __ATOMIC_RELAXED, __HIP_MEMORY_SCOPE_AGENT); }
#define XB_XHINT(j)  (3456 + 64 * (j))
__device__ __forceinline__ unsigned xb_ld_l(unsigned* p)              { return __hip_atomic_load(p, __ATOMIC_RELAXED, __HIP_MEMORY_SCOPE_WORKGROUP); }
__device__ __forceinline__ unsigned xb_add_l(unsigned* p, unsigned v) { return __hip_atomic_fetch_add(p, v, __ATOMIC_RELAXED, __HIP_MEMORY_SCOPE_WORKGROUP); }
__device__ __forceinline__ unsigned xb_xcc_id() { return (unsigned)__builtin_amdgcn_s_getreg((3 << 11) | 20) & 0xFu; }
#define XB_SPIN(cond, bar) do { unsigned _sp = 0; while (cond) { __builtin_amdgcn_s_sleep(1); \
    if ((++_sp & 255u) == 0u) { if (xb_ld(&(bar)[XB_TMO])) break; if (_sp > XB_SPIN_CAP) { atomicAdd(&(bar)[XB_TMO], 1u); break; } } } } while (0)
struct XcdBarrier { unsigned* bar; unsigned x; volatile LAS unsigned* st; };
__device__ __forceinline__ XcdBarrier xcd_barrier_post(unsigned* bar, volatile LAS unsigned* st) {
    XcdBarrier b; b.bar = bar; b.x = xb_xcc_id(); b.st = st;
    if (threadIdx.x == 0) (void)xb_add(&bar[XB_XCNT(b.x)], 1u);
    return b;
}
__device__ __forceinline__ void xcd_barrier_complete(unsigned* bar, unsigned x, unsigned& nloc, unsigned& nx) {
    const unsigned G = gridDim.x * gridDim.y * gridDim.z;
    unsigned sum, cnt, mine, sp = 0u;
    for (;;) {
        sum = 0u; cnt = 0u; mine = 0u;
#pragma unroll
        for (unsigned j = 0; j < 16; ++j) { const unsigned c = xb_ld(&bar[XB_XCNT(j)]); sum += c; cnt += (c > 0u) ? 1u : 0u; mine = (j == x) ? c : mine; }
        if (sum == G) break;
        __builtin_amdgcn_s_sleep(1);
        if ((++sp & 255u) == 0u) { if (xb_ld(&bar[XB_TMO])) break; if (sp > XB_SPIN_CAP) { atomicAdd(&bar[XB_TMO], 1u); break; } }
    }
    nloc = mine > 0u ? mine : 1u; nx = cnt > 0u ? cnt : 1u;
}
__device__ __forceinline__ void xcd_barrier(const XcdBarrier& b) {
    asm volatile("s_waitcnt vmcnt(0)" ::: "memory");
    __syncthreads();
    if (threadIdx.x == 0) {
        unsigned* bar = b.bar;
        __builtin_amdgcn_s_waitcnt(0);
        unsigned nloc = b.st[0], nx = b.st[1];
        if (nloc == 0u) { xcd_barrier_complete(bar, b.x, nloc, nx); b.st[0] = nloc; b.st[1] = nx; }
        const unsigned old = xb_add(&bar[XB_XSUB(b.x)], 1u);
        const unsigned gen = old / nloc;
        if (old + 1u == (gen + 1u) * nloc) {
            __builtin_amdgcn_fence(__ATOMIC_RELEASE, "agent");
            asm volatile("s_waitcnt vmcnt(0)" ::: "memory");
            const unsigned og = xb_add(&bar[XB_TOP], 1u);
            const unsigned target = (og / nx + 1u) * nx;
            if (og + 1u != target) XB_SPIN(xb_ld(&bar[XB_TOP]) < target, bar);
            __builtin_amdgcn_fence(__ATOMIC_ACQUIRE, "agent");
            xb_add(&bar[XB_XGEN(b.x)], 1u);
            __hip_atomic_store(&bar[XB_XHINT(b.x)], gen + 1u, __ATOMIC_RELAXED, __HIP_MEMORY_SCOPE_WORKGROUP);
            asm volatile("s_waitcnt vmcnt(0)" ::: "memory");
        } else {
            if (old + 1u == gen * nloc + (3u * nloc) / 4u) __builtin_amdgcn_fence(__ATOMIC_RELEASE, "agent");
            __builtin_amdgcn_fence(__ATOMIC_ACQUIRE, "agent");
            {
                unsigned sp_ = 0;
                for (;;) {
                    if (xb_ld_l(&bar[XB_XHINT(b.x)]) > gen) break;
                    if ((++sp_ & 3u) == 0u) { if (xb_ld(&bar[XB_XGEN(b.x)]) != gen) break; if ((sp_ & 1023u) == 0u) { if (xb_ld(&bar[XB_TMO])) break; if (sp_ > XB_SPIN_CAP) { atomicAdd(&bar[XB_TMO], 1u); break; } } }
                    __builtin_amdgcn_s_sleep(1);
                }
            }
            asm volatile("s_waitcnt vmcnt(0)" ::: "memory");
        }
    }
    __syncthreads();
}

#ifdef TS_A
#define TS_STAMP() do { if (blockIdx.x == 0 && threadIdx.x == 0) { volatile LAS unsigned* M_ = (volatile LAS unsigned*)(F.lds + MISC_OFF); const unsigned k_ = M_[12]; const unsigned long long t_ = __builtin_amdgcn_s_memrealtime(); M_[16 + 2 * k_] = (unsigned)t_; M_[17 + 2 * k_] = (unsigned)(t_ >> 32); M_[12] = k_ + 1; } } while (0)
#else
#define TS_STAMP() do {} while (0)
#endif
struct Args { const float* in[22]; float* out; unsigned char* ws; };
enum { I_X = 0, I_C, I_CTX, I_CCTX, I_WMOD, I_BMOD, I_WIN, I_WOUT, I_CONVW, I_DNCONVW, I_ALOG, I_DTB, I_NORMG, I_SINK, I_FG, I_FU, I_FD, I_ROUTER, I_MG, I_MU, I_MD, I_FNG };
struct Frame {
    LAS unsigned char* lds;
    int tid, lane, wave, vcu, G, gw, NGW;
    unsigned char* ws;
};

struct P0Item { const float* src; unsigned char* dst; int N, K, n0, k0, mode, f8; };
__device__ __forceinline__ int p0_drow(int ng, int mode) { return mode == 0 ? ng : (ng >> 2) * 8 + (mode == 2 ? 4 : 0) + (ng & 3); }
constexpr float MOE_WSCALE = 64.0f, MOE_HSCALE = 8.0f;
__device__ __forceinline__ void p0_prologue(Frame& F, const Args& A) {
    if (blockIdx.x < 192) {
        LAS float* sc = (LAS float*)F.lds;
        for (int i = F.tid; i < 1024; i += NTHREADS) { sc[i] = silu_f(A.in[I_C][i]); sc[1024 + i] = silu_f(A.in[I_CCTX][i]); }
        __syncthreads();
        const int l = blockIdx.x / 96, cg = blockIdx.x % 96;
        const float* W = A.in[I_WMOD] + (size_t)l * 1024 * 6144 + cg * 64 + F.lane;
        float ax = 0.f, ac = 0.f;
        const int kb = F.wave * 128;
#pragma unroll 64
        for (int k = 0; k < 128; ++k) { const float wv = W[(size_t)(kb + k) * 6144]; ax += sc[kb + k] * wv; ac += sc[1024 + kb + k] * wv; }
        LAS float* red = sc + 2048;
        red[F.wave * 64 + F.lane] = ax; red[512 + F.wave * 64 + F.lane] = ac;
        __syncthreads();
        if (F.wave == 0) {
            float sx = 0.f, sc2 = 0.f;
#pragma unroll
            for (int w = 0; w < 8; ++w) { sx += red[w * 64 + F.lane]; sc2 += red[512 + w * 64 + F.lane]; }
            const float b = A.in[I_BMOD][l * 6144 + cg * 64 + F.lane];
            float* mod = (float*)(F.ws + WS_MOD);
            mod[(l * 2 + 0) * 6144 + cg * 64 + F.lane] = sx + b;
            mod[(l * 2 + 1) * 6144 + cg * 64 + F.lane] = sc2 + b;
        }
        __syncthreads();
    } else if (blockIdx.x == 192) {
        float* rope = (float*)(F.ws + WS_ROPE);
        for (int i = F.tid; i < 256 * 16; i += NTHREADS) {
            const int pos = i >> 4, f = i & 15;
            const float inv = powf(10000.0f, -(float)(2 * f) / 32.0f);
            const float ang = (float)pos * inv;
            rope[2 * i] = cosf(ang); rope[2 * i + 1] = sinf(ang);
        }
    }
    LAS float* tile = (LAS float*)F.lds;
    constexpr int N_WIN = 2 * 8 * 12, N_WOUT = 2 * 8 * 4, N_FG = 8 * 11, N_FD = 22 * 4, N_MG = 8 * 8 * 14, N_MD = 8 * 28 * 4;
    constexpr int NITEMS = N_WIN + N_WOUT + 2 * N_FG + N_FD + 2 * N_MG + N_MD;
    auto decode = [&](int r) -> P0Item {
        P0Item t; t.f8 = 0; t.mode = 0;
        if (r < N_WIN) { const int l = r / 96, q = r % 96; t.src = A.in[I_WIN] + (size_t)l * 1024 * INC; t.N = INC; t.K = 1024; t.dst = F.ws + WS_WIN + (size_t)l * INP * 1024 * 2; t.k0 = 128 * (q / 12); t.n0 = 256 * (q % 12); return t; } r -= N_WIN;
        if (r < N_WOUT) { const int l = r / 32, q = r % 32; t.src = A.in[I_WOUT] + (size_t)l * 1024 * 1024; t.N = 1024; t.K = 1024; t.dst = F.ws + WS_WOUT + (size_t)l * 1024 * 1024 * 2; t.k0 = 128 * (q / 4); t.n0 = 256 * (q % 4); return t; } r -= N_WOUT;
        if (r < 2 * N_FG) { const int u = r >= N_FG; if (u) r -= N_FG; t.src = A.in[u ? I_FU : I_FG]; t.N = DFF; t.K = 1024; t.dst = F.ws + WS_WGU; t.mode = 1 + u; t.k0 = 128 * (r / 11); t.n0 = 256 * (r % 11); return t; } r -= 2 * N_FG;
        if (r < N_FD) { t.src = A.in[I_FD]; t.N = 1024; t.K = DFF; t.dst = F.ws + WS_WDN; t.k0 = 128 * (r / 4); t.n0 = 256 * (r % 4); return t; } r -= N_FD;
        t.f8 = 1;
        if (r < 2 * N_MG) { const int u = r >= N_MG; if (u) r -= N_MG; const int e = r / 112, q = r % 112; t.src = A.in[u ? I_MU : I_MG] + (size_t)e * 1024 * DFE; t.N = DFE; t.K = 1024; t.dst = F.ws + WS_MGU + (size_t)e * 2 * DFE * 1024; t.mode = 1 + u; t.k0 = 128 * (q / 14); t.n0 = 256 * (q % 14); return t; } r -= 2 * N_MG;
        { const int e = r / 112, q = r % 112; t.src = A.in[I_MD] + (size_t)e * DFE * 1024; t.N = 1024; t.K = DFE; t.dst = F.ws + WS_MDN + (size_t)e * 1024 * DFE; t.k0 = 128 * (q / 4); t.n0 = 256 * (q % 4); return t; }
    };
    volatile LAS unsigned* MQ = (volatile LAS unsigned*)(F.lds + MISC_OFF) + 14;
    unsigned* qctr = (unsigned*)(F.ws + WS_CTL) + 65536;
    unsigned tk = 0;
    if (F.tid == 0) { tk = __hip_atomic_fetch_add(qctr, 1u, __ATOMIC_RELAXED, __HIP_MEMORY_SCOPE_AGENT); *MQ = tk; }
    __syncthreads();
    int it = (int)*MQ;
    const int c = F.lane & 7, nn = F.lane >> 3;
    while (it < NITEMS) {
        if (F.tid == 0) tk = __hip_atomic_fetch_add(qctr, 1u, __ATOMIC_RELAXED, __HIP_MEMORY_SCOPE_AGENT);
        const P0Item t = decode(it);
        {
            const int gcol = t.n0 + 4 * (F.lane ^ F.wave);
            const float* sp = t.src + (size_t)(t.k0 + 16 * F.wave) * t.N + (gcol < t.N ? gcol : 0);
            LAS float* dp = tile + (16 * F.wave) * 256;
#pragma unroll
            for (int i = 0; i < 16; ++i)
                __builtin_amdgcn_global_load_lds((const unsigned*)(sp + (size_t)i * t.N), (LAS unsigned*)(dp + i * 256), 16, 0, 0);
        }
        VM_WAIT();
        __syncthreads();
#pragma unroll
        for (int q4 = 0; q4 < 4; ++q4) {
            const int nl = 32 * F.wave + 8 * q4 + nn, ng = t.n0 + nl;
            const LAS float* sp = tile + (16 * c) * 256 + 4 * ((nl >> 2) ^ c) + (nl & 3);
            float v[16];
#pragma unroll
            for (int j = 0; j < 16; ++j) v[j] = sp[j * 256];
            if (t.f8) {
                u32x4 o;
                o.x = pk_fp8x4(v[0] * MOE_WSCALE, v[1] * MOE_WSCALE, v[2] * MOE_WSCALE, v[3] * MOE_WSCALE);
                o.y = pk_fp8x4(v[4] * MOE_WSCALE, v[5] * MOE_WSCALE, v[6] * MOE_WSCALE, v[7] * MOE_WSCALE);
                o.z = pk_fp8x4(v[8] * MOE_WSCALE, v[9] * MOE_WSCALE, v[10] * MOE_WSCALE, v[11] * MOE_WSCALE);
                o.w = pk_fp8x4(v[12] * MOE_WSCALE, v[13] * MOE_WSCALE, v[14] * MOE_WSCALE, v[15] * MOE_WSCALE);
                *(GAS u32x4*)(t.dst + (size_t)p0_drow(ng, t.mode) * t.K + t.k0 + 16 * c) = o;
            } else {
                u32x4 o0, o1;
                o0.x = pk2(v[0], v[1]); o0.y = pk2(v[2], v[3]); o0.z = pk2(v[4], v[5]); o0.w = pk2(v[6], v[7]);
                o1.x = pk2(v[8], v[9]); o1.y = pk2(v[10], v[11]); o1.z = pk2(v[12], v[13]); o1.w = pk2(v[14], v[15]);
                if (ng >= t.N) { o0 = u32x4{0u, 0u, 0u, 0u}; o1 = o0; }
                GAS u32x4* op = (GAS u32x4*)(t.dst + ((size_t)p0_drow(ng, t.mode) * t.K + t.k0 + 16 * c) * 2);
                op[0] = o0; op[1] = o1;
            }
        }
        LDS_WAIT();
        if (F.tid == 0) *MQ = tk;
        __syncthreads();
        it = (int)*MQ;
    }
}

__device__ __forceinline__ void norm_mod_row(const float* xrow, const f32x4 (&sh)[4], const f32x4 (&sc1)[4], bf16_t* orow, int lane) {
    const GAS f32x4* xr = (const GAS f32x4*)xrow + lane;
    f32x4 v[4]; float s = 0.f;
#pragma unroll
    for (int j = 0; j < 4; ++j) { v[j] = xr[64 * j]; s += (v[j].x * v[j].x + v[j].y * v[j].y) + (v[j].z * v[j].z + v[j].w * v[j].w); }
    const float rstd = 1.0f / sqrtf(wave_sum(s) * (1.f / D) + EPS);
    GAS u32x2* o8 = (GAS u32x2*)orow + lane;
#pragma unroll
    for (int j = 0; j < 4; ++j) {
        const f32x4 y = v[j] * rstd * sc1[j] + sh[j];
        u32x2 w; w.x = pk2(y.x, y.y); w.y = pk2(y.z, y.w); o8[64 * j] = w;
    }
}
__device__ __forceinline__ void norm_phase(Frame& F, const float* xl, const float* xc, int layer, int s_shift, int s_scale, int nrows) {
    const float* mod = (const float*)(F.ws + WS_MOD);
    const float* mx = mod + (layer * 2 + 0) * 6144; const float* mc = mod + (layer * 2 + 1) * 6144;
    bf16_t* act = (bf16_t*)(F.ws + WS_ACT);
    f32x4 shl[4], scl[4];
#pragma unroll
    for (int j = 0; j < 4; ++j) { shl[j] = ((const GAS f32x4*)(mx + s_shift * 1024))[F.lane + 64 * j]; scl[j] = ((const GAS f32x4*)(mx + s_scale * 1024))[F.lane + 64 * j] + 1.0f; }
    for (int m = F.gw; m < nrows; m += F.NGW) {
        if (m < NL) norm_mod_row(xl + (size_t)m * D, shl, scl, act + (size_t)m * D, F.lane);
        else { f32x4 shc[4], scc[4];
#pragma unroll
            for (int j = 0; j < 4; ++j) { shc[j] = ((const GAS f32x4*)(mc + s_shift * 1024))[F.lane + 64 * j]; scc[j] = ((const GAS f32x4*)(mc + s_scale * 1024))[F.lane + 64 * j] + 1.0f; }
            norm_mod_row(xc + (size_t)(m - NL) * D, shc, scc, act + (size_t)m * D, F.lane); }
    }
}

namespace pg8 {
typedef int v8i __attribute__((ext_vector_type(8)));
constexpr int BM = 256, BK = 64, HALF = 128, HTB = HALF * BK * 2, STAGE_BYTES = 8 * HTB, NXCD = 8, WGM = 8;
__host__ __device__ __forceinline__ int lds_byte(int r, int c) { const int st = (r >> 4) * 2 + (c >> 5), rr = r & 15, cc = c & 31, ob = rr * 64 + cc * 2; return st * 1024 + (ob ^ (((ob >> 9) & 1) << 5)); }
__host__ __device__ __forceinline__ void stage_rc(int b, int& R, int& C) { const int st = b / 1024, sb = b % 1024, swz = sb ^ (((sb >> 9) & 1) << 5); R = (st >> 1) * 16 + swz / 64; C = (st & 1) * 32 + (swz % 64) / 2; }
__host__ __device__ __forceinline__ int perm32(int rho) { const int n = rho >> 4, i = rho & 15; return 8 * (i >> 2) + 4 * n + (i & 3); }
struct Unit { int pm, pn; const char* a; const char* b; int par; };
typedef __bf16 bf16x2_t __attribute__((ext_vector_type(2)));
__device__ __forceinline__ unsigned cvt_pk_bf16(float lo, float hi) { f32x2 v = {lo, hi}; bf16x2_t b = __builtin_convertvector(v, bf16x2_t); return __builtin_bit_cast(unsigned, b); }

__device__ __forceinline__ bool tile_order(int i, int G, int c, int nM, int nN, int& pm, int& pn) {
    const int nwg = nM * nN; const long L = (long)i * G + c; if (L >= nwg) return false;
    int wgid = (int)L; { const int q = nwg / NXCD, r = nwg % NXCD, xcd = wgid % NXCD, off = wgid / NXCD; wgid = (xcd < r ? xcd * (q + 1) : r * (q + 1) + (xcd - r) * q) + off; }
    const int nig = WGM * nN, gid = wgid / nig, fm = gid * WGM, gsz = (nM - fm) < WGM ? (nM - fm) : WGM;
    pm = fm + ((wgid % nig) % gsz); pn = (wgid % nig) / gsz; return true;
}
struct DenseSched {
    int nM, nN, G, c; const char* A; const char* B; size_t tstep;
    __device__ __forceinline__ bool next(int i, Unit& u) const {
        int pm, pn; if (!tile_order(i, G, c, nM, nN, pm, pn)) return false;
        u.pm = pm; u.pn = pn; u.a = A + (size_t)pm * tstep; u.b = B + (size_t)pn * tstep; return true;
    }
};
struct MoeSched {
    int nM, nN, G, c; const char* A; const char* B; size_t tstep, estride; const unsigned* tile_e; int t0, pm_off;
    __device__ __forceinline__ bool next(int i, Unit& u) const {
        int pm, pn; if (!tile_order(i, G, c, nM, nN, pm, pn)) return false;
        const unsigned e = __builtin_amdgcn_readfirstlane(__hip_atomic_load(tile_e + t0 + pm, __ATOMIC_RELAXED, __HIP_MEMORY_SCOPE_AGENT)) & 7u;
        u.pm = pm + pm_off; u.pn = pn; u.a = A + (size_t)pm * tstep; u.b = B + (size_t)e * estride + (size_t)pn * tstep; return true;
    }
};

using ::pk_fp8x4;
struct EpiSwiGLU8 {
    static constexpr bool NORM = false;
    static constexpr bool PERM = true;
    unsigned char* H; int ldh; float ascale, hs;
    __device__ __forceinline__ void operator()(const f32x4 (&acc)[2][2][4][2], const Unit& u, int wr, int wc, int fr, int fq) const {
        const int row0 = u.pm * BM + wr * 64 + fr, col0 = u.pn * 128 + wc * 16 + 4 * fq;
#pragma unroll
        for (int ai = 0; ai < 2; ++ai)
#pragma unroll
            for (int m = 0; m < 4; ++m) { unsigned char* rowp = H + (size_t)(row0 + ai * HALF + m * 16) * ldh + col0;
#pragma unroll
                for (int bj = 0; bj < 2; ++bj) { const f32x4 g = acc[ai][bj][m][0] * ascale, up = acc[ai][bj][m][1] * (ascale * hs);
                    float h[4];
#pragma unroll
                    for (int e = 0; e < 4; ++e) h[e] = g[e] * __builtin_amdgcn_rcpf(1.f + __expf(-g[e])) * up[e];
                    *(unsigned*)(rowp + bj * 64) = pk_fp8x4(h[0], h[1], h[2], h[3]); }
                asm volatile("" ::: "memory"); }
    }
};
struct EpiStoreBf16 {
    static constexpr bool NORM = false;
    static constexpr bool PERM = true;
    bf16_t* O; int ldc; float scale = 1.0f;
    __device__ __forceinline__ void operator()(const f32x4 (&acc)[2][2][4][2], const Unit& u, int wr, int wc, int fr, int fq) const {
        const int row0 = u.pm * BM + wr * 64 + fr, col0 = u.pn * BM + wc * 32 + 8 * fq;
#pragma unroll
        for (int ai = 0; ai < 2; ++ai)
#pragma unroll
            for (int m = 0; m < 4; ++m) { bf16_t* rowp = O + (size_t)(row0 + ai * HALF + m * 16) * ldc + col0;
#pragma unroll
                for (int bj = 0; bj < 2; ++bj) { const f32x4 v0 = acc[ai][bj][m][0] * scale, v1 = acc[ai][bj][m][1] * scale;
                    u32x4 w; w.x = cvt_pk_bf16(v0[0], v0[1]); w.y = cvt_pk_bf16(v0[2], v0[3]); w.z = cvt_pk_bf16(v1[0], v1[1]); w.w = cvt_pk_bf16(v1[2], v1[3]);
                    *(u32x4*)(rowp + bj * HALF) = w; } }
    }
};
struct EpiSwiGLU {
    static constexpr bool NORM = false;
    static constexpr bool PERM = true;
    bf16_t* H; int ldh;
    __device__ __forceinline__ void operator()(const f32x4 (&acc)[2][2][4][2], const Unit& u, int wr, int wc, int fr, int fq) const {
        const int row0 = u.pm * BM + wr * 64 + fr, col0 = u.pn * 128 + wc * 16 + 4 * fq;
#pragma unroll
        for (int ai = 0; ai < 2; ++ai)
#pragma unroll
            for (int m = 0; m < 4; ++m) { bf16_t* rowp = H + (size_t)(row0 + ai * HALF + m * 16) * ldh + col0;
#pragma unroll
                for (int bj = 0; bj < 2; ++bj) { const f32x4 g = acc[ai][bj][m][0], up = acc[ai][bj][m][1];
                    float h[4];
#pragma unroll
                    for (int e = 0; e < 4; ++e) h[e] = g[e] * __builtin_amdgcn_rcpf(1.f + __expf(-g[e])) * up[e];
                    u32x2 w; w.x = cvt_pk_bf16(h[0], h[1]); w.y = cvt_pk_bf16(h[2], h[3]);
                    *(u32x2*)(rowp + bj * 64) = w; }
                asm volatile("" ::: "memory"); }
    }
};
struct EpiResid {
    static constexpr bool NORM = false;
    static constexpr bool PERM = false;
    const float* base_l; float* out_l; const float* gate_l; const float* base_c; float* out_c; const float* gate_c; int ctx_tile;
    __device__ __forceinline__ void operator()(const f32x4 (&acc)[2][2][4][2], const Unit& u, int wr, int wc, int fr, int fq) const {
        const bool isc = u.pm >= ctx_tile;
        const float* base = isc ? base_c : base_l; float* out = isc ? out_c : out_l; const float* gate = isc ? gate_c : gate_l;
        const int row0 = (isc ? (u.pm - ctx_tile) : u.pm) * BM + wr * 64 + fr, col0 = u.pn * BM + wc * 32 + 4 * fq;
        f32x4 gv[2][2];
#pragma unroll
        for (int bj = 0; bj < 2; ++bj)
#pragma unroll
            for (int n = 0; n < 2; ++n) gv[bj][n] = *(const f32x4*)(gate + col0 + bj * HALF + n * 16);
#pragma unroll
        for (int ai = 0; ai < 2; ++ai) {
            f32x4 bsv[4][2][2];
#pragma unroll
            for (int m = 0; m < 4; ++m)
#pragma unroll
                for (int bj = 0; bj < 2; ++bj)
#pragma unroll
                    for (int n = 0; n < 2; ++n) bsv[m][bj][n] = *(const f32x4*)(base + (size_t)(row0 + ai * HALF + m * 16) * D + col0 + bj * HALF + n * 16);
            asm volatile("" ::: "memory");
#pragma unroll
            for (int m = 0; m < 4; ++m) { const size_t off = (size_t)(row0 + ai * HALF + m * 16) * D + col0;
#pragma unroll
                for (int bj = 0; bj < 2; ++bj)
#pragma unroll
                    for (int n = 0; n < 2; ++n) *(f32x4*)(out + off + bj * HALF + n * 16) = bsv[m][bj][n] + gv[bj][n] * acc[ai][bj][m][n]; }
        }
    }
};

constexpr int RSTD_OFF = 131072;
struct RstdPart { f32x4 a, b; };
__device__ __forceinline__ RstdPart rstd_load(const float* ssq, int pm, int wid, int lane) {
    const int t = wid * 64 + lane, row = t >> 1, hf = t & 1;
    const GAS f32x4* p = (const GAS f32x4*)(ssq + ((size_t)pm * 256 + row) * 16 + hf * 8);
    RstdPart r; r.a = p[0]; r.b = p[1]; return r;
}
__device__ __forceinline__ void rstd_store(LAS unsigned char* lds, const RstdPart& r, int wid, int lane) {
    const int t = wid * 64 + lane, row = t >> 1, hf = t & 1;
    float sm = ((r.a.x + r.a.y) + (r.a.z + r.a.w)) + ((r.b.x + r.b.y) + (r.b.z + r.b.w));
    sm += dpp_all<0xB1>(sm);
    if (hf == 0) ((LAS float*)(lds + RSTD_OFF))[row] = 1.0f / sqrtf(sm * (1.f / D) + EPS);
}
template <bool B16, bool O16, bool NX>
struct EpiResidN {
    static constexpr bool PERM = true;
    static constexpr bool NORM = false;
    const float* base; float* out; const float* gate; bf16_t* ap; float* ssq; const float* sc;
    __device__ __forceinline__ void operator()(const f32x4 (&acc)[2][2][4][2], const Unit& u, int wr, int wc, int fr, int fq) const {
        const int row0 = u.pm * BM + wr * 64 + fr, col0 = u.pn * BM + wc * 32 + 8 * fq;
        f32x4 gv[2][2], sv[2][2];
#pragma unroll
        for (int bj = 0; bj < 2; ++bj)
#pragma unroll
            for (int n = 0; n < 2; ++n) { gv[bj][n] = *(const f32x4*)(gate + col0 + bj * HALF + n * 4); if (NX) sv[bj][n] = *(const f32x4*)(sc + col0 + bj * HALF + n * 4) + 1.0f; }
#pragma unroll
        for (int ai = 0; ai < 2; ++ai)
#pragma unroll
        for (int mh = 0; mh < 2; ++mh) {
            f32x4 bsv[2][2][2];
#pragma unroll
            for (int mm = 0; mm < 2; ++mm)
#pragma unroll
                for (int bj = 0; bj < 2; ++bj) { const int row = row0 + ai * HALF + (2 * mh + mm) * 16;
                    if (B16) { const u32x4 bb = *(const u32x4*)((const bf16_t*)base + (size_t)row * (2 * D) + col0 + bj * HALF);
                        bsv[mm][bj][0] = (f32x4){bf2f(bb.x & 0xffffu), bf2f(bb.x >> 16), bf2f(bb.y & 0xffffu), bf2f(bb.y >> 16)};
                        bsv[mm][bj][1] = (f32x4){bf2f(bb.z & 0xffffu), bf2f(bb.z >> 16), bf2f(bb.w & 0xffffu), bf2f(bb.w >> 16)}; }
                    else { const float* bp = base + (size_t)row * D + col0 + bj * HALF; bsv[mm][bj][0] = *(const f32x4*)bp; bsv[mm][bj][1] = *(const f32x4*)(bp + 4); } }
            asm volatile("" ::: "memory");
#pragma unroll
            for (int mm = 0; mm < 2; ++mm) { const int m = 2 * mh + mm, row = row0 + ai * HALF + m * 16;
                float ss = 0.f;
#pragma unroll
                for (int bj = 0; bj < 2; ++bj) {
                    const f32x4 v0 = bsv[mm][bj][0] + gv[bj][0] * acc[ai][bj][m][0], v1 = bsv[mm][bj][1] + gv[bj][1] * acc[ai][bj][m][1];
                    if (O16) { u32x4 o; o.x = cvt_pk_bf16(v0.x, v0.y); o.y = cvt_pk_bf16(v0.z, v0.w); o.z = cvt_pk_bf16(v1.x, v1.y); o.w = cvt_pk_bf16(v1.z, v1.w);
                        *(u32x4*)((bf16_t*)out + (size_t)row * (2 * D) + col0 + bj * HALF) = o; }
                    else { float* op = out + (size_t)row * D + col0 + bj * HALF; *(f32x4*)op = v0; *(f32x4*)(op + 4) = v1; }
                    if (NX) {
                        ss += ((v0.x * v0.x + v0.y * v0.y) + (v0.z * v0.z + v0.w * v0.w)) + ((v1.x * v1.x + v1.y * v1.y) + (v1.z * v1.z + v1.w * v1.w));
                        const f32x4 w0 = v0 * sv[bj][0], w1 = v1 * sv[bj][1];
                        u32x4 o; o.x = cvt_pk_bf16(w0.x, w0.y); o.y = cvt_pk_bf16(w0.z, w0.w); o.z = cvt_pk_bf16(w1.x, w1.y); o.w = cvt_pk_bf16(w1.z, w1.w);
                        *(u32x4*)(ap + (size_t)row * D + col0 + bj * HALF) = o; } }
                if (NX) { ss += __shfl_xor(ss, 16); ss += __shfl_xor(ss, 32);
                    if (fq == 0) ssq[(size_t)row * 16 + u.pn * 4 + wc] = ss; } }
        }
    }
};
struct EpiStoreBf16N {
    static constexpr bool PERM = true;
    static constexpr bool NORM = true;
    bf16_t* O; int ldc; const float* sw_l; const float* sw_c; int ctx_tile; const float* ssq;
    __device__ __forceinline__ void operator()(const f32x4 (&acc)[2][2][4][2], const Unit& u, int wr, int wc, int fr, int fq, LAS unsigned char* lds) const {
        const int row0 = u.pm * BM + wr * 64 + fr, col0 = u.pn * BM + wc * 32 + 8 * fq;
        const float* sw = (u.pm >= ctx_tile ? sw_c : sw_l) + col0;
        const LAS float* rs = (const LAS float*)(lds + RSTD_OFF) + wr * 64 + fr;
        f32x4 s0[2], s1[2];
#pragma unroll
        for (int bj = 0; bj < 2; ++bj) { s0[bj] = *(const f32x4*)(sw + bj * HALF); s1[bj] = *(const f32x4*)(sw + bj * HALF + 4); }
#pragma unroll
        for (int ai = 0; ai < 2; ++ai)
#pragma unroll
            for (int m = 0; m < 4; ++m) { bf16_t* rowp = O + (size_t)(row0 + ai * HALF + m * 16) * ldc + col0; const float r = rs[ai * HALF + m * 16];
#pragma unroll
                for (int bj = 0; bj < 2; ++bj) { const f32x4 v0 = acc[ai][bj][m][0] * r + s0[bj], v1 = acc[ai][bj][m][1] * r + s1[bj];
                    u32x4 w; w.x = cvt_pk_bf16(v0[0], v0[1]); w.y = cvt_pk_bf16(v0[2], v0[3]); w.z = cvt_pk_bf16(v1[0], v1[1]); w.w = cvt_pk_bf16(v1[2], v1[3]);
                    *(u32x4*)(rowp + bj * HALF) = w; } }
    }
};
struct EpiSwiGLUN {
    static constexpr bool PERM = true;
    static constexpr bool NORM = true;
    bf16_t* H; int ldh; const float* sw_l; const float* sw_c; int ctx_tile; const float* ssq;
    __device__ __forceinline__ void operator()(const f32x4 (&acc)[2][2][4][2], const Unit& u, int wr, int wc, int fr, int fq, LAS unsigned char* lds) const {
        const int row0 = u.pm * BM + wr * 64 + fr, col0 = u.pn * 128 + wc * 16 + 4 * fq;
        const float* sw = (u.pm >= ctx_tile ? sw_c : sw_l) + u.pn * BM + wc * 32 + 8 * fq;
        const LAS float* rs = (const LAS float*)(lds + RSTD_OFF) + wr * 64 + fr;
        f32x4 sg[2], su[2];
#pragma unroll
        for (int bj = 0; bj < 2; ++bj) { sg[bj] = *(const f32x4*)(sw + bj * HALF); su[bj] = *(const f32x4*)(sw + bj * HALF + 4); }
#pragma unroll
        for (int ai = 0; ai < 2; ++ai)
#pragma unroll
            for (int m = 0; m < 4; ++m) { bf16_t* rowp = H + (size_t)(row0 + ai * HALF + m * 16) * ldh + col0; const float r = rs[ai * HALF + m * 16];
#pragma unroll
                for (int bj = 0; bj < 2; ++bj) { const f32x4 g = acc[ai][bj][m][0] * r + sg[bj], up = acc[ai][bj][m][1] * r + su[bj];
                    float h[4];
#pragma unroll
                    for (int e = 0; e < 4; ++e) h[e] = g[e] * __builtin_amdgcn_rcpf(1.f + __expf(-g[e])) * up[e];
                    u32x2 w; w.x = cvt_pk_bf16(h[0], h[1]); w.y = cvt_pk_bf16(h[2], h[3]);
                    *(u32x2*)(rowp + bj * 64) = w; }
                asm volatile("" ::: "memory"); }
    }
};

struct MoeTailSched {
    int ntail, G, c; const char* A; const char* B; size_t tstep, estride; const unsigned* tile_e; int tile0; size_t ksb;
    __device__ __forceinline__ bool next(int i, Unit& u) const {
        const long L = (long)i * G + c; if (L >= (long)ntail * 28) return false;
        const int ks = (int)(L % 7), q = (int)(L / 7), pn = q & 3, tt = q >> 2;
        const unsigned e = __builtin_amdgcn_readfirstlane(__hip_atomic_load(tile_e + tile0 + tt, __ATOMIC_RELAXED, __HIP_MEMORY_SCOPE_AGENT)) & 7u;
        u.pm = q * 7 + ks; u.pn = 0; u.a = A + (size_t)tt * tstep + (size_t)ks * ksb; u.b = B + (size_t)e * estride + (size_t)pn * tstep + (size_t)ks * ksb; return true;
    }
};
struct EpiSlab {
    static constexpr bool NORM = false;
    static constexpr bool PERM = false;
    float* slab; float scale = 1.0f;
    __device__ __forceinline__ void operator()(const f32x4 (&acc)[2][2][4][2], const Unit& u, int wr, int wc, int fr, int fq) const {
        float* base = slab + (size_t)u.pm * 65536 + (size_t)(wr * 64 + fr) * 256 + wc * 32 + 4 * fq;
#pragma unroll
        for (int ai = 0; ai < 2; ++ai)
#pragma unroll
            for (int m = 0; m < 4; ++m)
#pragma unroll
                for (int bj = 0; bj < 2; ++bj)
#pragma unroll
                    for (int n = 0; n < 2; ++n) *(f32x4*)(base + (size_t)(ai * HALF + m * 16) * 256 + bj * HALF + n * 16) = acc[ai][bj][m][n] * scale;
    }
};

template <bool FP8 = false, class Epi, class Sched>
__device__ __forceinline__ void gemm_phase(LAS unsigned char* lds, const int K, const Sched& S, const Epi& E, const int ntk = 0) {
    int tid_ = threadIdx.x; asm volatile("" : "+v"(tid_));
    const int tid = tid_, wid = __builtin_amdgcn_readfirstlane(tid >> 6), lane = tid & 63, wr = wid >> 2, wc = wid & 3, fr = lane & 15, fq = lane >> 4;
    const int nt = ntk ? ntk : K / BK;
    unsigned voffA[2], voffB[2];
#pragma unroll
    for (int i = 0; i < 2; ++i) { int R, C; stage_rc(tid * 16 + i * 8192, R, C); const int Rb = Epi::PERM ? ((R & ~31) + perm32(R & 31)) : R;
        voffA[i] = (unsigned)(R * K + C) * 2u; voffB[i] = (unsigned)(Rb * K + C) * 2u; }
    const size_t kstep = (size_t)(BK * 2);
    const size_t hstep = (size_t)HALF * K * 2;
    const unsigned ldsw = (unsigned)wid * 1024u;
    const int aoff = lds_byte(wr * 64 + fr, fq * 8), boff = lds_byte(wc * 32 + fr, fq * 8);
#define PG8_SA(b, h) (((b) * 2 + (h)) * HTB)
#define PG8_SB(b, h) ((4 + (b) * 2 + (h)) * HTB)
#define PG8_STAGE(bufoff, gbase, voff) do { _Pragma("unroll") for (int _i = 0; _i < 2; ++_i) \
        __builtin_amdgcn_global_load_lds((const unsigned*)((const char*)(gbase) + (voff)[_i]), (LAS unsigned*)(lds + (bufoff) + ldsw + _i * 8192), 16, 0, 0); } while (0)
#define PG8_LDA(dst, b, h) do { _Pragma("unroll") for (int m = 0; m < 4; ++m) _Pragma("unroll") for (int k = 0; k < 2; ++k) dst[m].k[k] = *(const LAS bf16x8*)(lds + PG8_SA(b, h) + aoff + m * 2048 + k * 1024); } while (0)
#define PG8_LDB(dst, b, h) do { _Pragma("unroll") for (int n = 0; n < 2; ++n) _Pragma("unroll") for (int k = 0; k < 2; ++k) dst[n].k[k] = *(const LAS bf16x8*)(lds + PG8_SB(b, h) + boff + n * 2048 + k * 1024); } while (0)
#define PG8_MMA(ai, bj, At, Bt) do { if constexpr (FP8) __builtin_amdgcn_sched_barrier(0); __builtin_amdgcn_s_setprio(1); _Pragma("unroll") for (int m = 0; m < 4; ++m) _Pragma("unroll") for (int n = 0; n < 2; ++n) { \
        if constexpr (FP8) acc[ai][bj][m][n] = __builtin_amdgcn_mfma_scale_f32_16x16x128_f8f6f4(__builtin_bit_cast(v8i, Bt[n]), __builtin_bit_cast(v8i, At[m]), acc[ai][bj][m][n], 0, 0, 0, 127, 0, 127); \
        else { _Pragma("unroll") for (int k = 0; k < 2; ++k) acc[ai][bj][m][n] = __builtin_amdgcn_mfma_f32_16x16x32_bf16(Bt[n].k[k], At[m].k[k], acc[ai][bj][m][n], 0, 0, 0); } } \
        if constexpr (FP8) { _Pragma("unroll") for (int m = 0; m < 4; ++m) _Pragma("unroll") for (int n = 0; n < 2; ++n) asm volatile("" : "+v"(acc[ai][bj][m][n])); } \
        __builtin_amdgcn_s_setprio(0); if constexpr (FP8) __builtin_amdgcn_sched_barrier(0); } while (0)
#define PG8_WAIT_V(n) asm volatile("s_waitcnt vmcnt(" #n ")" ::: "memory")
#define PG8_WAIT_L(n) asm volatile("s_waitcnt lgkmcnt(" #n ")" ::: "memory")
#define PG8_BAR __builtin_amdgcn_s_barrier()
#define PG8_SCHED __builtin_amdgcn_sched_barrier(0)
    Unit cur, nxt; int ui = 0;
    if (!S.next(0, cur)) return;
    cur.par = 0;
    f32x4 acc[2][2][4][2];
#pragma unroll
    for (int a = 0; a < 2; ++a)
#pragma unroll
        for (int b = 0; b < 2; ++b)
#pragma unroll
            for (int m = 0; m < 4; ++m)
#pragma unroll
                for (int n = 0; n < 2; ++n) acc[a][b][m][n] = (f32x4){0.f, 0.f, 0.f, 0.f};
    struct Frag { bf16x8 k[2]; };
    Frag At[4], B0[2], B1[2];
    const char* cA = cur.a; const char* cB = cur.b;
    PG8_STAGE(PG8_SB(0, 0), cB, voffB); PG8_STAGE(PG8_SB(0, 1), cB + hstep, voffB); PG8_STAGE(PG8_SA(0, 0), cA, voffA); PG8_STAGE(PG8_SA(0, 1), cA + hstep, voffA);
    if (wr == 1) PG8_BAR;
    PG8_WAIT_V(2); PG8_BAR;
    PG8_STAGE(PG8_SB(1, 0), cB + kstep, voffB); PG8_STAGE(PG8_SA(1, 0), cA + kstep, voffA); PG8_STAGE(PG8_SB(1, 1), cB + hstep + kstep, voffB);
    PG8_WAIT_V(6); PG8_BAR;
    for (;;) {
        const bool has_next = S.next(ui + 1, nxt);
        nxt.par = (ui + 1) & 1;
        RstdPart rsp; if constexpr (Epi::NORM) rsp = rstd_load(E.ssq, cur.pm, wid, fr + 16 * fq);
        const char* nA = has_next ? nxt.a : cA; const char* nB = has_next ? nxt.b : cB;
        for (int t = 0; t < nt; t += 2) {
            const bool last = (t == nt - 2);
            const char* a1 = cA + (size_t)(t + 1) * kstep;
            const char* a2 = last ? nA : cA + (size_t)(t + 2) * kstep; const char* b2 = last ? nB : cB + (size_t)(t + 2) * kstep;
            const char* a3 = a2 + kstep; const char* b3 = b2 + kstep;
            PG8_LDB(B0, 0, 0); PG8_LDB(B1, 0, 1); PG8_SCHED; PG8_LDA(At, 0, 0); PG8_STAGE(PG8_SA(1, 1), a1 + hstep, voffA);
            PG8_WAIT_V(8); PG8_WAIT_L(0); PG8_BAR; PG8_MMA(0, 0, At, B0); PG8_MMA(0, 1, At, B1); PG8_BAR; PG8_SCHED;
            PG8_LDA(At, 0, 1); PG8_STAGE(PG8_SB(0, 0), b2, voffB); PG8_STAGE(PG8_SB(0, 1), b2 + hstep, voffB); PG8_STAGE(PG8_SA(0, 0), a2, voffA);
            PG8_WAIT_V(8); PG8_WAIT_L(0); PG8_BAR; PG8_MMA(1, 0, At, B0); PG8_MMA(1, 1, At, B1); PG8_BAR; PG8_SCHED;
            PG8_LDB(B0, 1, 0); PG8_LDB(B1, 1, 1); PG8_SCHED; PG8_LDA(At, 1, 0); PG8_STAGE(PG8_SA(0, 1), a2 + hstep, voffA);
            PG8_WAIT_V(8); PG8_WAIT_L(0); PG8_BAR; PG8_MMA(0, 0, At, B0); PG8_MMA(0, 1, At, B1); PG8_BAR; PG8_SCHED;
            PG8_LDA(At, 1, 1); PG8_STAGE(PG8_SB(1, 0), b3, voffB); PG8_STAGE(PG8_SB(1, 1), b3 + hstep, voffB); PG8_STAGE(PG8_SA(1, 0), a3, voffA);
            PG8_WAIT_V(8); PG8_WAIT_L(0); PG8_BAR; PG8_MMA(1, 0, At, B0); PG8_MMA(1, 1, At, B1); PG8_BAR; PG8_SCHED;
        }
        if (wr == 0) PG8_BAR;
        if constexpr (Epi::NORM) { rstd_store(lds, rsp, wid, fr + 16 * fq); PG8_WAIT_L(0); PG8_BAR; E(acc, cur, wr, wc, fr, fq, lds); } else E(acc, cur, wr, wc, fr, fq);
        if (!has_next) break;
#pragma unroll
        for (int a = 0; a < 2; ++a)
#pragma unroll
            for (int b = 0; b < 2; ++b)
#pragma unroll
                for (int m = 0; m < 4; ++m)
#pragma unroll
                    for (int n = 0; n < 2; ++n) acc[a][b][m][n] = (f32x4){0.f, 0.f, 0.f, 0.f};
        cur = nxt; cA = nA; cB = nB; ++ui;
        if (wr == 1) PG8_BAR;
    }
    PG8_WAIT_V(0);
    PG8_BAR;
#undef PG8_SA
#undef PG8_SB
#undef PG8_STAGE
#undef PG8_LDA
#undef PG8_LDB
#undef PG8_MMA
#undef PG8_WAIT_V
#undef PG8_WAIT_L
#undef PG8_BAR
#undef PG8_SCHED
}
}

constexpr size_t WS_GL = 7 * MiB;
__device__ __forceinline__ float ldbf(const bf16_t* p) { return bf2f(*p); }
__device__ __forceinline__ void unpk8(const u32x4 v, float (&f)[8]) {
    f[0] = bf2f(v.x & 0xffffu); f[1] = bf2f(v.x >> 16); f[2] = bf2f(v.y & 0xffffu); f[3] = bf2f(v.y >> 16);
    f[4] = bf2f(v.z & 0xffffu); f[5] = bf2f(v.z >> 16); f[6] = bf2f(v.w & 0xffffu); f[7] = bf2f(v.w >> 16);
}
__device__ __forceinline__ u32x4 pk8(const float (&f)[8]) { u32x4 o; o.x = pk2(f[0], f[1]); o.y = pk2(f[2], f[3]); o.z = pk2(f[4], f[5]); o.w = pk2(f[6], f[7]); return o; }
struct PrepRow { u32x4 cc, hh, bb, dq0, dq1, dq2, ro; float ab; };
__device__ __forceinline__ PrepRow prep_load(const bf16_t* PX, int m, int lane) {
    PrepRow R; const bf16_t* r0 = PX + (size_t)m * INP;
    const int c0 = 8 * (lane & 31);
    R.cc = *(const u32x4*)(r0 + C_CC + c0); R.hh = *(const u32x4*)(r0 + C_CH + c0); R.bb = *(const u32x4*)(r0 + C_CB + c0);
    R.dq0 = *(const u32x4*)(r0 + C_DQ + 8 * lane); R.dq1 = *(const u32x4*)(r0 + C_DQ + 8 * (64 + lane)); R.dq2 = *(const u32x4*)(r0 + C_DQ + 8 * (128 + (lane & 15)));
    const int head = lane >> 3, v8 = lane & 7;
    R.ro = *(const u32x4*)(r0 + (head < 6 ? C_AQ + head * 64 : C_AK + (head - 6) * 64) + 8 * v8);
    const int q = (lane - 32) & 31; R.ab = bf2f(r0[C_DA + (q < 24 ? q : 23)]);
    return R;
}
__device__ __forceinline__ void prep_stage(Frame& F, const Args& A, int layer) {
    LAS float* sdw = (LAS float*)F.lds; LAS float* scw = sdw + 3 * 1152;
    for (int i = F.tid; i < 3 * 1152; i += NTHREADS) sdw[i] = A.in[I_DNCONVW][layer * 3 * 1152 + i];
    for (int i = F.tid; i < 3 * 256; i += NTHREADS) scw[i] = A.in[I_CONVW][layer * 3 * 256 + i];
}
__device__ __forceinline__ void prep_phase(Frame& F, const Args& A, int layer) {
    bf16_t* PX = (bf16_t*)(F.ws + WS_PX);
    bf16_t* ACT = (bf16_t*)(F.ws + WS_ACT);
    bf16_t* QD = (bf16_t*)(F.ws + WS_QD); bf16_t* KD = (bf16_t*)(F.ws + WS_QD + QKV_STRIDE); bf16_t* VD = (bf16_t*)(F.ws + WS_QD + 2 * QKV_STRIDE);
    float* Gg = (float*)(F.ws + WS_G); float* Bt = (float*)(F.ws + WS_BETA);
    const float* rope = (const float*)(F.ws + WS_ROPE);
    LAS float* sdw = (LAS float*)F.lds;
    LAS float* scw = sdw + 3 * 1152;
    const int lane = F.lane;
    constexpr int RPW = (NT + 2047) / 2048;
    const int mlo = F.gw * RPW, mhi = (mlo + RPW) < NT ? (mlo + RPW) : NT;
    const int qgb = lane - 32;
    const float dtb = (qgb >= 0 && qgb < 12) ? A.in[I_DTB][layer * 12 + qgb] : 0.f;
    const float nalog = (qgb >= 0 && qgb < 12) ? -__expf(A.in[I_ALOG][layer * 12 + qgb]) : 0.f;
    if (mlo < mhi) {
        PrepRow prv = prep_load(PX, mlo > 0 ? mlo - 1 : 0, lane), cur = prep_load(PX, mlo, lane), nxt = prep_load(PX, (mlo + 1) < NT ? mlo + 1 : mlo, lane);
#pragma unroll 1
        for (int m = mlo; m < mhi; ++m) {
            const PrepRow nn = prep_load(PX, (m + 2) < NT ? m + 2 : m, lane);
            const bool hasp = (m != 0 && m != NL), hasn = (m != NL - 1 && m != NT - 1);
            const float fp = hasp ? 1.f : 0.f, fn = hasn ? 1.f : 0.f;
            if (lane < 32) {
                const int c0 = 8 * lane;
                float b[8], c1[8], h1[8], cp[8], hp[8], cn[8], hn[8], o[8];
                unpk8(cur.bb, b); unpk8(cur.cc, c1); unpk8(cur.hh, h1); unpk8(prv.cc, cp); unpk8(prv.hh, hp); unpk8(nxt.cc, cn); unpk8(nxt.hh, hn);
#pragma unroll
                for (int e = 0; e < 8; ++e) o[e] = b[e] * (scw[c0 + e] * (cp[e] * hp[e]) * fp + scw[256 + c0 + e] * (c1[e] * h1[e]) + scw[512 + c0 + e] * (cn[e] * hn[e]) * fn);
                *(u32x4*)(ACT + (size_t)m * D + c0) = pk8(o);
            } else if (lane < 56) {
                if (qgb < 12) { const float sp = cur.ab + dtb; const float softp = (sp > 20.f) ? sp : __logf(1.0f + __expf(sp)); Gg[(size_t)m * 12 + qgb] = nalog * softp; }
                else Bt[(size_t)m * 12 + (qgb - 12)] = __builtin_amdgcn_rcpf(1.0f + __expf(-cur.ab));
            }
            __builtin_amdgcn_sched_barrier(0);
#pragma unroll
            for (int ps = 0; ps < 3; ++ps) {
                __builtin_amdgcn_sched_barrier(0);
                const int v = ps < 2 ? 64 * ps + lane : 128 + (lane & 15);
                const int c0 = 8 * v, p = c0 / 384;
                float x0[8], x1[8], x2[8], o[8];
                unpk8(ps == 0 ? prv.dq0 : ps == 1 ? prv.dq1 : prv.dq2, x0); unpk8(ps == 0 ? cur.dq0 : ps == 1 ? cur.dq1 : cur.dq2, x1); unpk8(ps == 0 ? nxt.dq0 : ps == 1 ? nxt.dq1 : nxt.dq2, x2);
                float ss = 0.f;
#pragma unroll
                for (int e = 0; e < 8; ++e) { o[e] = silu_f(sdw[c0 + e] * x0[e] * fp + sdw[1152 + c0 + e] * x1[e] + sdw[2304 + c0 + e] * x2[e] * fn); ss += o[e] * o[e]; }
                ss = sum8(ss);
                const float sc = p == 2 ? 1.0f : __builtin_amdgcn_rsqf(ss + 1e-6f) * (p == 0 ? 0.125f : 1.0f);
#pragma unroll
                for (int e = 0; e < 8; ++e) o[e] *= sc;
                if (ps < 2 || lane < 16) { bf16_t* dst = (p == 0 ? QD : (p == 1 ? KD : VD)) + (size_t)m * 384 + (c0 - p * 384); *(u32x4*)dst = pk8(o); }
            }
            __builtin_amdgcn_sched_barrier(0);
            if (m < NL) {
                const int head = lane >> 3, v8 = lane & 7, axis = v8 >> 2, vv = v8 & 3;
                bf16_t* px = PX + (size_t)m * INP + (head < 6 ? C_AQ + head * 64 : C_AK + (head - 6) * 64) + 8 * v8;
                const u32x4 own = cur.ro;
                u32x4 oth;
                oth.x = (unsigned)__builtin_amdgcn_update_dpp(0, (int)own.x, 0x4E, 0xF, 0xF, true); oth.y = (unsigned)__builtin_amdgcn_update_dpp(0, (int)own.y, 0x4E, 0xF, 0xF, true);
                oth.z = (unsigned)__builtin_amdgcn_update_dpp(0, (int)own.z, 0x4E, 0xF, 0xF, true); oth.w = (unsigned)__builtin_amdgcn_update_dpp(0, (int)own.w, 0x4E, 0xF, 0xF, true);
                float a[8], b[8], o[8]; unpk8(own, a); unpk8(oth, b);
                const int pos = axis == 0 ? (m >> 6) : (m & 63);
                const float* rt = rope + (pos * 16 + 8 * (vv & 1)) * 2;
                const float sgn = (vv < 2) ? -1.0f : 1.0f;
#pragma unroll
                for (int e = 0; e < 8; ++e) o[e] = a[e] * rt[2 * e] + sgn * b[e] * rt[2 * e + 1];
                *(u32x4*)px = pk8(o);
            }
            prv = cur; cur = nxt; nxt = nn;
        }
    }
    __syncthreads();
}

constexpr int DN_NS = 260, DN_NU = 12 * DN_NS;
__device__ __forceinline__ int dn_row0(int d, int s) {
    if (s < 4) return NL + 64 * (d == 0 ? s : 3 - s);
    return 64 * (d == 0 ? (s - 4) : 255 - (s - 4));
}
__device__ __forceinline__ void pair_bar(volatile LAS unsigned* cnt, unsigned& epoch, int lane) {
    epoch += 2u;
    asm volatile("s_waitcnt lgkmcnt(0)" ::: "memory");
    if (lane == 0) __hip_atomic_fetch_add((LAS unsigned*)cnt, 1u, __ATOMIC_RELAXED, __HIP_MEMORY_SCOPE_WORKGROUP);
    while (*cnt < epoch) __builtin_amdgcn_s_sleep(1);
    asm volatile("" ::: "memory");
}
__device__ __forceinline__ void dn_chunk_phase(Frame& F) {
    const bf16_t* KD = (const bf16_t*)(F.ws + WS_QD + QKV_STRIDE); const bf16_t* VD = (const bf16_t*)(F.ws + WS_QD + 2 * QKV_STRIDE);
    const float* Gg = (const float*)(F.ws + WS_G); const float* Bt = (const float*)(F.ws + WS_BETA);
    bf16_t* Wm = (bf16_t*)(F.ws + WS_DN); bf16_t* KDt = (bf16_t*)(F.ws + WS_DN + DN_STRIDE); bf16_t* Ut = (bf16_t*)(F.ws + WS_DN + 2 * DN_STRIDE);
    float* GL = (float*)(F.ws + WS_GL);
    const int gi = F.wave >> 1, wl = F.wave & 1;
    LAS unsigned char* R = F.lds + gi * 18432;
    LAS float* Am = (LAS float*)R;
    LAS float* gcs = Am + 64 * 68; LAS float* bts = gcs + 64;
    volatile LAS unsigned* pcnt = (volatile LAS unsigned*)(R + 17920);
    LAS float* INV = (LAS float*)(F.lds + 4 * 18432 + F.wave * 5120);
    if (F.tid < 4) *(volatile LAS unsigned*)(F.lds + F.tid * 18432 + 17920) = 0u;
    __syncthreads();
    unsigned epoch = 0u;
    const int nfull = DN_NU / (4 * F.G), ntail = DN_NU - nfull * 4 * F.G;
#pragma unroll 1
    for (int rd = 0; rd <= nfull; ++rd) {
        const int lane = opq(F.lane), r = lane & 15, g = lane >> 4;
        const int U = rd < nfull ? rd * 4 * F.G + blockIdx.x * 4 + gi : ((int)blockIdx.x + F.G * gi < ntail ? nfull * 4 * F.G + (int)blockIdx.x + F.G * gi : DN_NU);
        if (U >= DN_NU) break;
        const bool act = true;
        const int dh = act ? U / DN_NS : 0, s = act ? U % DN_NS : 0, d = dh / 6, h = dh % 6;
        const int row0 = dn_row0(d, s);
        const size_t ub = (size_t)U * 4096;
        if (act) {
            if (wl == 0) {
                const int io = d ? 63 - lane : lane;
                float gv = Gg[(size_t)(row0 + io) * 12 + d * 6 + h];
#pragma unroll
                for (int o = 1; o < 64; o <<= 1) { const float t = __shfl_up(gv, o); if (lane >= o) gv += t; }
                gcs[lane] = gv; bts[lane] = Bt[(size_t)(row0 + io) * 12 + d * 6 + h];
                if (lane == 63) GL[U] = expf(gv);
            }
            const bf16_t* tsrc = (wl == 0 ? VD : KD) + (size_t)row0 * 384 + h * 64;
            u32x4 tv[8];
#pragma unroll
            for (int j = 0; j < 8; ++j) tv[j] = *(const u32x4*)(tsrc + (size_t)(8 * j + (lane >> 3)) * 384 + (lane & 7) * 8);
#pragma unroll
            for (int j = 0; j < 8; ++j) *(LAS u32x4*)(R + (1 - wl) * 8192 + (8 * j + (lane >> 3)) * 128 + (lane & 7) * 16) = tv[j];
        }
        pair_bar(pcnt, epoch, lane);
        float y[4][4][4];
        if (act) {
            const LAS unsigned char* tb = R + (1 - wl) * 8192 + r * 2;
#pragma unroll
            for (int b = 0; b < 4; ++b)
#pragma unroll
                for (int e = 0; e < 4; ++e) { const int ip = 16 * b + 4 * g + e, trow = d ? 63 - ip : ip;
#pragma unroll
                    for (int n = 0; n < 4; ++n) y[b][n][e] = bf2f(*(const LAS bf16_t*)(tb + trow * 128 + n * 32)); }
            f32x4 gc4[4], bt4[4];
#pragma unroll
            for (int b = 0; b < 4; ++b) { gc4[b] = *(const LAS f32x4*)(gcs + 16 * b + 4 * g); bt4[b] = *(const LAS f32x4*)(bts + 16 * b + 4 * g); }
            if (wl == 1) {
                const float gcl = gcs[63];
                f32x4 ef[4];
#pragma unroll
                for (int b = 0; b < 4; ++b)
#pragma unroll
                    for (int e = 0; e < 4; ++e) ef[b][e] = __expf(gcl - gc4[b][e]);
#pragma unroll
                for (int n = 0; n < 4; ++n)
#pragma unroll
                    for (int bb = 0; bb < 2; ++bb) { u32x4 o;
                        o.x = pk2(y[2 * bb][n][0] * ef[2 * bb][0], y[2 * bb][n][1] * ef[2 * bb][1]); o.y = pk2(y[2 * bb][n][2] * ef[2 * bb][2], y[2 * bb][n][3] * ef[2 * bb][3]);
                        o.z = pk2(y[2 * bb + 1][n][0] * ef[2 * bb + 1][0], y[2 * bb + 1][n][1] * ef[2 * bb + 1][1]); o.w = pk2(y[2 * bb + 1][n][2] * ef[2 * bb + 1][2], y[2 * bb + 1][n][3] * ef[2 * bb + 1][3]);
                        const int dk = 16 * n + r, q = 4 * bb + g;
                        *(LAS u32x4*)(R + dk * 128 + ((q ^ (dk & 7)) << 4)) = o; }
#pragma unroll
                for (int j = 0; j < 8; ++j) { const int row = 8 * j + (lane >> 3), c = lane & 7;
                    ((GAS u32x4*)(KDt + ub))[64 * j + lane] = *(const LAS u32x4*)(R + row * 128 + ((c ^ (row & 7)) << 4)); }
#pragma unroll
                for (int b = 0; b < 4; ++b)
#pragma unroll
                    for (int e = 0; e < 4; ++e) { const float f = bt4[b][e] * __expf(gc4[b][e]);
#pragma unroll
                        for (int n = 0; n < 4; ++n) y[b][n][e] *= f; }
            } else {
#pragma unroll
                for (int b = 0; b < 4; ++b)
#pragma unroll
                    for (int e = 0; e < 4; ++e)
#pragma unroll
                        for (int n = 0; n < 4; ++n) y[b][n][e] *= bt4[b][e];
            }
        }
        pair_bar(pcnt, epoch, lane);
        if (act) {
            bf16x8 kf[4][2];
#pragma unroll
            for (int jt = 0; jt < 4; ++jt)
#pragma unroll
                for (int ks = 0; ks < 2; ++ks) kf[jt][ks] = *(const bf16x8*)(KD + (size_t)(row0 + 16 * jt + r) * 384 + h * 64 + 32 * ks + 8 * g);
#pragma unroll
            for (int itl = 0; itl < 2; ++itl) {
                const int it = 2 * wl + itl;
#pragma unroll
                for (int jt = 0; jt < 4; ++jt) {
                    f32x4 c = (f32x4){0.f, 0.f, 0.f, 0.f};
                    const bf16x8 a0 = (it == 0 ? kf[0][0] : it == 1 ? kf[1][0] : it == 2 ? kf[2][0] : kf[3][0]);
                    const bf16x8 a1 = (it == 0 ? kf[0][1] : it == 1 ? kf[1][1] : it == 2 ? kf[2][1] : kf[3][1]);
                    c = __builtin_amdgcn_mfma_f32_16x16x32_bf16(a0, kf[jt][0], c, 0, 0, 0);
                    c = __builtin_amdgcn_mfma_f32_16x16x32_bf16(a1, kf[jt][1], c, 0, 0, 0);
                    const int jo = 16 * jt + r, jp = d ? 63 - jo : jo;
#pragma unroll
                    for (int e = 0; e < 4; ++e) {
                        const int io = 16 * it + 4 * g + e, ip = d ? 63 - io : io;
                        Am[ip * 68 + jp] = (jp < ip) ? bts[ip] * c[e] * __expf(gcs[ip] - gcs[jp]) : 0.f;
                    }
                }
            }
        }
        pair_bar(pcnt, epoch, lane);
        if (act) {
            {
                float z[16];
#pragma unroll
                for (int i = 0; i < 16; ++i) z[i] = 0.f;
                const LAS float* ab = Am + (16 * g) * 68 + 16 * g;
#pragma unroll
                for (int i = 0; i < 16; ++i) {
                    float s0 = (i == r) ? 1.f : 0.f, s1 = 0.f;
#pragma unroll
                    for (int j4 = 0; j4 < (i + 3) / 4; ++j4) {
                        const f32x4 a = *(const LAS f32x4*)(ab + i * 68 + 4 * j4);
                        s0 -= a.x * z[4 * j4]; s1 -= a.y * z[4 * j4 + 1]; s0 -= a.z * z[4 * j4 + 2]; s1 -= a.w * z[4 * j4 + 3];
                    }
                    z[i] = s0 + s1;
                    if ((i & 3) == 3) asm volatile("" : "+v"(z[i]) :: "memory");
                }
#pragma unroll
                for (int i = 0; i < 16; ++i) INV[g * 320 + i * 20 + r] = z[i];
            }
            asm volatile("s_waitcnt lgkmcnt(0)" ::: "memory");
#pragma unroll
            for (int b = 0; b < 4; ++b) {
                f32x4 acc[4];
#pragma unroll
                for (int n = 0; n < 4; ++n) acc[n] = (f32x4){0.f, 0.f, 0.f, 0.f};
#pragma unroll
                for (int bp = 0; bp < b; ++bp) {
                    const f32x4 af = *(const LAS f32x4*)(Am + (16 * b + r) * 68 + 16 * bp + 4 * g);
#pragma unroll
                    for (int sk = 0; sk < 4; ++sk)
#pragma unroll
                        for (int n = 0; n < 4; ++n) acc[n] = __builtin_amdgcn_mfma_f32_16x16x4f32(af[sk], y[bp][n][sk], acc[n], 0, 0, 0);
                }
                const f32x4 vf = *(const LAS f32x4*)(INV + b * 320 + r * 20 + 4 * g);
                f32x4 xn[4];
#pragma unroll
                for (int n = 0; n < 4; ++n) xn[n] = (f32x4){0.f, 0.f, 0.f, 0.f};
#pragma unroll
                for (int sk = 0; sk < 4; ++sk)
#pragma unroll
                    for (int n = 0; n < 4; ++n) xn[n] = __builtin_amdgcn_mfma_f32_16x16x4f32(vf[sk], y[b][n][sk] - acc[n][sk], xn[n], 0, 0, 0);
#pragma unroll
                for (int n = 0; n < 4; ++n)
#pragma unroll
                    for (int e = 0; e < 4; ++e) y[b][n][e] = xn[n][e];
            }
        }
        pair_bar(pcnt, epoch, lane);
        if (act) {
            if (wl == 0) {
#pragma unroll
                for (int n = 0; n < 4; ++n)
#pragma unroll
                    for (int b = 0; b < 4; ++b) { const int col = 16 * n + r, q = 2 * b + (g >> 1);
                        u32x2 o; o.x = pk2(y[b][n][0], y[b][n][1]); o.y = pk2(y[b][n][2], y[b][n][3]);
                        *(LAS u32x2*)(R + col * 128 + ((q ^ (col & 7)) << 4) + 8 * (g & 1)) = o; }
#pragma unroll
                for (int j = 0; j < 8; ++j) { const int row = 8 * j + (lane >> 3), c = lane & 7;
                    ((GAS u32x4*)(Ut + ub))[64 * j + lane] = *(const LAS u32x4*)(R + row * 128 + ((c ^ (row & 7)) << 4)); }
            } else {
#pragma unroll
                for (int n = 0; n < 4; ++n) {
                    const int dk = 16 * n + r, kk2 = dk & 31, pc = (dk & 32) + 8 * ((kk2 & 15) >> 2) + 4 * (kk2 >> 4) + (kk2 & 3);
#pragma unroll
                    for (int b = 0; b < 4; ++b)
#pragma unroll
                        for (int e = 0; e < 4; ++e) { const int i = 16 * b + 4 * g + e;
                            *(LAS bf16_t*)(R + 8192 + i * 128 + ((((pc >> 3) ^ (i & 7)) << 4) | ((pc & 7) << 1))) = (bf16_t)f2bf(-y[b][n][e]); }
                }
#pragma unroll
                for (int j = 0; j < 8; ++j) { const int row = 8 * j + (lane >> 3), c = lane & 7;
                    ((GAS u32x4*)(Wm + ub))[64 * j + lane] = *(const LAS u32x4*)(R + 8192 + row * 128 + ((c ^ (row & 7)) << 4)); }
            }
        }
        pair_bar(pcnt, epoch, lane);
    }
}

constexpr int SC_D = 7, SC_STAGE = 16384, SC_P = 4;
__device__ __forceinline__ unsigned pkbf(float lo, float hi) { return pg8::cvt_pk_bf16(lo, hi); }
__device__ __forceinline__ int sc_off(int row, int col) {
    const int c = col >> 3; return row * 128 + ((c ^ ((row >> 1) & 7)) << 4) + ((col & 4) << 1);
}
constexpr int NSEG = 8;
constexpr size_t WS_SEG = 503 * MiB;
constexpr size_t WS_SST = 507 * MiB;
static_assert(WS_DN + 5 * DN_STRIDE <= WS_SEG && WS_SEG + (size_t)12 * NSEG * 2 * 16384 <= WS_SST && WS_SST + (size_t)12 * NSEG * 16384 <= WS_END, "seg map");
__host__ __device__ constexpr int seg_begin(int s) { return s == 0 ? 0 : 36 + 32 * (s - 1); }
__host__ __device__ constexpr int seg_len(int s) { return s == 0 ? 36 : 32; }
static_assert(seg_begin(NSEG - 1) + seg_len(NSEG - 1) == DN_NS, "segments cover the chain");
template <int MODE>
__device__ __forceinline__ void dn_scan_job(Frame& F, const int dh, const int sg) {
    const int d = dh / 6, lane = F.lane, wave = F.wave, r = lane & 15, g = lane >> 4;
    const int tb = seg_begin(sg), ns = seg_len(sg);
    const unsigned char* srcW = F.ws + WS_DN + ((size_t)dh * DN_NS + tb) * 8192;
    const unsigned char* srcK = srcW + DN_STRIDE; const unsigned char* srcU = srcW + 2 * DN_STRIDE;
    bf16_t* VT = (bf16_t*)(F.ws + WS_DN + 3 * DN_STRIDE) + ((size_t)dh * DN_NS + tb) * 4096;
    bf16_t* ST = (bf16_t*)(F.ws + WS_DN + 4 * DN_STRIDE) + ((size_t)dh * DN_NS + tb) * 4096;
    LAS float* gls = (LAS float*)(F.lds + MISC_OFF + 1024);
    LAS unsigned char* ost = F.lds + SC_D * SC_STAGE + (wave & 3) * 6144;
    { const float* GL = (const float*)(F.ws + WS_GL) + dh * DN_NS + tb; for (int i = F.tid; i < ns; i += NTHREADS) gls[i] = GL[i]; }
    __syncthreads();
#define SC_WAITV(n) asm volatile("s_waitcnt vmcnt(" #n ")" ::: "memory")
#define SC_BAR() do { asm volatile("" ::: "memory"); __builtin_amdgcn_s_barrier(); asm volatile("" ::: "memory"); } while (0)
    if (wave >= 4) {
        const int lw = wave - 4;
        const int lrow = lane >> 3, lc = lane & 7;
#define SC_ISSUE(st) do { const int slot_ = ((st) % SC_D) * SC_STAGE; \
            _Pragma("unroll") for (int e = 0; e < 4; ++e) { \
                const int q = lw * 4 + e, mi = q >> 3, n = q & 7, row = 8 * n + lrow; \
                const unsigned char* mb = (mi == 0 ? srcW : srcK) + (size_t)(st) * 8192; \
                const unsigned char* gp = mb + row * 128 + ((lc ^ ((row >> 1) & 7)) << 4); \
                __builtin_amdgcn_global_load_lds((const unsigned*)gp, (LAS unsigned*)(F.lds + slot_ + mi * 8192 + n * 1024), 16, 0, 0); } } while (0)
        SC_ISSUE(0); SC_ISSUE(1); SC_ISSUE(2); SC_ISSUE(3); SC_ISSUE(4); SC_ISSUE(5);
        SC_WAITV(20); SC_BAR();
        for (int t = 0; t < ns; ++t) {
            if (t + SC_D - 1 < ns) { SC_ISSUE(t + SC_D - 1); SC_WAITV(20); }
            else { SC_WAITV(0); }
            SC_BAR();
        }
    } else {
        f32x4 S[4];
        if (MODE == 0) {
            if (sg == 0) {
#pragma unroll
                for (int t = 0; t < 4; ++t) S[t] = (f32x4){0.f, 0.f, 0.f, 0.f};
            } else {
                const float* seg0 = (const float*)(F.ws + WS_SEG) + (size_t)dh * NSEG * 2 * 4096;
                { const float* q0 = seg0 + 4096 + 16 * wave + r;
#pragma unroll
                  for (int t = 0; t < 4; ++t)
#pragma unroll
                      for (int e2 = 0; e2 < 4; ++e2) S[t][e2] = q0[(16 * t + 4 * g + e2) * 64]; }
#pragma unroll 1
                for (int s = 1; s < sg; ++s) {
                    const float* Pm = seg0 + (size_t)s * 2 * 4096; const float* Qm = Pm + 4096 + 16 * wave + r;
                    u32x4 bsf[2];
#pragma unroll
                    for (int ks = 0; ks < 2; ++ks) { bsf[ks].x = pkbf(S[2 * ks][0], S[2 * ks][1]); bsf[ks].y = pkbf(S[2 * ks][2], S[2 * ks][3]); bsf[ks].z = pkbf(S[2 * ks + 1][0], S[2 * ks + 1][1]); bsf[ks].w = pkbf(S[2 * ks + 1][2], S[2 * ks + 1][3]); }
                    f32x4 Sn[4];
#pragma unroll
                    for (int t = 0; t < 4; ++t) {
                        f32x4 c;
#pragma unroll
                        for (int e2 = 0; e2 < 4; ++e2) c[e2] = Qm[(16 * t + 4 * g + e2) * 64];
#pragma unroll
                        for (int ks = 0; ks < 2; ++ks) {
                            const f32x4 lo = *(const f32x4*)(Pm + (16 * t + r) * 64 + 32 * ks + 4 * g), hi = *(const f32x4*)(Pm + (16 * t + r) * 64 + 32 * ks + 16 + 4 * g);
                            u32x4 a; a.x = pkbf(lo[0], lo[1]); a.y = pkbf(lo[2], lo[3]); a.z = pkbf(hi[0], hi[1]); a.w = pkbf(hi[2], hi[3]);
                            c = __builtin_amdgcn_mfma_f32_16x16x32_bf16(__builtin_bit_cast(bf16x8, a), __builtin_bit_cast(bf16x8, bsf[ks]), c, 0, 0, 0);
                        }
                        Sn[t] = c;
                    }
#pragma unroll
                    for (int t = 0; t < 4; ++t) S[t] = Sn[t];
                }
            }
        } else {
#pragma unroll
            for (int t = 0; t < 4; ++t)
#pragma unroll
                for (int e2 = 0; e2 < 4; ++e2) S[t][e2] = (MODE == 2 && (16 * t + 4 * g + e2) == 16 * wave + r) ? 1.f : 0.f;
        }
        const int dvrow = 16 * wave + r;
        const GAS u32x4* usrc = (const GAS u32x4*)(srcU + wave * 2048) + lane;
        u32x4 uq[SC_P][2];
        if (MODE != 2) {
#pragma unroll
            for (int p = 0; p < SC_P; ++p) { uq[p][0] = usrc[(size_t)p * 512]; uq[p][1] = usrc[(size_t)p * 512 + 64]; }
        }
        SC_BAR();
#define OST_W(base, t_, lo_, hi_) *(LAS u32x2*)(ost + (base) + r * 128 + (((2 * (t_) + (g >> 1)) ^ (r & 7)) << 4) + ((g & 1) << 3)) = (u32x2){lo_, hi_}
        for (int t4 = 0; t4 < ns; t4 += SC_P) {
#pragma unroll
          for (int tp = 0; tp < SC_P; ++tp) {
            const int t = t4 + tp;
            const LAS unsigned char* sb = F.lds + (t % SC_D) * SC_STAGE;
            const float gl = gls[t];
            if (MODE != 2) {
#pragma unroll
                for (int j = 0; j < 2; ++j) { const int row = 8 * j + (lane >> 3), c = lane & 7; *(LAS u32x4*)(ost + 4096 + row * 128 + ((c ^ (row & 7)) << 4)) = uq[tp][j]; }
                if (t + SC_P < ns) { uq[tp][0] = usrc[(size_t)(t + SC_P) * 512]; uq[tp][1] = usrc[(size_t)(t + SC_P) * 512 + 64]; }
            }
            u32x4 bs[2];
#pragma unroll
            for (int ks = 0; ks < 2; ++ks) { bs[ks].x = pkbf(S[2 * ks][0], S[2 * ks][1]); bs[ks].y = pkbf(S[2 * ks][2], S[2 * ks][3]); bs[ks].z = pkbf(S[2 * ks + 1][0], S[2 * ks + 1][1]); bs[ks].w = pkbf(S[2 * ks + 1][2], S[2 * ks + 1][3]); }
            if (MODE == 0) { OST_W(0, 0, bs[0].x, bs[0].y); OST_W(0, 1, bs[0].z, bs[0].w); OST_W(0, 2, bs[1].x, bs[1].y); OST_W(0, 3, bs[1].z, bs[1].w); }
            f32x4 vn[4];
#pragma unroll
            for (int it = 0; it < 4; ++it) {
                f32x4 c = (f32x4){0.f, 0.f, 0.f, 0.f};
                if (MODE != 2) { const u32x2 uu = *(const LAS u32x2*)(ost + 4096 + r * 128 + (((2 * it + (g >> 1)) ^ (r & 7)) << 4) + ((g & 1) << 3));
                    c = (f32x4){bf2f(uu.x & 0xffffu), bf2f(uu.x >> 16), bf2f(uu.y & 0xffffu), bf2f(uu.y >> 16)}; }
#pragma unroll
                for (int ks = 0; ks < 2; ++ks) {
                    const u32x4 a = *(const LAS u32x4*)(sb + sc_off(16 * it + r, 32 * ks + 8 * g));
                    c = __builtin_amdgcn_mfma_f32_16x16x32_bf16(__builtin_bit_cast(bf16x8, a), __builtin_bit_cast(bf16x8, bs[ks]), c, 0, 0, 0);
                }
                vn[it] = c;
            }
            u32x4 bv[2];
#pragma unroll
            for (int ks = 0; ks < 2; ++ks) { bv[ks].x = pkbf(vn[2 * ks][0], vn[2 * ks][1]); bv[ks].y = pkbf(vn[2 * ks][2], vn[2 * ks][3]); bv[ks].z = pkbf(vn[2 * ks + 1][0], vn[2 * ks + 1][1]); bv[ks].w = pkbf(vn[2 * ks + 1][2], vn[2 * ks + 1][3]); }
            if (MODE == 0) {
                if (d == 0) {
                    OST_W(2048, 0, bv[0].x, bv[0].y); OST_W(2048, 1, bv[0].z, bv[0].w); OST_W(2048, 2, bv[1].x, bv[1].y); OST_W(2048, 3, bv[1].z, bv[1].w);
                } else {
#define SC_ROT(a) (((a) >> 16) | ((a) << 16))
#define OST_WR(t_, lo_, hi_) *(LAS u32x2*)(ost + 2048 + r * 128 + (((2 * (3 - (t_)) + ((3 - g) >> 1)) ^ (r & 7)) << 4) + (((3 - g) & 1) << 3)) = (u32x2){SC_ROT(hi_), SC_ROT(lo_)}
                    OST_WR(0, bv[0].x, bv[0].y); OST_WR(1, bv[0].z, bv[0].w); OST_WR(2, bv[1].x, bv[1].y); OST_WR(3, bv[1].z, bv[1].w);
#undef OST_WR
#undef SC_ROT
                }
                GAS u32x4* gst = (GAS u32x4*)(ST + (size_t)t * 4096 + wave * 1024); GAS u32x4* gvt = (GAS u32x4*)(VT + (size_t)t * 4096 + wave * 1024);
#pragma unroll
                for (int j = 0; j < 2; ++j) {
                    const int row = 8 * j + (lane >> 3), c = lane & 7; const int off = row * 128 + ((c ^ (row & 7)) << 4);
                    gst[64 * j + lane] = *(const LAS u32x4*)(ost + off); gvt[64 * j + lane] = *(const LAS u32x4*)(ost + 2048 + off);
                }
            }
#pragma unroll
            for (int tt = 0; tt < 4; ++tt) {
                f32x4 c = S[tt] * gl;
#pragma unroll
                for (int ks = 0; ks < 2; ++ks) {
                    const u32x4 a = *(const LAS u32x4*)(sb + 8192 + sc_off(16 * tt + r, 32 * ks + 8 * g));
                    c = __builtin_amdgcn_mfma_f32_16x16x32_bf16(__builtin_bit_cast(bf16x8, a), __builtin_bit_cast(bf16x8, bv[ks]), c, 0, 0, 0);
                }
                S[tt] = c;
            }
            asm volatile("s_waitcnt lgkmcnt(0)" ::: "memory");
            SC_BAR();
          }
        }
        if (MODE != 0) {
            float* o = (float*)(F.ws + WS_SEG) + ((size_t)(dh * NSEG + sg) * 2 + (MODE == 2 ? 0 : 1)) * 4096 + 16 * wave + r;
#pragma unroll
            for (int t = 0; t < 4; ++t)
#pragma unroll
                for (int e2 = 0; e2 < 4; ++e2) o[(16 * t + 4 * g + e2) * 64] = S[t][e2];
        }
    }
#undef SC_WAITV
#undef OST_W
#undef SC_BAR
#undef SC_ISSUE
    asm volatile("s_waitcnt vmcnt(0) lgkmcnt(0)" ::: "memory");
    __syncthreads();
}
__device__ __forceinline__ void dn_combine(Frame& F, const int dh) {
    const float* SEG = (const float*)(F.ws + WS_SEG) + (size_t)dh * NSEG * 2 * 4096;
    float* SST = (float*)(F.ws + WS_SST) + (size_t)dh * NSEG * 4096;
    LAS float* Sl = (LAS float*)F.lds; LAS float* Pl = Sl + 4096;
    for (int i = F.tid; i < 4096; i += NTHREADS) { const float v = SEG[4096 + i]; Sl[i] = v; SST[4096 + i] = v; }
    __syncthreads();
    const int col = F.tid & 63, dk0 = F.tid >> 6;
    float pre[8], qre[8];
#pragma unroll
    for (int k = 0; k < 8; ++k) { pre[k] = SEG[(size_t)1 * 2 * 4096 + F.tid + NTHREADS * k]; qre[k] = SEG[(size_t)1 * 2 * 4096 + 4096 + (dk0 + 8 * k) * 64 + col]; }
#pragma unroll 1
    for (int sg = 1; sg <= NSEG - 2; ++sg) {
        float out[8];
#pragma unroll
        for (int k = 0; k < 8; ++k) { Pl[F.tid + NTHREADS * k] = pre[k]; out[k] = qre[k]; }
        if (sg + 1 <= NSEG - 2) {
#pragma unroll
            for (int k = 0; k < 8; ++k) { pre[k] = SEG[(size_t)(sg + 1) * 2 * 4096 + F.tid + NTHREADS * k]; qre[k] = SEG[(size_t)(sg + 1) * 2 * 4096 + 4096 + (dk0 + 8 * k) * 64 + col]; }
        }
        __syncthreads();
#pragma unroll 2
        for (int k4 = 0; k4 < 16; ++k4) {
            const float s0 = Sl[(4 * k4 + 0) * 64 + col], s1 = Sl[(4 * k4 + 1) * 64 + col], s2 = Sl[(4 * k4 + 2) * 64 + col], s3 = Sl[(4 * k4 + 3) * 64 + col];
#pragma unroll
            for (int k = 0; k < 8; ++k) { const f32x4 pv = *(const LAS f32x4*)(Pl + (dk0 + 8 * k) * 64 + 4 * k4); out[k] += (pv.x * s0 + pv.y * s1) + (pv.z * s2 + pv.w * s3); }
        }
        __syncthreads();
#pragma unroll
        for (int k = 0; k < 8; ++k) { Sl[(dk0 + 8 * k) * 64 + col] = out[k]; SST[(size_t)(sg + 1) * 4096 + (dk0 + 8 * k) * 64 + col] = out[k]; }
        __syncthreads();
    }
}

__device__ __forceinline__ void attn_unit(Frame& F, const Args& A, int layer, int unit) {
    const bf16_t* PX = (const bf16_t*)(F.ws + WS_PX);
    bf16_t* ACT = (bf16_t*)(F.ws + WS_ACT);
    const int lane = F.lane, wave = F.wave, r = lane & 15, g = lane >> 4, tid = F.tid;
    const bool isctx = unit >= 256;
    const int qb = isctx ? (unit - 256) >> 1 : unit >> 1, hk = unit & 1;
    const int qrow0 = (isctx ? NL : 0) + 128 * qb + 16 * wave;
    const int qpos = 128 * qb + 16 * wave + r;
    const float SCL = 0.125f * 1.4426950408889634f;
    bf16x8 qf[3][2];
#pragma unroll
    for (int a = 0; a < 3; ++a)
#pragma unroll
        for (int ks = 0; ks < 2; ++ks) qf[a][ks] = *(const bf16x8*)(PX + (size_t)(qrow0 + r) * INP + C_AQ + (3 * hk + a) * 64 + 32 * ks + 8 * g);
    float mrun[3], lrun[3]; f32x4 o[3][4];
#pragma unroll
    for (int a = 0; a < 3; ++a) { mrun[a] = A.in[I_SINK][layer * 6 + 3 * hk + a] * 1.4426950408889634f; lrun[a] = 1.f;
#pragma unroll
        for (int dt = 0; dt < 4; ++dt) o[a][dt] = (f32x4){0.f, 0.f, 0.f, 0.f}; }
    const int jlo = (!isctx && qb == 0) ? 2 : 0, jhi = isctx ? 0 : ((qb == 127) ? 4 : 6);
    const int ntile = 4 + (jhi - jlo);
    const int skey = tid >> 3, sch = tid & 7;
    const int spk = (skey & 32) + 8 * (((skey & 31) & 15) >> 2) + 4 * ((skey & 31) >> 4) + (skey & 3);
#define ATT_KROW(s_) ((s_) < 4 ? NL + 64 * (s_) : 128 * (qb - 1) + 64 * (jlo + (s_) - 4))
#define ATT_LOAD(s_) do { const size_t ro_ = (size_t)(ATT_KROW(s_) + skey) * INP; pkv = *(const u32x4*)(PX + ro_ + C_AK + hk * 64 + sch * 8); pvv = *(const u32x4*)(PX + ro_ + C_AV + hk * 64 + sch * 8); } while (0)
#define ATT_STAGE(buf_) do { LAS unsigned char* kb_ = F.lds + (buf_) * 18432; *(LAS u32x4*)(kb_ + skey * 144 + sch * 16) = pkv; LAS bf16_t* vt = (LAS bf16_t*)(kb_ + 9216); \
        vt[(sch * 8 + 0) * 72 + spk] = (bf16_t)(pvv.x & 0xffffu); vt[(sch * 8 + 1) * 72 + spk] = (bf16_t)(pvv.x >> 16); vt[(sch * 8 + 2) * 72 + spk] = (bf16_t)(pvv.y & 0xffffu); vt[(sch * 8 + 3) * 72 + spk] = (bf16_t)(pvv.y >> 16); \
        vt[(sch * 8 + 4) * 72 + spk] = (bf16_t)(pvv.z & 0xffffu); vt[(sch * 8 + 5) * 72 + spk] = (bf16_t)(pvv.z >> 16); vt[(sch * 8 + 6) * 72 + spk] = (bf16_t)(pvv.w & 0xffffu); vt[(sch * 8 + 7) * 72 + spk] = (bf16_t)(pvv.w >> 16); } while (0)
    u32x4 pkv, pvv;
    ATT_LOAD(0); ATT_STAGE(0);
    __syncthreads();
    for (int ti = 0; ti < ntile; ++ti) {
        const int krow0 = ATT_KROW(ti);
        const int q0w = 128 * qb + 16 * wave;
        const bool local = ti >= 4 && ((krow0 + 63 - q0w > 128) || (q0w + 15 - krow0 > 128));
        if (ti + 1 < ntile) ATT_LOAD(ti + 1);
        LAS unsigned char* Kl = F.lds + (ti & 1) * 18432;
        LAS unsigned char* Vl = Kl + 9216;
        f32x4 st[3][4];
#pragma unroll
        for (int kt = 0; kt < 4; ++kt) {
            const bf16x8 k0 = *(const LAS bf16x8*)(Kl + (16 * kt + r) * 144 + (8 * g) * 2);
            const bf16x8 k1 = *(const LAS bf16x8*)(Kl + (16 * kt + r) * 144 + (32 + 8 * g) * 2);
#pragma unroll
            for (int a = 0; a < 3; ++a) {
                f32x4 c = (f32x4){0.f, 0.f, 0.f, 0.f};
                c = __builtin_amdgcn_mfma_f32_16x16x32_bf16(k0, qf[a][0], c, 0, 0, 0);
                c = __builtin_amdgcn_mfma_f32_16x16x32_bf16(k1, qf[a][1], c, 0, 0, 0);
                st[a][kt] = c;
            }
        }
        u32x4 bp[3][2];
#pragma unroll
        for (int a = 0; a < 3; ++a) {
            float tmax = -INFINITY;
#pragma unroll
            for (int kt = 0; kt < 4; ++kt)
#pragma unroll
                for (int e = 0; e < 4; ++e) {
                    float sv = st[a][kt][e] * SCL;
                    if (local) { const int kp = krow0 + 16 * kt + 4 * g + e; const int df = qpos - kp; if (df > 128 || df < -128) sv = -INFINITY; }
                    st[a][kt][e] = sv; tmax = fmaxf(tmax, sv);
                }
            tmax = fmaxf(tmax, __shfl_xor(tmax, 16)); tmax = fmaxf(tmax, __shfl_xor(tmax, 32));
            const float mnew = fmaxf(mrun[a], tmax);
            const float alpha = __builtin_amdgcn_exp2f(mrun[a] - mnew);
            float ls = 0.f;
#pragma unroll
            for (int kt = 0; kt < 4; ++kt)
#pragma unroll
                for (int e = 0; e < 4; ++e) { const float p = __builtin_amdgcn_exp2f(st[a][kt][e] - mnew); st[a][kt][e] = p; ls += p; }
            ls += __shfl_xor(ls, 16); ls += __shfl_xor(ls, 32);
            lrun[a] = lrun[a] * alpha + ls; mrun[a] = mnew;
#pragma unroll
            for (int dt = 0; dt < 4; ++dt) o[a][dt] = o[a][dt] * alpha;
#pragma unroll
            for (int k2 = 0; k2 < 2; ++k2) { bp[a][k2].x = pkbf(st[a][2 * k2][0], st[a][2 * k2][1]); bp[a][k2].y = pkbf(st[a][2 * k2][2], st[a][2 * k2][3]);
                bp[a][k2].z = pkbf(st[a][2 * k2 + 1][0], st[a][2 * k2 + 1][1]); bp[a][k2].w = pkbf(st[a][2 * k2 + 1][2], st[a][2 * k2 + 1][3]); }
        }
#pragma unroll
        for (int dt = 0; dt < 4; ++dt)
#pragma unroll
            for (int k2 = 0; k2 < 2; ++k2) {
                const u32x4 av = *(const LAS u32x4*)(Vl + (16 * dt + r) * 144 + (32 * k2 + 8 * g) * 2);
#pragma unroll
                for (int a = 0; a < 3; ++a) o[a][dt] = __builtin_amdgcn_mfma_f32_16x16x32_bf16(__builtin_bit_cast(bf16x8, av), __builtin_bit_cast(bf16x8, bp[a][k2]), o[a][dt], 0, 0, 0);
            }
        if (ti + 1 < ntile) ATT_STAGE((ti + 1) & 1);
        __syncthreads();
    }
#undef ATT_KROW
#undef ATT_LOAD
#undef ATT_STAGE
#pragma unroll
    for (int a = 0; a < 3; ++a) {
        const float inv = 1.0f / lrun[a];
#pragma unroll
        for (int dt = 0; dt < 4; ++dt) {
            u32x2 w; w.x = pkbf(o[a][dt][0] * inv, o[a][dt][1] * inv); w.y = pkbf(o[a][dt][2] * inv, o[a][dt][3] * inv);
            *(u32x2*)(ACT + (size_t)(qrow0 + r) * D + 640 + (3 * hk + a) * 64 + 16 * dt + 4 * g) = w;
        }
    }
}

constexpr int X1_JOBS = 12 * (2 * (NSEG - 1) - 1);
__device__ __forceinline__ void scan_x1_phase(Frame& F, const Args& A, int layer) {
    const int b = blockIdx.x;
    if (b < X1_JOBS) {
        const int dh = b / (2 * (NSEG - 1) - 1), k = b % (2 * (NSEG - 1) - 1);
        if (k == 0) dn_scan_job<1>(F, dh, 0);
        else { const int sg = 1 + ((k - 1) >> 1); if ((k - 1) & 1) dn_scan_job<1>(F, dh, sg); else dn_scan_job<2>(F, dh, sg); }
        return;
    }
    const int nw = F.G - X1_JOBS;
    for (int u = b - X1_JOBS; u < 100; u += nw) { attn_unit(F, A, layer, u); __syncthreads(); }
}
__device__ __forceinline__ void scan_x2_phase(Frame& F) {
    if (blockIdx.x < 12) dn_combine(F, blockIdx.x);
}
__device__ __forceinline__ void scan_x3_phase(Frame& F, const Args& A, int layer) {
    if (blockIdx.x < 12 * NSEG) { dn_scan_job<0>(F, blockIdx.x / NSEG, blockIdx.x % NSEG); return; }
    const int nunits = layer == 0 ? 260 : 256, nw = F.G - 12 * NSEG;
    for (int u = 100 + blockIdx.x - 12 * NSEG; u < nunits; u += nw) { attn_unit(F, A, layer, u); __syncthreads(); }
}

constexpr int DO_BUF = 58880;
__device__ __forceinline__ void dn_out_phase(Frame& F, const Args& A, int layer) {
    const bf16_t* PX = (const bf16_t*)(F.ws + WS_PX);
    bf16_t* ACT = (bf16_t*)(F.ws + WS_ACT);
    const bf16_t* QD = (const bf16_t*)(F.ws + WS_QD); const bf16_t* KD = (const bf16_t*)(F.ws + WS_QD + QKV_STRIDE);
    const float* Gg = (const float*)(F.ws + WS_G);
    const bf16_t* VT = (const bf16_t*)(F.ws + WS_DN + 3 * DN_STRIDE); const bf16_t* ST = (const bf16_t*)(F.ws + WS_DN + 4 * DN_STRIDE);
    const float* ng = A.in[I_NORMG] + layer * 64;
    const int tid = F.tid, lane = F.lane, wave = F.wave, r = lane & 15, g = lane >> 4;
    const int it = wave & 3, hf = wave >> 2;
    const int nunits = (layer == 0 ? 260 : 256) * 6;
    const int srow = tid >> 3, sc = tid & 7;
    const int soff = srow * 128 + ((sc ^ ((srow >> 1) & 7)) << 4);
    u32x4 pre[7]; float gpre = 0.f;
#define DO_ROW0(u_) (((u_) / 6) < 256 ? 64 * ((u_) / 6) : NL + 64 * (((u_) / 6) - 256))
#define DO_LOAD(u_) do { const int oc_ = (u_) / 6, h_ = (u_) % 6, row0_ = DO_ROW0(u_); \
        const int s0_ = oc_ < 256 ? 4 + oc_ : oc_ - 256, s1_ = oc_ < 256 ? 4 + 255 - oc_ : 3 - (oc_ - 256); \
        const size_t U0_ = (size_t)(h_ * DN_NS + s0_) * 4096, U1_ = (size_t)((6 + h_) * DN_NS + s1_) * 4096; \
        pre[0] = *(const u32x4*)(QD + (size_t)(row0_ + srow) * 384 + h_ * 64 + sc * 8); pre[1] = *(const u32x4*)(KD + (size_t)(row0_ + srow) * 384 + h_ * 64 + sc * 8); \
        pre[2] = *(const u32x4*)(ST + U0_ + srow * 64 + sc * 8); pre[3] = *(const u32x4*)(ST + U1_ + srow * 64 + sc * 8); \
        pre[4] = *(const u32x4*)(VT + U0_ + srow * 64 + sc * 8); pre[5] = *(const u32x4*)(VT + U1_ + srow * 64 + sc * 8); \
        pre[6] = *(const u32x4*)(PX + (size_t)(row0_ + srow) * INP + C_DZ + h_ * 64 + sc * 8); \
        if (wave < 2) gpre = Gg[(size_t)(row0_ + lane) * 12 + wave * 6 + h_]; } while (0)
#define DO_STAGE(b_) do { LAS unsigned char* bb_ = F.lds + (b_) * DO_BUF; \
        _Pragma("unroll") for (int q_ = 0; q_ < 7; ++q_) *(LAS u32x4*)(bb_ + q_ * 8192 + soff) = pre[q_]; \
        if (wave < 2) { float gv_ = gpre; \
            _Pragma("unroll") for (int o_ = 1; o_ < 64; o_ <<= 1) { const float t_ = wave ? __shfl_down(gv_, o_) : __shfl_up(gv_, o_); if (wave ? (lane + o_ < 64) : (lane >= o_)) gv_ += t_; } \
            ((LAS float*)(bb_ + 57344))[wave * 64 + lane] = gv_; } } while (0)
    int u = blockIdx.x, cur = 0;
    if (u < nunits) { DO_LOAD(u); DO_STAGE(0); }
    __syncthreads();
    f32x4 ngv[2];
#pragma unroll
    for (int dtl = 0; dtl < 2; ++dtl) ngv[dtl] = *(const f32x4*)(ng + 16 * (2 * hf + dtl) + 4 * g);
#pragma unroll 1
    for (; u < nunits; u += F.G) {
        const int un = u + F.G;
        if (un < nunits) DO_LOAD(un);
        const int h = u % 6, row0 = DO_ROW0(u);
        LAS unsigned char* bb = F.lds + cur * DO_BUF;
        const LAS float* gc0 = (const LAS float*)(bb + 57344); const LAS float* gc1 = gc0 + 64;
        LAS float* ssx = (LAS float*)(bb + 57344 + 512);
        const int i = 16 * it + r;
        const float e0 = gc0[i], e1 = gc1[i];
        bf16x8 qf[2];
#pragma unroll
        for (int ks = 0; ks < 2; ++ks) qf[ks] = *(const LAS bf16x8*)(bb + sc_off(16 * it + r, 32 * ks + 8 * g));
        f32x4 pt[4];
#pragma unroll
        for (int jt = 0; jt < 4; ++jt) {
            f32x4 c = (f32x4){0.f, 0.f, 0.f, 0.f};
#pragma unroll
            for (int ks = 0; ks < 2; ++ks) c = __builtin_amdgcn_mfma_f32_16x16x32_bf16(*(const LAS bf16x8*)(bb + 8192 + sc_off(16 * jt + r, 32 * ks + 8 * g)), qf[ks], c, 0, 0, 0);
            pt[jt] = c;
        }
        f32x4 o[2];
#pragma unroll
        for (int dtl = 0; dtl < 2; ++dtl) o[dtl] = (f32x4){0.f, 0.f, 0.f, 0.f};
#pragma unroll
        for (int dir = 0; dir < 2; ++dir) {
            const LAS float* gcd = dir == 0 ? gc0 : gc1; const float ei = dir == 0 ? e0 : e1;
            const float xi = __expf(ei);
            u32x4 bp[2]; float pv[4][4];
#pragma unroll
            for (int jt = 0; jt < 4; ++jt)
#pragma unroll
                for (int e = 0; e < 4; ++e) {
                    const int j = 16 * jt + 4 * g + e;
                    const bool ok = dir == 0 ? (j <= i) : (j >= i);
                    pv[jt][e] = ok ? pt[jt][e] * __expf(ei - gcd[j]) : 0.f;
                }
#pragma unroll
            for (int k2 = 0; k2 < 2; ++k2) { bp[k2].x = pkbf(pv[2 * k2][0], pv[2 * k2][1]); bp[k2].y = pkbf(pv[2 * k2][2], pv[2 * k2][3]); bp[k2].z = pkbf(pv[2 * k2 + 1][0], pv[2 * k2 + 1][1]); bp[k2].w = pkbf(pv[2 * k2 + 1][2], pv[2 * k2 + 1][3]); }
            const LAS unsigned char* stt = bb + (2 + dir) * 8192; const LAS unsigned char* vtt = bb + (4 + dir) * 8192;
#pragma unroll
            for (int dtl = 0; dtl < 2; ++dtl) {
                const int dt = 2 * hf + dtl;
                f32x4 c = (f32x4){0.f, 0.f, 0.f, 0.f};
#pragma unroll
                for (int ks = 0; ks < 2; ++ks) c = __builtin_amdgcn_mfma_f32_16x16x32_bf16(*(const LAS bf16x8*)(stt + sc_off(16 * dt + r, 32 * ks + 8 * g)), qf[ks], c, 0, 0, 0);
                f32x4 acc = o[dtl] + c * xi;
#pragma unroll
                for (int k2 = 0; k2 < 2; ++k2) {
                    const u32x2 lo = *(const LAS u32x2*)(vtt + sc_off(16 * dt + r, 32 * k2 + 4 * g)), hi = *(const LAS u32x2*)(vtt + sc_off(16 * dt + r, 32 * k2 + 16 + 4 * g));
                    const u32x4 av = (u32x4){lo.x, lo.y, hi.x, hi.y};
                    acc = __builtin_amdgcn_mfma_f32_16x16x32_bf16(__builtin_bit_cast(bf16x8, av), __builtin_bit_cast(bf16x8, bp[k2]), acc, 0, 0, 0);
                }
                o[dtl] = acc;
            }
        }
        float ss = 0.f;
#pragma unroll
        for (int dtl = 0; dtl < 2; ++dtl) ss += (o[dtl][0] * o[dtl][0] + o[dtl][1] * o[dtl][1]) + (o[dtl][2] * o[dtl][2] + o[dtl][3] * o[dtl][3]);
        ss += __shfl_xor(ss, 16); ss += __shfl_xor(ss, 32);
        if (g == 0) ssx[wave * 16 + r] = ss;
        __syncthreads();
        const float rstd = 1.0f / sqrtf((ssx[wave * 16 + r] + ssx[(wave ^ 4) * 16 + r]) * (1.f / 64.f) + EPS);
#pragma unroll
        for (int dtl = 0; dtl < 2; ++dtl) {
            const int dt = 2 * hf + dtl;
            const u32x2 zz = *(const LAS u32x2*)(bb + 6 * 8192 + sc_off(i, 16 * dt + 4 * g));
            const float z0 = bf2f(zz.x & 0xffffu), z1 = bf2f(zz.x >> 16), z2 = bf2f(zz.y & 0xffffu), z3 = bf2f(zz.y >> 16);
            u32x2 w; w.x = pkbf(o[dtl][0] * rstd * ngv[dtl][0] * silu_f(z0), o[dtl][1] * rstd * ngv[dtl][1] * silu_f(z1));
            w.y = pkbf(o[dtl][2] * rstd * ngv[dtl][2] * silu_f(z2), o[dtl][3] * rstd * ngv[dtl][3] * silu_f(z3));
            *(LAS u32x2*)(bb + 8192 + sc_off(i, 16 * dt + 4 * g)) = w;
        }
        __syncthreads();
        *(u32x4*)(ACT + (size_t)(row0 + srow) * D + 256 + h * 64 + sc * 8) = *(const LAS u32x4*)(bb + 8192 + soff);
        if (un < nunits) DO_STAGE(cur ^ 1);
        __syncthreads();
        cur ^= 1;
    }
#undef DO_ROW0
#undef DO_LOAD
#undef DO_STAGE
}

constexpr size_t RT_EID = WS_ROUTE, RT_GATE = WS_ROUTE + 128 * 1024, RT_TSLOT = WS_ROUTE + 256 * 1024, RT_BCNT = WS_ROUTE + 384 * 1024, RT_TILEE = WS_ROUTE + 400 * 1024, RT_NT = WS_ROUTE + 404 * 1024;
constexpr size_t WS_XS = WS_BIG;
constexpr size_t WS_Y = 278 * MiB;
constexpr size_t WS_HM = 350 * MiB;
constexpr int MOE_CH = 136;
constexpr size_t WS_SLAB = 97 * MiB;
static_assert(WS_HM + (size_t)MOE_CH * 256 * DFE <= WS_END && WS_MGU + (size_t)8 * 2 * DFE * 1024 <= WS_SLAB && WS_SLAB + (size_t)8 * 28 * 65536 * 4 <= WS_MDN, "slab map");
static_assert(WS_XS + (size_t)36864 * 1024 <= WS_Y && WS_Y + (size_t)36864 * 2048 <= WS_HM, "moe map");

__device__ __forceinline__ void norm2_router_phase(Frame& F, const Args& A) {
    const float* mod = (const float*)(F.ws + WS_MOD) + (1 * 2 + 0) * 6144;
    const float* shift = mod + 3 * 1024; const float* scale = mod + 4 * 1024;
    unsigned char* act8 = F.ws + WS_ACT;
    int* EID = (int*)(F.ws + RT_EID); float* GATE = (float*)(F.ws + RT_GATE); int* BCNT = (int*)(F.ws + RT_BCNT);
    LAS int* se = (LAS int*)F.lds;
    const int lane = F.lane;
    f32x4 rw[16][2];
#pragma unroll
    for (int j = 0; j < 4; ++j)
#pragma unroll
        for (int q = 0; q < 4; ++q) { const GAS f32x4* rp = (const GAS f32x4*)(A.in[I_ROUTER] + (size_t)(4 * (lane + 64 * j) + q) * 8); rw[4 * j + q][0] = rp[0]; rw[4 * j + q][1] = rp[1]; }
    f32x4 shl[4], scl[4];
#pragma unroll
    for (int j = 0; j < 4; ++j) { shl[j] = ((const GAS f32x4*)shift)[lane + 64 * j]; scl[j] = ((const GAS f32x4*)scale)[lane + 64 * j] + 1.0f; }
    u32x2 xn[4];
    { const GAS u32x2* xr0 = (const GAS u32x2*)(A.out + (size_t)(blockIdx.x * 64 + F.wave * 8) * D) + lane;
#pragma unroll
      for (int j = 0; j < 4; ++j) xn[j] = xr0[64 * j]; }
    for (int k = 0; k < 8; ++k) {
        const int tl = F.wave * 8 + k, t = blockIdx.x * 64 + tl;
        u32x2 xc4[4];
#pragma unroll
        for (int j = 0; j < 4; ++j) xc4[j] = xn[j];
        if (k < 7) { const GAS u32x2* xr = (const GAS u32x2*)(A.out + (size_t)(t + 1) * D) + lane;
#pragma unroll
            for (int j = 0; j < 4; ++j) xn[j] = xr[64 * j]; }
        f32x4 v[4]; float s = 0.f;
#pragma unroll
        for (int j = 0; j < 4; ++j) { const u32x2 xb = xc4[j]; v[j] = (f32x4){bf2f(xb.x & 0xffffu), bf2f(xb.x >> 16), bf2f(xb.y & 0xffffu), bf2f(xb.y >> 16)};
            s += (v[j].x * v[j].x + v[j].y * v[j].y) + (v[j].z * v[j].z + v[j].w * v[j].w); }
        const float rstd = 1.0f / sqrtf(wave_sum(s) * (1.f / D) + EPS);
        float lg[8];
#pragma unroll
        for (int e = 0; e < 8; ++e) lg[e] = 0.f;
        GAS unsigned* o8 = (GAS unsigned*)(act8 + (size_t)t * D) + lane;
#pragma unroll
        for (int j = 0; j < 4; ++j) {
            const f32x4 y = v[j] * rstd * scl[j] + shl[j];
            o8[64 * j] = pk_fp8x4(y.x, y.y, y.z, y.w);
#pragma unroll
            for (int q = 0; q < 4; ++q) {
                const f32x4 r0 = rw[4 * j + q][0], r1 = rw[4 * j + q][1];
                const float yy = y[q];
                lg[0] += yy * r0.x; lg[1] += yy * r0.y; lg[2] += yy * r0.z; lg[3] += yy * r0.w; lg[4] += yy * r1.x; lg[5] += yy * r1.y; lg[6] += yy * r1.z; lg[7] += yy * r1.w;
            }
        }
#pragma unroll
        for (int e = 0; e < 8; ++e) lg[e] = wave_sum(lg[e]);
        int e0 = 0; float l0 = lg[0];
#pragma unroll
        for (int e = 1; e < 8; ++e) if (lg[e] > l0) { l0 = lg[e]; e0 = e; }
        int e1 = -1; float l1 = -INFINITY;
#pragma unroll
        for (int e = 0; e < 8; ++e) if (e != e0 && lg[e] > l1) { l1 = lg[e]; e1 = e; }
        if (lane == 0) {
            const float g0 = 1.0f / (1.0f + expf(l1 - l0));
            EID[t * 2] = e0; EID[t * 2 + 1] = e1; GATE[t * 2] = g0; GATE[t * 2 + 1] = 1.0f - g0;
            se[tl * 2] = e0; se[tl * 2 + 1] = e1;
        }
    }
    __syncthreads();
    if (F.wave == 0) {
        const int a0 = se[lane * 2], a1 = se[lane * 2 + 1];
#pragma unroll
        for (int e = 0; e < 8; ++e) { const unsigned long long mk = __ballot(a0 == e || a1 == e); if (lane == e) BCNT[blockIdx.x * 8 + e] = __popcll(mk); }
    }
    __syncthreads();
}

__device__ __forceinline__ void moe_assign_phase(Frame& F) {
    const int* EID = (const int*)(F.ws + RT_EID); int* TSLOT = (int*)(F.ws + RT_TSLOT); const int* BCNT = (const int*)(F.ws + RT_BCNT);
    unsigned* TILEE = (unsigned*)(F.ws + RT_TILEE); unsigned* NTL = (unsigned*)(F.ws + RT_NT);
    const unsigned char* act8 = F.ws + WS_ACT; unsigned char* XS = F.ws + WS_XS;
    LAS int* sm = (LAS int*)F.lds;
    const int b = blockIdx.x, lane = F.lane;
    {
        LAS int* part = sm + 160;
        const int bb = F.tid >> 1, hf = F.tid & 1;
        const u32x4 cv = *(const GAS u32x4*)(BCNT + bb * 8 + hf * 4);
        int tot4[4] = {(int)cv.x, (int)cv.y, (int)cv.z, (int)cv.w}, mine4[4];
#pragma unroll
        for (int q = 0; q < 4; ++q) mine4[q] = bb < b ? tot4[q] : 0;
#pragma unroll
        for (int o = 2; o < 64; o <<= 1)
#pragma unroll
            for (int q = 0; q < 4; ++q) { tot4[q] += __shfl_xor(tot4[q], o); mine4[q] += __shfl_xor(mine4[q], o); }
        if (lane < 2) {
#pragma unroll
            for (int q = 0; q < 4; ++q) { part[F.wave * 16 + lane * 4 + q] = tot4[q]; part[F.wave * 16 + 8 + lane * 4 + q] = mine4[q]; } }
        __syncthreads();
        if (F.tid < 16) { int a = 0;
#pragma unroll
            for (int w = 0; w < 8; ++w) a += part[w * 16 + F.tid];
            sm[F.tid] = a; }
    }
    __syncthreads();
    if (F.tid == 0) {
        int ps = 0, nt = 0;
        for (int e = 0; e < 8; ++e) { const int tl = (sm[e] + 255) >> 8; sm[16 + e] = ps; sm[24 + e] = tl; if (b == 0) for (int q = 0; q < tl; ++q) TILEE[nt + q] = (unsigned)e; ps += tl * 256; nt += tl; }
        if (b == 0) *NTL = (unsigned)nt;
    }
    __syncthreads();
    if (F.wave == 0) {
        const int t = b * 64 + lane;
        const int a0 = EID[t * 2], a1 = EID[t * 2 + 1];
        int s0 = 0, s1 = 0;
        const unsigned long long lower = (1ull << lane) - 1ull;
#pragma unroll
        for (int e = 0; e < 8; ++e) {
            const unsigned long long mk = __ballot(a0 == e || a1 == e);
            const int rank = __popcll(mk & lower), slot = sm[16 + e] + sm[8 + e] + rank;
            if (a0 == e) s0 = slot; if (a1 == e) s1 = slot;
        }
        TSLOT[t * 2] = s0; TSLOT[t * 2 + 1] = s1; sm[32 + lane * 2] = s0; sm[33 + lane * 2] = s1;
    }
    __syncthreads();
    for (int q = F.wave; q < 128; q += NWAVES) {
        const int t = b * 64 + (q >> 1), slot = sm[32 + q];
        const GAS u32x4* srcp = (const GAS u32x4*)(act8 + (size_t)t * D); GAS u32x4* dstp = (GAS u32x4*)(XS + (size_t)slot * D);
        dstp[lane] = srcp[lane];
    }
    { const int e = b & 7, cnt = sm[e], first = sm[16 + e] + cnt, npad = sm[24 + e] * 256 - cnt;
      for (int p = (b >> 3) * NWAVES + F.wave; p < npad; p += 32 * NWAVES) { GAS u32x4* dstp = (GAS u32x4*)(XS + (size_t)(first + p) * D); const u32x4 z = (u32x4){0u, 0u, 0u, 0u}; dstp[lane] = z; } }
}

__device__ __forceinline__ f32x4 moe_yrow(const bf16_t* Y, const float* SLAB, int slot, int tail0, int j, int lane) {
    const int tile = slot >> 8;
    if (tile < tail0) { const u32x2 a = ((const GAS u32x2*)(Y + (size_t)slot * D))[lane + 64 * j];
        return (f32x4){bf2f(a.x & 0xffffu), bf2f(a.x >> 16), bf2f(a.y & 0xffffu), bf2f(a.y >> 16)}; }
    const float* p = SLAB + (size_t)(((tile - tail0) * 4 + j) * 7) * 65536 + (size_t)(slot & 255) * 256 + 4 * lane;
    f32x4 s = *(const f32x4*)p;
#pragma unroll
    for (int ks = 1; ks < 7; ++ks) s = s + *(const f32x4*)(p + (size_t)ks * 65536);
    return s;
}
__device__ __forceinline__ void moe_final_phase(Frame& F, const Args& A) {
    const float* mod5 = (const float*)(F.ws + WS_MOD) + (1 * 2 + 0) * 6144 + 5 * 1024;
    const int* TSLOT = (const int*)(F.ws + RT_TSLOT); const float* GATE = (const float*)(F.ws + RT_GATE);
    const bf16_t* Y = (const bf16_t*)(F.ws + WS_Y); const float* SLAB = (const float*)(F.ws + WS_SLAB);
    const float* fng = A.in[I_FNG];
    const int lane = F.lane;
    const int ntl = (int)__builtin_amdgcn_readfirstlane(__hip_atomic_load((unsigned*)(F.ws + RT_NT), RLX_AGENT));
    const int tail0 = (ntl > 128 && ntl - 128 <= 8) ? 128 : (1 << 20);
    f32x4 m5v[4], fgv[4];
#pragma unroll
    for (int j = 0; j < 4; ++j) { m5v[j] = ((const GAS f32x4*)mod5)[lane + 64 * j]; fgv[j] = ((const GAS f32x4*)fng)[lane + 64 * j]; }
    for (int t = F.gw; t < NL; t += F.NGW) {
        const int s0 = TSLOT[t * 2], s1 = TSLOT[t * 2 + 1]; const float g0 = GATE[t * 2], g1 = GATE[t * 2 + 1];
        GAS f32x4* xr = (GAS f32x4*)(A.out + (size_t)t * D) + lane;
        const GAS u32x2* xb = (const GAS u32x2*)(A.out + (size_t)t * D) + lane;
        f32x4 v[4]; float s = 0.f;
        if (((s0 >> 8) < tail0) && ((s1 >> 8) < tail0)) {
            const GAS u32x2* y0 = (const GAS u32x2*)(Y + (size_t)s0 * D) + lane; const GAS u32x2* y1 = (const GAS u32x2*)(Y + (size_t)s1 * D) + lane;
#pragma unroll
            for (int j = 0; j < 4; ++j) {
                const u32x2 xq = xb[64 * j]; const f32x4 x = (f32x4){bf2f(xq.x & 0xffffu), bf2f(xq.x >> 16), bf2f(xq.y & 0xffffu), bf2f(xq.y >> 16)}; const u32x2 a = y0[64 * j], c = y1[64 * j];
                const f32x4 m5 = m5v[j];
                f32x4 f;
                f.x = g0 * bf2f(a.x & 0xffffu) + g1 * bf2f(c.x & 0xffffu); f.y = g0 * bf2f(a.x >> 16) + g1 * bf2f(c.x >> 16);
                f.z = g0 * bf2f(a.y & 0xffffu) + g1 * bf2f(c.y & 0xffffu); f.w = g0 * bf2f(a.y >> 16) + g1 * bf2f(c.y >> 16);
                v[j] = x + m5 * f;
                s += (v[j].x * v[j].x + v[j].y * v[j].y) + (v[j].z * v[j].z + v[j].w * v[j].w);
            }
        } else {
#pragma unroll
            for (int j = 0; j < 4; ++j) {
                const u32x2 xq = xb[64 * j]; const f32x4 x = (f32x4){bf2f(xq.x & 0xffffu), bf2f(xq.x >> 16), bf2f(xq.y & 0xffffu), bf2f(xq.y >> 16)};
                const f32x4 m5 = m5v[j];
                const f32x4 f = moe_yrow(Y, SLAB, s0, tail0, j, lane) * g0 + moe_yrow(Y, SLAB, s1, tail0, j, lane) * g1;
                v[j] = x + m5 * f;
                s += (v[j].x * v[j].x + v[j].y * v[j].y) + (v[j].z * v[j].z + v[j].w * v[j].w);
            }
        }
        const float rstd = 1.0f / sqrtf(wave_sum_l(s, lane) * (1.f / D) + EPS);
#pragma unroll
        for (int j = 0; j < 4; ++j) xr[64 * j] = v[j] * rstd * fgv[j];
    }
}

#define GRID_BAR() do { { unsigned* bp_ = (unsigned*)(F.ws + WS_CTL) + 4096; asm volatile("" : "+s"(bp_)); bar.bar = bp_; } xcd_barrier(bar); TS_STAMP(); F.tid = opq((int)threadIdx.x); F.lane = F.tid & 63; } while (0)

struct NormX { bf16_t* ap; float* ssq; const float* vec; };
template <int MODE>
__device__ __forceinline__ void ctx_pieces(Frame& F, const bf16_t* A, const bf16_t* Bt, int K, int ncg, void* O, int ldo, const float* base, const float* gate,
                                           int nrg = 16, const unsigned* tile_e = nullptr, int tile0 = 0, size_t estride = 0, NormX nx = NormX{nullptr, nullptr, nullptr}) {
    const int lane = F.lane, r = lane & 15, g = lane >> 4, wave = F.wave;
    LAS float* red = (LAS float*)F.lds;
    const int npieces = nrg * ncg, kw = K >> 3;
    for (int p = blockIdx.x; p < npieces; p += F.G) {
        const int rg = p % nrg, cg = p / nrg;
        f32x4 acc[4];
#pragma unroll
        for (int n = 0; n < 4; ++n) acc[n] = (f32x4){0.f, 0.f, 0.f, 0.f};
        const bf16_t* ap = A + (size_t)(16 * rg + r) * K + wave * kw + 8 * g;
        size_t eoff = 0;
        if (tile_e) eoff = (size_t)(__builtin_amdgcn_readfirstlane(__hip_atomic_load(tile_e + tile0 + (rg >> 4), __ATOMIC_RELAXED, __HIP_MEMORY_SCOPE_AGENT)) & 7u) * estride;
        const bf16_t* bp = Bt + eoff + (size_t)(64 * cg + r) * K + wave * kw + 8 * g;
        bf16x8 a0 = *(const bf16x8*)ap, b0[4];
#pragma unroll
        for (int n = 0; n < 4; ++n) b0[n] = *(const bf16x8*)(bp + (size_t)(16 * n) * K);
        for (int k = 32; k < kw; k += 32) {
            const bf16x8 a1 = *(const bf16x8*)(ap + k); bf16x8 b1[4];
#pragma unroll
            for (int n = 0; n < 4; ++n) b1[n] = *(const bf16x8*)(bp + (size_t)(16 * n) * K + k);
#pragma unroll
            for (int n = 0; n < 4; ++n) acc[n] = __builtin_amdgcn_mfma_f32_16x16x32_bf16(a0, b0[n], acc[n], 0, 0, 0);
            a0 = a1;
#pragma unroll
            for (int n = 0; n < 4; ++n) b0[n] = b1[n];
        }
#pragma unroll
        for (int n = 0; n < 4; ++n) acc[n] = __builtin_amdgcn_mfma_f32_16x16x32_bf16(a0, b0[n], acc[n], 0, 0, 0);
#pragma unroll
        for (int n = 0; n < 4; ++n)
#pragma unroll
            for (int e = 0; e < 4; ++e) red[wave * 1024 + (4 * g + e) * 64 + 16 * n + r] = acc[n][e];
        __syncthreads();
        for (int idx = F.tid; idx < 1024; idx += NTHREADS) {
            float s = 0.f;
#pragma unroll
            for (int w = 0; w < 8; ++w) s += red[w * 1024 + idx];
            const int row = 16 * rg + (idx >> 6), col = 64 * cg + (idx & 63);
            if (MODE == 0) ((bf16_t*)O)[(size_t)row * ldo + col] = (bf16_t)f2bf(s);
            else if (MODE == 3) {
                const float pr = F.lane < 16 ? nx.ssq[(size_t)(NL + row) * 16 + F.lane] : 0.f;
                const float rstd = 1.0f / sqrtf(wave_sum(pr) * (1.f / D) + EPS);
                ((bf16_t*)O)[(size_t)row * ldo + col] = (bf16_t)f2bf(s * rstd + nx.vec[col]);
            } else {
                const float v = base[(size_t)row * 1024 + col] + gate[col] * s;
                ((float*)O)[(size_t)row * 1024 + col] = v;
                if (MODE == 2) {
                    nx.ap[(size_t)(NL + row) * 1024 + col] = (bf16_t)f2bf(v * (1.0f + nx.vec[col]));
                    const float ss = wave_sum(v * v);
                    if (F.lane == 0) nx.ssq[(size_t)(NL + row) * 16 + cg] = ss;
                }
            }
        }
        __syncthreads();
    }
}

__device__ __forceinline__ void shiftw_phase(Frame& F) {
    const float* MOD = (const float*)(F.ws + WS_MOD); float* SW = (float*)(F.ws + WS_SW);
    for (int idx = F.gw; idx < 3072 + 5632; idx += F.NGW) {
        const bool gu = idx >= 3072; const int rr = gu ? idx - 3072 : idx;
        const bf16_t* wrow = gu ? (const bf16_t*)(F.ws + WS_WGU) + (size_t)rr * 1024 : (const bf16_t*)(F.ws + WS_WIN) + (size_t)(INP + rr) * 1024;
        const float* shx = gu ? MOD + (0 * 2 + 0) * 6144 + 3 * 1024 : MOD + (1 * 2 + 0) * 6144;
        const float* shc = gu ? MOD + (0 * 2 + 1) * 6144 + 3 * 1024 : MOD + (1 * 2 + 1) * 6144;
        const u32x4 w0 = *(const u32x4*)(wrow + 16 * F.lane), w1 = *(const u32x4*)(wrow + 16 * F.lane + 8);
        float wf[16]; { float a[8], b[8]; unpk8(w0, a); unpk8(w1, b);
#pragma unroll
            for (int j = 0; j < 8; ++j) { wf[j] = a[j]; wf[8 + j] = b[j]; } }
        float ax = 0.f, ac = 0.f;
#pragma unroll
        for (int j = 0; j < 4; ++j) { const f32x4 sx = *(const f32x4*)(shx + 16 * F.lane + 4 * j), sc = *(const f32x4*)(shc + 16 * F.lane + 4 * j);
            ax += sx.x * wf[4 * j] + sx.y * wf[4 * j + 1] + sx.z * wf[4 * j + 2] + sx.w * wf[4 * j + 3];
            ac += sc.x * wf[4 * j] + sc.y * wf[4 * j + 1] + sc.z * wf[4 * j + 2] + sc.w * wf[4 * j + 3]; }
        ax = wave_sum(ax); ac = wave_sum(ac);
        if (F.lane == 0) { SW[(gu ? SW2X : SW1X) + rr] = ax; SW[(gu ? SW2C : SW1C) + rr] = ac; }
    }
}

#ifndef STOP_AFTER
#define STOP_AFTER 0
#endif
__device__ __forceinline__ void dump_bf16(Frame& F, float* out, const bf16_t* buf, int ld, int ncols) {
    for (int m = F.gw; m < NL; m += F.NGW)
        for (int j = 0; j < 16; ++j) { const int c = F.lane + 64 * j; float s = 0.f; for (int k = 0; c + 1024 * k < ncols; ++k) s += bf2f(buf[(size_t)m * ld + c + 1024 * k]); out[(size_t)m * D + c] = s; }
}
#define STOP_DUMP(n, buf, ld, nc) do { if (layer == 0 && STOP_AFTER == (n)) { dump_bf16(F, args.out, (const bf16_t*)(buf), (ld), (nc)); F.ws = nullptr; return; } } while (0)
template <int layer>
__device__ __forceinline__ void layer_body(Frame& F, const Args& args, XcdBarrier& bar) {
    unsigned char* ws = F.ws;
    float* HC = (float*)(ws + WS_HC);
    const float* MOD = (const float*)(ws + WS_MOD);
        F.tid = opq((int)threadIdx.x); F.lane = F.tid & 63;
        const float* xl = layer == 0 ? args.in[I_X] : args.out;
        const float* xc = layer == 0 ? args.in[I_CTX] : HC;
        const float* modx = MOD + (layer * 2 + 0) * 6144; const float* modc = MOD + (layer * 2 + 1) * 6144;
        bf16_t* AP = (bf16_t*)(ws + WS_AP); float* SSQ = (float*)(ws + WS_SSQ); const float* SW = (const float*)(ws + WS_SW);
        if (layer == 0) {
            norm_phase(F, xl, xc, layer, 0, 1, NT);
            shiftw_phase(F);
            GRID_BAR();
            ctx_pieces<0>(F, (const bf16_t*)(ws + WS_ACT) + (size_t)NL * 1024, (const bf16_t*)(ws + WS_WIN) + (size_t)layer * INP * 1024, 1024, INP / 64, (bf16_t*)(ws + WS_PX) + (size_t)NL * INP, INP, nullptr, nullptr);
            { pg8::DenseSched S{NL / 256, INP / 256, F.G, (int)blockIdx.x, (const char*)(ws + WS_ACT), (const char*)(ws + WS_WIN) + (size_t)layer * INP * 1024 * 2, (size_t)256 * 1024 * 2};
              pg8::EpiStoreBf16 E{(bf16_t*)(ws + WS_PX), INP};
              pg8::gemm_phase(F.lds, 1024, S, E); }
        } else {
            ctx_pieces<3>(F, AP + (size_t)NL * 1024, (const bf16_t*)(ws + WS_WIN) + (size_t)layer * INP * 1024, 1024, INP / 64, (bf16_t*)(ws + WS_PX) + (size_t)NL * INP, INP, nullptr, nullptr, 16, nullptr, 0, 0, NormX{nullptr, SSQ, SW + SW1C});
            { pg8::DenseSched S{NL / 256, INP / 256, F.G, (int)blockIdx.x, (const char*)AP, (const char*)(ws + WS_WIN) + (size_t)layer * INP * 1024 * 2, (size_t)256 * 1024 * 2};
              pg8::EpiStoreBf16N E{(bf16_t*)(ws + WS_PX), INP, SW + SW1X, SW + SW1C, NL / 256, SSQ};
              pg8::gemm_phase(F.lds, 1024, S, E); }
        }
        prep_stage(F, args, layer);
        GRID_BAR();
        STOP_DUMP(2, ws + WS_PX, INP, INC);
        prep_phase(F, args, layer);
        GRID_BAR();
        STOP_DUMP(3, ws + WS_QD, 384, 384);
        STOP_DUMP(33, ws + WS_QD + QKV_STRIDE, 384, 384);
        dn_chunk_phase(F);
        GRID_BAR();
        STOP_DUMP(4, ws + WS_DN, 1024, 1024);
        STOP_DUMP(44, ws + WS_DN + DN_STRIDE, 1024, 1024);
        STOP_DUMP(45, ws + WS_DN + 2 * DN_STRIDE, 1024, 1024);
        scan_x1_phase(F, args, layer);
        GRID_BAR();
        scan_x3_phase(F, args, layer);
        GRID_BAR();
        STOP_DUMP(5, ws + WS_DN + 3 * DN_STRIDE, 1024, 1024);
        STOP_DUMP(55, ws + WS_DN + 4 * DN_STRIDE, 1024, 1024);
        STOP_DUMP(56, ws + WS_ACT, 1024, 1024);
        dn_out_phase(F, args, layer);
        GRID_BAR();
        STOP_DUMP(6, ws + WS_ACT, 1024, 1024);
        if (layer == 0) {
            ctx_pieces<2>(F, (const bf16_t*)(ws + WS_ACT) + (size_t)NL * 1024, (const bf16_t*)(ws + WS_WOUT), 1024, 16, HC, 1024, xc, modc + 2 * 1024, 16, nullptr, 0, 0, NormX{AP, SSQ, modc + 4 * 1024});
            pg8::DenseSched S{NL / 256, 4, F.G, (int)blockIdx.x, (const char*)(ws + WS_ACT), (const char*)(ws + WS_WOUT) + (size_t)layer * 1024 * 1024 * 2, (size_t)256 * 1024 * 2};
            pg8::EpiResidN<false, true, true> E{xl, args.out, modx + 2 * 1024, AP, SSQ, modx + 4 * 1024};
            pg8::gemm_phase(F.lds, 1024, S, E);
        } else {
            pg8::DenseSched S{NL / 256, 4, F.G, (int)blockIdx.x, (const char*)(ws + WS_ACT), (const char*)(ws + WS_WOUT) + (size_t)layer * 1024 * 1024 * 2, (size_t)256 * 1024 * 2};
            pg8::EpiResidN<true, true, false> E{args.out, args.out, modx + 2 * 1024, nullptr, nullptr, nullptr};
            pg8::gemm_phase(F.lds, 1024, S, E);
        }
        GRID_BAR();
        if (layer == 0 && STOP_AFTER == 7) { F.ws = nullptr; return; }
        if (layer == 0) {
            { pg8::DenseSched S{NT / 256, 2 * DFF / 256, F.G, (int)blockIdx.x, (const char*)AP, (const char*)(ws + WS_WGU), (size_t)256 * 1024 * 2};
              pg8::EpiSwiGLUN E{(bf16_t*)(ws + WS_BIG), DFF, SW + SW2X, SW + SW2C, NL / 256, SSQ};
              pg8::gemm_phase(F.lds, 1024, S, E); }
            GRID_BAR();
            ctx_pieces<2>(F, (const bf16_t*)(ws + WS_BIG) + (size_t)NL * DFF, (const bf16_t*)(ws + WS_WDN), DFF, 16, HC, 1024, HC, modc + 5 * 1024, 16, nullptr, 0, 0, NormX{AP, SSQ, MOD + (1 * 2 + 1) * 6144 + 1 * 1024});
            { pg8::DenseSched S{NL / 256, 4, F.G, (int)blockIdx.x, (const char*)(ws + WS_BIG), (const char*)(ws + WS_WDN), (size_t)256 * DFF * 2};
              pg8::EpiResidN<true, true, true> E{args.out, args.out, modx + 5 * 1024, AP, SSQ, MOD + (1 * 2 + 0) * 6144 + 1 * 1024};
              pg8::gemm_phase(F.lds, DFF, S, E); }
            GRID_BAR();
            if (STOP_AFTER == 9) { F.ws = nullptr; return; }
        } else {
            norm2_router_phase(F, args);
            GRID_BAR();
            moe_assign_phase(F);
            GRID_BAR();
            const int ntl = (int)__builtin_amdgcn_readfirstlane(__hip_atomic_load((unsigned*)(ws + RT_NT), RLX_AGENT));
#pragma unroll 1
            for (int t0 = 0; t0 < ntl; t0 += 64) {
                const int left = ntl - t0; const int nM = left > MOE_CH ? 64 : left;
                const int ntail = (nM > 64 && (nM & 63) != 0 && (nM & 63) <= 8) ? (nM & 63) : 0, nG2 = nM - ntail;
                { pg8::MoeSched S{nM, 2 * DFE / 256, F.G, (int)blockIdx.x, (const char*)(ws + WS_XS) + (size_t)t0 * 256 * 1024, (const char*)(ws + WS_MGU), (size_t)256 * 1024, (size_t)2 * DFE * 1024, (const unsigned*)(ws + RT_TILEE), t0, 0};
                  pg8::EpiSwiGLU8 E{ws + WS_HM, DFE, 1.0f / MOE_WSCALE, MOE_HSCALE};
                  pg8::gemm_phase<true>(F.lds, 512, S, E); }
                GRID_BAR();
                { pg8::MoeSched S{nG2, 4, F.G, (int)blockIdx.x, (const char*)(ws + WS_HM), (const char*)(ws + WS_MDN), (size_t)256 * DFE, (size_t)1024 * DFE, (const unsigned*)(ws + RT_TILEE), t0, t0};
                  pg8::EpiStoreBf16 E{(bf16_t*)(ws + WS_Y), 1024, 1.0f / (MOE_WSCALE * MOE_HSCALE)};
                  pg8::gemm_phase<true>(F.lds, DFE / 2, S, E); }
                if (ntail > 0) {
                    pg8::MoeTailSched S{ntail, F.G, (int)((blockIdx.x + 128) % F.G), (const char*)(ws + WS_HM) + (size_t)nG2 * 256 * DFE, (const char*)(ws + WS_MDN), (size_t)256 * DFE, (size_t)1024 * DFE, (const unsigned*)(ws + RT_TILEE), t0 + nG2, (size_t)512};
                    pg8::EpiSlab E{(float*)(ws + WS_SLAB), 1.0f / (MOE_WSCALE * MOE_HSCALE)};
                    pg8::gemm_phase<true>(F.lds, DFE / 2, S, E, 4);
                }
                GRID_BAR();
                if (left <= MOE_CH) break;
            }
            moe_final_phase(F, args);
        }
    }

__global__ void __launch_bounds__(NTHREADS, 2) fwd_kernel(Args args) {
    extern __shared__ __attribute__((aligned(16))) unsigned char lds[];
    Frame F;
    F.lds = (LAS unsigned char*)lds;
    F.tid = threadIdx.x; F.lane = F.tid & 63; F.wave = __builtin_amdgcn_readfirstlane(F.tid >> 6);
    F.G = gridDim.x; { const int bx = blockIdx.x; F.vcu = (F.G % 8 == 0) ? (bx % 8) * (F.G / 8) + bx / 8 : bx; }
    F.gw = F.vcu * NWAVES + F.wave; F.NGW = F.G * NWAVES;
    F.ws = args.ws;
    volatile LAS unsigned* MISC = (volatile LAS unsigned*)(F.lds + MISC_OFF);
    for (int u = F.tid; u < (LDS_BYTES - MISC_OFF) / 4; u += NTHREADS) ((LAS unsigned*)(F.lds + MISC_OFF))[u] = 0u;
    __syncthreads();
    XcdBarrier bar = xcd_barrier_post((unsigned*)(F.ws + WS_CTL) + 4096, MISC + 8);
    TS_STAMP();

    unsigned char* ws = F.ws;
    float* HC = (float*)(ws + WS_HC);
    const float* MOD = (const float*)(ws + WS_MOD);
#ifdef DIAG_ZERO
    { GAS u32x4* p = (GAS u32x4*)(F.ws + WS_MOD); const size_t n16 = (WS_END - WS_MOD) / 16; const u32x4 z = (u32x4){0u, 0u, 0u, 0u};
      for (size_t i = (size_t)blockIdx.x * NTHREADS + F.tid; i < n16; i += (size_t)F.G * NTHREADS) p[i] = z; }
    GRID_BAR();
#endif
    p0_prologue(F, args);
    GRID_BAR();
    layer_body<0>(F, args, bar);
    if (F.ws == nullptr) return;
    layer_body<1>(F, args, bar);
#ifdef TS_A
    TS_STAMP();
    if (blockIdx.x == 0 && threadIdx.x == 0) {
        volatile LAS unsigned* M_ = (volatile LAS unsigned*)(F.lds + MISC_OFF);
        const unsigned long long ta = ((unsigned long long)M_[17 + 2 * (TS_A)] << 32) | M_[16 + 2 * (TS_A)], tb = ((unsigned long long)M_[17 + 2 * (TS_B)] << 32) | M_[16 + 2 * (TS_B)];
        const unsigned long long dl = (tb - ta) * (TS_MUL), t0 = __builtin_amdgcn_s_memrealtime();
        while (__builtin_amdgcn_s_memrealtime() - t0 < dl) __builtin_amdgcn_s_sleep(8);
    }
#endif
}

extern "C" void kernel_launch(void* const* d_in, const int* in_sizes, int n_in, void* d_out, int out_size, void* d_ws, size_t ws_size, hipStream_t stream) {
    static int grid = 0;
    if (grid == 0) {
        if (n_in != 22 || out_size != NL * D || ws_size < WS_END) { fprintf(stderr, "kernel_launch: unexpected shapes (n_in %d out %d ws %zu)\n", n_in, out_size, ws_size); grid = -1; return; }
        int dev = 0, cus = 0;
        if (hipGetDevice(&dev) != hipSuccess || hipDeviceGetAttribute(&cus, hipDeviceAttributeMultiprocessorCount, dev) != hipSuccess) { grid = -1; return; }
        if (hipFuncSetAttribute((const void*)fwd_kernel, hipFuncAttributeMaxDynamicSharedMemorySize, LDS_BYTES) != hipSuccess) { fprintf(stderr, "kernel_launch: hipFuncSetAttribute failed\n"); grid = -1; return; }
        int per_cu = 0;
        (void)hipOccupancyMaxActiveBlocksPerMultiprocessor(&per_cu, (const void*)fwd_kernel, NTHREADS, LDS_BYTES);
        (void)hipGetLastError();
        grid = cus;
    }
    if (grid < 0) return;
    (void)hipMemsetAsync((char*)d_ws + WS_CTL, 0, CTL_ZERO_BYTES, stream);
    Args a{};
    for (int i = 0; i < 22; ++i) a.in[i] = (const float*)d_in[i];
    a.out = (float*)d_out; a.ws = (unsigned char*)d_ws;
    hipLaunchKernelGGL(fwd_kernel, dim3(grid), dim3(NTHREADS), LDS_BYTES, stream, a);
}
```
